# Optimizing an MI355X kernel written in HIP

```python
import math
import jax, jax.numpy as jnp
from jax import lax
import numpy as np

D_MODEL = 1024
BATCH = 8
SEQ = 8192
DEPTH = 2
DEC_BATCH = 32
DEC_SEQ = 16
PAST_LEN = 2048

CHUNK = 64
Q_BLOCK = 128
DA_HEADS = 8
DA_HEAD_DIM = 64
DA_K_ROW = 2 * DA_HEAD_DIM
DA_V_DIM = 2 * DA_HEAD_DIM
ROPE_DIM = DA_HEAD_DIM // 4
ROPE_THETA = 500000.0
GLA_HEADS = 4
GLA_DK = D_MODEL // 2 // GLA_HEADS
GLA_DV = D_MODEL // GLA_HEADS
GLA_RANK = 16
GLA_GATE_NORM = 16.0
D_FF = 2816
CONV_W = 3
EPS = 1e-6
DA_QK = DA_HEADS * 2 * DA_HEAD_DIM
DA_V = DA_HEADS * DA_V_DIM
GLA_QK = GLA_HEADS * GLA_DK
GLA_V = GLA_HEADS * GLA_DV
D_IN = 2 * DA_QK + DA_V + 2 * GLA_QK + 2 * GLA_V + GLA_RANK + 2 * D_MODEL

kernel_name = "diffattn_gla_gated_merge_streaming_step"


def _rmsnorm(x, w):
    xf = x.astype(jnp.float32)
    y = xf * lax.rsqrt(jnp.mean(xf * xf, axis=-1, keepdims=True) + EPS)
    return (y * w.astype(jnp.float32)).astype(x.dtype)


def _rope(x, pos):
    half = ROPE_DIM // 2
    inv = ROPE_THETA ** (-jnp.arange(half, dtype=jnp.float32) * 2.0 / ROPE_DIM)
    ang = pos.astype(jnp.float32)[:, None] * inv[None, :]
    cos = jnp.cos(ang)[None, :, None, None, :].astype(x.dtype)
    sin = jnp.sin(ang)[None, :, None, None, :].astype(x.dtype)
    x1 = x[..., :half]
    x2 = x[..., half:ROPE_DIM]
    return jnp.concatenate([x1 * cos - x2 * sin, x2 * cos + x1 * sin, x[..., ROPE_DIM:]], axis=-1)


def _diff_weights(s, lam):
    p = jax.nn.softmax(s, axis=-1)
    return p[:, :, 0] - lam * p[:, :, 1]


def _diff_attn_prompt(q, k, v, lam):
    B, S = q.shape[0], q.shape[1]
    nb = S // Q_BLOCK
    qb = jnp.moveaxis(q.reshape(B, nb, Q_BLOCK, DA_HEADS, 2, DA_HEAD_DIM), 1, 0)
    kpos = jnp.arange(S)
    vf = v.astype(jnp.float32)
    scale = DA_HEAD_DIM ** -0.5

    def block(args):
        qi, bi = args
        s = jnp.einsum('bqhcd,bkhcd->bhcqk', qi, k).astype(jnp.float32) * scale
        qpos = bi * Q_BLOCK + jnp.arange(Q_BLOCK)
        limit = (qpos // CHUNK + 1) * CHUNK
        mask = kpos[None, :] < limit[:, None]
        s = jnp.where(mask, s, -jnp.inf)
        w = _diff_weights(s, lam)
        return jnp.einsum('bhqk,bkhd->bqhd', w, vf)

    o = lax.map(block, (qb, jnp.arange(nb)))
    return jnp.moveaxis(o, 0, 1).reshape(B, S, DA_HEADS, DA_V_DIM)


def _diff_attn_sample(q, k_all, v_all, lam):
    s = jnp.einsum('bqhcd,bkhcd->bhcqk', q, k_all).astype(jnp.float32) * (DA_HEAD_DIM ** -0.5)
    w = _diff_weights(s, lam)
    return jnp.einsum('bhqk,bkhd->bqhd', w, v_all.astype(jnp.float32))


def _gla_chunk(S, inp):
    q, k, v, g = inp
    C = q.shape[2]
    b = jnp.cumsum(g, axis=2)
    o_inter = jnp.einsum('bhtk,bhkv->bhtv', q * jnp.exp(b), S)
    causal = jnp.tril(jnp.ones((C, C), dtype=bool))
    rel = b[:, :, :, None, :] - b[:, :, None, :, :]
    decay = jnp.exp(jnp.where(causal[:, :, None], rel, -jnp.inf))
    A = jnp.sum(q[:, :, :, None, :] * k[:, :, None, :, :] * decay, axis=-1)
    o = o_inter + jnp.einsum('bhts,bhsv->bhtv', A, v)
    b_last = b[:, :, -1:, :]
    S_new = (jnp.exp(b_last[:, :, 0, :])[..., None] * S
             + jnp.einsum('bhsk,bhsv->bhkv', k * jnp.exp(b_last - b), v))
    return S_new, o


def _gla(q, k, v, g, S0):
    B, H, L = q.shape[0], q.shape[1], q.shape[2]
    C = CHUNK if L % CHUNK == 0 else L
    n = L // C

    def split(t):
        return jnp.moveaxis(t.reshape(B, H, n, C, t.shape[-1]), 2, 0)

    S, o = lax.scan(_gla_chunk, S0, (split(q), split(k), split(v), split(g)))
    o = jnp.moveaxis(o, 0, 2).reshape(B, H, L, GLA_DV)
    return o, S


def _layer(x, pos, kv_past, S0, conv_past, li, w_in, w_gk2, b_gk2, lq1, lk1, lq2, lk2,
           da_norm_w, gla_norm_w, w_o, pre_mix_w, post_mix_w, pre_ffn_w, post_ffn_w,
           w_up, conv_w, conv_b, w_down):
    B, L = x.shape[0], x.shape[1]
    f32 = jnp.float32
    xn = _rmsnorm(x, pre_mix_w)
    proj = xn @ w_in
    sizes = (DA_QK, DA_QK, DA_V, GLA_QK, GLA_QK, GLA_V, GLA_V, GLA_RANK, D_MODEL)
    cuts = []
    acc = 0
    for sz in sizes:
        acc += sz
        cuts.append(acc)
    qa, ka, va, qg, kg, vg, rg, lr, ga, gb = jnp.split(proj, cuts, axis=-1)

    qa = _rope(qa.reshape(B, L, DA_HEADS, 2, DA_HEAD_DIM), pos)
    ka = _rope(ka.reshape(B, L, DA_HEADS, 2, DA_HEAD_DIM), pos)
    va = va.reshape(B, L, DA_HEADS, DA_V_DIM)
    lam_init = 0.8 - 0.6 * math.exp(-0.3 * li)
    lam = (jnp.exp(jnp.sum(lq1.astype(f32) * lk1.astype(f32)))
           - jnp.exp(jnp.sum(lq2.astype(f32) * lk2.astype(f32))) + lam_init)
    if kv_past is None:
        oa = _diff_attn_prompt(qa, ka, va, lam)
    else:
        k_past, v_past = kv_past
        P = k_past.shape[1]
        k_all = jnp.concatenate(
            [k_past.reshape(B, P, DA_HEADS, 2, DA_HEAD_DIM).astype(ka.dtype), ka], axis=1)
        v_all = jnp.concatenate([v_past.astype(va.dtype), va], axis=1)
        oa = _diff_attn_sample(qa, k_all, v_all, lam)
    oa = (_rmsnorm(oa, da_norm_w) * (1.0 - lam_init)).reshape(B, L, D_MODEL).astype(x.dtype)
    new_k = ka.reshape(B, L, DA_HEADS, DA_K_ROW)
    new_v = va

    def heads(t, d):
        return t.reshape(B, L, GLA_HEADS, d).transpose(0, 2, 1, 3).astype(f32)

    gk = jax.nn.log_sigmoid((lr @ w_gk2 + b_gk2).astype(f32)) / GLA_GATE_NORM
    og, S_new = _gla(heads(qg, GLA_DK) * (GLA_DK ** -0.5), heads(kg, GLA_DK),
                     heads(vg, GLA_DV), heads(gk, GLA_DK), S0.astype(f32))
    og = og.transpose(0, 2, 1, 3)
    og = _rmsnorm(og, gla_norm_w) * jax.nn.silu(rg.astype(f32)).reshape(B, L, GLA_HEADS, GLA_DV)
    ob = og.reshape(B, L, D_MODEL).astype(x.dtype)

    merged = jax.nn.sigmoid(ga) * oa + jax.nn.sigmoid(gb) * ob
    h = x + _rmsnorm(merged @ w_o, post_mix_w)

    hn = _rmsnorm(h, pre_ffn_w)
    u, g = jnp.split(hn @ w_up, [D_FF], axis=-1)
    gpad = jnp.concatenate([conv_past.astype(g.dtype), g], axis=1)
    gc = conv_b + sum(conv_w[j] * gpad[:, j:j + L] for j in range(CONV_W))
    ffn = (jax.nn.gelu(gc, approximate=True) * u) @ w_down
    out = h + _rmsnorm(ffn, post_ffn_w)
    return out, new_k, new_v, S_new, gpad[:, -(CONV_W - 1):]


def setup_inputs(seed: int = 0) -> dict:
    key = jax.random.key(seed)
    ks = jax.random.split(key, 32)
    nrm = jax.random.normal
    f32 = jnp.float32
    return {
        "x_prompt": nrm(ks[0], (BATCH, SEQ, D_MODEL), f32),
        "x_sample": nrm(ks[1], (DEC_BATCH, DEC_SEQ, D_MODEL), f32),
        "cache_k": nrm(ks[2], (DEPTH, DEC_BATCH, PAST_LEN, DA_HEADS, DA_K_ROW), f32),
        "cache_v": nrm(ks[3], (DEPTH, DEC_BATCH, PAST_LEN, DA_HEADS, DA_V_DIM), f32),
        "state_gla": nrm(ks[4], (DEPTH, DEC_BATCH, GLA_HEADS, GLA_DK, GLA_DV), f32),
        "state_conv": nrm(ks[5], (DEPTH, DEC_BATCH, CONV_W - 1, D_FF), f32),
        "w_in": nrm(ks[6], (DEPTH, D_MODEL, D_IN), f32) * D_MODEL ** -0.5,
        "w_gk2": nrm(ks[7], (DEPTH, GLA_RANK, GLA_QK), f32) * GLA_RANK ** -0.5,
        "b_gk2": nrm(ks[8], (DEPTH, GLA_QK), f32) * 0.1,
        "lambda_q1": nrm(ks[9], (DEPTH, DA_HEAD_DIM), f32) * 0.1,
        "lambda_k1": nrm(ks[10], (DEPTH, DA_HEAD_DIM), f32) * 0.1,
        "lambda_q2": nrm(ks[11], (DEPTH, DA_HEAD_DIM), f32) * 0.1,
        "lambda_k2": nrm(ks[12], (DEPTH, DA_HEAD_DIM), f32) * 0.1,
        "da_norm_w": 1.0 + 0.05 * nrm(ks[13], (DEPTH, DA_V_DIM), f32),
        "gla_norm_w": 1.0 + 0.05 * nrm(ks[14], (DEPTH, GLA_DV), f32),
        "w_o": nrm(ks[15], (DEPTH, D_MODEL, D_MODEL), f32) * D_MODEL ** -0.5,
        "pre_mix_w": 1.0 + 0.05 * nrm(ks[16], (DEPTH, D_MODEL), f32),
        "post_mix_w": 1.0 + 0.05 * nrm(ks[17], (DEPTH, D_MODEL), f32),
        "pre_ffn_w": 1.0 + 0.05 * nrm(ks[18], (DEPTH, D_MODEL), f32),
        "post_ffn_w": 1.0 + 0.05 * nrm(ks[19], (DEPTH, D_MODEL), f32),
        "w_up": nrm(ks[20], (DEPTH, D_MODEL, 2 * D_FF), f32) * D_MODEL ** -0.5,
        "conv_w": nrm(ks[21], (DEPTH, CONV_W, D_FF), f32) * CONV_W ** -0.5,
        "conv_b": nrm(ks[22], (DEPTH, D_FF), f32) * 0.02,
        "w_down": nrm(ks[23], (DEPTH, D_FF, D_MODEL), f32) * D_FF ** -0.5,
    }


def reference(x_prompt, x_sample, cache_k, cache_v, state_gla, state_conv,
              w_in, w_gk2, b_gk2, lambda_q1, lambda_k1, lambda_q2, lambda_k2,
              da_norm_w, gla_norm_w, w_o, pre_mix_w, post_mix_w, pre_ffn_w, post_ffn_w,
              w_up, conv_w, conv_b, w_down):
    B, S = x_prompt.shape[0], x_prompt.shape[1]
    L = x_sample.shape[1]
    P = cache_k.shape[2]
    pos_p = jnp.arange(S)
    pos_s = P + jnp.arange(L)
    hp, hs = x_prompt, x_sample
    kp_l, vp_l, sp_l, cp_l = [], [], [], []
    ks_l, vs_l, ss_l, cs_l = [], [], [], []
    for li in range(DEPTH):
        params = (w_in[li], w_gk2[li], b_gk2[li], lambda_q1[li], lambda_k1[li],
                  lambda_q2[li], lambda_k2[li], da_norm_w[li], gla_norm_w[li], w_o[li],
                  pre_mix_w[li], post_mix_w[li], pre_ffn_w[li], post_ffn_w[li],
                  w_up[li], conv_w[li], conv_b[li], w_down[li])
        S0_p = jnp.zeros((B, GLA_HEADS, GLA_DK, GLA_DV), jnp.float32)
        conv0_p = jnp.zeros((B, CONV_W - 1, D_FF), x_prompt.dtype)
        hp, kp, vp, sp, cp = _layer(hp, pos_p, None, S0_p, conv0_p, li, *params)
        hs, kn, vn, sn, cn = _layer(hs, pos_s, (cache_k[li], cache_v[li]),
                                    state_gla[li], state_conv[li], li, *params)
        kp_l.append(kp); vp_l.append(vp); sp_l.append(sp); cp_l.append(cp)
        ks_l.append(kn); vs_l.append(vn); ss_l.append(sn.astype(state_gla.dtype)); cs_l.append(cn)
    return (hp, hs,
            jnp.stack(kp_l), jnp.stack(vp_l), jnp.stack(sp_l), jnp.stack(cp_l),
            jnp.stack(ks_l), jnp.stack(vs_l), jnp.stack(ss_l), jnp.stack(cs_l))
```

```cpp
#include <hip/hip_runtime.h>
#include <cstdio>
#include <cstdint>
#include <cmath>
__device__ __forceinline__ int opaque_tid() { int t = threadIdx.x; asm volatile("" : "+v"(t)); return t; }
namespace pg8 {
#define PG8_LAS __attribute__((address_space(3)))
typedef unsigned short bf16_t;
typedef short bf16x8 __attribute__((ext_vector_type(8)));
typedef float f32x4 __attribute__((ext_vector_type(4)));
typedef unsigned u32x4 __attribute__((ext_vector_type(4)));
constexpr int BM = 256, BK = 64, HALF = 128, HTB = HALF * BK * 2  , STAGE_BYTES = 8 * HTB, NXCD = 8, WGM = 8;

__host__ __device__ __forceinline__ int lds_byte(int r, int c) { const int st = (r >> 4) * 2 + (c >> 5), rr = r & 15, cc = c & 31, ob = rr * 64 + cc * 2; return st * 1024 + (ob ^ (((ob >> 9) & 1) << 5)); }
__host__ __device__ __forceinline__ void stage_rc(int b, int& R, int& C) { const int st = b / 1024, sb = b % 1024, swz = sb ^ (((sb >> 9) & 1) << 5); R = (st >> 1) * 16 + swz / 64; C = (st & 1) * 32 + (swz % 64) / 2; }
__host__ __device__ __forceinline__ int perm32(int rho) { const int n = rho >> 4, i = rho & 15; return 8 * (i >> 2) + 4 * n + (i & 3); }

struct Unit { int pm, pn; };
struct Gemm { const bf16_t* A; const bf16_t* Bt; int M, N, K; };

struct StaticOrder {
    int nM, nN, nwg, G, c;
    __host__ __device__ void init(int M, int N, int G_, int c_) { nM = M / BM; nN = N / BM; nwg = nM * nN; G = G_; c = c_; }
    __host__ __device__ bool next(int i, Unit& u) const {
        const long L = (long)i * G + c; if (L >= nwg) return false;
        int wgid = (int)L; { const int q = nwg / NXCD, r = nwg % NXCD, xcd = wgid % NXCD, off = wgid / NXCD; wgid = (xcd < r ? xcd * (q + 1) : r * (q + 1) + (xcd - r) * q) + off; }
        const int nig = WGM * nN, gid = wgid / nig, fm = gid * WGM, gsz = (nM - fm) < WGM ? (nM - fm) : WGM;
        u.pm = fm + ((wgid % nig) % gsz); u.pn = (wgid % nig) / gsz; return true;
    }
    __device__ __forceinline__ void a_ready(const Unit&) const {}
    __device__ __forceinline__ void done(const Unit&) const {}
};

__device__ __forceinline__ unsigned cvt_pk_bf16(float lo, float hi) { unsigned r; asm volatile("v_cvt_pk_bf16_f32 %0, %1, %2" : "=v"(r) : "v"(lo), "v"(hi)); return r; }
template <class Epi, class Sched, bool ALIGN_EPI = false, bool SP2 = false>
__device__ __forceinline__ void gemm_phase(PG8_LAS unsigned char* lds, const Gemm g, const Sched& S, const Epi& E) {
    const int tid = opaque_tid(), wid = __builtin_amdgcn_readfirstlane(tid >> 6), lane = tid & 63, wr = wid >> 2, wc = wid & 3, fr = lane & 15, fq = lane >> 4;
    const int K = g.K, nt = K / BK;
    unsigned voffA[2], voffB[2];
#pragma unroll
    for (int i = 0; i < 2; ++i) { int R, C; stage_rc(tid * 16 + i * 8192, R, C); const int Rb = Epi::PERM ? ((R & ~31) + perm32(R & 31)) : R;
        voffA[i] = (unsigned)(R * K + C) * 2u; voffB[i] = (unsigned)(Rb * K + C) * 2u; }
    const size_t kstep = (size_t)(BK * 2);
    const size_t hstep = (size_t)HALF * K * 2;
    const size_t tstep = 2 * hstep;
    const unsigned ldsw = (unsigned)wid * 1024u;
    const int aoff = lds_byte(wr * 64 + fr, fq * 8), boff = lds_byte(wc * 32 + fr, fq * 8);
#define PG8_SA(b, h) (((b) * 2 + (h)) * HTB)
#define PG8_SB(b, h) ((4 + (b) * 2 + (h)) * HTB)
#define PG8_STAGE(bufoff, gbase, voff) do { _Pragma("unroll") for (int _i = 0; _i < 2; ++_i) \
        __builtin_amdgcn_global_load_lds((const unsigned*)((const char*)(gbase) + (voff)[_i]), (PG8_LAS unsigned*)(lds + (bufoff) + ldsw + _i * 8192), 16, 0, 0); } while (0)
#define PG8_LDA(dst, b, h) do { _Pragma("unroll") for (int m = 0; m < 4; ++m) _Pragma("unroll") for (int k = 0; k < 2; ++k) dst[m][k] = *(const PG8_LAS bf16x8*)(lds + PG8_SA(b, h) + aoff + m * 2048 + k * 1024); } while (0)
#define PG8_LDB(dst, b, h) do { _Pragma("unroll") for (int n = 0; n < 2; ++n) _Pragma("unroll") for (int k = 0; k < 2; ++k) dst[n][k] = *(const PG8_LAS bf16x8*)(lds + PG8_SB(b, h) + boff + n * 2048 + k * 1024); } while (0)
#define PG8_MMA(ai, bj, At, Bt) do { __builtin_amdgcn_s_setprio(1); _Pragma("unroll") for (int m = 0; m < 4; ++m) _Pragma("unroll") for (int n = 0; n < 2; ++n) _Pragma("unroll") for (int k = 0; k < 2; ++k) \
        acc[ai][bj][m][n] = __builtin_amdgcn_mfma_f32_16x16x32_bf16(Bt[n][k], At[m][k], acc[ai][bj][m][n], 0, 0, 0); __builtin_amdgcn_s_setprio(0); } while (0)
#define PG8_WAIT_V(n) asm volatile("s_waitcnt vmcnt(" #n ")" ::: "memory")
#define PG8_WAIT_L(n) asm volatile("s_waitcnt lgkmcnt(" #n ")" ::: "memory")
#define PG8_BAR __builtin_amdgcn_s_barrier()
#define PG8_SCHED __builtin_amdgcn_sched_barrier(0)
    Unit cur, nxt; int ui = 0;
    if (!S.next(0, cur)) return;
    f32x4 acc[2][2][4][2];
#pragma unroll
    for (int a = 0; a < 2; ++a)
#pragma unroll
        for (int b = 0; b < 2; ++b)
#pragma unroll
            for (int m = 0; m < 4; ++m)
#pragma unroll
                for (int n = 0; n < 2; ++n) acc[a][b][m][n] = (f32x4){0.f, 0.f, 0.f, 0.f};
    bf16x8 At[4][2], B0[2][2], B1[2][2];
    const char* cA = (const char*)g.A + (size_t)cur.pm * tstep; const char* cB = (const char*)g.Bt + (size_t)cur.pn * tstep;
    S.a_ready(cur);
    if constexpr (SP2) {
        PG8_STAGE(PG8_SB(0, 0), cB, voffB); PG8_STAGE(PG8_SB(0, 1), cB + hstep, voffB); PG8_STAGE(PG8_SA(0, 0), cA, voffA); PG8_STAGE(PG8_SA(0, 1), cA + hstep, voffA);
        if (wr == 1) PG8_BAR;
        PG8_WAIT_V(2); PG8_BAR;
        PG8_STAGE(PG8_SB(1, 0), cB + kstep, voffB); PG8_STAGE(PG8_SA(1, 0), cA + kstep, voffA); PG8_STAGE(PG8_SB(1, 1), cB + hstep + kstep, voffB);
        PG8_WAIT_V(6); PG8_BAR;
    } else {
        PG8_STAGE(PG8_SB(0, 0), cB, voffB); PG8_STAGE(PG8_SA(0, 0), cA, voffA); PG8_STAGE(PG8_SB(0, 1), cB + hstep, voffB); PG8_STAGE(PG8_SA(0, 1), cA + hstep, voffA);
        if (wr == 1) PG8_BAR;
        PG8_WAIT_V(4); PG8_BAR;
        PG8_STAGE(PG8_SB(1, 0), cB + kstep, voffB); PG8_STAGE(PG8_SA(1, 0), cA + kstep, voffA); PG8_STAGE(PG8_SB(1, 1), cB + hstep + kstep, voffB);
        PG8_WAIT_V(6); PG8_BAR;
    }
    for (;;) {
        const bool has_next = S.next(ui + 1, nxt);
        const char* nA = has_next ? (const char*)g.A + (size_t)nxt.pm * tstep : cA; const char* nB = has_next ? (const char*)g.Bt + (size_t)nxt.pn * tstep : cB;
        for (int t = 0; t < nt; t += 2) {
            const bool last = (t == nt - 2);
            const char* a1 = cA + (size_t)(t + 1) * kstep;
            const char* a2 = last ? nA : cA + (size_t)(t + 2) * kstep; const char* b2 = last ? nB : cB + (size_t)(t + 2) * kstep;
            const char* a3 = a2 + kstep; const char* b3 = b2 + kstep;
            if (last && has_next) S.a_ready(nxt);
            if constexpr (SP2) {
            PG8_LDB(B0, 0, 0); PG8_LDB(B1, 0, 1); PG8_SCHED; PG8_LDA(At, 0, 0); PG8_STAGE(PG8_SA(1, 1), a1 + hstep, voffA);
            PG8_WAIT_V(8); PG8_WAIT_L(0); PG8_BAR; PG8_MMA(0, 0, At, B0); PG8_MMA(0, 1, At, B1); PG8_BAR; PG8_SCHED;
            PG8_LDA(At, 0, 1); PG8_STAGE(PG8_SB(0, 0), b2, voffB); PG8_STAGE(PG8_SB(0, 1), b2 + hstep, voffB); PG8_STAGE(PG8_SA(0, 0), a2, voffA);
            PG8_WAIT_V(8); PG8_WAIT_L(0); PG8_BAR; PG8_MMA(1, 0, At, B0); PG8_MMA(1, 1, At, B1); PG8_BAR; PG8_SCHED;
            PG8_LDB(B0, 1, 0); PG8_LDB(B1, 1, 1); PG8_SCHED; PG8_LDA(At, 1, 0); PG8_STAGE(PG8_SA(0, 1), a2 + hstep, voffA);
            PG8_WAIT_V(8); PG8_WAIT_L(0); PG8_BAR; PG8_MMA(0, 0, At, B0); PG8_MMA(0, 1, At, B1); PG8_BAR; PG8_SCHED;
            PG8_LDA(At, 1, 1); PG8_STAGE(PG8_SB(1, 0), b3, voffB); PG8_STAGE(PG8_SB(1, 1), b3 + hstep, voffB); PG8_STAGE(PG8_SA(1, 0), a3, voffA);
            PG8_WAIT_V(8); PG8_WAIT_L(0); PG8_BAR; PG8_MMA(1, 0, At, B0); PG8_MMA(1, 1, At, B1); PG8_BAR; PG8_SCHED;
            } else {
            PG8_LDB(B0, 0, 0); PG8_SCHED; PG8_LDA(At, 0, 0); PG8_STAGE(PG8_SA(1, 1), a1 + hstep, voffA);
            PG8_WAIT_L(8); PG8_BAR; PG8_WAIT_L(0); PG8_MMA(0, 0, At, B0); PG8_BAR; PG8_SCHED;
            PG8_LDB(B1, 0, 1); PG8_STAGE(PG8_SB(0, 0), b2, voffB);
            PG8_BAR; PG8_WAIT_L(0); PG8_MMA(0, 1, At, B1); PG8_BAR;
            PG8_LDA(At, 0, 1); PG8_STAGE(PG8_SA(0, 0), a2, voffA);
            PG8_BAR; PG8_WAIT_L(0); PG8_MMA(1, 0, At, B0); PG8_BAR; PG8_SCHED;
            PG8_STAGE(PG8_SB(0, 1), b2 + hstep, voffB);
            PG8_WAIT_V(6); PG8_BAR; PG8_MMA(1, 1, At, B1); PG8_BAR;
            PG8_LDB(B0, 1, 0); PG8_SCHED; PG8_LDA(At, 1, 0); PG8_STAGE(PG8_SA(0, 1), a2 + hstep, voffA);
            PG8_WAIT_L(8); PG8_BAR; PG8_WAIT_L(0); PG8_MMA(0, 0, At, B0); PG8_BAR; PG8_SCHED;
            PG8_LDB(B1, 1, 1); PG8_STAGE(PG8_SB(1, 0), b3, voffB);
            PG8_BAR; PG8_WAIT_L(0); PG8_MMA(0, 1, At, B1); PG8_BAR;
            PG8_LDA(At, 1, 1); PG8_STAGE(PG8_SA(1, 0), a3, voffA);
            PG8_BAR; PG8_WAIT_L(0); PG8_MMA(1, 0, At, B0); PG8_BAR; PG8_SCHED;
            PG8_STAGE(PG8_SB(1, 1), b3 + hstep, voffB);
            PG8_WAIT_V(6); PG8_BAR; PG8_MMA(1, 1, At, B1); PG8_BAR;
            }
        }
        if constexpr (ALIGN_EPI) { if (wr == 0) PG8_BAR; }
        if constexpr (!Epi::AFTER_DRAIN) { E(acc, cur, wr, wc, fr, fq); S.done(cur); }
        if (!has_next) break;
#pragma unroll
        for (int a = 0; a < 2; ++a)
#pragma unroll
            for (int b = 0; b < 2; ++b)
#pragma unroll
                for (int m = 0; m < 4; ++m)
#pragma unroll
                    for (int n = 0; n < 2; ++n) acc[a][b][m][n] = (f32x4){0.f, 0.f, 0.f, 0.f};
        cur = nxt; cA = nA; cB = nB; ++ui;
        if constexpr (ALIGN_EPI) { if (wr == 1) PG8_BAR; }
    }
    PG8_WAIT_V(0);
    if constexpr (!ALIGN_EPI) { if (wr == 0) PG8_BAR; }
    PG8_BAR;
    if constexpr (Epi::AFTER_DRAIN) { E.fused(acc, cur, wr, wc, fr, fq, lds, wid, lane); S.done(cur); }
#undef PG8_SA
#undef PG8_SB
#undef PG8_STAGE
#undef PG8_LDA
#undef PG8_LDB
#undef PG8_MMA
#undef PG8_WAIT_V
#undef PG8_WAIT_L
#undef PG8_BAR
#undef PG8_SCHED
}
}

#define GAS __attribute__((address_space(1)))
#define LAS __attribute__((address_space(3)))
typedef unsigned short bf16;
typedef short bf16x8 __attribute__((ext_vector_type(8)));
typedef short s16x4 __attribute__((ext_vector_type(4)));
typedef float f32x4 __attribute__((ext_vector_type(4)));
typedef float f32x2 __attribute__((ext_vector_type(2)));
typedef float f32x16 __attribute__((ext_vector_type(16)));
typedef unsigned u32x4 __attribute__((ext_vector_type(4)));
typedef unsigned u32x2 __attribute__((ext_vector_type(2)));

constexpr int DM = 1024, NB = 8, SEQ = 8192, DEPTH = 2, DB = 32, DL = 16, PAST = 2048;
constexpr int MP = NB * SEQ;
constexpr int MS = DB * DL;
constexpr int MT = MP + MS;
constexpr int DFF = 2816, DIN = 8208, NIN = 8704;
constexpr float EPS = 1e-6f;
constexpr float C2 = 0.125f * 1.4426950408889634f;
constexpr int NWAVES = 8;

constexpr size_t O_Y = 0;
constexpr size_t O_KP = (size_t)MT * DM;
constexpr size_t O_VP = O_KP + (size_t)DEPTH * MP * DM;
constexpr size_t O_GP = O_VP + (size_t)DEPTH * MP * DM;
constexpr size_t O_CP = O_GP + (size_t)DEPTH * NB * 4 * 128 * 256;
constexpr size_t O_KS = O_CP + (size_t)DEPTH * NB * 2 * DFF;
constexpr size_t O_VS = O_KS + (size_t)DEPTH * MS * DM;
constexpr size_t O_GS = O_VS + (size_t)DEPTH * MS * DM;
constexpr size_t O_CS = O_GS + (size_t)DEPTH * DB * 4 * 128 * 256;
constexpr size_t O_END = O_CS + (size_t)DEPTH * DB * 2 * DFF;

constexpr size_t MiB = 1u << 20, HMiB = 1u << 19;
constexpr size_t WS_CTL = 0, CTL_ZERO_BYTES = 1 * MiB;
constexpr size_t WS_ROPE = 1 * MiB;
constexpr size_t WS_DG = 1 * MiB + HMiB;
constexpr size_t WS_W = 2 * MiB;
constexpr size_t W_IN = 0, W_O = 17 * MiB, W_UP = 19 * MiB, W_DN = 30 * MiB, W_LAYER = 35 * MiB + HMiB;
constexpr size_t WS_SLOC = 74 * MiB;
constexpr size_t UB = (size_t)MT * DM * 2;
constexpr size_t WS_XN = 112 * MiB;
constexpr size_t WS_QA = WS_XN + UB, WS_KA = WS_QA + UB, WS_VA = WS_KA + UB, WS_QG = WS_VA + UB, WS_KG = WS_QG + UB / 2, WS_VG = WS_KG + UB / 2,
                 WS_RG = WS_VG + UB, WS_GK = WS_RG + UB, WS_GA = WS_GK + UB / 2, WS_GB = WS_GA + UB, WS_PEND = WS_GB + UB;
constexpr size_t WS_UG = WS_QA;
constexpr size_t WS_ACT = WS_UG + (size_t)MT * 5632 * 2;
constexpr size_t WS_TMP = WS_PEND;
constexpr size_t WS_END = WS_TMP + 2 * UB;
static_assert(WS_ACT + (size_t)MT * DFF * 2 <= WS_PEND, "ws overlay");
static_assert(WS_W + 2 * W_LAYER <= WS_SLOC && WS_SLOC + 32 * MiB <= WS_XN, "ws map");
constexpr int CW_BAR = 4096;

constexpr int RING_BYTES = 131072, MISC_OFF = RING_BYTES, LDS_BYTES = 147456;

__device__ __forceinline__ float bf2f(bf16 b) { return __uint_as_float((unsigned)b << 16); }
__device__ __forceinline__ float bflo(unsigned u) { return __uint_as_float(u << 16); }
__device__ __forceinline__ float bfhi(unsigned u) { return __uint_as_float(u & 0xffff0000u); }
typedef __bf16 bf16x2_t __attribute__((ext_vector_type(2)));
__device__ __forceinline__ unsigned pk2(float lo, float hi) { f32x2 v = {lo, hi}; bf16x2_t b = __builtin_convertvector(v, bf16x2_t); return __builtin_bit_cast(unsigned, b); }
__device__ __forceinline__ bf16 f2bf(float f) { return (bf16)(pk2(f, 0.f) & 0xffffu); }
__device__ __forceinline__ float wave_sum(float v) {
#pragma unroll
    for (int o = 1; o < 64; o <<= 1) v += __shfl_xor(v, o);
    return v;
}
__device__ __forceinline__ float sigmoidf_(float x) { return 1.0f / (1.0f + __expf(-x)); }
#define LDS_WAIT() asm volatile("s_waitcnt lgkmcnt(0)" ::: "memory")
#define VM_WAIT() asm volatile("s_waitcnt vmcnt(0)" ::: "memory")

struct EpiIn {
    static constexpr bool PERM = true, AFTER_DRAIN = false;
    unsigned char* ws; float* kout_p; float* vout_p; float* kout_s; float* vout_s; const float* rope; const float* bgk;
    __device__ __forceinline__ void operator()(const pg8::f32x4 (&acc)[2][2][4][2], const pg8::Unit& u, int wr, int wc, int fr, int fq) const {
        const int pn = u.pn;
        const int row0 = u.pm * 256 + wr * 64 + fr;
        const bool sample = (u.pm >= 256);
        bf16* dst; int ldc, tcol; int kind;
        if (pn < 4)       { dst = (bf16*)(ws + WS_QA); ldc = 1024; tcol = pn * 256; kind = 0; }
        else if (pn < 8)  { dst = (bf16*)(ws + WS_KA); ldc = 1024; tcol = (pn - 4) * 256; kind = 1; }
        else if (pn < 12) { dst = (bf16*)(ws + WS_VA); ldc = 1024; tcol = (pn - 8) * 256; kind = 2; }
        else if (pn < 14) { dst = (bf16*)(ws + WS_QG); ldc = 512; tcol = (pn - 12) * 256; kind = 3; }
        else if (pn < 16) { dst = (bf16*)(ws + WS_KG); ldc = 512; tcol = (pn - 14) * 256; kind = 4; }
        else if (pn < 20) { dst = (bf16*)(ws + WS_VG); ldc = 1024; tcol = (pn - 16) * 256; kind = 4; }
        else if (pn < 24) { dst = (bf16*)(ws + WS_RG); ldc = 1024; tcol = (pn - 20) * 256; kind = 4; }
        else if (pn < 28) { dst = (bf16*)(ws + WS_GA); ldc = 1024; tcol = (pn - 24) * 256; kind = 4; }
        else if (pn < 32) { dst = (bf16*)(ws + WS_GB); ldc = 1024; tcol = (pn - 28) * 256; kind = 4; }
        else              { dst = (bf16*)(ws + WS_GK); ldc = 512; tcol = (pn - 32) * 256; kind = 5; }
        const int colw = wc * 32 + 8 * fq;
        const bool do_rope = (kind <= 1) && ((wc & 1) == 0);
#pragma unroll
        for (int ai = 0; ai < 2; ++ai)
#pragma unroll
            for (int m = 0; m < 4; ++m) {
                const int row = row0 + ai * 128 + m * 16;
                const int pos = sample ? (PAST + (row & 15)) : (row & (SEQ - 1));
                f32x4 cs0 = {1.f, 1.f, 1.f, 1.f}, cs1 = cs0, sn0 = {0.f, 0.f, 0.f, 0.f}, sn1 = sn0;
                if (do_rope) { const f32x4* rp = (const f32x4*)(rope + (size_t)pos * 16); cs0 = rp[0]; cs1 = rp[1]; sn0 = rp[2]; sn1 = rp[3]; }
#pragma unroll
                for (int bj = 0; bj < 2; ++bj) {
                    f32x4 v0 = acc[ai][bj][m][0], v1 = acc[ai][bj][m][1];
                    const int col = tcol + bj * 128 + colw;
                    if (do_rope) {
                        f32x4 o0, o1;
#pragma unroll
                        for (int e = 0; e < 4; ++e) { o0[e] = __shfl_xor(v0[e], 16); o1[e] = __shfl_xor(v1[e], 16); }
                        if (fq == 0) { v0 = v0 * cs0 - o0 * sn0; v1 = v1 * cs1 - o1 * sn1; }
                        else if (fq == 1) { v0 = v0 * cs0 + o0 * sn0; v1 = v1 * cs1 + o1 * sn1; }
                    }
                    if (kind == 1 || kind == 2) {
                        float* fo = sample ? ((kind == 1 ? kout_s : vout_s) + (size_t)(row - MP) * 1024 + col)
                                           : ((kind == 1 ? kout_p : vout_p) + (size_t)row * 1024 + col);
                        *(f32x4*)fo = v0; *(f32x4*)(fo + 4) = v1;
                    }
                    if (kind == 0) { v0 = v0 * C2; v1 = v1 * C2; }
                    if (kind == 3) { v0 = v0 * 0.08838834764831845f; v1 = v1 * 0.08838834764831845f; }
                    if (kind == 5) {
                        const f32x4 b0 = *(const f32x4*)(bgk + col), b1 = *(const f32x4*)(bgk + col + 4);
#pragma unroll
                        for (int e = 0; e < 4; ++e) {
                            float x = v0[e] + b0[e]; v0[e] = (fminf(x, 0.f) - __logf(1.f + __expf(-fabsf(x)))) * 0.0625f;
                            x = v1[e] + b1[e];       v1[e] = (fminf(x, 0.f) - __logf(1.f + __expf(-fabsf(x)))) * 0.0625f;
                        }
                    }
                    u32x4 w; w.x = pk2(v0[0], v0[1]); w.y = pk2(v0[2], v0[3]); w.z = pk2(v1[0], v1[1]); w.w = pk2(v1[2], v1[3]);
                    *(u32x4*)(dst + (size_t)row * ldc + col) = w;
                }
            }
    }
};
struct EpiF32 {
    static constexpr bool PERM = true, AFTER_DRAIN = false;
    float* O; int ldc;
    __device__ __forceinline__ void operator()(const pg8::f32x4 (&acc)[2][2][4][2], const pg8::Unit& u, int wr, int wc, int fr, int fq) const {
        const int row0 = u.pm * 256 + wr * 64 + fr, col0 = u.pn * 256 + wc * 32 + 8 * fq;
#pragma unroll
        for (int ai = 0; ai < 2; ++ai)
#pragma unroll
            for (int m = 0; m < 4; ++m) { float* rowp = O + (size_t)(row0 + ai * 128 + m * 16) * ldc + col0;
#pragma unroll
                for (int bj = 0; bj < 2; ++bj) { *(f32x4*)(rowp + bj * 128) = acc[ai][bj][m][0]; *(f32x4*)(rowp + bj * 128 + 4) = acc[ai][bj][m][1]; } }
    }
};
struct EpiB16 {
    static constexpr bool PERM = true, AFTER_DRAIN = false;
    bf16* O; int ldc;
    __device__ __forceinline__ void operator()(const pg8::f32x4 (&acc)[2][2][4][2], const pg8::Unit& u, int wr, int wc, int fr, int fq) const {
        const int row0 = u.pm * 256 + wr * 64 + fr, col0 = u.pn * 256 + wc * 32 + 8 * fq;
#pragma unroll
        for (int ai = 0; ai < 2; ++ai)
#pragma unroll
            for (int m = 0; m < 4; ++m) { bf16* rowp = O + (size_t)(row0 + ai * 128 + m * 16) * ldc + col0;
#pragma unroll
                for (int bj = 0; bj < 2; ++bj) { const f32x4 v0 = acc[ai][bj][m][0], v1 = acc[ai][bj][m][1];
                    u32x4 w; w.x = pk2(v0[0], v0[1]); w.y = pk2(v0[2], v0[3]); w.z = pk2(v1[0], v1[1]); w.w = pk2(v1[2], v1[3]);
                    *(u32x4*)(rowp + bj * 128) = w; } }
    }
};
#define XB_TMO      128
#define XB_XCNT(j)  (256  + 64 * (j))
#define XB_XSUB(j)  (1280 + 64 * (j))
#define XB_XGEN(j)  (2304 + 64 * (j))
#define XB_TOP      3328
#define XB_TOPGEN   3392
#define XCD_BAR_WORDS 3456
#define XB_SPIN_CAP (1u << 18)

__device__ __forceinline__ unsigned xb_ld(unsigned* p)              { return __hip_atomic_load(p, __ATOMIC_RELAXED, __HIP_MEMORY_SCOPE_AGENT); }
__device__ __forceinline__ unsigned xb_add(unsigned* p, unsigned v) { return __hip_atomic_fetch_add(p, v, __ATOMIC_RELAXED, __HIP_MEMORY_SCOPE_AGENT); }
__device__ __forceinline__ unsigned xb_xcc_id() { return (unsigned)__builtin_amdgcn_s_getreg((3 << 11) | 20) & 0xFu; }
#define XB_SPIN(cond, bar) do { unsigned _sp = 0; while (cond) { __builtin_amdgcn_s_sleep(1); \
    if ((++_sp & 255u) == 0u) { if (xb_ld(&(bar)[XB_TMO])) break; if (_sp > XB_SPIN_CAP) { atomicAdd(&(bar)[XB_TMO], 1u); break; } } } } while (0)

struct XcdBarrier {
    unsigned* bar; unsigned x;
    volatile LAS unsigned* st;
};

__device__ __forceinline__ XcdBarrier xcd_barrier_post(unsigned* bar, volatile LAS unsigned* st) {
    XcdBarrier b; b.bar = bar; b.x = xb_xcc_id(); b.st = st;
    if (threadIdx.x == 0) (void)xb_add(&bar[XB_XCNT(b.x)], 1u);
    return b;
}
__device__ __forceinline__ void xcd_barrier_complete(unsigned* bar, unsigned x, unsigned& nloc, unsigned& nx) {
    const unsigned G = gridDim.x * gridDim.y * gridDim.z;
    unsigned sum, cnt, mine, sp = 0u;
    for (;;) {
        sum = 0u; cnt = 0u; mine = 0u;
#pragma unroll
        for (unsigned j = 0; j < 16; ++j) { const unsigned c = xb_ld(&bar[XB_XCNT(j)]); sum += c; cnt += (c > 0u) ? 1u : 0u; mine = (j == x) ? c : mine; }
        if (sum == G) break;
        __builtin_amdgcn_s_sleep(1);
        if ((++sp & 255u) == 0u) { if (xb_ld(&bar[XB_TMO])) break; if (sp > XB_SPIN_CAP) { atomicAdd(&bar[XB_TMO], 1u); break; } }
    }
    nloc = mine > 0u ? mine : 1u; nx = cnt > 0u ? cnt : 1u;
}

__device__ __forceinline__ void xcd_barrier(const XcdBarrier& b) {
    asm volatile("s_waitcnt vmcnt(0)" ::: "memory");
    __syncthreads();
    if (threadIdx.x == 0) {
        unsigned* bar = b.bar;
        __builtin_amdgcn_s_waitcnt(0);
        unsigned nloc = b.st[0], nx = b.st[1];
        if (nloc == 0u) { xcd_barrier_complete(bar, b.x, nloc, nx); b.st[0] = nloc; b.st[1] = nx; }
        const unsigned old = xb_add(&bar[XB_XSUB(b.x)], 1u);
        const unsigned gen = old / nloc;
        if (old + 1u == (gen + 1u) * nloc) {
            __builtin_amdgcn_fence(__ATOMIC_RELEASE, "agent");
            asm volatile("s_waitcnt vmcnt(0)" ::: "memory");
            const unsigned og = xb_add(&bar[XB_TOP], 1u);
            const unsigned tg = og / nx;
            if (og + 1u == (tg + 1u) * nx) xb_add(&bar[XB_TOPGEN], 1u);
            else XB_SPIN(xb_ld(&bar[XB_TOPGEN]) == tg, bar);
            __builtin_amdgcn_fence(__ATOMIC_ACQUIRE, "agent");
            xb_add(&bar[XB_XGEN(b.x)], 1u);
            asm volatile("s_waitcnt vmcnt(0)" ::: "memory");
        } else {
            XB_SPIN(xb_ld(&bar[XB_XGEN(b.x)]) == gen, bar);
            __builtin_amdgcn_fence(__ATOMIC_ACQUIRE, "agent");
            asm volatile("s_waitcnt vmcnt(0)" ::: "memory");
        }
    }
    __syncthreads();
}

struct Args { const float* in[24]; float* out; unsigned char* ws; float inv_freq[8]; int ph_lo, ph_hi; };
enum { I_XP = 0, I_XS, I_CK, I_CV, I_SG, I_SC, I_WIN, I_WGK2, I_BGK2, I_LQ1, I_LK1, I_LQ2, I_LK2, I_DANW, I_GLANW, I_WO, I_PREMIX, I_POSTMIX, I_PREFFN, I_POSTFFN, I_WUP, I_CONVW, I_CONVB, I_WDOWN };

__device__ __forceinline__ void transpose_item(const float* W, int N, int K, bf16* WT, LAS float* scr, int kb, int n0_src, int n0_dst, int lane, const float* wg) {
    const int k0 = 64 * kb;
    if (wg == nullptr) {
#pragma unroll 8
        for (int i = 0; i < 32; ++i) { const int kk = 2 * i + (lane >> 5); scr[kk * 33 + (lane & 31)] = W[(size_t)(k0 + kk) * N + n0_src + (lane & 31)]; }
    } else {
        float g[16];
#pragma unroll
        for (int r = 0; r < 16; ++r) g[r] = wg[r * 512 + n0_src + (lane & 31)];
        for (int i = 0; i < 32; ++i) { const int kk = 2 * i + (lane >> 5); const float* lr = W + (size_t)(k0 + kk) * N + 6144; float s = 0.f;
#pragma unroll
            for (int r = 0; r < 16; ++r) s += lr[r] * g[r];
            scr[kk * 33 + (lane & 31)] = s; }
    }
    LDS_WAIT(); asm volatile("" ::: "memory");
    const int c = lane & 7;
#pragma unroll
    for (int j = 0; j < 4; ++j) { const int n = (lane >> 3) + 8 * j; const LAS float* s = scr + (8 * c) * 33 + n;
        u32x4 o; o.x = pk2(s[0 * 33], s[1 * 33]); o.y = pk2(s[2 * 33], s[3 * 33]); o.z = pk2(s[4 * 33], s[5 * 33]); o.w = pk2(s[6 * 33], s[7 * 33]);
        *(GAS u32x4*)(WT + (size_t)(n0_dst + n) * K + k0 + 8 * c) = o; }
    LDS_WAIT(); asm volatile("" ::: "memory");
}
__device__ __forceinline__ void rms_row_to_bf16(const float* xrow, const float* w, bf16* orow, int lane) {
    const f32x4* xr = (const f32x4*)xrow + lane; const f32x4* wr = (const f32x4*)w + lane;
    f32x4 v[4]; float s = 0.f;
#pragma unroll
    for (int j = 0; j < 4; ++j) { v[j] = xr[64 * j]; s += (v[j].x * v[j].x + v[j].y * v[j].y) + (v[j].z * v[j].z + v[j].w * v[j].w); }
    const float rstd = 1.f / sqrtf(wave_sum(s) * (1.f / DM) + EPS);
    u32x2* o8 = (u32x2*)orow + lane;
#pragma unroll
    for (int j = 0; j < 4; ++j) { const f32x4 g = wr[64 * j]; u32x2 o; o.x = pk2(v[j].x * rstd * g.x, v[j].y * rstd * g.y); o.y = pk2(v[j].z * rstd * g.z, v[j].w * rstd * g.w); o8[64 * j] = o; }
}
__device__ __forceinline__ void sincos_acc(float angf, float& sn, float& cs) {
    const double a = (double)angf; const double k = rint(a * 0.15915494309189535); const double r = a - k * 6.283185307179586476925;
    const double r2 = r * r; double ts = 1.0, tc = 1.0, ss = 1.0, sc = 1.0;
#pragma unroll
    for (int n = 1; n <= 13; ++n) { tc = -tc * r2 / (double)((2 * n - 1) * (2 * n)); ts = -ts * r2 / (double)((2 * n) * (2 * n + 1)); sc += tc; ss += ts; }
    sn = (float)(ss * r); cs = (float)sc;
}

#define MFMA32(a, b, c) __builtin_amdgcn_mfma_f32_32x32x16_bf16((a), (b), (c), 0, 0, 0)
__device__ __forceinline__ int crow(int r, int hi) { return (r & 3) + 8 * (r >> 2) + 4 * hi; }
__device__ __forceinline__ s16x4 tr16(const LAS unsigned char* p) { return __builtin_bit_cast(s16x4, __builtin_amdgcn_ds_read_tr16_b64_v4i16((LAS s16x4*)p)); }
__device__ __forceinline__ bf16x8 cat8(s16x4 lo, s16x4 hi) { return (bf16x8){lo[0], lo[1], lo[2], lo[3], hi[0], hi[1], hi[2], hi[3]}; }
__device__ __forceinline__ u32x4 cvt8(f32x4 a, f32x4 b) { u32x4 w; w.x = pk2(a[0], a[1]); w.y = pk2(a[2], a[3]); w.z = pk2(b[0], b[1]); w.w = pk2(b[2], b[3]); return w; }

template <int MODE>
__device__ __forceinline__ void attn_unit(LAS unsigned char* lds, const bf16* Q, const bf16* Kb, const bf16* Vb, bf16* O, const float* ck, const float* cv,
                                          int b, int h, int qblk, float lam, float onem, const float* normw) {
    const int tid = opaque_tid(), lane = tid & 63, w = __builtin_amdgcn_readfirstlane(tid >> 6), r32 = lane & 31, hi = lane >> 5;
    const int comp = w & 1, rg = w >> 1;
    int NT, my_nt; size_t qrow, orow0;
    if (MODE == 0) { NT = 2 * qblk + 2; my_nt = 2 * qblk + 1 + (rg >> 1); orow0 = (size_t)b * SEQ + qblk * 128 + rg * 32; qrow = orow0 + r32; }
    else { NT = 33; my_nt = (rg == 0) ? 33 : 0; orow0 = (size_t)MP + b * 16; qrow = orow0 + (r32 < 15 ? r32 : 15); }
    bf16x8 qr[4];
    { const bf16* qp = Q + qrow * 1024 + h * 128 + comp * 64 + hi * 8;
#pragma unroll
      for (int s = 0; s < 4; ++s) qr[s] = *(const bf16x8*)(qp + 16 * s); }
    LAS float* wsf = (LAS float*)(lds + 65536) + w * 64;
    f32x16 o[4];
#pragma unroll
    for (int d = 0; d < 4; ++d)
#pragma unroll
        for (int r = 0; r < 16; ++r) o[d][r] = 0.f;
    float mrow = 0.f, lrow = 0.f;
    u32x4 kst[2], vst[2];
    const int vrow_l = lane >> 2, vpc = lane & 3;
#define ATT_LOAD(t) do { \
        if (MODE == 0) { const size_t kr0 = (size_t)b * SEQ + 64 * (t); \
            _Pragma("unroll") for (int i = 0; i < 2; ++i) { const int p = w + 8 * i; \
                kst[i] = *(const u32x4*)(Kb + (kr0 + lane) * 1024 + h * 128 + p * 8); \
                vst[i] = *(const u32x4*)(Vb + (kr0 + 16 * (p & 3) + vrow_l) * 1024 + h * 128 + 32 * (p >> 2) + 8 * vpc); } } \
        else if ((t) < 32) { const size_t kr0 = (size_t)b * PAST + 64 * (t); \
            _Pragma("unroll") for (int i = 0; i < 2; ++i) { const int p = w + 8 * i; \
                const float* kp = ck + ((kr0 + lane) * 8 + h) * 128 + p * 8; kst[i] = cvt8(*(const f32x4*)kp, *(const f32x4*)(kp + 4)); \
                const float* vp = cv + ((kr0 + 16 * (p & 3) + vrow_l) * 8 + h) * 128 + 32 * (p >> 2) + 8 * vpc; vst[i] = cvt8(*(const f32x4*)vp, *(const f32x4*)(vp + 4)); } } \
        else { const size_t kr0 = (size_t)MP + b * 16; \
            _Pragma("unroll") for (int i = 0; i < 2; ++i) { const int p = w + 8 * i; const int vr = 16 * (p & 3) + vrow_l; \
                kst[i] = (lane < 16) ? *(const u32x4*)(Kb + (kr0 + lane) * 1024 + h * 128 + p * 8) : (u32x4){0u, 0u, 0u, 0u}; \
                vst[i] = (vr < 16) ? *(const u32x4*)(Vb + (kr0 + vr) * 1024 + h * 128 + 32 * (p >> 2) + 8 * vpc) : (u32x4){0u, 0u, 0u, 0u}; } } \
    } while (0)
#define ATT_STORE(bufo) do { _Pragma("unroll") for (int i = 0; i < 2; ++i) { const int p = w + 8 * i; \
        *(LAS u32x4*)(lds + (bufo) + p * 1024 + lane * 16) = kst[i]; *(LAS u32x4*)(lds + (bufo) + 16384 + p * 1024 + lane * 16) = vst[i]; } } while (0)
    ATT_LOAD(0); ATT_STORE(0); __syncthreads();
    const int kfo = (8 * comp + hi) * 1024 + r32 * 16;
    const int vfo = 16384 + ((lane >> 4) & 1) * 32 + (lane & 3) * 8 + (4 * hi + ((lane & 15) >> 2)) * 64;
    for (int t = 0; t < NT; ++t) {
        const int bufo = (t & 1) * 32768;
        if (t + 1 < NT) ATT_LOAD(t + 1);
        if (t < my_nt) {
            f32x16 p0, p1;
#pragma unroll
            for (int r = 0; r < 16; ++r) { p0[r] = 0.f; p1[r] = 0.f; }
            const LAS unsigned char* kb = lds + bufo + kfo;
#pragma unroll
            for (int s = 0; s < 4; ++s) { const bf16x8 a0 = *(const LAS bf16x8*)(kb + s * 2048), a1 = *(const LAS bf16x8*)(kb + s * 2048 + 512);
                p0 = MFMA32(a0, qr[s], p0); p1 = MFMA32(a1, qr[s], p1); }
            if (MODE == 1 && t == 32) {
#pragma unroll
                for (int r = 0; r < 16; ++r) { if (r >= 8) p0[r] = -INFINITY; p1[r] = -INFINITY; }
            }
            float mx = fmaxf(p0[0], p1[0]);
#pragma unroll
            for (int r = 1; r < 16; ++r) mx = fmaxf(mx, fmaxf(p0[r], p1[r]));
            mx = fmaxf(mx, __shfl_xor(mx, 32));
            if (t == 0) mrow = mx;
            else if (__any(mx > mrow + 8.f)) {
                const float mn = fmaxf(mrow, mx); const float f = __builtin_amdgcn_exp2f(mrow - mn); lrow *= f; mrow = mn;
                if (hi == 0) wsf[r32] = f;
                LDS_WAIT();
#pragma unroll
                for (int r = 0; r < 16; ++r) { const float fr_ = wsf[crow(r, hi)];
#pragma unroll
                    for (int d = 0; d < 4; ++d) o[d][r] *= fr_; }
            }
            float ls = 0.f;
#pragma unroll
            for (int r = 0; r < 16; ++r) { p0[r] = __builtin_amdgcn_exp2f(p0[r] - mrow); p1[r] = __builtin_amdgcn_exp2f(p1[r] - mrow); ls += p0[r] + p1[r]; }
            lrow += ls;
            bf16x8 pw[4];
            { u32x4 x;
              x.x = pk2(p0[0], p0[1]); x.y = pk2(p0[2], p0[3]); x.z = pk2(p0[4], p0[5]); x.w = pk2(p0[6], p0[7]); pw[0] = __builtin_bit_cast(bf16x8, x);
              x.x = pk2(p0[8], p0[9]); x.y = pk2(p0[10], p0[11]); x.z = pk2(p0[12], p0[13]); x.w = pk2(p0[14], p0[15]); pw[1] = __builtin_bit_cast(bf16x8, x);
              x.x = pk2(p1[0], p1[1]); x.y = pk2(p1[2], p1[3]); x.z = pk2(p1[4], p1[5]); x.w = pk2(p1[6], p1[7]); pw[2] = __builtin_bit_cast(bf16x8, x);
              x.x = pk2(p1[8], p1[9]); x.y = pk2(p1[10], p1[11]); x.z = pk2(p1[12], p1[13]); x.w = pk2(p1[14], p1[15]); pw[3] = __builtin_bit_cast(bf16x8, x); }
            const LAS unsigned char* vb = lds + bufo + vfo;
#pragma unroll
            for (int d = 0; d < 4; ++d)
#pragma unroll
                for (int ks = 0; ks < 4; ++ks) { const s16x4 lo = tr16(vb + d * 4096 + ks * 1024), hh = tr16(vb + d * 4096 + ks * 1024 + 512);
                    o[d] = MFMA32(pw[ks], cat8(lo, hh), o[d]); }
        }
        if (t + 1 < NT) ATT_STORE(((t + 1) & 1) * 32768);
        __syncthreads();
    }
#undef ATT_LOAD
#undef ATT_STORE
    const bool active = (MODE == 0) || (rg == 0);
    if (active) {
        const float lt = lrow + __shfl_xor(lrow, 32);
        if (hi == 0) wsf[32 + r32] = lt;
        LDS_WAIT();
#pragma unroll
        for (int r = 0; r < 16; ++r) { const float il = 1.0f / wsf[32 + crow(r, hi)];
#pragma unroll
            for (int d = 0; d < 4; ++d) o[d][r] *= il; }
    }
    LAS float* X = (LAS float*)lds;
    if (active && comp == 1) {
#pragma unroll
        for (int d = 0; d < 4; ++d)
#pragma unroll
            for (int r = 0; r < 16; ++r) X[((rg * 4 + d) * 16 + r) * 64 + lane] = o[d][r];
    }
    __syncthreads();
    if (active && comp == 0) {
        float nw[4];
#pragma unroll
        for (int d = 0; d < 4; ++d) nw[d] = normw[32 * d + r32];
#pragma unroll
        for (int r = 0; r < 16; ++r) {
            float ss = 0.f;
#pragma unroll
            for (int d = 0; d < 4; ++d) { const float x = o[d][r] - lam * X[((rg * 4 + d) * 16 + r) * 64 + lane]; o[d][r] = x; ss += x * x; }
#pragma unroll
            for (int off = 1; off < 32; off <<= 1) ss += __shfl_xor(ss, off);
            const float rs = onem / sqrtf(ss * (1.0f / 128.0f) + EPS);
            const int rr = crow(r, hi);
            if (MODE == 0 || rr < 16) {
                bf16* op = O + (orow0 + rr) * 1024 + h * 128 + r32;
#pragma unroll
                for (int d = 0; d < 4; ++d) op[32 * d] = f2bf(o[d][r] * rs * nw[d]);
            }
        }
    }
    __syncthreads();
}

constexpr int G_QET = 0, G_KET = 24576, G_KDT = 49152, G_VIM = 67584, G_AM = 100352, G_TOT = 109568, G_DV = 113664, G_SSQ = 114176, G_END = 116224;
static_assert(G_END <= RING_BYTES, "gla lds");
struct GlaP { const bf16* QG; const bf16* KG; const bf16* VG; const bf16* GK; const bf16* RG; const bf16* GA; const bf16* GB; bf16* OA; const float* gnw; };

template <bool FULL, int MODE>
__device__ __forceinline__ void gla_run(LAS unsigned char* lds, const GlaP& P, size_t m0, int h, int nch, f32x16 (&S)[4], float& dsum0, float& dsum1) {
    const int tid = opaque_tid(), lane = tid & 63, w = __builtin_amdgcn_readfirstlane(tid >> 6), r32 = lane & 31, hi = lane >> 5;
    const int trq = ((lane >> 4) & 1) * 32 + (lane & 3) * 8, q4 = (lane & 15) >> 2;
    for (int ch = 0; ch < nch; ++ch) {
        const size_t mc = m0 + (size_t)ch * 64;
        {
            float b0[8], b1[8]; unsigned qv[8], kv[8];
#pragma unroll
            for (int i = 0; i < 8; ++i) {
                const bool valid = (MODE == 0) || (8 * w + i < 16);
                const size_t off = (mc + 8 * w + i) * 512 + h * 128 + 2 * lane;
                const unsigned gu = valid ? *(const unsigned*)(P.GK + off) : 0u;
                qv[i] = valid ? *(const unsigned*)(P.QG + off) : 0u; kv[i] = valid ? *(const unsigned*)(P.KG + off) : 0u;
                b0[i] = bflo(gu); b1[i] = bfhi(gu);
            }
#pragma unroll
            for (int i = 1; i < 8; ++i) { b0[i] += b0[i - 1]; b1[i] += b1[i - 1]; }
            LAS float* TOT = (LAS float*)(lds + G_TOT);
            *(LAS f32x2*)(TOT + w * 128 + 2 * lane) = (f32x2){b0[7], b1[7]};
            __syncthreads();
            float p0 = 0.f, p1 = 0.f, t0 = 0.f, t1 = 0.f;
#pragma unroll
            for (int ww = 0; ww < 8; ++ww) { const f32x2 tv = *(const LAS f32x2*)(TOT + ww * 128 + 2 * lane); if (ww < w) { p0 += tv.x; p1 += tv.y; } t0 += tv.x; t1 += tv.y; }
            u32x4 qe0, qe1, ke0, ke1, kd0, kd1;
#pragma unroll
            for (int i = 0; i < 8; i += 2) {
                float v[12];
#pragma unroll
                for (int j = 0; j < 2; ++j) {
                    const float ba = b0[i + j] + p0, bb = b1[i + j] + p1;
                    const float ea = __expf(ba), eb = __expf(bb), na = __expf(-ba), nb_ = __expf(-bb), da = __expf(t0 - ba), db = __expf(t1 - bb);
                    const float qa = bflo(qv[i + j]), qb = bfhi(qv[i + j]), ka = bflo(kv[i + j]), kb_ = bfhi(kv[i + j]);
                    v[j] = qa * ea; v[2 + j] = qb * eb; v[4 + j] = ka * na; v[6 + j] = kb_ * nb_; v[8 + j] = ka * da; v[10 + j] = kb_ * db;
                }
                qe0[i >> 1] = pk2(v[0], v[1]); qe1[i >> 1] = pk2(v[2], v[3]); ke0[i >> 1] = pk2(v[4], v[5]); ke1[i >> 1] = pk2(v[6], v[7]); kd0[i >> 1] = pk2(v[8], v[9]); kd1[i >> 1] = pk2(v[10], v[11]);
            }
            const int c0 = 2 * lane;
            *(LAS u32x4*)(lds + G_QET + c0 * 192 + w * 16) = qe0; *(LAS u32x4*)(lds + G_QET + (c0 + 1) * 192 + w * 16) = qe1;
            *(LAS u32x4*)(lds + G_KET + c0 * 192 + w * 16) = ke0; *(LAS u32x4*)(lds + G_KET + (c0 + 1) * 192 + w * 16) = ke1;
            *(LAS u32x4*)(lds + G_KDT + c0 * 144 + w * 16) = kd0; *(LAS u32x4*)(lds + G_KDT + (c0 + 1) * 144 + w * 16) = kd1;
            if (w == 0) { *(LAS f32x2*)((LAS float*)(lds + G_DV) + c0) = (f32x2){__expf(t0), __expf(t1)}; }
            dsum0 += t0; dsum1 += t1;
#pragma unroll
            for (int i = 0; i < 4; ++i) { const int s = (lane >> 2) + 16 * i; const bool valid = (MODE == 0) || (s < 16);
                const u32x4 vv = valid ? *(const u32x4*)(P.VG + (mc + s) * 1024 + h * 256 + 32 * w + 8 * (lane & 3)) : (u32x4){0u, 0u, 0u, 0u};
                *(LAS u32x4*)(lds + G_VIM + w * 4096 + s * 64 + (lane & 3) * 16) = vv; }
        }
        __syncthreads();
        f32x16 o[2];
        if (FULL) {
            if (w < 3) {
                const int tb = (w + 1) >> 1, sb = w >> 1;
                f32x16 c;
#pragma unroll
                for (int r = 0; r < 16; ++r) c[r] = 0.f;
                const int tro = trq + (8 * hi + q4) * 192;
#pragma unroll
                for (int ks = 0; ks < 8; ++ks) {
                    const LAS unsigned char* ap = lds + G_KET + tro + ks * 16 * 192 + sb * 64; const LAS unsigned char* bp = lds + G_QET + tro + ks * 16 * 192 + tb * 64;
                    c = MFMA32(cat8(tr16(ap), tr16(ap + 4 * 192)), cat8(tr16(bp), tr16(bp + 4 * 192)), c);
                }
                const int t = 32 * tb + r32;
#pragma unroll
                for (int g = 0; g < 4; ++g) { const int s0 = 32 * sb + 8 * g + 4 * hi; float x[4];
#pragma unroll
                    for (int e = 0; e < 4; ++e) x[e] = (s0 + e <= t) ? c[4 * g + e] : 0.f;
                    *(LAS u32x2*)(lds + G_AM + t * 144 + s0 * 2) = (u32x2){pk2(x[0], x[1]), pk2(x[2], x[3])}; }
            } else if (w == 3) {
#pragma unroll
                for (int g = 0; g < 4; ++g) *(LAS u32x2*)(lds + G_AM + r32 * 144 + (32 + 8 * g + 4 * hi) * 2) = (u32x2){0u, 0u};
            }
            __syncthreads();
        }
        bf16x8 vf[4];
        { const LAS unsigned char* vp = lds + G_VIM + w * 4096 + trq + (8 * hi + q4) * 64;
#pragma unroll
          for (int ss = 0; ss < 4; ++ss) vf[ss] = cat8(tr16(vp + ss * 1024), tr16(vp + ss * 1024 + 256)); }
        if (FULL) {
#pragma unroll
            for (int tb = 0; tb < 2; ++tb)
#pragma unroll
                for (int r = 0; r < 16; ++r) o[tb][r] = 0.f;
            const int trk = trq + (4 * hi + q4) * 192;
#pragma unroll
            for (int kb = 0; kb < 4; ++kb)
#pragma unroll
                for (int s2 = 0; s2 < 2; ++s2) {
                    u32x4 x; x.x = pk2(S[kb][8 * s2 + 0], S[kb][8 * s2 + 1]); x.y = pk2(S[kb][8 * s2 + 2], S[kb][8 * s2 + 3]); x.z = pk2(S[kb][8 * s2 + 4], S[kb][8 * s2 + 5]); x.w = pk2(S[kb][8 * s2 + 6], S[kb][8 * s2 + 7]);
                    const bf16x8 bS = __builtin_bit_cast(bf16x8, x);
#pragma unroll
                    for (int tb = 0; tb < 2; ++tb) { const LAS unsigned char* ap = lds + G_QET + trk + (32 * kb + 16 * s2) * 192 + tb * 64;
                        o[tb] = MFMA32(cat8(tr16(ap), tr16(ap + 8 * 192)), bS, o[tb]); }
                }
#pragma unroll
            for (int ss = 0; ss < 4; ++ss)
#pragma unroll
                for (int tb = 0; tb < 2; ++tb) { const bf16x8 a = *(const LAS bf16x8*)(lds + G_AM + (32 * tb + r32) * 144 + (16 * ss + 8 * hi) * 2);
                    o[tb] = MFMA32(a, vf[ss], o[tb]); }
        }
#pragma unroll
        for (int kb = 0; kb < 4; ++kb) {
#pragma unroll
            for (int g = 0; g < 4; ++g) { const f32x4 d4 = *(const LAS f32x4*)((LAS float*)(lds + G_DV) + 32 * kb + 8 * g + 4 * hi);
#pragma unroll
                for (int e = 0; e < 4; ++e) S[kb][4 * g + e] *= d4[e]; }
#pragma unroll
            for (int ss = 0; ss < 4; ++ss) { const bf16x8 a = *(const LAS bf16x8*)(lds + G_KDT + (32 * kb + r32) * 144 + (16 * ss + 8 * hi) * 2);
                S[kb] = MFMA32(a, vf[ss], S[kb]); }
        }
        if (FULL) {
            LAS float* SSQ = (LAS float*)(lds + G_SSQ);
#pragma unroll
            for (int tb = 0; tb < 2; ++tb)
#pragma unroll
                for (int r = 0; r < 16; ++r) { float q = o[tb][r] * o[tb][r];
#pragma unroll
                    for (int off = 1; off < 32; off <<= 1) q += __shfl_xor(q, off);
                    if (r32 == 0) SSQ[(32 * tb + crow(r, hi)) * 8 + w] = q; }
            __syncthreads();
            LAS float* OST = (LAS float*)lds;
#pragma unroll
            for (int tb = 0; tb < 2; ++tb)
#pragma unroll
                for (int r = 0; r < 16; ++r) OST[(32 * tb + crow(r, hi)) * 256 + 32 * w + r32] = o[tb][r];
            __syncthreads();
#pragma unroll 1
            for (int i = 0; i < 4; ++i) {
                const int idx = tid + 512 * i, t = idx >> 5, c8 = idx & 31;
                if (MODE == 0 || t < 16) {
                    const f32x4 sa = *(const LAS f32x4*)(SSQ + t * 8), sb2 = *(const LAS f32x4*)(SSQ + t * 8 + 4);
                    const float rstd = 1.0f / sqrtf(((sa.x + sa.y) + (sa.z + sa.w) + (sb2.x + sb2.y) + (sb2.z + sb2.w)) * (1.0f / 256.0f) + EPS);
                    const f32x4 oa4 = *(const LAS f32x4*)(OST + t * 256 + 8 * c8), ob4 = *(const LAS f32x4*)(OST + t * 256 + 8 * c8 + 4);
                    const size_t off = (mc + t) * 1024 + h * 256 + 8 * c8;
                    const u32x4 rg = *(const u32x4*)(P.RG + off), ga = *(const u32x4*)(P.GA + off), gb = *(const u32x4*)(P.GB + off), oa = *(const u32x4*)(P.OA + off);
                    const f32x4 gw0 = *(const f32x4*)(P.gnw + 8 * c8), gw1 = *(const f32x4*)(P.gnw + 8 * c8 + 4);
                    float ov[8] = {oa4.x, oa4.y, oa4.z, oa4.w, ob4.x, ob4.y, ob4.z, ob4.w}; float gwv[8] = {gw0.x, gw0.y, gw0.z, gw0.w, gw1.x, gw1.y, gw1.z, gw1.w};
                    float res[8];
#pragma unroll
                    for (int e = 0; e < 8; ++e) {
                        const unsigned ru = rg[e >> 1], gau = ga[e >> 1], gbu = gb[e >> 1], oau = oa[e >> 1];
                        const float rv = (e & 1) ? bfhi(ru) : bflo(ru), gav = (e & 1) ? bfhi(gau) : bflo(gau), gbv = (e & 1) ? bfhi(gbu) : bflo(gbu), oav = (e & 1) ? bfhi(oau) : bflo(oau);
                        const float og = ov[e] * rstd * gwv[e] * (rv * sigmoidf_(rv));
                        res[e] = sigmoidf_(gav) * oav + sigmoidf_(gbv) * og;
                    }
                    u32x4 mo; mo.x = pk2(res[0], res[1]); mo.y = pk2(res[2], res[3]); mo.z = pk2(res[4], res[5]); mo.w = pk2(res[6], res[7]);
                    *(u32x4*)(P.OA + off) = mo;
                }
            }
        }
        __syncthreads();
    }
}
__device__ __forceinline__ void gla_store_state(float* p, const f32x16 (&S)[4], int w, int r32, int hi) {
    unsigned off = (unsigned)(4 * hi * 256 + 32 * w + r32);
#pragma unroll
    for (int kb = 0; kb < 4; ++kb)
#pragma unroll
        for (int g4 = 0; g4 < 4; ++g4) {
#pragma unroll
            for (int e = 0; e < 4; ++e) p[off + e * 256] = S[kb][4 * g4 + e];
            off += 8 * 256; asm volatile("" : "+v"(off)); }
}
__device__ __forceinline__ void gla_load_state(const float* p, f32x16 (&S)[4], int w, int r32, int hi) {
    unsigned off = (unsigned)(4 * hi * 256 + 32 * w + r32);
#pragma unroll
    for (int kb = 0; kb < 4; ++kb)
#pragma unroll
        for (int g4 = 0; g4 < 4; ++g4) {
#pragma unroll
            for (int e = 0; e < 4; ++e) S[kb][4 * g4 + e] = p[off + e * 256];
            off += 8 * 256; asm volatile("" : "+v"(off)); }
}

__device__ __forceinline__ void rowpass(const float* tmp, const float* xin_p, const float* xin_s, float* xout, const float* wpost, const float* wnext, bf16* xn, int gw, int ngw, int lane) {
    for (int m = gw; m < MT; m += ngw) {
        const f32x4* tr = (const f32x4*)(tmp + (size_t)m * DM) + lane;
        const float* xrow = (m < MP) ? xin_p + (size_t)m * DM : xin_s + (size_t)(m - MP) * DM;
        const f32x4* xr = (const f32x4*)xrow + lane;
        f32x4 tv[4], xv[4]; float s = 0.f;
#pragma unroll
        for (int j = 0; j < 4; ++j) { tv[j] = tr[64 * j]; xv[j] = xr[64 * j]; s += (tv[j].x * tv[j].x + tv[j].y * tv[j].y) + (tv[j].z * tv[j].z + tv[j].w * tv[j].w); }
        const float r1 = 1.f / sqrtf(wave_sum(s) * (1.f / DM) + EPS);
        float s2 = 0.f;
#pragma unroll
        for (int j = 0; j < 4; ++j) { const f32x4 g = *((const f32x4*)wpost + lane + 64 * j); xv[j] = xv[j] + tv[j] * r1 * g; s2 += (xv[j].x * xv[j].x + xv[j].y * xv[j].y) + (xv[j].z * xv[j].z + xv[j].w * xv[j].w); }
        f32x4* orow = (f32x4*)(xout + (size_t)m * DM) + lane;
#pragma unroll
        for (int j = 0; j < 4; ++j) orow[64 * j] = xv[j];
        if (xn) {
            const float r2 = 1.f / sqrtf(wave_sum(s2) * (1.f / DM) + EPS);
            u32x2* o8 = (u32x2*)(xn + (size_t)m * DM) + lane;
#pragma unroll
            for (int j = 0; j < 4; ++j) { const f32x4 g = *((const f32x4*)wnext + lane + 64 * j); u32x2 o; o.x = pk2(xv[j].x * r2 * g.x, xv[j].y * r2 * g.y); o.y = pk2(xv[j].z * r2 * g.z, xv[j].w * r2 * g.w); o8[64 * j] = o; }
        }
    }
}
__device__ __forceinline__ float gelu_tanh(float x) {
    const float u = 0.7978845608028654f * (x + 0.044715f * x * x * x);
    const float e = __expf(2.f * u);
    const float th = 1.f - 2.f / (e + 1.f);
    return 0.5f * x * (1.f + th);
}
__device__ __forceinline__ void act_pass(const bf16* UG, bf16* ACT, const float* convw, const float* convb, const float* sconv  ,
                                         float* cout_p, float* cout_s, int vcu, int G, int tid) {
    if (tid >= DFF / 8) return;
    const int c = tid * 8;
    float w0[8], w1[8], w2[8], cb[8];
#pragma unroll
    for (int e = 0; e < 8; ++e) { w0[e] = convw[c + e]; w1[e] = convw[DFF + c + e]; w2[e] = convw[2 * DFF + c + e]; cb[e] = convb[c + e]; }
    for (int strip = vcu; strip < MT / 16; strip += G) {
        const int m0 = strip * 16; const bool sample = (m0 >= MP);
        float gm2[8], gm1[8];
        if (sample) { const int b = (m0 - MP) >> 4; const float* sc = sconv + (size_t)b * 2 * DFF + c;
#pragma unroll
            for (int e = 0; e < 8; ++e) { gm2[e] = sc[e]; gm1[e] = sc[DFF + e]; } }
        else if ((m0 & (SEQ - 1)) == 0) {
#pragma unroll
            for (int e = 0; e < 8; ++e) { gm2[e] = 0.f; gm1[e] = 0.f; } }
        else { const u32x4 a = *(const u32x4*)(UG + (size_t)(m0 - 2) * 5632 + DFF + c), bq = *(const u32x4*)(UG + (size_t)(m0 - 1) * 5632 + DFF + c);
#pragma unroll
            for (int e = 0; e < 4; ++e) { gm2[2 * e] = bflo(a[e]); gm2[2 * e + 1] = bfhi(a[e]); gm1[2 * e] = bflo(bq[e]); gm1[2 * e + 1] = bfhi(bq[e]); } }
#pragma unroll 4
        for (int i = 0; i < 16; ++i) {
            const size_t m = (size_t)m0 + i;
            const u32x4 uu = *(const u32x4*)(UG + m * 5632 + c), gg = *(const u32x4*)(UG + m * 5632 + DFF + c);
            float g0[8], res[8];
#pragma unroll
            for (int e = 0; e < 4; ++e) { g0[2 * e] = bflo(gg[e]); g0[2 * e + 1] = bfhi(gg[e]); }
#pragma unroll
            for (int e = 0; e < 8; ++e) { const float uv = (e & 1) ? bfhi(uu[e >> 1]) : bflo(uu[e >> 1]);
                const float gc = cb[e] + w0[e] * gm2[e] + w1[e] * gm1[e] + w2[e] * g0[e]; res[e] = gelu_tanh(gc) * uv; gm2[e] = gm1[e]; gm1[e] = g0[e]; }
            u32x4 o; o.x = pk2(res[0], res[1]); o.y = pk2(res[2], res[3]); o.z = pk2(res[4], res[5]); o.w = pk2(res[6], res[7]);
            *(u32x4*)(ACT + m * DFF + c) = o;
        }
        if (sample) { const int b = (m0 - MP) >> 4; float* co = cout_s + (size_t)b * 2 * DFF + c;
#pragma unroll
            for (int e = 0; e < 8; ++e) { co[e] = gm2[e]; co[DFF + e] = gm1[e]; } }
        else if ((m0 & (SEQ - 1)) == SEQ - 16) { const int b = m0 >> 13; float* co = cout_p + (size_t)b * 2 * DFF + c;
#pragma unroll
            for (int e = 0; e < 8; ++e) { co[e] = gm2[e]; co[DFF + e] = gm1[e]; } }
    }
}

__global__ void __launch_bounds__(NWAVES * 64, 2) mega_fwd(Args args) {
    extern __shared__ __attribute__((aligned(16))) unsigned char lds_raw[];
    LAS unsigned char* lds = (LAS unsigned char*)lds_raw;
    volatile LAS unsigned* MISC = (volatile LAS unsigned*)(lds + MISC_OFF);
    const int tid0 = threadIdx.x;
    const int G = gridDim.x; const int bx = blockIdx.x; const int vcu = (G % 8 == 0) ? (bx % 8) * (G / 8) + bx / 8 : bx;
    const int NGW = G * NWAVES;
    unsigned char* ws0 = args.ws;
#define OPQ() unsigned char* ws = ws0; float* out = out0; asm volatile("" : "+s"(ws), "+s"(out)); const int tid = opaque_tid(), lane = tid & 63, wave = __builtin_amdgcn_readfirstlane(tid >> 6), gw = vcu * NWAVES + wave; (void)gw; (void)lane
#define GRID_BAR() do { XcdBarrier b_ = bar; asm volatile("" : "+s"(b_.bar)); xcd_barrier(b_); } while (0)
    for (int u = tid0; u < (LDS_BYTES - MISC_OFF) / 4; u += NWAVES * 64) ((LAS unsigned*)(lds + MISC_OFF))[u] = 0u;
    __syncthreads();
    XcdBarrier bar = xcd_barrier_post((unsigned*)(ws0 + WS_CTL) + CW_BAR, MISC + 8);
    const int lo = args.ph_lo, hi_ph = args.ph_hi;
#ifndef PHMASK
#define PHMASK 0xfffff
#endif
#define IN(k) (lo <= (k) && (k) < hi_ph)
#define EN(i) ((PHMASK >> (i)) & 1)
#ifndef NOFOLD
#define NOFOLD 0
#endif
    float* const out0 = args.out;

    if (EN(0) && IN(0)) { OPQ(); bf16* const XN = (bf16*)(ws + WS_XN);
        LAS float* scr = (LAS float*)(lds + wave * 16384);
        for (int li = 0; li < DEPTH; ++li) {
            unsigned char* wl = ws + WS_W + (size_t)li * W_LAYER;
            const float* w_in = args.in[I_WIN] + (size_t)li * DM * DIN; const float* w_gk2 = args.in[I_WGK2] + (size_t)li * 16 * 512;
            const float* w_o = args.in[I_WO] + (size_t)li * DM * DM; const float* w_up = args.in[I_WUP] + (size_t)li * DM * 2 * DFF; const float* w_dn = args.in[I_WDOWN] + (size_t)li * DFF * DM;
            constexpr int IT_IN = (NIN / 32) * 16, IT_O = 32 * 16, IT_UP = (2 * DFF / 32) * 16, IT_DN = 32 * (DFF / 64);
            for (int it = gw; it < IT_IN + IT_O + IT_UP + IT_DN; it += NGW) {
                int r = it;
                if (r < IT_IN) { const int nb = r >> 4, kb = r & 15;
                    if (nb < 192) transpose_item(w_in, DIN, DM, (bf16*)(wl + W_IN), scr, kb, 32 * nb, 32 * nb, lane, nullptr);
                    else if (nb < 256) transpose_item(w_in, DIN, DM, (bf16*)(wl + W_IN), scr, kb, 32 * nb + 16, 32 * nb, lane, nullptr);
                    else transpose_item(w_in, DIN, DM, (bf16*)(wl + W_IN), scr, kb, 32 * (nb - 256), 32 * nb, lane, w_gk2);
                    continue; }
                r -= IT_IN;
                if (r < IT_O) { transpose_item(w_o, DM, DM, (bf16*)(wl + W_O), scr, r & 15, 32 * (r >> 4), 32 * (r >> 4), lane, nullptr); continue; }
                r -= IT_O;
                if (r < IT_UP) { transpose_item(w_up, 2 * DFF, DM, (bf16*)(wl + W_UP), scr, r & 15, 32 * (r >> 4), 32 * (r >> 4), lane, nullptr); continue; }
                r -= IT_UP;
                { const int nb = r / (DFF / 64), kb = r % (DFF / 64); transpose_item(w_dn, DM, DFF, (bf16*)(wl + W_DN), scr, kb, 32 * nb, 32 * nb, lane, nullptr); }
            }
        }
        for (int i = vcu * 512 + tid; i < SEQ * 8; i += G * 512) { const int pos = i >> 3, f = i & 7; float sn, cs; sincos_acc((float)pos * args.inv_freq[f], sn, cs);
            ((float*)(ws + WS_ROPE))[pos * 16 + f] = cs; ((float*)(ws + WS_ROPE))[pos * 16 + 8 + f] = sn; }
        for (int m = gw; m < MT; m += NGW) { const float* xrow = (m < MP) ? args.in[I_XP] + (size_t)m * DM : args.in[I_XS] + (size_t)(m - MP) * DM;
            rms_row_to_bf16(xrow, args.in[I_PREMIX], XN + (size_t)m * DM, lane); }
        GRID_BAR();
    }

    for (int li = 0; li < DEPTH; ++li) {
        const int pb = 1 + li * 16;
        if (EN(1) && IN(pb + 0)) { OPQ(); unsigned char* wl = ws + WS_W + (size_t)li * W_LAYER; bf16* const XN = (bf16*)(ws + WS_XN); const float* rope = (const float*)(ws + WS_ROPE);
            pg8::Gemm g{(const pg8::bf16_t*)XN, (const pg8::bf16_t*)(wl + W_IN), MT, NIN, DM}; pg8::StaticOrder S; S.init(MT, NIN, G, bx);
            EpiIn E{ws, out + O_KP + (size_t)li * MP * DM, out + O_VP + (size_t)li * MP * DM, out + O_KS + (size_t)li * MS * DM, out + O_VS + (size_t)li * MS * DM, rope, args.in[I_BGK2] + li * 512};
            pg8::gemm_phase<EpiIn, pg8::StaticOrder, true, true>(lds, g, S, E);
            GRID_BAR();
        }
        if (EN(2) && IN(pb + 1)) { OPQ(); unsigned char* wl = ws + WS_W + (size_t)li * W_LAYER; bf16* const XN = (bf16*)(ws + WS_XN); const float* rope = (const float*)(ws + WS_ROPE);
            float lam, onem;
            { const float a = wave_sum(args.in[I_LQ1][li * 64 + lane] * args.in[I_LK1][li * 64 + lane]), c = wave_sum(args.in[I_LQ2][li * 64 + lane] * args.in[I_LK2][li * 64 + lane]);
              const float lam_init = 0.8f - 0.6f * expf(-0.3f * (float)li); lam = expf(a) - expf(c) + lam_init; onem = 1.0f - lam_init; }
            const bf16* QA = (const bf16*)(ws + WS_QA); const bf16* KA = (const bf16*)(ws + WS_KA); const bf16* VA = (const bf16*)(ws + WS_VA);
            const float* nw = args.in[I_DANW] + li * 128;
            if (EN(10)) for (int un = vcu; un < DB * 8; un += G)
                attn_unit<1>(lds, QA, KA, VA, (bf16*)(ws + WS_QA), args.in[I_CK] + (size_t)li * DB * PAST * DM, args.in[I_CV] + (size_t)li * DB * PAST * DM, un >> 3, un & 7, 0, lam, onem, nw);
            if (EN(11)) for (int it = vcu; it < 256; it += G) {
                GlaP P{(const bf16*)(ws + WS_QG), (const bf16*)(ws + WS_KG), (const bf16*)(ws + WS_VG), (const bf16*)(ws + WS_GK), nullptr, nullptr, nullptr, nullptr, nullptr};
                f32x16 S[4];
#pragma unroll
                for (int kb = 0; kb < 4; ++kb)
#pragma unroll
                    for (int r = 0; r < 16; ++r) S[kb][r] = 0.f;
                float ds0 = 0.f, ds1 = 0.f;
                const int bh = it >> 3, grp = it & 7;
                gla_run<false, 0>(lds, P, (size_t)(bh >> 2) * SEQ + grp * 1024, bh & 3, 16, S, ds0, ds1);
                gla_store_state((float*)(ws + WS_SLOC) + (size_t)it * 32768, S, wave, lane & 31, lane >> 5);
                if (wave == 0) { float* dg = (float*)(ws + WS_DG) + it * 128 + 2 * lane; dg[0] = __expf(ds0); dg[1] = __expf(ds1); }
            }
            if (EN(12)) for (int pi = vcu; pi < 2048; pi += G) {
                const int bh = (pi % 256) >> 2, s = (pi & 3) + 4 * (pi / 256);
                attn_unit<0>(lds, QA, KA, VA, (bf16*)(ws + WS_QA), nullptr, nullptr, bh >> 3, bh & 7, 63 - s, lam, onem, nw);
                attn_unit<0>(lds, QA, KA, VA, (bf16*)(ws + WS_QA), nullptr, nullptr, bh >> 3, bh & 7, s, lam, onem, nw);
            }
            GRID_BAR();
        }
        if (EN(3) && IN(pb + 2)) { OPQ(); unsigned char* wl = ws + WS_W + (size_t)li * W_LAYER; bf16* const XN = (bf16*)(ws + WS_XN); const float* rope = (const float*)(ws + WS_ROPE);
            GlaP P{(const bf16*)(ws + WS_QG), (const bf16*)(ws + WS_KG), (const bf16*)(ws + WS_VG), (const bf16*)(ws + WS_GK), (const bf16*)(ws + WS_RG), (const bf16*)(ws + WS_GA), (const bf16*)(ws + WS_GB),
                   (bf16*)(ws + WS_QA), args.in[I_GLANW] + li * 256};
            const int r32 = lane & 31, hh = lane >> 5;
            if (EN(13)) for (int it = vcu; it < 256; it += G) {
                const int bh = it >> 3, grp = it & 7;
                f32x16 S[4];
#pragma unroll
                for (int kb = 0; kb < 4; ++kb)
#pragma unroll
                    for (int r = 0; r < 16; ++r) S[kb][r] = 0.f;
                for (int j = 0; j < (NOFOLD ? 0 : grp); ++j) {
                    const float* dg = (const float*)(ws + WS_DG) + (size_t)(bh * 8 + j) * 128 + 4 * hh; const float* sl = (const float*)(ws + WS_SLOC) + (size_t)(bh * 8 + j) * 32768;
                    unsigned off = (unsigned)(4 * hh * 256 + 32 * wave + r32);
#pragma unroll
                    for (int kb = 0; kb < 4; ++kb)
#pragma unroll
                        for (int g4 = 0; g4 < 4; ++g4) { const f32x4 d4 = *(const f32x4*)(dg + 32 * kb + 8 * g4);
#pragma unroll
                            for (int e = 0; e < 4; ++e) S[kb][4 * g4 + e] = S[kb][4 * g4 + e] * d4[e] + sl[off + e * 256];
                            off += 8 * 256; asm volatile("" : "+v"(off)); }
                }
                float ds0 = 0.f, ds1 = 0.f;
                gla_run<true, 0>(lds, P, (size_t)(bh >> 2) * SEQ + grp * 1024, bh & 3, 16, S, ds0, ds1);
                if (grp == 7) gla_store_state(out + O_GP + ((size_t)li * 32 + bh) * 32768, S, wave, r32, hh);
            }
            if (EN(14)) for (int it = vcu; it < DB * 4; it += G) {
                const int b = it >> 2, h = it & 3;
                const float* s0 = args.in[I_SG] + ((size_t)li * DB * 4 + it) * 32768;
                f32x16 S[4];
                gla_load_state(s0, S, wave, r32, hh);
                float ds0 = 0.f, ds1 = 0.f;
                gla_run<true, 1>(lds, P, (size_t)MP + b * 16, h, 1, S, ds0, ds1);
                gla_store_state(out + O_GS + ((size_t)li * DB * 4 + it) * 32768, S, wave, r32, hh);
            }
            GRID_BAR();
        }
        if (EN(4) && IN(pb + 3)) { OPQ(); unsigned char* wl = ws + WS_W + (size_t)li * W_LAYER; bf16* const XN = (bf16*)(ws + WS_XN); const float* rope = (const float*)(ws + WS_ROPE);
            pg8::Gemm g{(const pg8::bf16_t*)(ws + WS_QA), (const pg8::bf16_t*)(wl + W_O), MT, DM, DM}; pg8::StaticOrder S; S.init(MT, DM, G, bx);
            EpiF32 E{(float*)(ws + WS_TMP), DM};
            pg8::gemm_phase<EpiF32, pg8::StaticOrder, true, true>(lds, g, S, E);
            GRID_BAR();
        }
        if (EN(5) && IN(pb + 4)) { OPQ(); unsigned char* wl = ws + WS_W + (size_t)li * W_LAYER; bf16* const XN = (bf16*)(ws + WS_XN); const float* rope = (const float*)(ws + WS_ROPE);
            rowpass((const float*)(ws + WS_TMP), li == 0 ? args.in[I_XP] : out, li == 0 ? args.in[I_XS] : out + (size_t)MP * DM, out,
                    args.in[I_POSTMIX] + li * DM, args.in[I_PREFFN] + li * DM, XN, gw, NGW, lane);
            GRID_BAR();
        }
        if (EN(6) && IN(pb + 5)) { OPQ(); unsigned char* wl = ws + WS_W + (size_t)li * W_LAYER; bf16* const XN = (bf16*)(ws + WS_XN); const float* rope = (const float*)(ws + WS_ROPE);
            pg8::Gemm g{(const pg8::bf16_t*)XN, (const pg8::bf16_t*)(wl + W_UP), MT, 2 * DFF, DM}; pg8::StaticOrder S; S.init(MT, 2 * DFF, G, bx);
            EpiB16 E{(bf16*)(ws + WS_UG), 2 * DFF};
            pg8::gemm_phase<EpiB16, pg8::StaticOrder, true, true>(lds, g, S, E);
            GRID_BAR();
        }
        if (EN(7) && IN(pb + 6)) { OPQ(); unsigned char* wl = ws + WS_W + (size_t)li * W_LAYER; bf16* const XN = (bf16*)(ws + WS_XN); const float* rope = (const float*)(ws + WS_ROPE);
            act_pass((const bf16*)(ws + WS_UG), (bf16*)(ws + WS_ACT), args.in[I_CONVW] + (size_t)li * 3 * DFF, args.in[I_CONVB] + (size_t)li * DFF, args.in[I_SC] + (size_t)li * DB * 2 * DFF,
                     out + O_CP + (size_t)li * NB * 2 * DFF, out + O_CS + (size_t)li * DB * 2 * DFF, vcu, G, tid);
            GRID_BAR();
        }
        if (EN(8) && IN(pb + 7)) { OPQ(); unsigned char* wl = ws + WS_W + (size_t)li * W_LAYER; bf16* const XN = (bf16*)(ws + WS_XN); const float* rope = (const float*)(ws + WS_ROPE);
            pg8::Gemm g{(const pg8::bf16_t*)(ws + WS_ACT), (const pg8::bf16_t*)(wl + W_DN), MT, DM, DFF}; pg8::StaticOrder S; S.init(MT, DM, G, bx);
            EpiF32 E{(float*)(ws + WS_TMP), DM};
            pg8::gemm_phase<EpiF32, pg8::StaticOrder, true, true>(lds, g, S, E);
            GRID_BAR();
        }
        if (EN(9) && IN(pb + 8)) { OPQ(); unsigned char* wl = ws + WS_W + (size_t)li * W_LAYER; bf16* const XN = (bf16*)(ws + WS_XN); const float* rope = (const float*)(ws + WS_ROPE);
            const bool more = (li + 1 < DEPTH);
            rowpass((const float*)(ws + WS_TMP), out, out + (size_t)MP * DM, out, args.in[I_POSTFFN] + li * DM, more ? args.in[I_PREMIX] + (li + 1) * DM : nullptr, more ? XN : nullptr, gw, NGW, lane);
            if (more) GRID_BAR();
        }
    }
#undef IN
}

extern "C" void kernel_launch(void* const* d_in, const int* in_sizes, int n_in, void* d_out, int out_size, void* d_ws, size_t ws_size, hipStream_t stream) {
    static int grid = 0;
    if (grid == 0) {
        if (n_in != 24 || (size_t)out_size != O_END || ws_size < WS_END) { fprintf(stderr, "kernel_launch: unexpected shapes: n_in %d out %d (want %zu) ws %zu (want %zu)\n", n_in, out_size, (size_t)O_END, ws_size, (size_t)WS_END); grid = -1; return; }
        int dev = 0, cus = 0, per_cu = 0;
        if (hipGetDevice(&dev) != hipSuccess || hipDeviceGetAttribute(&cus, hipDeviceAttributeMultiprocessorCount, dev) != hipSuccess) { grid = -1; return; }
        if (hipFuncSetAttribute((const void*)mega_fwd, hipFuncAttributeMaxDynamicSharedMemorySize, LDS_BYTES) != hipSuccess) { fprintf(stderr, "kernel_launch: hipFuncSetAttribute failed\n"); grid = -1; return; }
        if (hipOccupancyMaxActiveBlocksPerMultiprocessor(&per_cu, (const void*)mega_fwd, NWAVES * 64, LDS_BYTES) != hipSuccess || per_cu < 1) { fprintf(stderr, "kernel_launch: occupancy query reports %d\n", per_cu); }
        (void)hipGetLastError();
        grid = cus;
    }
    if (grid < 0) return;
    if (hipMemsetAsync((char*)d_ws + WS_CTL, 0, CTL_ZERO_BYTES, stream) != hipSuccess) return;
    Args a{};
    for (int i = 0; i < 24; ++i) a.in[i] = (const float*)d_in[i];
    a.out = (float*)d_out; a.ws = (unsigned char*)d_ws;
    for (int i = 0; i < 8; ++i) a.inv_freq[i] = (float)pow(500000.0, -(double)i / 8.0);
    a.ph_lo = 0; a.ph_hi = 1000;
    hipLaunchKernelGGL(mega_fwd, dim3(grid), dim3(NWAVES * 64), LDS_BYTES, stream, a);
}
```

```cpp
#include <hip/hip_runtime.h>
#include <cstdio>
#include <cstdint>
#include <cmath>
__device__ __forceinline__ int opaque_tid() { int t = threadIdx.x; asm volatile("" : "+v"(t)); return t; }
namespace pg8 {
#define PG8_LAS __attribute__((address_space(3)))
typedef unsigned short bf16_t;
typedef short bf16x8 __attribute__((ext_vector_type(8)));
typedef float f32x4 __attribute__((ext_vector_type(4)));
typedef unsigned u32x4 __attribute__((ext_vector_type(4)));
constexpr int BM = 256, BK = 64, HALF = 128, HTB = HALF * BK * 2  , STAGE_BYTES = 8 * HTB, NXCD = 8, WGM = 8;

__host__ __device__ __forceinline__ int lds_byte(int r, int c) { const int st = (r >> 4) * 2 + (c >> 5), rr = r & 15, cc = c & 31, ob = rr * 64 + cc * 2; return st * 1024 + (ob ^ (((ob >> 9) & 1) << 5)); }
__host__ __device__ __forceinline__ void stage_rc(int b, int& R, int& C) { const int st = b / 1024, sb = b % 1024, swz = sb ^ (((sb >> 9) & 1) << 5); R = (st >> 1) * 16 + swz / 64; C = (st & 1) * 32 + (swz % 64) / 2; }
__host__ __device__ __forceinline__ int perm32(int rho) { const int n = rho >> 4, i = rho & 15; return 8 * (i >> 2) + 4 * n + (i & 3); }

struct Unit { int pm, pn; };
struct Gemm { const __attribute__((address_space(1))) bf16_t* A; const __attribute__((address_space(1))) bf16_t* Bt; int M, N, K; };

struct StaticOrder {
    int nM, nN, nwg, G, c;
    __host__ __device__ void init(int M, int N, int G_, int c_) { nM = M / BM; nN = N / BM; nwg = nM * nN; G = G_; c = c_; }
    __host__ __device__ bool next(int i, Unit& u) const {
        const long L = (long)i * G + c; if (L >= nwg) return false;
        int wgid = (int)L; { const int q = nwg / NXCD, r = nwg % NXCD, xcd = wgid % NXCD, off = wgid / NXCD; wgid = (xcd < r ? xcd * (q + 1) : r * (q + 1) + (xcd - r) * q) + off; }
        const int nig = WGM * nN, gid = wgid / nig, fm = gid * WGM, gsz = (nM - fm) < WGM ? (nM - fm) : WGM;
        u.pm = fm + ((wgid % nig) % gsz); u.pn = (wgid % nig) / gsz; return true;
    }
    __device__ __forceinline__ void a_ready(const Unit&) const {}
    __device__ __forceinline__ void done(const Unit&) const {}
};

__device__ __forceinline__ unsigned cvt_pk_bf16(float lo, float hi) { unsigned r; asm volatile("v_cvt_pk_bf16_f32 %0, %1, %2" : "=v"(r) : "v"(lo), "v"(hi)); return r; }
template <class Epi, class Sched, bool ALIGN_EPI = false, bool SP2 = false>
__device__ __forceinline__ void gemm_phase(PG8_LAS unsigned char* lds, const Gemm g, const Sched& S, const Epi& E) {
    const int tid = opaque_tid(), wid = __builtin_amdgcn_readfirstlane(tid >> 6), lane = tid & 63, wr = wid >> 2, wc = wid & 3, fr = lane & 15, fq = lane >> 4;
    const int K = g.K, nt = K / BK;
    unsigned voffA[2], voffB[2];
#pragma unroll
    for (int i = 0; i < 2; ++i) { int R, C; stage_rc(tid * 16 + i * 8192, R, C); const int Rb = Epi::PERM ? ((R & ~31) + perm32(R & 31)) : R;
        voffA[i] = (unsigned)(R * K + C) * 2u; voffB[i] = (unsigned)(Rb * K + C) * 2u; }
    const size_t kstep = (size_t)(BK * 2);
    const size_t hstep = (size_t)HALF * K * 2;
    const size_t tstep = 2 * hstep;
    const unsigned ldsw = (unsigned)wid * 1024u;
    const int aoff = lds_byte(wr * 64 + fr, fq * 8), boff = lds_byte(wc * 32 + fr, fq * 8);
#define PG8_SA(b, h) (((b) * 2 + (h)) * HTB)
#define PG8_SB(b, h) ((4 + (b) * 2 + (h)) * HTB)
#define PG8_STAGE(bufoff, gbase, voff) do { _Pragma("unroll") for (int _i = 0; _i < 2; ++_i) \
        __builtin_amdgcn_global_load_lds((const unsigned*)((const char*)(gbase) + (voff)[_i]), (PG8_LAS unsigned*)(lds + (bufoff) + ldsw + _i * 8192), 16, 0, 0); } while (0)
#define PG8_LDA(dst, b, h) do { _Pragma("unroll") for (int m = 0; m < 4; ++m) _Pragma("unroll") for (int k = 0; k < 2; ++k) dst[m][k] = *(const PG8_LAS bf16x8*)(lds + PG8_SA(b, h) + aoff + m * 2048 + k * 1024); } while (0)
#define PG8_LDB(dst, b, h) do { _Pragma("unroll") for (int n = 0; n < 2; ++n) _Pragma("unroll") for (int k = 0; k < 2; ++k) dst[n][k] = *(const PG8_LAS bf16x8*)(lds + PG8_SB(b, h) + boff + n * 2048 + k * 1024); } while (0)
#define PG8_MMA(ai, bj, At, Bt) do { __builtin_amdgcn_s_setprio(1); _Pragma("unroll") for (int m = 0; m < 4; ++m) _Pragma("unroll") for (int n = 0; n < 2; ++n) _Pragma("unroll") for (int k = 0; k < 2; ++k) \
        acc[ai][bj][m][n] = __builtin_amdgcn_mfma_f32_16x16x32_bf16(Bt[n][k], At[m][k], acc[ai][bj][m][n], 0, 0, 0); __builtin_amdgcn_s_setprio(0); } while (0)
#define PG8_WAIT_V(n) asm volatile("s_waitcnt vmcnt(" #n ")" ::: "memory")
#define PG8_WAIT_L(n) asm volatile("s_waitcnt lgkmcnt(" #n ")" ::: "memory")
#define PG8_BAR __builtin_amdgcn_s_barrier()
#define PG8_SCHED __builtin_amdgcn_sched_barrier(0)
    Unit cur, nxt; int ui = 0;
    if (!S.next(0, cur)) return;
    f32x4 acc[2][2][4][2];
#pragma unroll
    for (int a = 0; a < 2; ++a)
#pragma unroll
        for (int b = 0; b < 2; ++b)
#pragma unroll
            for (int m = 0; m < 4; ++m)
#pragma unroll
                for (int n = 0; n < 2; ++n) acc[a][b][m][n] = (f32x4){0.f, 0.f, 0.f, 0.f};
    bf16x8 At[4][2], B0[2][2], B1[2][2];
    const char* cA = (const char*)g.A + (size_t)cur.pm * tstep; const char* cB = (const char*)g.Bt + (size_t)cur.pn * tstep;
    S.a_ready(cur);
    if constexpr (SP2) {
        PG8_STAGE(PG8_SB(0, 0), cB, voffB); PG8_STAGE(PG8_SB(0, 1), cB + hstep, voffB); PG8_STAGE(PG8_SA(0, 0), cA, voffA); PG8_STAGE(PG8_SA(0, 1), cA + hstep, voffA);
        if (wr == 1) PG8_BAR;
        PG8_WAIT_V(2); PG8_BAR;
        PG8_STAGE(PG8_SB(1, 0), cB + kstep, voffB); PG8_STAGE(PG8_SA(1, 0), cA + kstep, voffA); PG8_STAGE(PG8_SB(1, 1), cB + hstep + kstep, voffB);
        PG8_WAIT_V(6); PG8_BAR;
    } else {
        PG8_STAGE(PG8_SB(0, 0), cB, voffB); PG8_STAGE(PG8_SA(0, 0), cA, voffA); PG8_STAGE(PG8_SB(0, 1), cB + hstep, voffB); PG8_STAGE(PG8_SA(0, 1), cA + hstep, voffA);
        if (wr == 1) PG8_BAR;
        PG8_WAIT_V(4); PG8_BAR;
        PG8_STAGE(PG8_SB(1, 0), cB + kstep, voffB); PG8_STAGE(PG8_SA(1, 0), cA + kstep, voffA); PG8_STAGE(PG8_SB(1, 1), cB + hstep + kstep, voffB);
        PG8_WAIT_V(6); PG8_BAR;
    }
    for (;;) {
        const bool has_next = S.next(ui + 1, nxt);
        const char* nA = has_next ? (const char*)g.A + (size_t)nxt.pm * tstep : cA; const char* nB = has_next ? (const char*)g.Bt + (size_t)nxt.pn * tstep : cB;
        for (int t = 0; t < nt; t += 2) {
            const bool last = (t == nt - 2);
            const char* a1 = cA + (size_t)(t + 1) * kstep;
            const char* a2 = last ? nA : cA + (size_t)(t + 2) * kstep; const char* b2 = last ? nB : cB + (size_t)(t + 2) * kstep;
            const char* a3 = a2 + kstep; const char* b3 = b2 + kstep;
            if (last && has_next) S.a_ready(nxt);
            if constexpr (SP2) {
            PG8_LDB(B0, 0, 0); PG8_LDB(B1, 0, 1); PG8_SCHED; PG8_LDA(At, 0, 0); PG8_STAGE(PG8_SA(1, 1), a1 + hstep, voffA);
            PG8_WAIT_V(8); PG8_WAIT_L(0); PG8_BAR; PG8_MMA(0, 0, At, B0); PG8_MMA(0, 1, At, B1); PG8_BAR; PG8_SCHED;
            PG8_LDA(At, 0, 1); PG8_STAGE(PG8_SB(0, 0), b2, voffB); PG8_STAGE(PG8_SB(0, 1), b2 + hstep, voffB); PG8_STAGE(PG8_SA(0, 0), a2, voffA);
            PG8_WAIT_V(8); PG8_WAIT_L(0); PG8_BAR; PG8_MMA(1, 0, At, B0); PG8_MMA(1, 1, At, B1); PG8_BAR; PG8_SCHED;
            PG8_LDB(B0, 1, 0); PG8_LDB(B1, 1, 1); PG8_SCHED; PG8_LDA(At, 1, 0); PG8_STAGE(PG8_SA(0, 1), a2 + hstep, voffA);
            PG8_WAIT_V(8); PG8_WAIT_L(0); PG8_BAR; PG8_MMA(0, 0, At, B0); PG8_MMA(0, 1, At, B1); PG8_BAR; PG8_SCHED;
            PG8_LDA(At, 1, 1); PG8_STAGE(PG8_SB(1, 0), b3, voffB); PG8_STAGE(PG8_SB(1, 1), b3 + hstep, voffB); PG8_STAGE(PG8_SA(1, 0), a3, voffA);
            PG8_WAIT_V(8); PG8_WAIT_L(0); PG8_BAR; PG8_MMA(1, 0, At, B0); PG8_MMA(1, 1, At, B1); PG8_BAR; PG8_SCHED;
            } else {
            PG8_LDB(B0, 0, 0); PG8_SCHED; PG8_LDA(At, 0, 0); PG8_STAGE(PG8_SA(1, 1), a1 + hstep, voffA);
            PG8_WAIT_L(8); PG8_BAR; PG8_WAIT_L(0); PG8_MMA(0, 0, At, B0); PG8_BAR; PG8_SCHED;
            PG8_LDB(B1, 0, 1); PG8_STAGE(PG8_SB(0, 0), b2, voffB);
            PG8_BAR; PG8_WAIT_L(0); PG8_MMA(0, 1, At, B1); PG8_BAR;
            PG8_LDA(At, 0, 1); PG8_STAGE(PG8_SA(0, 0), a2, voffA);
            PG8_BAR; PG8_WAIT_L(0); PG8_MMA(1, 0, At, B0); PG8_BAR; PG8_SCHED;
            PG8_STAGE(PG8_SB(0, 1), b2 + hstep, voffB);
            PG8_WAIT_V(6); PG8_BAR; PG8_MMA(1, 1, At, B1); PG8_BAR;
            PG8_LDB(B0, 1, 0); PG8_SCHED; PG8_LDA(At, 1, 0); PG8_STAGE(PG8_SA(0, 1), a2 + hstep, voffA);
            PG8_WAIT_L(8); PG8_BAR; PG8_WAIT_L(0); PG8_MMA(0, 0, At, B0); PG8_BAR; PG8_SCHED;
            PG8_LDB(B1, 1, 1); PG8_STAGE(PG8_SB(1, 0), b3, voffB);
            PG8_BAR; PG8_WAIT_L(0); PG8_MMA(0, 1, At, B1); PG8_BAR;
            PG8_LDA(At, 1, 1); PG8_STAGE(PG8_SA(1, 0), a3, voffA);
            PG8_BAR; PG8_WAIT_L(0); PG8_MMA(1, 0, At, B0); PG8_BAR; PG8_SCHED;
            PG8_STAGE(PG8_SB(1, 1), b3 + hstep, voffB);
            PG8_WAIT_V(6); PG8_BAR; PG8_MMA(1, 1, At, B1); PG8_BAR;
            }
        }
        if constexpr (ALIGN_EPI) { if (wr == 0) PG8_BAR; }
        if constexpr (!Epi::AFTER_DRAIN) { E(acc, cur, wr, wc, fr, fq); S.done(cur); }
        if (!has_next) break;
#pragma unroll
        for (int a = 0; a < 2; ++a)
#pragma unroll
            for (int b = 0; b < 2; ++b)
#pragma unroll
                for (int m = 0; m < 4; ++m)
#pragma unroll
                    for (int n = 0; n < 2; ++n) acc[a][b][m][n] = (f32x4){0.f, 0.f, 0.f, 0.f};
        cur = nxt; cA = nA; cB = nB; ++ui;
        if constexpr (ALIGN_EPI) { if (wr == 1) PG8_BAR; }
    }
    PG8_WAIT_V(0);
    if constexpr (!ALIGN_EPI) { if (wr == 0) PG8_BAR; }
    PG8_BAR;
    if constexpr (Epi::AFTER_DRAIN) { E.fused(acc, cur, wr, wc, fr, fq, lds, wid, lane); S.done(cur); }
#undef PG8_SA
#undef PG8_SB
#undef PG8_STAGE
#undef PG8_LDA
#undef PG8_LDB
#undef PG8_MMA
#undef PG8_WAIT_V
#undef PG8_WAIT_L
#undef PG8_BAR
#undef PG8_SCHED
}
}

#define GAS __attribute__((address_space(1)))
#define LAS __attribute__((address_space(3)))
typedef unsigned short bf16;
typedef short bf16x8 __attribute__((ext_vector_type(8)));
typedef short s16x4 __attribute__((ext_vector_type(4)));
typedef float f32x4 __attribute__((ext_vector_type(4)));
typedef float f32x2 __attribute__((ext_vector_type(2)));
typedef float f32x16 __attribute__((ext_vector_type(16)));
typedef unsigned u32x4 __attribute__((ext_vector_type(4)));
typedef unsigned u32x2 __attribute__((ext_vector_type(2)));

constexpr int DM = 1024, NB = 8, SEQ = 8192, DEPTH = 2, DB = 32, DL = 16, PAST = 2048;
constexpr int MP = NB * SEQ;
constexpr int MS = DB * DL;
constexpr int MT = MP + MS;
constexpr int DFF = 2816, DIN = 8208, NIN = 8704;
constexpr float EPS = 1e-6f;
constexpr float C2 = 0.125f * 1.4426950408889634f;
constexpr int NWAVES = 8;

constexpr size_t O_Y = 0;
constexpr size_t O_KP = (size_t)MT * DM;
constexpr size_t O_VP = O_KP + (size_t)DEPTH * MP * DM;
constexpr size_t O_GP = O_VP + (size_t)DEPTH * MP * DM;
constexpr size_t O_CP = O_GP + (size_t)DEPTH * NB * 4 * 128 * 256;
constexpr size_t O_KS = O_CP + (size_t)DEPTH * NB * 2 * DFF;
constexpr size_t O_VS = O_KS + (size_t)DEPTH * MS * DM;
constexpr size_t O_GS = O_VS + (size_t)DEPTH * MS * DM;
constexpr size_t O_CS = O_GS + (size_t)DEPTH * DB * 4 * 128 * 256;
constexpr size_t O_END = O_CS + (size_t)DEPTH * DB * 2 * DFF;

constexpr size_t MiB = 1u << 20, HMiB = 1u << 19;
constexpr size_t WS_CTL = 0, CTL_ZERO_BYTES = 1 * MiB;
constexpr size_t WS_ROPE = 1 * MiB;
constexpr size_t WS_DG = 1 * MiB + HMiB;
constexpr size_t WS_W = 2 * MiB;
constexpr size_t W_IN = 0, W_O = 17 * MiB, W_UP = 19 * MiB, W_DN = 30 * MiB, W_LAYER = 35 * MiB + HMiB;
constexpr size_t WS_SLOC = 74 * MiB;
constexpr size_t UB = (size_t)MT * DM * 2;
constexpr size_t WS_XN = 112 * MiB;
constexpr size_t WS_QA = WS_XN + UB, WS_KA = WS_QA + UB, WS_VA = WS_KA + UB, WS_QG = WS_VA + UB, WS_KG = WS_QG + UB / 2, WS_VG = WS_KG + UB / 2,
                 WS_RG = WS_VG + UB, WS_GK = WS_RG + UB, WS_GA = WS_GK + UB / 2, WS_GB = WS_GA + UB, WS_PEND = WS_GB + UB;
constexpr size_t WS_UG = WS_QA;
constexpr size_t WS_ACT = WS_UG + (size_t)MT * 5632 * 2;
constexpr size_t WS_TMP = WS_PEND;
constexpr size_t WS_OA = WS_TMP + 2 * UB;
constexpr size_t WS_END = WS_OA + UB;
static_assert(WS_ACT + (size_t)MT * DFF * 2 <= WS_PEND, "ws overlay");
static_assert(WS_W + 2 * W_LAYER <= WS_SLOC && WS_SLOC + 32 * MiB <= WS_XN, "ws map");
constexpr int CW_BAR = 4096;

constexpr int RING_BYTES = 131072, MISC_OFF = RING_BYTES, LDS_BYTES = 147456;

__device__ __forceinline__ float bf2f(bf16 b) { return __uint_as_float((unsigned)b << 16); }
__device__ __forceinline__ float bflo(unsigned u) { return __uint_as_float(u << 16); }
__device__ __forceinline__ float bfhi(unsigned u) { return __uint_as_float(u & 0xffff0000u); }
typedef __bf16 bf16x2_t __attribute__((ext_vector_type(2)));
__device__ __forceinline__ unsigned pk2(float lo, float hi) { f32x2 v = {lo, hi}; bf16x2_t b = __builtin_convertvector(v, bf16x2_t); return __builtin_bit_cast(unsigned, b); }
__device__ __forceinline__ bf16 f2bf(float f) { return (bf16)(pk2(f, 0.f) & 0xffffu); }
template <int M> __device__ __forceinline__ float shx(float v) { return __int_as_float(__builtin_amdgcn_ds_swizzle(__float_as_int(v), 0x1F | (M << 10))); }
__device__ __forceinline__ float sum32x(float v) { auto r = __builtin_amdgcn_permlane32_swap(__float_as_uint(v), __float_as_uint(v), false, false); return __uint_as_float(r[0]) + __uint_as_float(r[1]); }
__device__ __forceinline__ float max32x(float v) { auto r = __builtin_amdgcn_permlane32_swap(__float_as_uint(v), __float_as_uint(v), false, false); return fmaxf(__uint_as_float(r[0]), __uint_as_float(r[1])); }
__device__ __forceinline__ float half_sum(float v) { v += shx<1>(v); v += shx<2>(v); v += shx<4>(v); v += shx<8>(v); v += shx<16>(v); return v; }
__device__ __forceinline__ float wave_sum(float v) { return sum32x(half_sum(v)); }
__device__ __forceinline__ float frcp(float x) { return __builtin_amdgcn_rcpf(x); }
__device__ __forceinline__ float frsq(float x) { return __builtin_amdgcn_rsqf(x); }
__device__ __forceinline__ float sigmoidf_(float x) { return frcp(1.0f + __expf(-x)); }
#define LDS_WAIT() asm volatile("s_waitcnt lgkmcnt(0)" ::: "memory")
#define VM_WAIT() asm volatile("s_waitcnt vmcnt(0)" ::: "memory")

struct EpiIn {
    static constexpr bool PERM = true, AFTER_DRAIN = false;
    GAS unsigned char* ws; GAS float* kout_p; GAS float* vout_p; GAS float* kout_s; GAS float* vout_s; const GAS float* rope; const GAS float* bgk;
    __device__ __forceinline__ void operator()(const pg8::f32x4 (&acc)[2][2][4][2], const pg8::Unit& u, int wr, int wc, int fr, int fq) const {
        const int pn = u.pn;
        const int row0 = u.pm * 256 + wr * 64 + fr;
        const bool sample = (u.pm >= 256);
        GAS bf16* dst; int ldc, tcol; int kind;
        if (pn < 4)       { dst = (GAS bf16*)(ws + WS_QA); ldc = 1024; tcol = pn * 256; kind = 0; }
        else if (pn < 8)  { dst = (GAS bf16*)(ws + WS_KA); ldc = 1024; tcol = (pn - 4) * 256; kind = 1; }
        else if (pn < 12) { dst = (GAS bf16*)(ws + WS_VA); ldc = 1024; tcol = (pn - 8) * 256; kind = 2; }
        else if (pn < 14) { dst = (GAS bf16*)(ws + WS_QG); ldc = 512; tcol = (pn - 12) * 256; kind = 3; }
        else if (pn < 16) { dst = (GAS bf16*)(ws + WS_KG); ldc = 512; tcol = (pn - 14) * 256; kind = 4; }
        else if (pn < 20) { dst = (GAS bf16*)(ws + WS_VG); ldc = 1024; tcol = (pn - 16) * 256; kind = 4; }
        else if (pn < 24) { dst = (GAS bf16*)(ws + WS_RG); ldc = 1024; tcol = (pn - 20) * 256; kind = 4; }
        else if (pn < 28) { dst = (GAS bf16*)(ws + WS_GA); ldc = 1024; tcol = (pn - 24) * 256; kind = 4; }
        else if (pn < 32) { dst = (GAS bf16*)(ws + WS_GB); ldc = 1024; tcol = (pn - 28) * 256; kind = 4; }
        else              { dst = (GAS bf16*)(ws + WS_GK); ldc = 512; tcol = (pn - 32) * 256; kind = 5; }
        const int colw = wc * 32 + 8 * fq;
        const bool do_rope = (kind <= 1) && ((wc & 1) == 0);
#pragma unroll
        for (int ai = 0; ai < 2; ++ai)
#pragma unroll
            for (int m = 0; m < 4; ++m) {
                const int row = row0 + ai * 128 + m * 16;
                const int pos = sample ? (PAST + (row & 15)) : (row & (SEQ - 1));
                f32x4 cs0 = {1.f, 1.f, 1.f, 1.f}, cs1 = cs0, sn0 = {0.f, 0.f, 0.f, 0.f}, sn1 = sn0;
                if (do_rope) { const GAS f32x4* rp = (const GAS f32x4*)(rope + (size_t)pos * 16); cs0 = rp[0]; cs1 = rp[1]; sn0 = rp[2]; sn1 = rp[3]; }
#pragma unroll
                for (int bj = 0; bj < 2; ++bj) {
                    f32x4 v0 = acc[ai][bj][m][0], v1 = acc[ai][bj][m][1];
                    const int col = tcol + bj * 128 + colw;
                    if (do_rope) {
                        f32x4 o0, o1;
#pragma unroll
                        for (int e = 0; e < 4; ++e) { o0[e] = shx<16>(v0[e]); o1[e] = shx<16>(v1[e]); }
                        if (fq == 0) { v0 = v0 * cs0 - o0 * sn0; v1 = v1 * cs1 - o1 * sn1; }
                        else if (fq == 1) { v0 = v0 * cs0 + o0 * sn0; v1 = v1 * cs1 + o1 * sn1; }
                    }
                    if (kind == 1 || kind == 2) {
                        GAS float* fo = sample ? ((kind == 1 ? kout_s : vout_s) + (size_t)(row - MP) * 1024 + col)
                                           : ((kind == 1 ? kout_p : vout_p) + (size_t)row * 1024 + col);
                        *(GAS f32x4*)fo = v0; *(GAS f32x4*)(fo + 4) = v1;
                    }
                    if (kind == 0) { v0 = v0 * C2; v1 = v1 * C2; }
                    if (kind == 3) { v0 = v0 * 0.08838834764831845f; v1 = v1 * 0.08838834764831845f; }
                    if (kind == 5) {
                        const f32x4 b0 = *(const GAS f32x4*)(bgk + col), b1 = *(const GAS f32x4*)(bgk + col + 4);
#pragma unroll
                        for (int e = 0; e < 4; ++e) {
                            float x = v0[e] + b0[e]; v0[e] = (fminf(x, 0.f) - __logf(1.f + __expf(-fabsf(x)))) * 0.0625f;
                            x = v1[e] + b1[e];       v1[e] = (fminf(x, 0.f) - __logf(1.f + __expf(-fabsf(x)))) * 0.0625f;
                        }
                    }
                    u32x4 w; w.x = pk2(v0[0], v0[1]); w.y = pk2(v0[2], v0[3]); w.z = pk2(v1[0], v1[1]); w.w = pk2(v1[2], v1[3]);
                    *(GAS u32x4*)(dst + (size_t)row * ldc + col) = w;
                }
            }
    }
};
struct EpiF32 {
    static constexpr bool PERM = true, AFTER_DRAIN = false;
    GAS float* O; int ldc;
    __device__ __forceinline__ void operator()(const pg8::f32x4 (&acc)[2][2][4][2], const pg8::Unit& u, int wr, int wc, int fr, int fq) const {
        const int row0 = u.pm * 256 + wr * 64 + fr, col0 = u.pn * 256 + wc * 32 + 8 * fq;
#pragma unroll
        for (int ai = 0; ai < 2; ++ai)
#pragma unroll
            for (int m = 0; m < 4; ++m) { GAS float* rowp = O + (size_t)(row0 + ai * 128 + m * 16) * ldc + col0;
#pragma unroll
                for (int bj = 0; bj < 2; ++bj) { *(GAS f32x4*)(rowp + bj * 128) = acc[ai][bj][m][0]; *(GAS f32x4*)(rowp + bj * 128 + 4) = acc[ai][bj][m][1]; } }
    }
};
struct EpiB16 {
    static constexpr bool PERM = true, AFTER_DRAIN = false;
    GAS bf16* O; int ldc;
    __device__ __forceinline__ void operator()(const pg8::f32x4 (&acc)[2][2][4][2], const pg8::Unit& u, int wr, int wc, int fr, int fq) const {
        const int row0 = u.pm * 256 + wr * 64 + fr, col0 = u.pn * 256 + wc * 32 + 8 * fq;
#pragma unroll
        for (int ai = 0; ai < 2; ++ai)
#pragma unroll
            for (int m = 0; m < 4; ++m) { GAS bf16* rowp = O + (size_t)(row0 + ai * 128 + m * 16) * ldc + col0;
#pragma unroll
                for (int bj = 0; bj < 2; ++bj) { const f32x4 v0 = acc[ai][bj][m][0], v1 = acc[ai][bj][m][1];
                    u32x4 w; w.x = pk2(v0[0], v0[1]); w.y = pk2(v0[2], v0[3]); w.z = pk2(v1[0], v1[1]); w.w = pk2(v1[2], v1[3]);
                    *(GAS u32x4*)(rowp + bj * 128) = w; } }
    }
};
#define XB_TMO      128
#define XB_XCNT(j)  (256  + 64 * (j))
#define XB_XSUB(j)  (1280 + 64 * (j))
#define XB_XGEN(j)  (2304 + 64 * (j))
#define XB_TOP      3328
#define XB_TOPGEN   3392
#define XCD_BAR_WORDS 3456
#define XB_SPIN_CAP (1u << 18)

__device__ __forceinline__ unsigned xb_ld(unsigned* p)              { return __hip_atomic_load(p, __ATOMIC_RELAXED, __HIP_MEMORY_SCOPE_AGENT); }
__device__ __forceinline__ unsigned xb_add(unsigned* p, unsigned v) { return __hip_atomic_fetch_add(p, v, __ATOMIC_RELAXED, __HIP_MEMORY_SCOPE_AGENT); }
__device__ __forceinline__ unsigned xb_xcc_id() { return (unsigned)__builtin_amdgcn_s_getreg((3 << 11) | 20) & 0xFu; }
#define XB_SPIN(cond, bar) do { unsigned _sp = 0; while (cond) { __builtin_amdgcn_s_sleep(1); \
    if ((++_sp & 255u) == 0u) { if (xb_ld(&(bar)[XB_TMO])) break; if (_sp > XB_SPIN_CAP) { atomicAdd(&(bar)[XB_TMO], 1u); break; } } } } while (0)

struct XcdBarrier {
    unsigned* bar; unsigned x;
    volatile LAS unsigned* st;
};

__device__ __forceinline__ XcdBarrier xcd_barrier_post(unsigned* bar, volatile LAS unsigned* st) {
    XcdBarrier b; b.bar = bar; b.x = xb_xcc_id(); b.st = st;
    if (threadIdx.x == 0) (void)xb_add(&bar[XB_XCNT(b.x)], 1u);
    return b;
}
__device__ __forceinline__ void xcd_barrier_complete(unsigned* bar, unsigned x, unsigned& nloc, unsigned& nx) {
    const unsigned G = gridDim.x * gridDim.y * gridDim.z;
    unsigned sum, cnt, mine, sp = 0u;
    for (;;) {
        sum = 0u; cnt = 0u; mine = 0u;
#pragma unroll
        for (unsigned j = 0; j < 16; ++j) { const unsigned c = xb_ld(&bar[XB_XCNT(j)]); sum += c; cnt += (c > 0u) ? 1u : 0u; mine = (j == x) ? c : mine; }
        if (sum == G) break;
        __builtin_amdgcn_s_sleep(1);
        if ((++sp & 255u) == 0u) { if (xb_ld(&bar[XB_TMO])) break; if (sp > XB_SPIN_CAP) { atomicAdd(&bar[XB_TMO], 1u); break; } }
    }
    nloc = mine > 0u ? mine : 1u; nx = cnt > 0u ? cnt : 1u;
}

__device__ __forceinline__ void xcd_barrier(const XcdBarrier& b) {
    asm volatile("s_waitcnt vmcnt(0)" ::: "memory");
    __syncthreads();
    if (threadIdx.x == 0) {
        unsigned* bar = b.bar;
        __builtin_amdgcn_s_waitcnt(0);
        unsigned nloc = b.st[0], nx = b.st[1];
        if (nloc == 0u) { xcd_barrier_complete(bar, b.x, nloc, nx); b.st[0] = nloc; b.st[1] = nx; }
        const unsigned old = xb_add(&bar[XB_XSUB(b.x)], 1u);
        const unsigned gen = old / nloc;
        if (old + 1u == (gen + 1u) * nloc) {
            __builtin_amdgcn_fence(__ATOMIC_RELEASE, "agent");
            asm volatile("s_waitcnt vmcnt(0)" ::: "memory");
            const unsigned og = xb_add(&bar[XB_TOP], 1u);
            const unsigned tg = og / nx;
            if (og + 1u == (tg + 1u) * nx) xb_add(&bar[XB_TOPGEN], 1u);
            else XB_SPIN(xb_ld(&bar[XB_TOPGEN]) == tg, bar);
            __builtin_amdgcn_fence(__ATOMIC_ACQUIRE, "agent");
            xb_add(&bar[XB_XGEN(b.x)], 1u);
            asm volatile("s_waitcnt vmcnt(0)" ::: "memory");
        } else {
            XB_SPIN(xb_ld(&bar[XB_XGEN(b.x)]) == gen, bar);
            __builtin_amdgcn_fence(__ATOMIC_ACQUIRE, "agent");
            asm volatile("s_waitcnt vmcnt(0)" ::: "memory");
        }
    }
    __syncthreads();
}

__device__ __noinline__ void xcd_barrier_ni(unsigned* bar, unsigned x, volatile LAS unsigned* st) { XcdBarrier b; b.bar = bar; b.x = x; b.st = st; xcd_barrier(b); }

struct Args { const float* in[24]; float* out; unsigned char* ws; float inv_freq[8]; int ph_lo, ph_hi; };
enum { I_XP = 0, I_XS, I_CK, I_CV, I_SG, I_SC, I_WIN, I_WGK2, I_BGK2, I_LQ1, I_LK1, I_LQ2, I_LK2, I_DANW, I_GLANW, I_WO, I_PREMIX, I_POSTMIX, I_PREFFN, I_POSTFFN, I_WUP, I_CONVW, I_CONVB, I_WDOWN };

__device__ __forceinline__ void transpose_item(const GAS float* W, int N, int K, GAS bf16* WT, LAS float* scr, int kb, int n0_src, int n0_dst, int lane, const GAS float* wg) {
    const int k0 = 64 * kb;
    if (wg == nullptr) {
#pragma unroll 8
        for (int i = 0; i < 32; ++i) { const int kk = 2 * i + (lane >> 5); scr[kk * 33 + (lane & 31)] = W[(size_t)(k0 + kk) * N + n0_src + (lane & 31)]; }
    } else {
        float g[16];
#pragma unroll
        for (int r = 0; r < 16; ++r) g[r] = wg[r * 512 + n0_src + (lane & 31)];
        for (int i = 0; i < 32; ++i) { const int kk = 2 * i + (lane >> 5); const GAS float* lr = W + (size_t)(k0 + kk) * N + 6144; float s = 0.f;
#pragma unroll
            for (int r = 0; r < 16; ++r) s += lr[r] * g[r];
            scr[kk * 33 + (lane & 31)] = s; }
    }
    LDS_WAIT(); asm volatile("" ::: "memory");
    const int c = lane & 7;
#pragma unroll
    for (int j = 0; j < 4; ++j) { const int n = (lane >> 3) + 8 * j; const LAS float* s = scr + (8 * c) * 33 + n;
        u32x4 o; o.x = pk2(s[0 * 33], s[1 * 33]); o.y = pk2(s[2 * 33], s[3 * 33]); o.z = pk2(s[4 * 33], s[5 * 33]); o.w = pk2(s[6 * 33], s[7 * 33]);
        *(GAS u32x4*)(WT + (size_t)(n0_dst + n) * K + k0 + 8 * c) = o; }
    LDS_WAIT(); asm volatile("" ::: "memory");
}
__device__ __forceinline__ void rms_row_to_bf16(const GAS float* xrow, const GAS float* w, GAS bf16* orow, int lane) {
    const GAS f32x4* xr = (const GAS f32x4*)xrow + lane; const GAS f32x4* wr = (const GAS f32x4*)w + lane;
    f32x4 v[4]; float s = 0.f;
#pragma unroll
    for (int j = 0; j < 4; ++j) { v[j] = xr[64 * j]; s += (v[j].x * v[j].x + v[j].y * v[j].y) + (v[j].z * v[j].z + v[j].w * v[j].w); }
    const float rstd = frsq(wave_sum(s) * (1.f / DM) + EPS);
    GAS u32x2* o8 = (GAS u32x2*)orow + lane;
#pragma unroll
    for (int j = 0; j < 4; ++j) { const f32x4 g = wr[64 * j]; u32x2 o; o.x = pk2(v[j].x * rstd * g.x, v[j].y * rstd * g.y); o.y = pk2(v[j].z * rstd * g.z, v[j].w * rstd * g.w); o8[64 * j] = o; }
}
__device__ __forceinline__ void sincos_acc(float angf, float& sn, float& cs) {
    const double a = (double)angf; const double k = rint(a * 0.15915494309189535); const double r = a - k * 6.283185307179586476925;
    const double r2 = r * r; double ts = 1.0, tc = 1.0, ss = 1.0, sc = 1.0;
#pragma unroll
    for (int n = 1; n <= 13; ++n) { tc = -tc * r2 / (double)((2 * n - 1) * (2 * n)); ts = -ts * r2 / (double)((2 * n) * (2 * n + 1)); sc += tc; ss += ts; }
    sn = (float)(ss * r); cs = (float)sc;
}

#define MFMA32(a, b, c) __builtin_amdgcn_mfma_f32_32x32x16_bf16((a), (b), (c), 0, 0, 0)
__device__ __forceinline__ int crow(int r, int hi) { return (r & 3) + 8 * (r >> 2) + 4 * hi; }
__device__ __forceinline__ s16x4 tr16(const LAS unsigned char* p) { return __builtin_bit_cast(s16x4, __builtin_amdgcn_ds_read_tr16_b64_v4i16((LAS s16x4*)p)); }
__device__ __forceinline__ bf16x8 cat8(s16x4 lo, s16x4 hi) { return (bf16x8){lo[0], lo[1], lo[2], lo[3], hi[0], hi[1], hi[2], hi[3]}; }
__device__ __forceinline__ u32x4 cvt8(f32x4 a, f32x4 b) { u32x4 w; w.x = pk2(a[0], a[1]); w.y = pk2(a[2], a[3]); w.z = pk2(b[0], b[1]); w.w = pk2(b[2], b[3]); return w; }

__device__ __forceinline__ void glds16(const GAS void* gsrc, unsigned lds_dst) { unsigned keep;
    asm volatile("s_mov_b32 %0, m0\n\ts_mov_b32 m0, %2\n\ts_nop 0\n\tglobal_load_lds_dwordx4 %1, off\n\ts_mov_b32 m0, %0" : "=&s"(keep) : "v"(gsrc), "s"(lds_dst) : "memory"); }
template <int MODE>
__device__ __forceinline__ void attn_unit(LAS unsigned char* lds, const GAS bf16* Q, const GAS bf16* Kb, const GAS bf16* Vb, GAS bf16* O, const GAS float* ck, const GAS float* cv,
                                          int b, int h, int qblk, float lam, float onem, const GAS float* normw) {
    const int tid = opaque_tid(), lane = tid & 63, w = __builtin_amdgcn_readfirstlane(tid >> 6), r32 = lane & 31, hi = lane >> 5;
    const int comp = w & 1, rg = w >> 1, half = w >> 2;
    int NT, my_nt; size_t qrow, orow0;
    if (MODE == 0) { NT = 2 * qblk + 2; my_nt = 2 * qblk + 1 + half; orow0 = (size_t)b * SEQ + qblk * 128 + rg * 32; qrow = orow0 + r32; }
    else { NT = 33; my_nt = (rg == 0) ? 33 : 0; orow0 = (size_t)MP + b * 16; qrow = orow0 + (r32 < 15 ? r32 : 15); }
    bf16x8 qr[4];
    { const GAS bf16* qp = Q + qrow * 1024 + h * 128 + comp * 64 + hi * 8;
#pragma unroll
      for (int s = 0; s < 4; ++s) qr[s] = *(const GAS bf16x8*)(qp + 16 * s); }
    asm volatile("" : "+v"(qr[0]), "+v"(qr[1]), "+v"(qr[2]), "+v"(qr[3]));
    LAS float* wsf = (LAS float*)(lds + 98304) + w * 64;
    f32x16 o[4];
#pragma unroll
    for (int d = 0; d < 4; ++d)
#pragma unroll
        for (int r = 0; r < 16; ++r) o[d][r] = 0.f;
    float mrow = 0.f, lrow = 0.f;
    u32x4 kst[2], vst[2];
    bf16x8 pw[4];
#pragma unroll
    for (int k = 0; k < 4; ++k) pw[k] = (bf16x8){0, 0, 0, 0, 0, 0, 0, 0};
    const int vrow_l = lane >> 2, vpc = lane & 3;
#define ATT_LOAD(t) do { \
        if (MODE == 0) { const size_t kr0 = (size_t)b * SEQ + 64 * (t); \
            _Pragma("unroll") for (int i = 0; i < 2; ++i) { const int p = w + 8 * i; \
                kst[i] = *(const GAS u32x4*)(Kb + (kr0 + lane) * 1024 + h * 128 + p * 8); \
                vst[i] = *(const GAS u32x4*)(Vb + (kr0 + 16 * (p & 3) + vrow_l) * 1024 + h * 128 + 32 * (p >> 2) + 8 * vpc); } } \
        else if ((t) < 32) { const size_t kr0 = (size_t)b * PAST + 64 * (t); \
            _Pragma("unroll") for (int i = 0; i < 2; ++i) { const int p = w + 8 * i; \
                const GAS float* kp = ck + ((kr0 + lane) * 8 + h) * 128 + p * 8; kst[i] = cvt8(*(const GAS f32x4*)kp, *(const GAS f32x4*)(kp + 4)); \
                const GAS float* vp = cv + ((kr0 + 16 * (p & 3) + vrow_l) * 8 + h) * 128 + 32 * (p >> 2) + 8 * vpc; vst[i] = cvt8(*(const GAS f32x4*)vp, *(const GAS f32x4*)(vp + 4)); } } \
        else { const size_t kr0 = (size_t)MP + b * 16; \
            _Pragma("unroll") for (int i = 0; i < 2; ++i) { const int p = w + 8 * i; const int vr = 16 * (p & 3) + vrow_l; \
                kst[i] = (lane < 16) ? *(const GAS u32x4*)(Kb + (kr0 + lane) * 1024 + h * 128 + p * 8) : (u32x4){0u, 0u, 0u, 0u}; \
                vst[i] = (vr < 16) ? *(const GAS u32x4*)(Vb + (kr0 + vr) * 1024 + h * 128 + 32 * (p >> 2) + 8 * vpc) : (u32x4){0u, 0u, 0u, 0u}; } } \
    } while (0)
#define ATT_STORE(bufo) do { _Pragma("unroll") for (int i = 0; i < 2; ++i) { const int p = w + 8 * i; \
        *(LAS u32x4*)(lds + (bufo) + p * 1024 + lane * 16) = kst[i]; *(LAS u32x4*)(lds + (bufo) + 16384 + p * 1024 + lane * 16) = vst[i]; } } while (0)
#define ATT_X(t, bo) do { \
        f32x16 p0, p1; \
        _Pragma("unroll") for (int r = 0; r < 16; ++r) { p0[r] = 0.f; p1[r] = 0.f; } \
        const LAS unsigned char* kb_ = lds + (bo) + kfo; \
        _Pragma("unroll") for (int s = 0; s < 4; ++s) { const bf16x8 a0 = *(const LAS bf16x8*)(kb_ + s * 2048), a1 = *(const LAS bf16x8*)(kb_ + s * 2048 + 512); \
            p0 = MFMA32(a0, qr[s], p0); p1 = MFMA32(a1, qr[s], p1); } \
        if (MODE == 1 && (t) == 32) { _Pragma("unroll") for (int r = 0; r < 16; ++r) { if (r >= 8) p0[r] = -INFINITY; p1[r] = -INFINITY; } } \
        float mx = fmaxf(p0[0], p1[0]); \
        _Pragma("unroll") for (int r = 1; r < 16; ++r) mx = fmaxf(mx, fmaxf(p0[r], p1[r])); \
        mx = max32x(mx); \
        if ((t) == 0) mrow = mx; \
        else if (__any(mx > mrow + 8.f)) { \
            const float mn = fmaxf(mrow, mx); const float f = __builtin_amdgcn_exp2f(mrow - mn); lrow *= f; mrow = mn; \
            if (hi == 0) wsf[r32] = f; \
            LDS_WAIT(); \
            _Pragma("unroll") for (int r = 0; r < 16; ++r) { const float fr_ = wsf[crow(r, hi)]; \
                _Pragma("unroll") for (int d = 0; d < 4; ++d) o[d][r] *= fr_; } } \
        float ls = 0.f; \
        _Pragma("unroll") for (int r = 0; r < 16; ++r) { p0[r] = __builtin_amdgcn_exp2f(p0[r] - mrow); p1[r] = __builtin_amdgcn_exp2f(p1[r] - mrow); ls += p0[r] + p1[r]; } \
        lrow += ls; \
        { u32x4 x; \
          x.x = pk2(p0[0], p0[1]); x.y = pk2(p0[2], p0[3]); x.z = pk2(p0[4], p0[5]); x.w = pk2(p0[6], p0[7]); pw[0] = __builtin_bit_cast(bf16x8, x); \
          x.x = pk2(p0[8], p0[9]); x.y = pk2(p0[10], p0[11]); x.z = pk2(p0[12], p0[13]); x.w = pk2(p0[14], p0[15]); pw[1] = __builtin_bit_cast(bf16x8, x); \
          x.x = pk2(p1[0], p1[1]); x.y = pk2(p1[2], p1[3]); x.z = pk2(p1[4], p1[5]); x.w = pk2(p1[6], p1[7]); pw[2] = __builtin_bit_cast(bf16x8, x); \
          x.x = pk2(p1[8], p1[9]); x.y = pk2(p1[10], p1[11]); x.z = pk2(p1[12], p1[13]); x.w = pk2(p1[14], p1[15]); pw[3] = __builtin_bit_cast(bf16x8, x); } \
    } while (0)
#define ATT_Y(bo) do { const LAS unsigned char* vb_ = lds + (bo) + vfo; \
        _Pragma("unroll") for (int d = 0; d < 4; ++d) { \
            _Pragma("unroll") for (int ks = 0; ks < 4; ++ks) { const s16x4 lo_ = tr16(vb_ + d * 4096 + ks * 1024), hh_ = tr16(vb_ + d * 4096 + ks * 1024 + 512); \
                o[d] = MFMA32(pw[ks], cat8(lo_, hh_), o[d]); } \
            __builtin_amdgcn_sched_barrier(0); } } while (0)
#define ATT_DMA(t, bufo) do { const size_t kr0 = (size_t)b * SEQ + 64 * (t); \
        _Pragma("unroll") for (int i = 0; i < 2; ++i) { const int p = w + 8 * i; \
            glds16(Kb + (kr0 + lane) * 1024 + h * 128 + p * 8, (unsigned)__builtin_amdgcn_readfirstlane((int)(lds0 + (bufo) + p * 1024))); \
            glds16(Vb + (kr0 + 16 * (p & 3) + vrow_l) * 1024 + h * 128 + 32 * (p >> 2) + 8 * vpc, (unsigned)__builtin_amdgcn_readfirstlane((int)(lds0 + (bufo) + 16384 + p * 1024))); } } while (0)
    const unsigned lds0 = (unsigned)(size_t)lds;
    if (MODE == 0) { ATT_DMA(0, 0); VM_WAIT(); } else { ATT_LOAD(0); ATT_STORE(0); }
    __syncthreads();
    const int kfo = (8 * comp + hi) * 1024 + r32 * 16;
    const int vfo = 16384 + ((lane >> 4) & 1) * 32 + (lane & 3) * 8 + (4 * hi + ((lane & 15) >> 2)) * 64;
    int b_prev = 0, b_cur = 0, b_next = 32768;
    const int NI = (MODE == 0) ? NT + 1 : NT;
    for (int i = 0; i < NI; ++i) {
        if (i + 1 < NT) { if (MODE == 0) { ATT_DMA(i + 1, b_next); } else { ATT_LOAD(i + 1); } }
        if (half == 0) { if (i < my_nt) { ATT_X(i, b_cur); ATT_Y(b_cur); } }
        else if (MODE == 0) { if (i >= 1) ATT_Y(b_prev); if (i < NT) ATT_X(i, b_cur); }
        if (MODE == 1 && i + 1 < NT) ATT_STORE(b_next);
        if (MODE == 0) VM_WAIT();
        __syncthreads();
        b_prev = b_cur; b_cur = b_next; b_next = (b_next == 65536) ? 0 : b_next + 32768;
    }
#undef ATT_LOAD
#undef ATT_STORE
#undef ATT_DMA
#undef ATT_X
#undef ATT_Y
    const bool active = (MODE == 0) || (rg == 0);
    if (active) {
        const float lt = sum32x(lrow);
        if (hi == 0) wsf[32 + r32] = lt;
        LDS_WAIT();
#pragma unroll
        for (int r = 0; r < 16; ++r) { const float il = frcp(wsf[32 + crow(r, hi)]);
#pragma unroll
            for (int d = 0; d < 4; ++d) o[d][r] *= il; }
    }
    LAS float* X = (LAS float*)lds;
    if (active && comp == 1) {
#pragma unroll
        for (int d = 0; d < 4; ++d)
#pragma unroll
            for (int r = 0; r < 16; ++r) X[((rg * 4 + d) * 16 + r) * 64 + lane] = o[d][r];
    }
    __syncthreads();
    if (active && comp == 0) {
        float nw[4];
#pragma unroll
        for (int d = 0; d < 4; ++d) nw[d] = normw[32 * d + r32];
#pragma unroll
        for (int r = 0; r < 16; ++r) {
            float ss = 0.f;
#pragma unroll
            for (int d = 0; d < 4; ++d) { const float x = o[d][r] - lam * X[((rg * 4 + d) * 16 + r) * 64 + lane]; o[d][r] = x; ss += x * x; }
            ss = half_sum(ss);
            const float rs = onem * frsq(ss * (1.0f / 128.0f) + EPS);
            const int rr = crow(r, hi);
            if (MODE == 0 || rr < 16) {
                GAS bf16* op = O + (orow0 + rr) * 1024 + h * 128 + r32;
#pragma unroll
                for (int d = 0; d < 4; ++d) op[32 * d] = f2bf(o[d][r] * rs * nw[d]);
            }
        }
    }
    __syncthreads();
}

constexpr int G_QET = 0, G_KET = 24576, G_KDT = 49152, G_VIM = 67584, G_AM = 100352, G_TOT = 109568, G_DV = 113664, G_SSQ = 114176, G_END = 116224;
static_assert(G_END <= RING_BYTES, "gla lds");
struct GlaP { const GAS bf16* QG; const GAS bf16* KG; const GAS bf16* VG; const GAS bf16* GK; const GAS bf16* RG; const GAS bf16* GA; const GAS bf16* GB; const GAS bf16* OA; GAS bf16* MG; const GAS float* gnw; };

template <bool FULL, int MODE>
__device__ __forceinline__ void gla_run(LAS unsigned char* lds, const GlaP& P, size_t m0, int h, int nch, f32x16 (&S)[4], float& dsum0, float& dsum1) {
    const int tid = opaque_tid(), lane = tid & 63, w = __builtin_amdgcn_readfirstlane(tid >> 6), r32 = lane & 31, hi = lane >> 5;
    const int trq = ((lane >> 4) & 1) * 32 + (lane & 3) * 8, q4 = (lane & 15) >> 2;
    unsigned gq[8], qv[8], kv[8]; u32x4 vpre[4];
    unsigned lo_g = (unsigned)((8 * w) * 1024 + 4 * lane), lo_v = (unsigned)((lane >> 2) * 2048 + w * 64 + (lane & 3) * 16);
#define GLA_LOADS(chn) do { const size_t mcn = m0 + (size_t)(chn) * 64; asm volatile("" : "+v"(lo_g), "+v"(lo_v)); \
        const GAS char* gkb = (const GAS char*)(P.GK + mcn * 512 + h * 128); const GAS char* qgb = (const GAS char*)(P.QG + mcn * 512 + h * 128); const GAS char* kgb = (const GAS char*)(P.KG + mcn * 512 + h * 128); \
        const GAS char* vgb = (const GAS char*)(P.VG + mcn * 1024 + h * 256); \
        _Pragma("unroll") for (int i = 0; i < 8; ++i) { const bool valid = (MODE == 0) || (8 * w + i < 16); \
            gq[i] = valid ? *(const GAS unsigned*)(gkb + i * 1024 + lo_g) : 0u; if (FULL) qv[i] = valid ? *(const GAS unsigned*)(qgb + i * 1024 + lo_g) : 0u; kv[i] = valid ? *(const GAS unsigned*)(kgb + i * 1024 + lo_g) : 0u; } \
        _Pragma("unroll") for (int i = 0; i < 4; ++i) { const int s = (lane >> 2) + 16 * i; const bool valid = (MODE == 0) || (s < 16); \
            vpre[i] = valid ? *(const GAS u32x4*)(vgb + i * 32768 + lo_v) : (u32x4){0u, 0u, 0u, 0u}; } } while (0)
    GLA_LOADS(0);
    for (int ch = 0; ch < nch; ++ch) {
        const size_t mc = m0 + (size_t)ch * 64;
        {
            float b0[8], b1[8];
#pragma unroll
            for (int i = 0; i < 8; ++i) { b0[i] = bflo(gq[i]); b1[i] = bfhi(gq[i]); }
#pragma unroll
            for (int i = 1; i < 8; ++i) { b0[i] += b0[i - 1]; b1[i] += b1[i - 1]; }
            LAS float* TOT = (LAS float*)(lds + G_TOT);
            *(LAS f32x2*)(TOT + w * 128 + 2 * lane) = (f32x2){b0[7], b1[7]};
            __syncthreads();
            float p0 = 0.f, p1 = 0.f, t0 = 0.f, t1 = 0.f;
#pragma unroll
            for (int ww = 0; ww < 8; ++ww) { const f32x2 tv = *(const LAS f32x2*)(TOT + ww * 128 + 2 * lane); if (ww < w) { p0 += tv.x; p1 += tv.y; } t0 += tv.x; t1 += tv.y; }
            u32x4 qe0, qe1, ke0, ke1, kd0, kd1;
#pragma unroll
            for (int i = 0; i < 8; i += 2) {
                float v[12];
#pragma unroll
                for (int j = 0; j < 2; ++j) {
                    const float ba = b0[i + j] + p0, bb = b1[i + j] + p1;
                    const float ka = bflo(kv[i + j]), kb_ = bfhi(kv[i + j]);
                    v[8 + j] = ka * __expf(t0 - ba); v[10 + j] = kb_ * __expf(t1 - bb);
                    if (FULL) { const float qa = bflo(qv[i + j]), qb = bfhi(qv[i + j]);
                        v[j] = qa * __expf(ba); v[2 + j] = qb * __expf(bb); v[4 + j] = ka * __expf(-ba); v[6 + j] = kb_ * __expf(-bb); }
                }
                if (FULL) { qe0[i >> 1] = pk2(v[0], v[1]); qe1[i >> 1] = pk2(v[2], v[3]); ke0[i >> 1] = pk2(v[4], v[5]); ke1[i >> 1] = pk2(v[6], v[7]); }
                kd0[i >> 1] = pk2(v[8], v[9]); kd1[i >> 1] = pk2(v[10], v[11]);
            }
            const int c0 = 2 * lane;
            if (FULL) {
                *(LAS u32x4*)(lds + G_QET + c0 * 192 + w * 16) = qe0; *(LAS u32x4*)(lds + G_QET + (c0 + 1) * 192 + w * 16) = qe1;
                *(LAS u32x4*)(lds + G_KET + c0 * 192 + w * 16) = ke0; *(LAS u32x4*)(lds + G_KET + (c0 + 1) * 192 + w * 16) = ke1;
            }
            *(LAS u32x4*)(lds + G_KDT + c0 * 144 + w * 16) = kd0; *(LAS u32x4*)(lds + G_KDT + (c0 + 1) * 144 + w * 16) = kd1;
            if (w == 0) { *(LAS f32x2*)((LAS float*)(lds + G_DV) + c0) = (f32x2){__expf(t0), __expf(t1)}; }
            dsum0 += t0; dsum1 += t1;
#pragma unroll
            for (int i = 0; i < 4; ++i) { const int s = (lane >> 2) + 16 * i; *(LAS u32x4*)(lds + G_VIM + w * 4096 + s * 64 + (lane & 3) * 16) = vpre[i]; }
            if (ch + 1 < nch) GLA_LOADS(ch + 1);
        }
        asm volatile("s_waitcnt lgkmcnt(0)\n\ts_barrier" ::: "memory");
        f32x16 o[2];
        if (FULL) {
            if (w < 3) {
                const int tb = (w + 1) >> 1, sb = w >> 1;
                f32x16 c;
#pragma unroll
                for (int r = 0; r < 16; ++r) c[r] = 0.f;
                const int tro = trq + (8 * hi + q4) * 192;
#pragma unroll
                for (int ks = 0; ks < 8; ++ks) {
                    const LAS unsigned char* ap = lds + G_KET + tro + ks * 16 * 192 + sb * 64; const LAS unsigned char* bp = lds + G_QET + tro + ks * 16 * 192 + tb * 64;
                    c = MFMA32(cat8(tr16(ap), tr16(ap + 4 * 192)), cat8(tr16(bp), tr16(bp + 4 * 192)), c);
                }
                const int t = 32 * tb + r32;
#pragma unroll
                for (int g = 0; g < 4; ++g) { const int s0 = 32 * sb + 8 * g + 4 * hi; float x[4];
#pragma unroll
                    for (int e = 0; e < 4; ++e) x[e] = (s0 + e <= t) ? c[4 * g + e] : 0.f;
                    *(LAS u32x2*)(lds + G_AM + t * 144 + s0 * 2) = (u32x2){pk2(x[0], x[1]), pk2(x[2], x[3])}; }
            } else if (w == 3) {
#pragma unroll
                for (int g = 0; g < 4; ++g) *(LAS u32x2*)(lds + G_AM + r32 * 144 + (32 + 8 * g + 4 * hi) * 2) = (u32x2){0u, 0u};
            }
            asm volatile("s_waitcnt lgkmcnt(0)\n\ts_barrier" ::: "memory");
        }
        bf16x8 vf[4];
        { const LAS unsigned char* vp = lds + G_VIM + w * 4096 + trq + (8 * hi + q4) * 64;
#pragma unroll
          for (int ss = 0; ss < 4; ++ss) vf[ss] = cat8(tr16(vp + ss * 1024), tr16(vp + ss * 1024 + 256)); }
        if (FULL) {
#pragma unroll
            for (int tb = 0; tb < 2; ++tb)
#pragma unroll
                for (int r = 0; r < 16; ++r) o[tb][r] = 0.f;
            const int trk = trq + (4 * hi + q4) * 192;
#pragma unroll
            for (int kb = 0; kb < 4; ++kb)
#pragma unroll
                for (int s2 = 0; s2 < 2; ++s2) {
                    u32x4 x; x.x = pk2(S[kb][8 * s2 + 0], S[kb][8 * s2 + 1]); x.y = pk2(S[kb][8 * s2 + 2], S[kb][8 * s2 + 3]); x.z = pk2(S[kb][8 * s2 + 4], S[kb][8 * s2 + 5]); x.w = pk2(S[kb][8 * s2 + 6], S[kb][8 * s2 + 7]);
                    const bf16x8 bS = __builtin_bit_cast(bf16x8, x);
#pragma unroll
                    for (int tb = 0; tb < 2; ++tb) { const LAS unsigned char* ap = lds + G_QET + trk + (32 * kb + 16 * s2) * 192 + tb * 64;
                        o[tb] = MFMA32(cat8(tr16(ap), tr16(ap + 8 * 192)), bS, o[tb]); }
                }
#pragma unroll
            for (int ss = 0; ss < 4; ++ss)
#pragma unroll
                for (int tb = 0; tb < 2; ++tb) { const bf16x8 a = *(const LAS bf16x8*)(lds + G_AM + (32 * tb + r32) * 144 + (16 * ss + 8 * hi) * 2);
                    o[tb] = MFMA32(a, vf[ss], o[tb]); }
        }
#pragma unroll
        for (int kb = 0; kb < 4; ++kb) {
#pragma unroll
            for (int g = 0; g < 4; ++g) { const f32x4 d4 = *(const LAS f32x4*)((LAS float*)(lds + G_DV) + 32 * kb + 8 * g + 4 * hi);
#pragma unroll
                for (int e = 0; e < 4; ++e) S[kb][4 * g + e] *= d4[e]; }
#pragma unroll
            for (int ss = 0; ss < 4; ++ss) { const bf16x8 a = *(const LAS bf16x8*)(lds + G_KDT + (32 * kb + r32) * 144 + (16 * ss + 8 * hi) * 2);
                S[kb] = MFMA32(a, vf[ss], S[kb]); }
        }
        if (FULL) {
            asm volatile("s_waitcnt lgkmcnt(0)\n\ts_barrier" ::: "memory");
            LAS float* OST = (LAS float*)lds;
#pragma unroll
            for (int tb = 0; tb < 2; ++tb)
#pragma unroll
                for (int r = 0; r < 16; ++r) OST[(32 * tb + crow(r, hi)) * 256 + 32 * w + r32] = o[tb][r];
            u32x4 erg[2], ega[2], egb[2], eoa[2];
            unsigned lo_e = (unsigned)((((MODE == 0) ? (tid >> 5) : ((tid >> 5) & 15)) * 1024 + 8 * (tid & 31)) * 2);
#define GLA_ELOADS(i0) do { asm volatile("" : "+v"(lo_e)); _Pragma("unroll") for (int i = 0; i < 2; ++i) { \
                const size_t ub = ((mc + ((MODE == 0) ? 16 * ((i0) + i) : 0)) * 1024 + h * 256) * 2; \
                erg[i] = *(const GAS u32x4*)((const GAS char*)P.RG + ub + lo_e); ega[i] = *(const GAS u32x4*)((const GAS char*)P.GA + ub + lo_e); \
                egb[i] = *(const GAS u32x4*)((const GAS char*)P.GB + ub + lo_e); eoa[i] = *(const GAS u32x4*)((const GAS char*)P.OA + ub + lo_e); } } while (0)
            GLA_ELOADS(0);
            asm volatile("s_waitcnt lgkmcnt(0)\n\ts_barrier" ::: "memory");
#pragma unroll
            for (int i0 = 0; i0 < 4; i0 += 2) {
#pragma unroll
              for (int i = 0; i < 2; ++i) {
                const int idx = tid + 512 * (i0 + i), t = idx >> 5, c8 = idx & 31;
                const f32x4 oa4 = *(const LAS f32x4*)(OST + t * 256 + 8 * c8), ob4 = *(const LAS f32x4*)(OST + t * 256 + 8 * c8 + 4);
                float ssq = (oa4.x * oa4.x + oa4.y * oa4.y) + (oa4.z * oa4.z + oa4.w * oa4.w) + (ob4.x * ob4.x + ob4.y * ob4.y) + (ob4.z * ob4.z + ob4.w * ob4.w);
                ssq = half_sum(ssq);
                const float rstd = frsq(ssq * (1.0f / 256.0f) + EPS);
                if (MODE == 0 || t < 16) {
                    const size_t off = (mc + t) * 1024 + h * 256 + 8 * c8;
                    const f32x4 gw0 = *(const GAS f32x4*)(P.gnw + 8 * c8), gw1 = *(const GAS f32x4*)(P.gnw + 8 * c8 + 4);
                    float ov[8] = {oa4.x, oa4.y, oa4.z, oa4.w, ob4.x, ob4.y, ob4.z, ob4.w}; float gwv[8] = {gw0.x, gw0.y, gw0.z, gw0.w, gw1.x, gw1.y, gw1.z, gw1.w};
                    float res[8];
#pragma unroll
                    for (int e = 0; e < 8; ++e) {
                        const unsigned ru = erg[i][e >> 1], gau = ega[i][e >> 1], gbu = egb[i][e >> 1], oau = eoa[i][e >> 1];
                        const float rv = (e & 1) ? bfhi(ru) : bflo(ru), gav = (e & 1) ? bfhi(gau) : bflo(gau), gbv = (e & 1) ? bfhi(gbu) : bflo(gbu), oav = (e & 1) ? bfhi(oau) : bflo(oau);
                        const float og = ov[e] * rstd * gwv[e] * (rv * sigmoidf_(rv));
                        res[e] = sigmoidf_(gav) * oav + sigmoidf_(gbv) * og;
                    }
                    u32x4 mo; mo.x = pk2(res[0], res[1]); mo.y = pk2(res[2], res[3]); mo.z = pk2(res[4], res[5]); mo.w = pk2(res[6], res[7]);
                    *(GAS u32x4*)(P.MG + off) = mo;
                }
              }
              if (i0 == 0) { asm volatile("" ::: "memory"); GLA_ELOADS(2); }
            }
#undef GLA_ELOADS
        }
        asm volatile("s_waitcnt lgkmcnt(0)\n\ts_barrier" ::: "memory");
    }
#undef GLA_LOADS
}
__device__ __forceinline__ void gla_store_state(GAS float* p, const f32x16 (&S)[4], int w, int r32, int hi) {
    unsigned off = (unsigned)(4 * hi * 256 + 32 * w + r32);
#pragma unroll
    for (int kb = 0; kb < 4; ++kb)
#pragma unroll
        for (int g4 = 0; g4 < 4; ++g4) {
#pragma unroll
            for (int e = 0; e < 4; ++e) p[off + e * 256] = S[kb][4 * g4 + e];
            off += 8 * 256; asm volatile("" : "+v"(off)); }
}
__device__ __forceinline__ void gla_load_state(const GAS float* p, f32x16 (&S)[4], int w, int r32, int hi) {
    unsigned off = (unsigned)(4 * hi * 256 + 32 * w + r32);
#pragma unroll
    for (int kb = 0; kb < 4; ++kb)
#pragma unroll
        for (int g4 = 0; g4 < 4; ++g4) {
#pragma unroll
            for (int e = 0; e < 4; ++e) S[kb][4 * g4 + e] = p[off + e * 256];
            off += 8 * 256; asm volatile("" : "+v"(off)); }
}

__device__ __forceinline__ void rowpass(const GAS float* tmp, const GAS float* xin_p, const GAS float* xin_s, GAS float* xout, const GAS float* wpost, const GAS float* wnext, GAS bf16* xn, int gw, int ngw, int lane) {
    for (int m = gw; m < MT; m += ngw) {
        const GAS f32x4* tr = (const GAS f32x4*)(tmp + (size_t)m * DM) + lane;
        const GAS float* xrow = (m < MP) ? xin_p + (size_t)m * DM : xin_s + (size_t)(m - MP) * DM;
        const GAS f32x4* xr = (const GAS f32x4*)xrow + lane;
        f32x4 tv[4], xv[4]; float s = 0.f;
#pragma unroll
        for (int j = 0; j < 4; ++j) { tv[j] = tr[64 * j]; xv[j] = xr[64 * j]; s += (tv[j].x * tv[j].x + tv[j].y * tv[j].y) + (tv[j].z * tv[j].z + tv[j].w * tv[j].w); }
        const float r1 = frsq(wave_sum(s) * (1.f / DM) + EPS);
        float s2 = 0.f;
#pragma unroll
        for (int j = 0; j < 4; ++j) { const f32x4 g = *((const GAS f32x4*)wpost + lane + 64 * j); xv[j] = xv[j] + tv[j] * r1 * g; s2 += (xv[j].x * xv[j].x + xv[j].y * xv[j].y) + (xv[j].z * xv[j].z + xv[j].w * xv[j].w); }
        GAS f32x4* orow = (GAS f32x4*)(xout + (size_t)m * DM) + lane;
#pragma unroll
        for (int j = 0; j < 4; ++j) orow[64 * j] = xv[j];
        if (xn) {
            const float r2 = frsq(wave_sum(s2) * (1.f / DM) + EPS);
            GAS u32x2* o8 = (GAS u32x2*)(xn + (size_t)m * DM) + lane;
#pragma unroll
            for (int j = 0; j < 4; ++j) { const f32x4 g = *((const GAS f32x4*)wnext + lane + 64 * j); u32x2 o; o.x = pk2(xv[j].x * r2 * g.x, xv[j].y * r2 * g.y); o.y = pk2(xv[j].z * r2 * g.z, xv[j].w * r2 * g.w); o8[64 * j] = o; }
        }
    }
}
__device__ __forceinline__ float gelu_tanh(float x) {
    const float u = 0.7978845608028654f * (x + 0.044715f * x * x * x);
    const float e = __expf(2.f * u);
    const float th = 1.f - 2.f * frcp(e + 1.f);
    return 0.5f * x * (1.f + th);
}
__device__ __forceinline__ void act_pass(const GAS bf16* UG, GAS bf16* ACT, const GAS float* convw, const GAS float* convb, const GAS float* sconv  ,
                                         GAS float* cout_p, GAS float* cout_s, int vcu, int G, int tid) {
    if (tid >= DFF / 8) return;
    const int c = tid * 8;
    float w0[8], w1[8], w2[8], cb[8];
#pragma unroll
    for (int e = 0; e < 8; ++e) { w0[e] = convw[c + e]; w1[e] = convw[DFF + c + e]; w2[e] = convw[2 * DFF + c + e]; cb[e] = convb[c + e]; }
    for (int strip = vcu; strip < MT / 16; strip += G) {
        const int m0 = strip * 16; const bool sample = (m0 >= MP);
        float gm2[8], gm1[8];
        if (sample) { const int b = (m0 - MP) >> 4; const GAS float* sc = sconv + (size_t)b * 2 * DFF + c;
#pragma unroll
            for (int e = 0; e < 8; ++e) { gm2[e] = sc[e]; gm1[e] = sc[DFF + e]; } }
        else if ((m0 & (SEQ - 1)) == 0) {
#pragma unroll
            for (int e = 0; e < 8; ++e) { gm2[e] = 0.f; gm1[e] = 0.f; } }
        else { const u32x4 a = *(const GAS u32x4*)(UG + (size_t)(m0 - 2) * 5632 + DFF + c), bq = *(const GAS u32x4*)(UG + (size_t)(m0 - 1) * 5632 + DFF + c);
#pragma unroll
            for (int e = 0; e < 4; ++e) { gm2[2 * e] = bflo(a[e]); gm2[2 * e + 1] = bfhi(a[e]); gm1[2 * e] = bflo(bq[e]); gm1[2 * e + 1] = bfhi(bq[e]); } }
#pragma unroll 4
        for (int i = 0; i < 16; ++i) {
            const size_t m = (size_t)m0 + i;
            const u32x4 uu = *(const GAS u32x4*)(UG + m * 5632 + c), gg = *(const GAS u32x4*)(UG + m * 5632 + DFF + c);
            float g0[8], res[8];
#pragma unroll
            for (int e = 0; e < 4; ++e) { g0[2 * e] = bflo(gg[e]); g0[2 * e + 1] = bfhi(gg[e]); }
#pragma unroll
            for (int e = 0; e < 8; ++e) { const float uv = (e & 1) ? bfhi(uu[e >> 1]) : bflo(uu[e >> 1]);
                const float gc = cb[e] + w0[e] * gm2[e] + w1[e] * gm1[e] + w2[e] * g0[e]; res[e] = gelu_tanh(gc) * uv; gm2[e] = gm1[e]; gm1[e] = g0[e]; }
            u32x4 o; o.x = pk2(res[0], res[1]); o.y = pk2(res[2], res[3]); o.z = pk2(res[4], res[5]); o.w = pk2(res[6], res[7]);
            *(GAS u32x4*)(ACT + m * DFF + c) = o;
        }
        if (sample) { const int b = (m0 - MP) >> 4; GAS float* co = cout_s + (size_t)b * 2 * DFF + c;
#pragma unroll
            for (int e = 0; e < 8; ++e) { co[e] = gm2[e]; co[DFF + e] = gm1[e]; } }
        else if ((m0 & (SEQ - 1)) == SEQ - 16) { const int b = m0 >> 13; GAS float* co = cout_p + (size_t)b * 2 * DFF + c;
#pragma unroll
            for (int e = 0; e < 8; ++e) { co[e] = gm2[e]; co[DFF + e] = gm1[e]; } }
    }
}

__global__ void __launch_bounds__(NWAVES * 64, 2) mega_fwd(Args args) {
#define AIN(i) ((const GAS float*)args.in[i])
    extern __shared__ __attribute__((aligned(16))) unsigned char lds_raw[];
    LAS unsigned char* lds = (LAS unsigned char*)lds_raw;
    volatile LAS unsigned* MISC = (volatile LAS unsigned*)(lds + MISC_OFF);
    const int tid0 = threadIdx.x;
    const int G = gridDim.x; const int bx = blockIdx.x; const int vcu = (G % 8 == 0) ? (bx % 8) * (G / 8) + bx / 8 : bx;
    const int NGW = G * NWAVES;
    GAS unsigned char* ws0 = (GAS unsigned char*)args.ws;
#define OPQ() GAS unsigned char* ws = ws0; GAS float* out = out0; asm volatile("" : "+s"(ws), "+s"(out)); const int tid = opaque_tid(), lane = tid & 63, wave = __builtin_amdgcn_readfirstlane(tid >> 6), gw = vcu * NWAVES + wave; (void)gw; (void)lane
#define GRID_BAR() xcd_barrier_ni(bar.bar, bar.x, bar.st)
    for (int u = tid0; u < (LDS_BYTES - MISC_OFF) / 4; u += NWAVES * 64) ((LAS unsigned*)(lds + MISC_OFF))[u] = 0u;
    __syncthreads();
    XcdBarrier bar = xcd_barrier_post((unsigned*)args.ws + CW_BAR, MISC + 8);
    (void)args.ph_lo;
#ifndef PHMASK
#define PHMASK 0xfffff
#endif
#define IN(k) true
#define EN(i) ((PHMASK >> (i)) & 1)
#ifndef REPMASK
#define REPMASK 0
#endif
#define REP(i) ((REPMASK >> (i)) & 1)
#ifndef NOFOLD
#define NOFOLD 0
#endif
    GAS float* const out0 = (GAS float*)args.out;

    if (EN(0) && IN(0)) { OPQ(); GAS bf16* const XN = (GAS bf16*)(ws + WS_XN);
        LAS float* scr = (LAS float*)(lds + wave * 16384);
        for (int li = 0; li < DEPTH; ++li) {
            GAS unsigned char* wl = ws + WS_W + (size_t)li * W_LAYER;
            const GAS float* w_in = AIN(I_WIN) + (size_t)li * DM * DIN; const GAS float* w_gk2 = AIN(I_WGK2) + (size_t)li * 16 * 512;
            const GAS float* w_o = AIN(I_WO) + (size_t)li * DM * DM; const GAS float* w_up = AIN(I_WUP) + (size_t)li * DM * 2 * DFF; const GAS float* w_dn = AIN(I_WDOWN) + (size_t)li * DFF * DM;
            constexpr int IT_IN = (NIN / 32) * 16, IT_O = 32 * 16, IT_UP = (2 * DFF / 32) * 16, IT_DN = 32 * (DFF / 64);
            for (int it = gw; it < IT_IN + IT_O + IT_UP + IT_DN; it += NGW) {
                int r = it;
                if (r < IT_IN) { const int nb = r >> 4, kb = r & 15;
                    if (nb < 192) transpose_item(w_in, DIN, DM, (GAS bf16*)(wl + W_IN), scr, kb, 32 * nb, 32 * nb, lane, nullptr);
                    else if (nb < 256) transpose_item(w_in, DIN, DM, (GAS bf16*)(wl + W_IN), scr, kb, 32 * nb + 16, 32 * nb, lane, nullptr);
                    else transpose_item(w_in, DIN, DM, (GAS bf16*)(wl + W_IN), scr, kb, 32 * (nb - 256), 32 * nb, lane, w_gk2);
                    continue; }
                r -= IT_IN;
                if (r < IT_O) { transpose_item(w_o, DM, DM, (GAS bf16*)(wl + W_O), scr, r & 15, 32 * (r >> 4), 32 * (r >> 4), lane, nullptr); continue; }
                r -= IT_O;
                if (r < IT_UP) { transpose_item(w_up, 2 * DFF, DM, (GAS bf16*)(wl + W_UP), scr, r & 15, 32 * (r >> 4), 32 * (r >> 4), lane, nullptr); continue; }
                r -= IT_UP;
                { const int nb = r / (DFF / 64), kb = r % (DFF / 64); transpose_item(w_dn, DM, DFF, (GAS bf16*)(wl + W_DN), scr, kb, 32 * nb, 32 * nb, lane, nullptr); }
            }
        }
        for (int i = vcu * 512 + tid; i < SEQ * 8; i += G * 512) { const int pos = i >> 3, f = i & 7; float sn, cs; sincos_acc((float)pos * args.inv_freq[f], sn, cs);
            ((GAS float*)(ws + WS_ROPE))[pos * 16 + f] = cs; ((GAS float*)(ws + WS_ROPE))[pos * 16 + 8 + f] = sn; }
        for (int m = gw; m < MT; m += NGW) { const GAS float* xrow = (m < MP) ? AIN(I_XP) + (size_t)m * DM : AIN(I_XS) + (size_t)(m - MP) * DM;
            rms_row_to_bf16(xrow, AIN(I_PREMIX), XN + (size_t)m * DM, lane); }
        GRID_BAR();
    }

    for (int li = 0; li < DEPTH; ++li) {
        const int pb = 1 + li * 16;
        if (EN(1) && IN(pb + 0)) { OPQ(); GAS unsigned char* wl = ws + WS_W + (size_t)li * W_LAYER; GAS bf16* const XN = (GAS bf16*)(ws + WS_XN); const GAS float* rope = (const GAS float*)(ws + WS_ROPE);
          for (int rep = 0; rep < ((REP(1) && li == 0) ? 2 : 1); ++rep) {
            pg8::Gemm g{(const GAS pg8::bf16_t*)XN, (const GAS pg8::bf16_t*)(wl + W_IN), MT, NIN, DM}; pg8::StaticOrder S; S.init(MT, NIN, G, bx);
            EpiIn E{ws, out + O_KP + (size_t)li * MP * DM, out + O_VP + (size_t)li * MP * DM, out + O_KS + (size_t)li * MS * DM, out + O_VS + (size_t)li * MS * DM, rope, AIN(I_BGK2) + li * 512};
            pg8::gemm_phase<EpiIn, pg8::StaticOrder, true, true>(lds, g, S, E);
            GRID_BAR();
          }
        }
        if (EN(2) && IN(pb + 1)) { OPQ(); GAS unsigned char* wl = ws + WS_W + (size_t)li * W_LAYER; GAS bf16* const XN = (GAS bf16*)(ws + WS_XN); const GAS float* rope = (const GAS float*)(ws + WS_ROPE);
          for (int rep = 0; rep < ((REP(2) && li == 0) ? 2 : 1); ++rep) {
            float lam, onem;
            { const float a = wave_sum(AIN(I_LQ1)[li * 64 + lane] * AIN(I_LK1)[li * 64 + lane]), c = wave_sum(AIN(I_LQ2)[li * 64 + lane] * AIN(I_LK2)[li * 64 + lane]);
              const float lam_init = 0.8f - 0.6f * expf(-0.3f * (float)li); lam = expf(a) - expf(c) + lam_init; onem = 1.0f - lam_init; }
            const GAS bf16* QA = (const GAS bf16*)(ws + WS_QA); const GAS bf16* KA = (const GAS bf16*)(ws + WS_KA); const GAS bf16* VA = (const GAS bf16*)(ws + WS_VA);
            const GAS float* nw = AIN(I_DANW) + li * 128;
            for (int rp = 0; rp < ((REP(10) && li == 0) ? 2 : 1); ++rp)
            if (EN(10)) for (int un = vcu; un < DB * 8; un += G)
                attn_unit<1>(lds, QA, KA, VA, (GAS bf16*)(ws + WS_OA), AIN(I_CK) + (size_t)li * DB * PAST * DM, AIN(I_CV) + (size_t)li * DB * PAST * DM, un >> 3, un & 7, 0, lam, onem, nw);
            for (int rp = 0; rp < ((REP(11) && li == 0) ? 2 : 1); ++rp)
            if (EN(11)) for (int it = vcu; it < 256; it += G) {
                GlaP P{(const GAS bf16*)(ws + WS_QG), (const GAS bf16*)(ws + WS_KG), (const GAS bf16*)(ws + WS_VG), (const GAS bf16*)(ws + WS_GK), nullptr, nullptr, nullptr, nullptr, nullptr, nullptr};
                f32x16 S[4];
#pragma unroll
                for (int kb = 0; kb < 4; ++kb)
#pragma unroll
                    for (int r = 0; r < 16; ++r) S[kb][r] = 0.f;
                float ds0 = 0.f, ds1 = 0.f;
                const int bh = it >> 3, grp = it & 7;
                gla_run<false, 0>(lds, P, (size_t)(bh >> 2) * SEQ + grp * 1024, bh & 3, 16, S, ds0, ds1);
                gla_store_state((GAS float*)(ws + WS_SLOC) + (size_t)it * 32768, S, wave, lane & 31, lane >> 5);
                if (wave == 0) { GAS float* dg = (GAS float*)(ws + WS_DG) + it * 128 + 2 * lane; dg[0] = __expf(ds0); dg[1] = __expf(ds1); }
            }
            if (EN(12)) for (int pi = vcu; pi < 2048; pi += G) {
                const int bh = (pi % 256) >> 2, s = (pi & 3) + 4 * (pi / 256);
                attn_unit<0>(lds, QA, KA, VA, (GAS bf16*)(ws + WS_OA), nullptr, nullptr, bh >> 3, bh & 7, 63 - s, lam, onem, nw);
                attn_unit<0>(lds, QA, KA, VA, (GAS bf16*)(ws + WS_OA), nullptr, nullptr, bh >> 3, bh & 7, s, lam, onem, nw);
            }
            GRID_BAR();
          }
        }
        if (EN(3) && IN(pb + 2)) { OPQ(); GAS unsigned char* wl = ws + WS_W + (size_t)li * W_LAYER; GAS bf16* const XN = (GAS bf16*)(ws + WS_XN); const GAS float* rope = (const GAS float*)(ws + WS_ROPE);
          for (int rep = 0; rep < ((REP(3) && li == 0) ? 2 : 1); ++rep) {
            GlaP P{(const GAS bf16*)(ws + WS_QG), (const GAS bf16*)(ws + WS_KG), (const GAS bf16*)(ws + WS_VG), (const GAS bf16*)(ws + WS_GK), (const GAS bf16*)(ws + WS_RG), (const GAS bf16*)(ws + WS_GA), (const GAS bf16*)(ws + WS_GB),
                   (const GAS bf16*)(ws + WS_OA), (GAS bf16*)(ws + WS_QA), AIN(I_GLANW) + li * 256};
            const int r32 = lane & 31, hh = lane >> 5;
            if (EN(13)) for (int it = vcu; it < 256; it += G) {
                const int bh = it >> 3, grp = it & 7;
                f32x16 S[4];
#pragma unroll
                for (int kb = 0; kb < 4; ++kb)
#pragma unroll
                    for (int r = 0; r < 16; ++r) S[kb][r] = 0.f;
                for (int j = 0; j < (NOFOLD ? 0 : grp); ++j) {
                    const GAS float* dg = (const GAS float*)(ws + WS_DG) + (size_t)(bh * 8 + j) * 128 + 4 * hh; const GAS float* sl = (const GAS float*)(ws + WS_SLOC) + (size_t)(bh * 8 + j) * 32768;
                    unsigned off = (unsigned)(4 * hh * 256 + 32 * wave + r32);
#pragma unroll
                    for (int kb = 0; kb < 4; ++kb)
#pragma unroll
                        for (int g4 = 0; g4 < 4; ++g4) { const f32x4 d4 = *(const GAS f32x4*)(dg + 32 * kb + 8 * g4);
#pragma unroll
                            for (int e = 0; e < 4; ++e) S[kb][4 * g4 + e] = S[kb][4 * g4 + e] * d4[e] + sl[off + e * 256];
                            off += 8 * 256; asm volatile("" : "+v"(off)); }
                }
                float ds0 = 0.f, ds1 = 0.f;
                gla_run<true, 0>(lds, P, (size_t)(bh >> 2) * SEQ + grp * 1024, bh & 3, 16, S, ds0, ds1);
                if (grp == 7) gla_store_state(out + O_GP + ((size_t)li * 32 + bh) * 32768, S, wave, r32, hh);
            }
            if (EN(14)) for (int it = vcu; it < DB * 4; it += G) {
                const int b = it >> 2, h = it & 3;
                const GAS float* s0 = AIN(I_SG) + ((size_t)li * DB * 4 + it) * 32768;
                f32x16 S[4];
                gla_load_state(s0, S, wave, r32, hh);
                float ds0 = 0.f, ds1 = 0.f;
                gla_run<true, 1>(lds, P, (size_t)MP + b * 16, h, 1, S, ds0, ds1);
                gla_store_state(out + O_GS + ((size_t)li * DB * 4 + it) * 32768, S, wave, r32, hh);
            }
            GRID_BAR();
          }
        }
        if (EN(4) && IN(pb + 3)) { OPQ(); GAS unsigned char* wl = ws + WS_W + (size_t)li * W_LAYER; GAS bf16* const XN = (GAS bf16*)(ws + WS_XN); const GAS float* rope = (const GAS float*)(ws + WS_ROPE);
          for (int rep = 0; rep < ((REP(4) && li == 0) ? 2 : 1); ++rep) {
            pg8::Gemm g{(const GAS pg8::bf16_t*)(ws + WS_QA), (const GAS pg8::bf16_t*)(wl + W_O), MT, DM, DM}; pg8::StaticOrder S; S.init(MT, DM, G, bx);
            EpiF32 E{(GAS float*)(ws + WS_TMP), DM};
            pg8::gemm_phase<EpiF32, pg8::StaticOrder, true, true>(lds, g, S, E);
            GRID_BAR();
          }
        }
        if (EN(5) && IN(pb + 4)) { OPQ(); GAS unsigned char* wl = ws + WS_W + (size_t)li * W_LAYER; GAS bf16* const XN = (GAS bf16*)(ws + WS_XN); const GAS float* rope = (const GAS float*)(ws + WS_ROPE);
          for (int rep = 0; rep < ((REP(5) && li == 0) ? 2 : 1); ++rep) {
            rowpass((const GAS float*)(ws + WS_TMP), li == 0 ? AIN(I_XP) : out, li == 0 ? AIN(I_XS) : out + (size_t)MP * DM, out,
                    AIN(I_POSTMIX) + li * DM, AIN(I_PREFFN) + li * DM, XN, gw, NGW, lane);
            GRID_BAR();
          }
        }
        if (EN(6) && IN(pb + 5)) { OPQ(); GAS unsigned char* wl = ws + WS_W + (size_t)li * W_LAYER; GAS bf16* const XN = (GAS bf16*)(ws + WS_XN); const GAS float* rope = (const GAS float*)(ws + WS_ROPE);
          for (int rep = 0; rep < ((REP(6) && li == 0) ? 2 : 1); ++rep) {
            pg8::Gemm g{(const GAS pg8::bf16_t*)XN, (const GAS pg8::bf16_t*)(wl + W_UP), MT, 2 * DFF, DM}; pg8::StaticOrder S; S.init(MT, 2 * DFF, G, bx);
            EpiB16 E{(GAS bf16*)(ws + WS_UG), 2 * DFF};
            pg8::gemm_phase<EpiB16, pg8::StaticOrder, true, true>(lds, g, S, E);
            GRID_BAR();
          }
        }
        if (EN(7) && IN(pb + 6)) { OPQ(); GAS unsigned char* wl = ws + WS_W + (size_t)li * W_LAYER; GAS bf16* const XN = (GAS bf16*)(ws + WS_XN); const GAS float* rope = (const GAS float*)(ws + WS_ROPE);
          for (int rep = 0; rep < ((REP(7) && li == 0) ? 2 : 1); ++rep) {
            act_pass((const GAS bf16*)(ws + WS_UG), (GAS bf16*)(ws + WS_ACT), AIN(I_CONVW) + (size_t)li * 3 * DFF, AIN(I_CONVB) + (size_t)li * DFF, AIN(I_SC) + (size_t)li * DB * 2 * DFF,
                     out + O_CP + (size_t)li * NB * 2 * DFF, out + O_CS + (size_t)li * DB * 2 * DFF, vcu, G, tid);
            GRID_BAR();
          }
        }
        if (EN(8) && IN(pb + 7)) { OPQ(); GAS unsigned char* wl = ws + WS_W + (size_t)li * W_LAYER; GAS bf16* const XN = (GAS bf16*)(ws + WS_XN); const GAS float* rope = (const GAS float*)(ws + WS_ROPE);
          for (int rep = 0; rep < ((REP(8) && li == 0) ? 2 : 1); ++rep) {
            pg8::Gemm g{(const GAS pg8::bf16_t*)(ws + WS_ACT), (const GAS pg8::bf16_t*)(wl + W_DN), MT, DM, DFF}; pg8::StaticOrder S; S.init(MT, DM, G, bx);
            EpiF32 E{(GAS float*)(ws + WS_TMP), DM};
            pg8::gemm_phase<EpiF32, pg8::StaticOrder, true, true>(lds, g, S, E);
            GRID_BAR();
          }
        }
        if (EN(9) && IN(pb + 8)) { OPQ(); GAS unsigned char* wl = ws + WS_W + (size_t)li * W_LAYER; GAS bf16* const XN = (GAS bf16*)(ws + WS_XN); const GAS float* rope = (const GAS float*)(ws + WS_ROPE);
            const bool more = (li + 1 < DEPTH);
            rowpass((const GAS float*)(ws + WS_TMP), out, out + (size_t)MP * DM, out, AIN(I_POSTFFN) + li * DM, more ? AIN(I_PREMIX) + (li + 1) * DM : nullptr, more ? XN : nullptr, gw, NGW, lane);
            if (more) GRID_BAR();
        }
    }
#undef IN
}

extern "C" void kernel_launch(void* const* d_in, const int* in_sizes, int n_in, void* d_out, int out_size, void* d_ws, size_t ws_size, hipStream_t stream) {
    static int grid = 0;
    if (grid == 0) {
        if (n_in != 24 || (size_t)out_size != O_END || ws_size < WS_END) { fprintf(stderr, "kernel_launch: unexpected shapes: n_in %d out %d (want %zu) ws %zu (want %zu)\n", n_in, out_size, (size_t)O_END, ws_size, (size_t)WS_END); grid = -1; return; }
        int dev = 0, cus = 0, per_cu = 0;
        if (hipGetDevice(&dev) != hipSuccess || hipDeviceGetAttribute(&cus, hipDeviceAttributeMultiprocessorCount, dev) != hipSuccess) { grid = -1; return; }
        if (hipFuncSetAttribute((const void*)mega_fwd, hipFuncAttributeMaxDynamicSharedMemorySize, LDS_BYTES) != hipSuccess) { fprintf(stderr, "kernel_launch: hipFuncSetAttribute failed\n"); grid = -1; return; }
        if (hipOccupancyMaxActiveBlocksPerMultiprocessor(&per_cu, (const void*)mega_fwd, NWAVES * 64, LDS_BYTES) != hipSuccess || per_cu < 1) { fprintf(stderr, "kernel_launch: occupancy query reports %d\n", per_cu); }
        (void)hipGetLastError();
        grid = cus;
    }
    if (grid < 0) return;
    if (hipMemsetAsync((char*)d_ws + WS_CTL, 0, CTL_ZERO_BYTES, stream) != hipSuccess) return;
    Args a{};
    for (int i = 0; i < 24; ++i) a.in[i] = (const float*)d_in[i];
    a.out = (float*)d_out; a.ws = (unsigned char*)d_ws;
    for (int i = 0; i < 8; ++i) a.inv_freq[i] = (float)pow(500000.0, -(double)i / 8.0);
    a.ph_lo = 0; a.ph_hi = 1000;
    hipLaunchKernelGGL(mega_fwd, dim3(grid), dim3(NWAVES * 64), LDS_BYTES, stream, a);
}
```

```cpp
#include <hip/hip_runtime.h>
#include <cstdio>
#include <cstdint>
#include <cmath>
__device__ __forceinline__ int opaque_tid() { int t = threadIdx.x; asm volatile("" : "+v"(t)); return t; }
namespace pg8 {
#define PG8_LAS __attribute__((address_space(3)))
typedef unsigned short bf16_t;
typedef short bf16x8 __attribute__((ext_vector_type(8)));
typedef float f32x4 __attribute__((ext_vector_type(4)));
typedef unsigned u32x4 __attribute__((ext_vector_type(4)));
constexpr int BM = 256, BK = 64, HALF = 128, HTB = HALF * BK * 2  , STAGE_BYTES = 8 * HTB, NXCD = 8, WGM = 8;

__host__ __device__ __forceinline__ int lds_byte(int r, int c) { const int st = (r >> 4) * 2 + (c >> 5), rr = r & 15, cc = c & 31, ob = rr * 64 + cc * 2; return st * 1024 + (ob ^ (((ob >> 9) & 1) << 5)); }
__host__ __device__ __forceinline__ void stage_rc(int b, int& R, int& C) { const int st = b / 1024, sb = b % 1024, swz = sb ^ (((sb >> 9) & 1) << 5); R = (st >> 1) * 16 + swz / 64; C = (st & 1) * 32 + (swz % 64) / 2; }
__host__ __device__ __forceinline__ int perm32(int rho) { const int n = rho >> 4, i = rho & 15; return 8 * (i >> 2) + 4 * n + (i & 3); }

struct Unit { int pm, pn; };
struct Gemm { const __attribute__((address_space(1))) bf16_t* A; const __attribute__((address_space(1))) bf16_t* Bt; int M, N, K; };

struct StaticOrder {
    int nM, nN, nwg, G, c;
    __host__ __device__ void init(int M, int N, int G_, int c_) { nM = M / BM; nN = N / BM; nwg = nM * nN; G = G_; c = c_; }
    __host__ __device__ bool next(int i, Unit& u) const {
        const long L = (long)i * G + c; if (L >= nwg) return false;
        int wgid = (int)L; { const int q = nwg / NXCD, r = nwg % NXCD, xcd = wgid % NXCD, off = wgid / NXCD; wgid = (xcd < r ? xcd * (q + 1) : r * (q + 1) + (xcd - r) * q) + off; }
        const int nig = WGM * nN, gid = wgid / nig, fm = gid * WGM, gsz = (nM - fm) < WGM ? (nM - fm) : WGM;
        u.pm = fm + ((wgid % nig) % gsz); u.pn = (wgid % nig) / gsz; return true;
    }
    __device__ __forceinline__ void a_ready(const Unit&) const {}
    __device__ __forceinline__ void done(const Unit&) const {}
};

__device__ __forceinline__ unsigned cvt_pk_bf16(float lo, float hi) { unsigned r; asm volatile("v_cvt_pk_bf16_f32 %0, %1, %2" : "=v"(r) : "v"(lo), "v"(hi)); return r; }
template <class Epi, class Sched, bool ALIGN_EPI = false, bool SP2 = false>
__device__ __forceinline__ void gemm_phase(PG8_LAS unsigned char* lds, const Gemm g, const Sched& S, const Epi& E) {
    const int tid = opaque_tid(), wid = __builtin_amdgcn_readfirstlane(tid >> 6), lane = tid & 63, wr = wid >> 2, wc = wid & 3, fr = lane & 15, fq = lane >> 4;
    const int K = g.K, nt = K / BK;
    unsigned voffA[2], voffB[2];
#pragma unroll
    for (int i = 0; i < 2; ++i) { int R, C; stage_rc(tid * 16 + i * 8192, R, C); const int Rb = Epi::PERM ? ((R & ~31) + perm32(R & 31)) : R;
        voffA[i] = (unsigned)(R * K + C) * 2u; voffB[i] = (unsigned)(Rb * K + C) * 2u; }
    const size_t kstep = (size_t)(BK * 2);
    const size_t hstep = (size_t)HALF * K * 2;
    const size_t tstep = 2 * hstep;
    const unsigned ldsw = (unsigned)wid * 1024u;
    const int aoff = lds_byte(wr * 64 + fr, fq * 8), boff = lds_byte(wc * 32 + fr, fq * 8);
#define PG8_SA(b, h) (((b) * 2 + (h)) * HTB)
#define PG8_SB(b, h) ((4 + (b) * 2 + (h)) * HTB)
#define PG8_STAGE(bufoff, gbase, voff) do { _Pragma("unroll") for (int _i = 0; _i < 2; ++_i) \
        __builtin_amdgcn_global_load_lds((const unsigned*)((const char*)(gbase) + (voff)[_i]), (PG8_LAS unsigned*)(lds + (bufoff) + ldsw + _i * 8192), 16, 0, 0); } while (0)
#define PG8_LDA(dst, b, h) do { _Pragma("unroll") for (int m = 0; m < 4; ++m) _Pragma("unroll") for (int k = 0; k < 2; ++k) dst[m][k] = *(const PG8_LAS bf16x8*)(lds + PG8_SA(b, h) + aoff + m * 2048 + k * 1024); } while (0)
#define PG8_LDB(dst, b, h) do { _Pragma("unroll") for (int n = 0; n < 2; ++n) _Pragma("unroll") for (int k = 0; k < 2; ++k) dst[n][k] = *(const PG8_LAS bf16x8*)(lds + PG8_SB(b, h) + boff + n * 2048 + k * 1024); } while (0)
#define PG8_MMA(ai, bj, At, Bt) do { __builtin_amdgcn_s_setprio(1); _Pragma("unroll") for (int m = 0; m < 4; ++m) _Pragma("unroll") for (int n = 0; n < 2; ++n) _Pragma("unroll") for (int k = 0; k < 2; ++k) \
        acc[ai][bj][m][n] = __builtin_amdgcn_mfma_f32_16x16x32_bf16(Bt[n][k], At[m][k], acc[ai][bj][m][n], 0, 0, 0); __builtin_amdgcn_s_setprio(0); } while (0)
#define PG8_WAIT_V(n) asm volatile("s_waitcnt vmcnt(" #n ")" ::: "memory")
#define PG8_WAIT_L(n) asm volatile("s_waitcnt lgkmcnt(" #n ")" ::: "memory")
#define PG8_BAR __builtin_amdgcn_s_barrier()
#define PG8_SCHED __builtin_amdgcn_sched_barrier(0)
    Unit cur, nxt; int ui = 0;
    if (!S.next(0, cur)) return;
    f32x4 acc[2][2][4][2];
#pragma unroll
    for (int a = 0; a < 2; ++a)
#pragma unroll
        for (int b = 0; b < 2; ++b)
#pragma unroll
            for (int m = 0; m < 4; ++m)
#pragma unroll
                for (int n = 0; n < 2; ++n) acc[a][b][m][n] = (f32x4){0.f, 0.f, 0.f, 0.f};
    bf16x8 At[4][2], B0[2][2], B1[2][2];
    const char* cA = (const char*)g.A + (size_t)cur.pm * tstep; const char* cB = (const char*)g.Bt + (size_t)cur.pn * tstep;
    S.a_ready(cur);
    if constexpr (SP2) {
        PG8_STAGE(PG8_SB(0, 0), cB, voffB); PG8_STAGE(PG8_SB(0, 1), cB + hstep, voffB); PG8_STAGE(PG8_SA(0, 0), cA, voffA); PG8_STAGE(PG8_SA(0, 1), cA + hstep, voffA);
        if (wr == 1) PG8_BAR;
        PG8_WAIT_V(2); PG8_BAR;
        PG8_STAGE(PG8_SB(1, 0), cB + kstep, voffB); PG8_STAGE(PG8_SA(1, 0), cA + kstep, voffA); PG8_STAGE(PG8_SB(1, 1), cB + hstep + kstep, voffB);
        PG8_WAIT_V(6); PG8_BAR;
    } else {
        PG8_STAGE(PG8_SB(0, 0), cB, voffB); PG8_STAGE(PG8_SA(0, 0), cA, voffA); PG8_STAGE(PG8_SB(0, 1), cB + hstep, voffB); PG8_STAGE(PG8_SA(0, 1), cA + hstep, voffA);
        if (wr == 1) PG8_BAR;
        PG8_WAIT_V(4); PG8_BAR;
        PG8_STAGE(PG8_SB(1, 0), cB + kstep, voffB); PG8_STAGE(PG8_SA(1, 0), cA + kstep, voffA); PG8_STAGE(PG8_SB(1, 1), cB + hstep + kstep, voffB);
        PG8_WAIT_V(6); PG8_BAR;
    }
    for (;;) {
        const bool has_next = S.next(ui + 1, nxt);
        const char* nA = has_next ? (const char*)g.A + (size_t)nxt.pm * tstep : cA; const char* nB = has_next ? (const char*)g.Bt + (size_t)nxt.pn * tstep : cB;
        for (int t = 0; t < nt; t += 2) {
            const bool last = (t == nt - 2);
            const char* a1 = cA + (size_t)(t + 1) * kstep;
            const char* a2 = last ? nA : cA + (size_t)(t + 2) * kstep; const char* b2 = last ? nB : cB + (size_t)(t + 2) * kstep;
            const char* a3 = a2 + kstep; const char* b3 = b2 + kstep;
            if (last && has_next) S.a_ready(nxt);
            if constexpr (SP2) {
            PG8_LDB(B0, 0, 0); PG8_LDB(B1, 0, 1); PG8_SCHED; PG8_LDA(At, 0, 0); PG8_STAGE(PG8_SA(1, 1), a1 + hstep, voffA);
            PG8_WAIT_V(8); PG8_WAIT_L(0); PG8_BAR; PG8_MMA(0, 0, At, B0); PG8_MMA(0, 1, At, B1); PG8_BAR; PG8_SCHED;
            PG8_LDA(At, 0, 1); PG8_STAGE(PG8_SB(0, 0), b2, voffB); PG8_STAGE(PG8_SB(0, 1), b2 + hstep, voffB); PG8_STAGE(PG8_SA(0, 0), a2, voffA);
            PG8_WAIT_V(8); PG8_WAIT_L(0); PG8_BAR; PG8_MMA(1, 0, At, B0); PG8_MMA(1, 1, At, B1); PG8_BAR; PG8_SCHED;
            PG8_LDB(B0, 1, 0); PG8_LDB(B1, 1, 1); PG8_SCHED; PG8_LDA(At, 1, 0); PG8_STAGE(PG8_SA(0, 1), a2 + hstep, voffA);
            PG8_WAIT_V(8); PG8_WAIT_L(0); PG8_BAR; PG8_MMA(0, 0, At, B0); PG8_MMA(0, 1, At, B1); PG8_BAR; PG8_SCHED;
            PG8_LDA(At, 1, 1); PG8_STAGE(PG8_SB(1, 0), b3, voffB); PG8_STAGE(PG8_SB(1, 1), b3 + hstep, voffB); PG8_STAGE(PG8_SA(1, 0), a3, voffA);
            PG8_WAIT_V(8); PG8_WAIT_L(0); PG8_BAR; PG8_MMA(1, 0, At, B0); PG8_MMA(1, 1, At, B1); PG8_BAR; PG8_SCHED;
            } else {
            PG8_LDB(B0, 0, 0); PG8_SCHED; PG8_LDA(At, 0, 0); PG8_STAGE(PG8_SA(1, 1), a1 + hstep, voffA);
            PG8_WAIT_L(8); PG8_BAR; PG8_WAIT_L(0); PG8_MMA(0, 0, At, B0); PG8_BAR; PG8_SCHED;
            PG8_LDB(B1, 0, 1); PG8_STAGE(PG8_SB(0, 0), b2, voffB);
            PG8_BAR; PG8_WAIT_L(0); PG8_MMA(0, 1, At, B1); PG8_BAR;
            PG8_LDA(At, 0, 1); PG8_STAGE(PG8_SA(0, 0), a2, voffA);
            PG8_BAR; PG8_WAIT_L(0); PG8_MMA(1, 0, At, B0); PG8_BAR; PG8_SCHED;
            PG8_STAGE(PG8_SB(0, 1), b2 + hstep, voffB);
            PG8_WAIT_V(6); PG8_BAR; PG8_MMA(1, 1, At, B1); PG8_BAR;
            PG8_LDB(B0, 1, 0); PG8_SCHED; PG8_LDA(At, 1, 0); PG8_STAGE(PG8_SA(0, 1), a2 + hstep, voffA);
            PG8_WAIT_L(8); PG8_BAR; PG8_WAIT_L(0); PG8_MMA(0, 0, At, B0); PG8_BAR; PG8_SCHED;
            PG8_LDB(B1, 1, 1); PG8_STAGE(PG8_SB(1, 0), b3, voffB);
            PG8_BAR; PG8_WAIT_L(0); PG8_MMA(0, 1, At, B1); PG8_BAR;
            PG8_LDA(At, 1, 1); PG8_STAGE(PG8_SA(1, 0), a3, voffA);
            PG8_BAR; PG8_WAIT_L(0); PG8_MMA(1, 0, At, B0); PG8_BAR; PG8_SCHED;
            PG8_STAGE(PG8_SB(1, 1), b3 + hstep, voffB);
            PG8_WAIT_V(6); PG8_BAR; PG8_MMA(1, 1, At, B1); PG8_BAR;
            }
        }
        if constexpr (ALIGN_EPI) { if (wr == 0) PG8_BAR; }
        if constexpr (!Epi::AFTER_DRAIN) { E(acc, cur, wr, wc, fr, fq); S.done(cur); }
        if (!has_next) break;
#pragma unroll
        for (int a = 0; a < 2; ++a)
#pragma unroll
            for (int b = 0; b < 2; ++b)
#pragma unroll
                for (int m = 0; m < 4; ++m)
#pragma unroll
                    for (int n = 0; n < 2; ++n) acc[a][b][m][n] = (f32x4){0.f, 0.f, 0.f, 0.f};
        cur = nxt; cA = nA; cB = nB; ++ui;
        if constexpr (ALIGN_EPI) { if (wr == 1) PG8_BAR; }
    }
    PG8_WAIT_V(0);
    if constexpr (!ALIGN_EPI) { if (wr == 0) PG8_BAR; }
    PG8_BAR;
    if constexpr (Epi::AFTER_DRAIN) { E.fused(acc, cur, wr, wc, fr, fq, lds, wid, lane); S.done(cur); }
#undef PG8_SA
#undef PG8_SB
#undef PG8_STAGE
#undef PG8_LDA
#undef PG8_LDB
#undef PG8_MMA
#undef PG8_WAIT_V
#undef PG8_WAIT_L
#undef PG8_BAR
#undef PG8_SCHED
}
}

#define GAS __attribute__((address_space(1)))
#define LAS __attribute__((address_space(3)))
typedef unsigned short bf16;
typedef short bf16x8 __attribute__((ext_vector_type(8)));
typedef short s16x4 __attribute__((ext_vector_type(4)));
typedef float f32x4 __attribute__((ext_vector_type(4)));
typedef float f32x2 __attribute__((ext_vector_type(2)));
typedef float f32x16 __attribute__((ext_vector_type(16)));
typedef unsigned u32x4 __attribute__((ext_vector_type(4)));
typedef unsigned u32x2 __attribute__((ext_vector_type(2)));

constexpr int DM = 1024, NB = 8, SEQ = 8192, DEPTH = 2, DB = 32, DL = 16, PAST = 2048;
constexpr int MP = NB * SEQ;
constexpr int MS = DB * DL;
constexpr int MT = MP + MS;
constexpr int DFF = 2816, DIN = 8208, NIN = 8704;
constexpr float EPS = 1e-6f;
constexpr float C2 = 0.125f * 1.4426950408889634f;
constexpr int NWAVES = 8;

constexpr size_t O_Y = 0;
constexpr size_t O_KP = (size_t)MT * DM;
constexpr size_t O_VP = O_KP + (size_t)DEPTH * MP * DM;
constexpr size_t O_GP = O_VP + (size_t)DEPTH * MP * DM;
constexpr size_t O_CP = O_GP + (size_t)DEPTH * NB * 4 * 128 * 256;
constexpr size_t O_KS = O_CP + (size_t)DEPTH * NB * 2 * DFF;
constexpr size_t O_VS = O_KS + (size_t)DEPTH * MS * DM;
constexpr size_t O_GS = O_VS + (size_t)DEPTH * MS * DM;
constexpr size_t O_CS = O_GS + (size_t)DEPTH * DB * 4 * 128 * 256;
constexpr size_t O_END = O_CS + (size_t)DEPTH * DB * 2 * DFF;

constexpr size_t MiB = 1u << 20, HMiB = 1u << 19;
constexpr size_t WS_CTL = 0, CTL_ZERO_BYTES = 1 * MiB;
constexpr size_t WS_ROPE = 1 * MiB;
constexpr size_t WS_DG = 1 * MiB + HMiB;
constexpr size_t WS_W = 2 * MiB;
constexpr size_t W_IN = 0, W_O = 17 * MiB, W_UP = 19 * MiB, W_DN = 30 * MiB, W_LAYER = 35 * MiB + HMiB;
constexpr size_t WS_SLOC = 74 * MiB;
constexpr size_t UB = (size_t)MT * DM * 2;
constexpr size_t WS_XN = 112 * MiB;
constexpr size_t WS_QA = WS_XN + UB, WS_KA = WS_QA + UB, WS_VA = WS_KA + UB, WS_QG = WS_VA + UB, WS_KG = WS_QG + UB / 2, WS_VG = WS_KG + UB / 2,
                 WS_RG = WS_VG + UB, WS_GK = WS_RG + UB, WS_GA = WS_GK + UB / 2, WS_GB = WS_GA + UB, WS_PEND = WS_GB + UB;
constexpr size_t WS_UG = WS_QA;
constexpr size_t WS_ACT = WS_UG + (size_t)MT * 5632 * 2;
constexpr size_t WS_TMP = WS_PEND;
constexpr size_t WS_OA = WS_TMP + 2 * UB;
constexpr size_t WS_END = WS_OA + UB;
static_assert(WS_ACT + (size_t)MT * DFF * 2 <= WS_PEND, "ws overlay");
static_assert(WS_W + 2 * W_LAYER <= WS_SLOC && WS_SLOC + 32 * MiB <= WS_XN, "ws map");
constexpr int CW_BAR = 4096;

constexpr int RING_BYTES = 131072, MISC_OFF = RING_BYTES, LDS_BYTES = 147456;

__device__ __forceinline__ float bf2f(bf16 b) { return __uint_as_float((unsigned)b << 16); }
__device__ __forceinline__ float bflo(unsigned u) { return __uint_as_float(u << 16); }
__device__ __forceinline__ float bfhi(unsigned u) { return __uint_as_float(u & 0xffff0000u); }
typedef __bf16 bf16x2_t __attribute__((ext_vector_type(2)));
__device__ __forceinline__ unsigned pk2(float lo, float hi) { f32x2 v = {lo, hi}; bf16x2_t b = __builtin_convertvector(v, bf16x2_t); return __builtin_bit_cast(unsigned, b); }
__device__ __forceinline__ bf16 f2bf(float f) { return (bf16)(pk2(f, 0.f) & 0xffffu); }
template <int M> __device__ __forceinline__ float shx(float v) { return __int_as_float(__builtin_amdgcn_ds_swizzle(__float_as_int(v), 0x1F | (M << 10))); }
__device__ __forceinline__ float sum32x(float v) { auto r = __builtin_amdgcn_permlane32_swap(__float_as_uint(v), __float_as_uint(v), false, false); return __uint_as_float(r[0]) + __uint_as_float(r[1]); }
__device__ __forceinline__ float max32x(float v) { auto r = __builtin_amdgcn_permlane32_swap(__float_as_uint(v), __float_as_uint(v), false, false); return fmaxf(__uint_as_float(r[0]), __uint_as_float(r[1])); }
__device__ __forceinline__ float half_sum(float v) { v += shx<1>(v); v += shx<2>(v); v += shx<4>(v); v += shx<8>(v); v += shx<16>(v); return v; }
__device__ __forceinline__ float wave_sum(float v) { return sum32x(half_sum(v)); }
__device__ __forceinline__ float frcp(float x) { return __builtin_amdgcn_rcpf(x); }
__device__ __forceinline__ float frsq(float x) { return __builtin_amdgcn_rsqf(x); }
__device__ __forceinline__ float sigmoidf_(float x) { return frcp(1.0f + __expf(-x)); }
#define LDS_WAIT() asm volatile("s_waitcnt lgkmcnt(0)" ::: "memory")
#define VM_WAIT() asm volatile("s_waitcnt vmcnt(0)" ::: "memory")

struct EpiIn {
    static constexpr bool PERM = true, AFTER_DRAIN = false;
    GAS unsigned char* ws; GAS float* kout_p; GAS float* vout_p; GAS float* kout_s; GAS float* vout_s; const GAS float* rope; const GAS float* bgk;
    __device__ __forceinline__ void operator()(const pg8::f32x4 (&acc)[2][2][4][2], const pg8::Unit& u, int wr, int wc, int fr, int fq) const {
        const int pn = u.pn;
        const int row0 = u.pm * 256 + wr * 64 + fr;
        const bool sample = (u.pm >= 256);
        GAS bf16* dst; int ldc, tcol; int kind;
        if (pn < 4)       { dst = (GAS bf16*)(ws + WS_QA); ldc = 1024; tcol = pn * 256; kind = 0; }
        else if (pn < 8)  { dst = (GAS bf16*)(ws + WS_KA); ldc = 1024; tcol = (pn - 4) * 256; kind = 1; }
        else if (pn < 12) { dst = (GAS bf16*)(ws + WS_VA); ldc = 1024; tcol = (pn - 8) * 256; kind = 2; }
        else if (pn < 14) { dst = (GAS bf16*)(ws + WS_QG); ldc = 512; tcol = (pn - 12) * 256; kind = 3; }
        else if (pn < 16) { dst = (GAS bf16*)(ws + WS_KG); ldc = 512; tcol = (pn - 14) * 256; kind = 4; }
        else if (pn < 20) { dst = (GAS bf16*)(ws + WS_VG); ldc = 1024; tcol = (pn - 16) * 256; kind = 4; }
        else if (pn < 24) { dst = (GAS bf16*)(ws + WS_RG); ldc = 1024; tcol = (pn - 20) * 256; kind = 4; }
        else if (pn < 28) { dst = (GAS bf16*)(ws + WS_GA); ldc = 1024; tcol = (pn - 24) * 256; kind = 4; }
        else if (pn < 32) { dst = (GAS bf16*)(ws + WS_GB); ldc = 1024; tcol = (pn - 28) * 256; kind = 4; }
        else              { dst = (GAS bf16*)(ws + WS_GK); ldc = 512; tcol = (pn - 32) * 256; kind = 5; }
        const int colw = wc * 32 + 8 * fq;
        const bool do_rope = (kind <= 1) && ((wc & 1) == 0);
#pragma unroll
        for (int ai = 0; ai < 2; ++ai)
#pragma unroll
            for (int m = 0; m < 4; ++m) {
                const int row = row0 + ai * 128 + m * 16;
                const int pos = sample ? (PAST + (row & 15)) : (row & (SEQ - 1));
                f32x4 cs0 = {1.f, 1.f, 1.f, 1.f}, cs1 = cs0, sn0 = {0.f, 0.f, 0.f, 0.f}, sn1 = sn0;
                if (do_rope) { const GAS f32x4* rp = (const GAS f32x4*)(rope + (size_t)pos * 16); cs0 = rp[0]; cs1 = rp[1]; sn0 = rp[2]; sn1 = rp[3]; }
#pragma unroll
                for (int bj = 0; bj < 2; ++bj) {
                    f32x4 v0 = acc[ai][bj][m][0], v1 = acc[ai][bj][m][1];
                    const int col = tcol + bj * 128 + colw;
                    if (do_rope) {
                        f32x4 o0, o1;
#pragma unroll
                        for (int e = 0; e < 4; ++e) { o0[e] = shx<16>(v0[e]); o1[e] = shx<16>(v1[e]); }
                        if (fq == 0) { v0 = v0 * cs0 - o0 * sn0; v1 = v1 * cs1 - o1 * sn1; }
                        else if (fq == 1) { v0 = v0 * cs0 + o0 * sn0; v1 = v1 * cs1 + o1 * sn1; }
                    }
                    if (kind == 1 || kind == 2) {
                        GAS float* fo = sample ? ((kind == 1 ? kout_s : vout_s) + (size_t)(row - MP) * 1024 + col)
                                           : ((kind == 1 ? kout_p : vout_p) + (size_t)row * 1024 + col);
                        *(GAS f32x4*)fo = v0; *(GAS f32x4*)(fo + 4) = v1;
                    }
                    if (kind == 0) { v0 = v0 * C2; v1 = v1 * C2; }
                    if (kind == 3) { v0 = v0 * 0.08838834764831845f; v1 = v1 * 0.08838834764831845f; }
                    if (kind == 5) {
                        const f32x4 b0 = *(const GAS f32x4*)(bgk + col), b1 = *(const GAS f32x4*)(bgk + col + 4);
#pragma unroll
                        for (int e = 0; e < 4; ++e) {
                            float x = v0[e] + b0[e]; v0[e] = (fminf(x, 0.f) - __logf(1.f + __expf(-fabsf(x)))) * 0.0625f;
                            x = v1[e] + b1[e];       v1[e] = (fminf(x, 0.f) - __logf(1.f + __expf(-fabsf(x)))) * 0.0625f;
                        }
                    }
                    u32x4 w; w.x = pk2(v0[0], v0[1]); w.y = pk2(v0[2], v0[3]); w.z = pk2(v1[0], v1[1]); w.w = pk2(v1[2], v1[3]);
                    *(GAS u32x4*)(dst + (size_t)row * ldc + col) = w;
                }
            }
    }
};
struct EpiF32 {
    static constexpr bool PERM = true, AFTER_DRAIN = false;
    GAS float* O; int ldc;
    __device__ __forceinline__ void operator()(const pg8::f32x4 (&acc)[2][2][4][2], const pg8::Unit& u, int wr, int wc, int fr, int fq) const {
        const int row0 = u.pm * 256 + wr * 64 + fr, col0 = u.pn * 256 + wc * 32 + 8 * fq;
#pragma unroll
        for (int ai = 0; ai < 2; ++ai)
#pragma unroll
            for (int m = 0; m < 4; ++m) { GAS float* rowp = O + (size_t)(row0 + ai * 128 + m * 16) * ldc + col0;
#pragma unroll
                for (int bj = 0; bj < 2; ++bj) { *(GAS f32x4*)(rowp + bj * 128) = acc[ai][bj][m][0]; *(GAS f32x4*)(rowp + bj * 128 + 4) = acc[ai][bj][m][1]; } }
    }
};
struct EpiB16 {
    static constexpr bool PERM = true, AFTER_DRAIN = false;
    GAS bf16* O; int ldc;
    __device__ __forceinline__ void operator()(const pg8::f32x4 (&acc)[2][2][4][2], const pg8::Unit& u, int wr, int wc, int fr, int fq) const {
        const int row0 = u.pm * 256 + wr * 64 + fr, col0 = u.pn * 256 + wc * 32 + 8 * fq;
#pragma unroll
        for (int ai = 0; ai < 2; ++ai)
#pragma unroll
            for (int m = 0; m < 4; ++m) { GAS bf16* rowp = O + (size_t)(row0 + ai * 128 + m * 16) * ldc + col0;
#pragma unroll
                for (int bj = 0; bj < 2; ++bj) { const f32x4 v0 = acc[ai][bj][m][0], v1 = acc[ai][bj][m][1];
                    u32x4 w; w.x = pk2(v0[0], v0[1]); w.y = pk2(v0[2], v0[3]); w.z = pk2(v1[0], v1[1]); w.w = pk2(v1[2], v1[3]);
                    *(GAS u32x4*)(rowp + bj * 128) = w; } }
    }
};
#define XB_TMO      128
#define XB_XCNT(j)  (256  + 64 * (j))
#define XB_XSUB(j)  (1280 + 64 * (j))
#define XB_XGEN(j)  (2304 + 64 * (j))
#define XB_TOP      3328
#define XB_TOPGEN   3392
#define XCD_BAR_WORDS 3456
#define XB_SPIN_CAP (1u << 18)

__device__ __forceinline__ unsigned xb_ld(unsigned* p)              { return __hip_atomic_load(p, __ATOMIC_RELAXED, __HIP_MEMORY_SCOPE_AGENT); }
__device__ __forceinline__ unsigned xb_add(unsigned* p, unsigned v) { return __hip_atomic_fetch_add(p, v, __ATOMIC_RELAXED, __HIP_MEMORY_SCOPE_AGENT); }
__device__ __forceinline__ unsigned xb_xcc_id() { return (unsigned)__builtin_amdgcn_s_getreg((3 << 11) | 20) & 0xFu; }
#define XB_SPIN(cond, bar) do { unsigned _sp = 0; while (cond) { __builtin_amdgcn_s_sleep(1); \
    if ((++_sp & 255u) == 0u) { if (xb_ld(&(bar)[XB_TMO])) break; if (_sp > XB_SPIN_CAP) { atomicAdd(&(bar)[XB_TMO], 1u); break; } } } } while (0)

struct XcdBarrier {
    unsigned* bar; unsigned x;
    volatile LAS unsigned* st;
};

__device__ __forceinline__ XcdBarrier xcd_barrier_post(unsigned* bar, volatile LAS unsigned* st) {
    XcdBarrier b; b.bar = bar; b.x = xb_xcc_id(); b.st = st;
    if (threadIdx.x == 0) (void)xb_add(&bar[XB_XCNT(b.x)], 1u);
    return b;
}
__device__ __forceinline__ void xcd_barrier_complete(unsigned* bar, unsigned x, unsigned& nloc, unsigned& nx) {
    const unsigned G = gridDim.x * gridDim.y * gridDim.z;
    unsigned sum, cnt, mine, sp = 0u;
    for (;;) {
        sum = 0u; cnt = 0u; mine = 0u;
#pragma unroll
        for (unsigned j = 0; j < 16; ++j) { const unsigned c = xb_ld(&bar[XB_XCNT(j)]); sum += c; cnt += (c > 0u) ? 1u : 0u; mine = (j == x) ? c : mine; }
        if (sum == G) break;
        __builtin_amdgcn_s_sleep(1);
        if ((++sp & 255u) == 0u) { if (xb_ld(&bar[XB_TMO])) break; if (sp > XB_SPIN_CAP) { atomicAdd(&bar[XB_TMO], 1u); break; } }
    }
    nloc = mine > 0u ? mine : 1u; nx = cnt > 0u ? cnt : 1u;
}

__device__ __forceinline__ void xcd_barrier(const XcdBarrier& b) {
    asm volatile("s_waitcnt vmcnt(0)" ::: "memory");
    __syncthreads();
    if (threadIdx.x == 0) {
        unsigned* bar = b.bar;
        __builtin_amdgcn_s_waitcnt(0);
        unsigned nloc = b.st[0], nx = b.st[1];
        if (nloc == 0u) { xcd_barrier_complete(bar, b.x, nloc, nx); b.st[0] = nloc; b.st[1] = nx; }
        const unsigned old = xb_add(&bar[XB_XSUB(b.x)], 1u);
        const unsigned gen = old / nloc;
        if (old + 1u == (gen + 1u) * nloc) {
            __builtin_amdgcn_fence(__ATOMIC_RELEASE, "agent");
            asm volatile("s_waitcnt vmcnt(0)" ::: "memory");
            const unsigned og = xb_add(&bar[XB_TOP], 1u);
            const unsigned tg = og / nx;
            if (og + 1u == (tg + 1u) * nx) xb_add(&bar[XB_TOPGEN], 1u);
            else XB_SPIN(xb_ld(&bar[XB_TOPGEN]) == tg, bar);
            __builtin_amdgcn_fence(__ATOMIC_ACQUIRE, "agent");
            xb_add(&bar[XB_XGEN(b.x)], 1u);
            asm volatile("s_waitcnt vmcnt(0)" ::: "memory");
        } else {
            XB_SPIN(xb_ld(&bar[XB_XGEN(b.x)]) == gen, bar);
            __builtin_amdgcn_fence(__ATOMIC_ACQUIRE, "agent");
            asm volatile("s_waitcnt vmcnt(0)" ::: "memory");
        }
    }
    __syncthreads();
}

__device__ __noinline__ void xcd_barrier_ni(unsigned* bar, unsigned x, volatile LAS unsigned* st) { XcdBarrier b; b.bar = bar; b.x = x; b.st = st; xcd_barrier(b); }

struct Args { const float* in[24]; float* out; unsigned char* ws; float inv_freq[8]; int ph_lo, ph_hi; };
enum { I_XP = 0, I_XS, I_CK, I_CV, I_SG, I_SC, I_WIN, I_WGK2, I_BGK2, I_LQ1, I_LK1, I_LQ2, I_LK2, I_DANW, I_GLANW, I_WO, I_PREMIX, I_POSTMIX, I_PREFFN, I_POSTFFN, I_WUP, I_CONVW, I_CONVB, I_WDOWN };

__device__ __forceinline__ void transpose_item(const GAS float* W, int N, int K, GAS bf16* WT, LAS float* scr, int kb, int n0_src, int n0_dst, int lane, const GAS float* wg) {
    const int k0 = 64 * kb;
    if (wg == nullptr) {
#pragma unroll 8
        for (int i = 0; i < 32; ++i) { const int kk = 2 * i + (lane >> 5); scr[kk * 33 + (lane & 31)] = W[(size_t)(k0 + kk) * N + n0_src + (lane & 31)]; }
    } else {
        float g[16];
#pragma unroll
        for (int r = 0; r < 16; ++r) g[r] = wg[r * 512 + n0_src + (lane & 31)];
        for (int i = 0; i < 32; ++i) { const int kk = 2 * i + (lane >> 5); const GAS float* lr = W + (size_t)(k0 + kk) * N + 6144; float s = 0.f;
#pragma unroll
            for (int r = 0; r < 16; ++r) s += lr[r] * g[r];
            scr[kk * 33 + (lane & 31)] = s; }
    }
    LDS_WAIT(); asm volatile("" ::: "memory");
    const int c = lane & 7;
#pragma unroll
    for (int j = 0; j < 4; ++j) { const int n = (lane >> 3) + 8 * j; const LAS float* s = scr + (8 * c) * 33 + n;
        u32x4 o; o.x = pk2(s[0 * 33], s[1 * 33]); o.y = pk2(s[2 * 33], s[3 * 33]); o.z = pk2(s[4 * 33], s[5 * 33]); o.w = pk2(s[6 * 33], s[7 * 33]);
        *(GAS u32x4*)(WT + (size_t)(n0_dst + n) * K + k0 + 8 * c) = o; }
    LDS_WAIT(); asm volatile("" ::: "memory");
}
__device__ __forceinline__ void rms_row_to_bf16(const GAS float* xrow, const GAS float* w, GAS bf16* orow, int lane) {
    const GAS f32x4* xr = (const GAS f32x4*)xrow + lane; const GAS f32x4* wr = (const GAS f32x4*)w + lane;
    f32x4 v[4]; float s = 0.f;
#pragma unroll
    for (int j = 0; j < 4; ++j) { v[j] = xr[64 * j]; s += (v[j].x * v[j].x + v[j].y * v[j].y) + (v[j].z * v[j].z + v[j].w * v[j].w); }
    const float rstd = frsq(wave_sum(s) * (1.f / DM) + EPS);
    GAS u32x2* o8 = (GAS u32x2*)orow + lane;
#pragma unroll
    for (int j = 0; j < 4; ++j) { const f32x4 g = wr[64 * j]; u32x2 o; o.x = pk2(v[j].x * rstd * g.x, v[j].y * rstd * g.y); o.y = pk2(v[j].z * rstd * g.z, v[j].w * rstd * g.w); o8[64 * j] = o; }
}
__device__ __forceinline__ void sincos_acc(float angf, float& sn, float& cs) {
    const double a = (double)angf; const double k = rint(a * 0.15915494309189535); const double r = a - k * 6.283185307179586476925;
    const double r2 = r * r; double ts = 1.0, tc = 1.0, ss = 1.0, sc = 1.0;
#pragma unroll
    for (int n = 1; n <= 13; ++n) { tc = -tc * r2 / (double)((2 * n - 1) * (2 * n)); ts = -ts * r2 / (double)((2 * n) * (2 * n + 1)); sc += tc; ss += ts; }
    sn = (float)(ss * r); cs = (float)sc;
}

#define MFMA32(a, b, c) __builtin_amdgcn_mfma_f32_32x32x16_bf16((a), (b), (c), 0, 0, 0)
__device__ __forceinline__ int crow(int r, int hi) { return (r & 3) + 8 * (r >> 2) + 4 * hi; }
__device__ __forceinline__ s16x4 tr16(const LAS unsigned char* p) { return __builtin_bit_cast(s16x4, __builtin_amdgcn_ds_read_tr16_b64_v4i16((LAS s16x4*)p)); }
__device__ __forceinline__ bf16x8 cat8(s16x4 lo, s16x4 hi) { return (bf16x8){lo[0], lo[1], lo[2], lo[3], hi[0], hi[1], hi[2], hi[3]}; }
__device__ __forceinline__ u32x4 cvt8(f32x4 a, f32x4 b) { u32x4 w; w.x = pk2(a[0], a[1]); w.y = pk2(a[2], a[3]); w.z = pk2(b[0], b[1]); w.w = pk2(b[2], b[3]); return w; }

__device__ __forceinline__ void glds16(const GAS void* gsrc, unsigned lds_dst) { unsigned keep;
    asm volatile("s_mov_b32 %0, m0\n\ts_mov_b32 m0, %2\n\ts_nop 0\n\tglobal_load_lds_dwordx4 %1, off\n\ts_mov_b32 m0, %0" : "=&s"(keep) : "v"(gsrc), "s"(lds_dst) : "memory"); }
template <int MODE>
__device__ __forceinline__ void attn_unit(LAS unsigned char* lds, const GAS bf16* Q, const GAS bf16* Kb, const GAS bf16* Vb, GAS bf16* O, const GAS float* ck, const GAS float* cv,
                                          int b, int h, int qblk, float lam, float onem, const GAS float* normw) {
    const int tid = opaque_tid(), lane = tid & 63, w = __builtin_amdgcn_readfirstlane(tid >> 6), r32 = lane & 31, hi = lane >> 5;
    const int comp = w & 1, rg = w >> 1, half = w >> 2;
    int NT, my_nt; size_t qrow, orow0;
    if (MODE == 0) { NT = 2 * qblk + 2; my_nt = 2 * qblk + 1 + half; orow0 = (size_t)b * SEQ + qblk * 128 + rg * 32; qrow = orow0 + r32; }
    else { NT = 33; my_nt = (rg == 0) ? 33 : 0; orow0 = (size_t)MP + b * 16; qrow = orow0 + (r32 < 15 ? r32 : 15); }
    bf16x8 qr[4];
    { const GAS bf16* qp = Q + qrow * 1024 + h * 128 + comp * 64 + hi * 8;
#pragma unroll
      for (int s = 0; s < 4; ++s) qr[s] = *(const GAS bf16x8*)(qp + 16 * s); }
    asm volatile("" : "+v"(qr[0]), "+v"(qr[1]), "+v"(qr[2]), "+v"(qr[3]));
    LAS float* wsf = (LAS float*)(lds + 98304) + w * 64;
    f32x16 o[4];
#pragma unroll
    for (int d = 0; d < 4; ++d)
#pragma unroll
        for (int r = 0; r < 16; ++r) o[d][r] = 0.f;
    float mrow = 0.f, lrow = 0.f;
    u32x4 kst[2], vst[2];
    bf16x8 pw[4];
#pragma unroll
    for (int k = 0; k < 4; ++k) pw[k] = (bf16x8){0, 0, 0, 0, 0, 0, 0, 0};
    const int vrow_l = lane >> 2, vpc = lane & 3;
#define ATT_LOAD(t) do { \
        if (MODE == 0) { const size_t kr0 = (size_t)b * SEQ + 64 * (t); \
            _Pragma("unroll") for (int i = 0; i < 2; ++i) { const int p = w + 8 * i; \
                kst[i] = *(const GAS u32x4*)(Kb + (kr0 + lane) * 1024 + h * 128 + p * 8); \
                vst[i] = *(const GAS u32x4*)(Vb + (kr0 + 16 * (p & 3) + vrow_l) * 1024 + h * 128 + 32 * (p >> 2) + 8 * vpc); } } \
        else if ((t) < 32) { const size_t kr0 = (size_t)b * PAST + 64 * (t); \
            _Pragma("unroll") for (int i = 0; i < 2; ++i) { const int p = w + 8 * i; \
                const GAS float* kp = ck + ((kr0 + lane) * 8 + h) * 128 + p * 8; kst[i] = cvt8(*(const GAS f32x4*)kp, *(const GAS f32x4*)(kp + 4)); \
                const GAS float* vp = cv + ((kr0 + 16 * (p & 3) + vrow_l) * 8 + h) * 128 + 32 * (p >> 2) + 8 * vpc; vst[i] = cvt8(*(const GAS f32x4*)vp, *(const GAS f32x4*)(vp + 4)); } } \
        else { const size_t kr0 = (size_t)MP + b * 16; \
            _Pragma("unroll") for (int i = 0; i < 2; ++i) { const int p = w + 8 * i; const int vr = 16 * (p & 3) + vrow_l; \
                kst[i] = (lane < 16) ? *(const GAS u32x4*)(Kb + (kr0 + lane) * 1024 + h * 128 + p * 8) : (u32x4){0u, 0u, 0u, 0u}; \
                vst[i] = (vr < 16) ? *(const GAS u32x4*)(Vb + (kr0 + vr) * 1024 + h * 128 + 32 * (p >> 2) + 8 * vpc) : (u32x4){0u, 0u, 0u, 0u}; } } \
    } while (0)
#define ATT_STORE(bufo) do { _Pragma("unroll") for (int i = 0; i < 2; ++i) { const int p = w + 8 * i; \
        *(LAS u32x4*)(lds + (bufo) + p * 1024 + lane * 16) = kst[i]; *(LAS u32x4*)(lds + (bufo) + 16384 + p * 1024 + lane * 16) = vst[i]; } } while (0)
#define ATT_X(t, bo) do { \
        f32x16 p0, p1; \
        _Pragma("unroll") for (int r = 0; r < 16; ++r) { p0[r] = 0.f; p1[r] = 0.f; } \
        const LAS unsigned char* kb_ = lds + (bo) + kfo; \
        _Pragma("unroll") for (int s = 0; s < 4; ++s) { const bf16x8 a0 = *(const LAS bf16x8*)(kb_ + s * 2048), a1 = *(const LAS bf16x8*)(kb_ + s * 2048 + 512); \
            p0 = MFMA32(a0, qr[s], p0); p1 = MFMA32(a1, qr[s], p1); } \
        if (MODE == 1 && (t) == 32) { _Pragma("unroll") for (int r = 0; r < 16; ++r) { if (r >= 8) p0[r] = -INFINITY; p1[r] = -INFINITY; } } \
        float mx = fmaxf(p0[0], p1[0]); \
        _Pragma("unroll") for (int r = 1; r < 16; ++r) mx = fmaxf(mx, fmaxf(p0[r], p1[r])); \
        mx = max32x(mx); \
        if ((t) == 0) mrow = mx; \
        else if (__any(mx > mrow + 8.f)) { \
            const float mn = fmaxf(mrow, mx); const float f = __builtin_amdgcn_exp2f(mrow - mn); lrow *= f; mrow = mn; \
            if (hi == 0) wsf[r32] = f; \
            LDS_WAIT(); \
            _Pragma("unroll") for (int r = 0; r < 16; ++r) { const float fr_ = wsf[crow(r, hi)]; \
                _Pragma("unroll") for (int d = 0; d < 4; ++d) o[d][r] *= fr_; } } \
        float ls = 0.f; \
        _Pragma("unroll") for (int r = 0; r < 16; ++r) { p0[r] = __builtin_amdgcn_exp2f(p0[r] - mrow); p1[r] = __builtin_amdgcn_exp2f(p1[r] - mrow); ls += p0[r] + p1[r]; } \
        lrow += ls; \
        { u32x4 x; \
          x.x = pk2(p0[0], p0[1]); x.y = pk2(p0[2], p0[3]); x.z = pk2(p0[4], p0[5]); x.w = pk2(p0[6], p0[7]); pw[0] = __builtin_bit_cast(bf16x8, x); \
          x.x = pk2(p0[8], p0[9]); x.y = pk2(p0[10], p0[11]); x.z = pk2(p0[12], p0[13]); x.w = pk2(p0[14], p0[15]); pw[1] = __builtin_bit_cast(bf16x8, x); \
          x.x = pk2(p1[0], p1[1]); x.y = pk2(p1[2], p1[3]); x.z = pk2(p1[4], p1[5]); x.w = pk2(p1[6], p1[7]); pw[2] = __builtin_bit_cast(bf16x8, x); \
          x.x = pk2(p1[8], p1[9]); x.y = pk2(p1[10], p1[11]); x.z = pk2(p1[12], p1[13]); x.w = pk2(p1[14], p1[15]); pw[3] = __builtin_bit_cast(bf16x8, x); } \
    } while (0)
#define ATT_Y(bo) do { const LAS unsigned char* vb_ = lds + (bo) + vfo; \
        _Pragma("unroll") for (int d = 0; d < 4; ++d) { \
            _Pragma("unroll") for (int ks = 0; ks < 4; ++ks) { const s16x4 lo_ = tr16(vb_ + d * 4096 + ks * 1024), hh_ = tr16(vb_ + d * 4096 + ks * 1024 + 512); \
                o[d] = MFMA32(pw[ks], cat8(lo_, hh_), o[d]); } \
            __builtin_amdgcn_sched_barrier(0); } } while (0)
#define ATT_DMA(t, bufo) do { const size_t kr0 = (size_t)b * SEQ + 64 * (t); \
        _Pragma("unroll") for (int i = 0; i < 2; ++i) { const int p = w + 8 * i; \
            glds16(Kb + (kr0 + lane) * 1024 + h * 128 + p * 8, (unsigned)__builtin_amdgcn_readfirstlane((int)(lds0 + (bufo) + p * 1024))); \
            glds16(Vb + (kr0 + 16 * (p & 3) + vrow_l) * 1024 + h * 128 + 32 * (p >> 2) + 8 * vpc, (unsigned)__builtin_amdgcn_readfirstlane((int)(lds0 + (bufo) + 16384 + p * 1024))); } } while (0)
    const unsigned lds0 = (unsigned)(size_t)lds;
    if (MODE == 0) { ATT_DMA(0, 0); VM_WAIT(); } else { ATT_LOAD(0); ATT_STORE(0); }
    __syncthreads();
    const int kfo = (8 * comp + hi) * 1024 + r32 * 16;
    const int vfo = 16384 + ((lane >> 4) & 1) * 32 + (lane & 3) * 8 + (4 * hi + ((lane & 15) >> 2)) * 64;
    int b_prev = 0, b_cur = 0, b_next = 32768;
    const int NI = (MODE == 0) ? NT + 1 : NT;
    for (int i = 0; i < NI; ++i) {
        if (i + 1 < NT) { if (MODE == 0) { ATT_DMA(i + 1, b_next); } else { ATT_LOAD(i + 1); } }
        if (half == 0) { if (i < my_nt) { ATT_X(i, b_cur); ATT_Y(b_cur); } }
        else if (MODE == 0) { if (i >= 1) ATT_Y(b_prev); if (i < NT) ATT_X(i, b_cur); }
        if (MODE == 1 && i + 1 < NT) ATT_STORE(b_next);
        if (MODE == 0) VM_WAIT();
        __syncthreads();
        b_prev = b_cur; b_cur = b_next; b_next = (b_next == 65536) ? 0 : b_next + 32768;
    }
#undef ATT_LOAD
#undef ATT_STORE
#undef ATT_DMA
#undef ATT_X
#undef ATT_Y
    const bool active = (MODE == 0) || (rg == 0);
    if (active) {
        const float lt = sum32x(lrow);
        if (hi == 0) wsf[32 + r32] = lt;
        LDS_WAIT();
#pragma unroll
        for (int r = 0; r < 16; ++r) { const float il = frcp(wsf[32 + crow(r, hi)]);
#pragma unroll
            for (int d = 0; d < 4; ++d) o[d][r] *= il; }
    }
    LAS float* X = (LAS float*)lds;
    if (active && comp == 1) {
#pragma unroll
        for (int d = 0; d < 4; ++d)
#pragma unroll
            for (int r = 0; r < 16; ++r) X[((rg * 4 + d) * 16 + r) * 64 + lane] = o[d][r];
    }
    __syncthreads();
    if (active && comp == 0) {
        float nw[4];
#pragma unroll
        for (int d = 0; d < 4; ++d) nw[d] = normw[32 * d + r32];
#pragma unroll
        for (int r = 0; r < 16; ++r) {
            float ss = 0.f;
#pragma unroll
            for (int d = 0; d < 4; ++d) { const float x = o[d][r] - lam * X[((rg * 4 + d) * 16 + r) * 64 + lane]; o[d][r] = x; ss += x * x; }
            ss = half_sum(ss);
            const float rs = onem * frsq(ss * (1.0f / 128.0f) + EPS);
            const int rr = crow(r, hi);
            if (MODE == 0 || rr < 16) {
                GAS bf16* op = O + (orow0 + rr) * 1024 + h * 128 + r32;
#pragma unroll
                for (int d = 0; d < 4; ++d) op[32 * d] = f2bf(o[d][r] * rs * nw[d]);
            }
        }
    }
    __syncthreads();
}

constexpr int ATT_WSF = 131072 + 1024;
#define ASBAR() __builtin_amdgcn_sched_barrier(0)
#define APIN(x) asm volatile("" : "+v"(x))
__device__ __forceinline__ float max3f(float a, float b, float c) { float r; asm("v_max3_f32 %0, %1, %2, %3" : "=v"(r) : "v"(a), "v"(b), "v"(c)); return r; }
__device__ __forceinline__ void attn_prompt_unit(LAS unsigned char* lds, const GAS bf16* Q, const GAS bf16* Kb, const GAS bf16* Vb, GAS bf16* O,
                                                 int b, int h, int qblk, float lam, float onem, const GAS float* normw) {
    const int tid = opaque_tid(), lane = tid & 63, w = __builtin_amdgcn_readfirstlane(tid >> 6), r32 = lane & 31, hi = lane >> 5;
    const int comp = w & 1, rg = w >> 1, half = w >> 2;
    const int NT = 2 * qblk + 2, my_nt = NT - 1 + half;
    const size_t orow0 = (size_t)b * SEQ + qblk * 128 + rg * 32;
    bf16x8 qr[4];
    { const GAS bf16* qp = Q + (orow0 + r32) * 1024 + h * 128 + comp * 64 + hi * 8;
#pragma unroll
      for (int s = 0; s < 4; ++s) qr[s] = *(const GAS bf16x8*)(qp + 16 * s); }
    asm volatile("" : "+v"(qr[0]), "+v"(qr[1]), "+v"(qr[2]), "+v"(qr[3]));
    LAS float* wsf = (LAS float*)(lds + ATT_WSF) + w * 64;
    f32x16 o[4];
#pragma unroll
    for (int d = 0; d < 4; ++d)
#pragma unroll
        for (int r = 0; r < 16; ++r) o[d][r] = 0.f;
    float mrow = 0.f, lrow = 0.f;
    f32x16 pA0, pA1, pB0, pB1;
    const f32x16 zero16 = {0.f, 0.f, 0.f, 0.f, 0.f, 0.f, 0.f, 0.f, 0.f, 0.f, 0.f, 0.f, 0.f, 0.f, 0.f, 0.f};
    const unsigned lds0 = (unsigned)(size_t)lds;
    const int vrow_l = lane >> 2, vpc = lane & 3;
    const int kfo = (8 * comp + hi) * 1024 + r32 * 16;
    const int vfo = 16384 + ((lane >> 4) & 1) * 32 + (lane & 3) * 8 + (4 * hi + ((lane & 15) >> 2)) * 64;
    const GAS bf16* kg = Kb + ((size_t)b * SEQ + lane) * 1024 + h * 128 + w * 8;
    const GAS bf16* vg = Vb + ((size_t)b * SEQ + 16 * (w & 3) + vrow_l) * 1024 + h * 128 + 32 * (w >> 2) + 8 * vpc;
#define PA_DMA(t) do { const int so_ = ((t) & 3) * 32768; const size_t to_ = (size_t)(t) * 65536; \
        glds16(kg + to_, (unsigned)__builtin_amdgcn_readfirstlane((int)(lds0 + so_ + w * 1024))); \
        glds16(kg + to_ + 64, (unsigned)__builtin_amdgcn_readfirstlane((int)(lds0 + so_ + (w + 8) * 1024))); \
        glds16(vg + to_, (unsigned)__builtin_amdgcn_readfirstlane((int)(lds0 + so_ + 16384 + w * 1024))); \
        glds16(vg + to_ + 64, (unsigned)__builtin_amdgcn_readfirstlane((int)(lds0 + so_ + 16384 + (w + 8) * 1024))); } while (0)
#define PA_KF(so, j) (*(const LAS bf16x8*)(lds + (so) + kfo + ((j) >> 1) * 2048 + ((j) & 1) * 512))
#define PA_VF(so, g) cat8(tr16(lds + (so) + vfo + ((g) >> 2) * 4096 + ((g) & 3) * 1024), tr16(lds + (so) + vfo + ((g) >> 2) * 4096 + ((g) & 3) * 1024 + 512))
#define PA_SEL(P0, P1, e) (((e) < 16) ? P0[(e) & 15] : P1[(e) & 15])
#define PA_WAITBAR(n) asm volatile("s_waitcnt vmcnt(" #n ") lgkmcnt(0)\n\ts_barrier" ::: "memory")
#define PA_STEP(C0, C1, P0, P1, kso, vso, MASKED) do { \
        bf16x8 kf_[8]; bf16x8 vf_[16]; u32x4 pk_[4]; bool resc_ = false; \
        kf_[0] = PA_KF(kso, 0); kf_[1] = PA_KF(kso, 1); ASBAR(); \
        float sacc_ = P0[0] + P0[1]; \
        _Pragma("unroll") for (int j = 0; j < 8; ++j) { \
            if (j + 2 < 8) kf_[j + 2] = PA_KF(kso, j + 2); else vf_[j - 6] = PA_VF(vso, j - 6); \
            if (j == 0) C0 = MFMA32(kf_[j], qr[0], zero16); else if (j == 1) C1 = MFMA32(kf_[j], qr[0], zero16); \
            else if (j & 1) C1 = MFMA32(kf_[j], qr[j >> 1], C1); else C0 = MFMA32(kf_[j], qr[j >> 1], C0); \
            sacc_ += PA_SEL(P0, P1, 2 + 4 * j); sacc_ += PA_SEL(P0, P1, 3 + 4 * j); \
            if (j < 7) { sacc_ += PA_SEL(P0, P1, 4 + 4 * j); sacc_ += PA_SEL(P0, P1, 5 + 4 * j); } \
            APIN(sacc_); \
            pk_[j >> 1][(j & 1) * 2] = pk2(PA_SEL(P0, P1, 4 * j), PA_SEL(P0, P1, 4 * j + 1)); pk_[j >> 1][(j & 1) * 2 + 1] = pk2(PA_SEL(P0, P1, 4 * j + 2), PA_SEL(P0, P1, 4 * j + 3)); \
            APIN(pk_[j >> 1]); ASBAR(); } \
        lrow += sacc_; \
        if (MASKED) { _Pragma("unroll") for (int r = 0; r < 16; ++r) { C0[r] = -1.0e30f; C1[r] = -1.0e30f; } } \
        { float a_ = max3f(C0[0], C0[1], C1[0]), b_ = max3f(C0[2], C0[3], C1[1]); a_ = max3f(a_, C1[2], C1[3]); \
          _Pragma("unroll") for (int r = 4; r < 16; r += 4) { a_ = max3f(a_, C0[r], C0[r + 1]); b_ = max3f(b_, C0[r + 2], C0[r + 3]); a_ = max3f(a_, C1[r], C1[r + 1]); b_ = max3f(b_, C1[r + 2], C1[r + 3]); } \
          const float mx_ = max32x(fmaxf(a_, b_)); \
          if (__builtin_expect(__any(mx_ > mrow + 8.f), 0)) { const float mn_ = fmaxf(mrow, mx_); const float f_ = __builtin_amdgcn_exp2f(mrow - mn_); lrow *= f_; mrow = mn_; if (hi == 0) wsf[r32] = f_; resc_ = true; } } \
        ASBAR(); \
        _Pragma("unroll") for (int g = 0; g < 16; ++g) { \
            if (g + 2 < 16) vf_[g + 2] = PA_VF(vso, g + 2); \
            o[g >> 2] = MFMA32(__builtin_bit_cast(bf16x8, pk_[g & 3]), vf_[g], o[g >> 2]); \
            if (g < 8) { C0[2 * g] = __builtin_amdgcn_exp2f(C0[2 * g] - mrow); C0[2 * g + 1] = __builtin_amdgcn_exp2f(C0[2 * g + 1] - mrow); APIN(C0); } \
            else { C1[2 * g - 16] = __builtin_amdgcn_exp2f(C1[2 * g - 16] - mrow); C1[2 * g - 15] = __builtin_amdgcn_exp2f(C1[2 * g - 15] - mrow); APIN(C1); } \
            ASBAR(); } \
        if (resc_) { LDS_WAIT(); \
            _Pragma("unroll") for (int r = 0; r < 16; ++r) { const float fr_ = wsf[crow(r, hi)]; \
                _Pragma("unroll") for (int d = 0; d < 4; ++d) o[d][r] *= fr_; } } \
    } while (0)
#define PA_DRAIN(P0, P1, vso) do { float sacc_ = 0.f; \
        _Pragma("unroll") for (int r = 0; r < 16; ++r) sacc_ += P0[r] + P1[r]; \
        lrow += sacc_; u32x4 pk_[4]; \
        _Pragma("unroll") for (int k = 0; k < 4; ++k) { pk_[k][0] = pk2(PA_SEL(P0, P1, 8 * k), PA_SEL(P0, P1, 8 * k + 1)); pk_[k][1] = pk2(PA_SEL(P0, P1, 8 * k + 2), PA_SEL(P0, P1, 8 * k + 3)); \
            pk_[k][2] = pk2(PA_SEL(P0, P1, 8 * k + 4), PA_SEL(P0, P1, 8 * k + 5)); pk_[k][3] = pk2(PA_SEL(P0, P1, 8 * k + 6), PA_SEL(P0, P1, 8 * k + 7)); } \
        _Pragma("unroll") for (int g = 0; g < 16; ++g) o[g >> 2] = MFMA32(__builtin_bit_cast(bf16x8, pk_[g & 3]), PA_VF(vso, g), o[g >> 2]); } while (0)
#pragma unroll
    for (int r = 0; r < 16; ++r) { pB0[r] = 0.f; pB1[r] = 0.f; }
    mrow = -1.0e30f;
    PA_DMA(0); PA_DMA(1); PA_WAITBAR(4);
    for (int i = 0; i < NT; i += 2) {
        if (i + 2 < NT) PA_DMA(i + 2);
        PA_STEP(pA0, pA1, pB0, pB1, (i & 3) * 32768, ((i == 0 ? 0 : i - 1) & 3) * 32768, false);
        if (i + 2 < NT) PA_WAITBAR(4); else PA_WAITBAR(0);
        if (i + 3 < NT) PA_DMA(i + 3);
        PA_STEP(pB0, pB1, pA0, pA1, ((i + 1) & 3) * 32768, (i & 3) * 32768, (half == 0 && i + 2 == NT));
        if (i + 3 < NT) PA_WAITBAR(4); else PA_WAITBAR(0);
    }
    PA_DRAIN(pB0, pB1, ((NT - 1) & 3) * 32768);
    __syncthreads();
#undef PA_DMA
#undef PA_KF
#undef PA_VF
#undef PA_SEL
#undef PA_WAITBAR
#undef PA_STEP
#undef PA_DRAIN
    {
        const float lt = sum32x(lrow);
        if (hi == 0) wsf[32 + r32] = lt;
        LDS_WAIT();
#pragma unroll
        for (int r = 0; r < 16; ++r) { const float il = frcp(wsf[32 + crow(r, hi)]);
#pragma unroll
            for (int d = 0; d < 4; ++d) o[d][r] *= il; }
    }
    LAS float* X = (LAS float*)lds;
    if (comp == 1) {
#pragma unroll
        for (int d = 0; d < 4; ++d)
#pragma unroll
            for (int r = 0; r < 16; ++r) X[((rg * 4 + d) * 16 + r) * 64 + lane] = o[d][r];
    }
    __syncthreads();
    if (comp == 0) {
        float nw[4];
#pragma unroll
        for (int d = 0; d < 4; ++d) nw[d] = normw[32 * d + r32];
#pragma unroll
        for (int r = 0; r < 16; ++r) {
            float ss = 0.f;
#pragma unroll
            for (int d = 0; d < 4; ++d) { const float x = o[d][r] - lam * X[((rg * 4 + d) * 16 + r) * 64 + lane]; o[d][r] = x; ss += x * x; }
            ss = half_sum(ss);
            const float rs = onem * frsq(ss * (1.0f / 128.0f) + EPS);
            GAS bf16* op = O + (orow0 + crow(r, hi)) * 1024 + h * 128 + r32;
#pragma unroll
            for (int d = 0; d < 4; ++d) op[32 * d] = f2bf(o[d][r] * rs * nw[d]);
        }
    }
    __syncthreads();
}

constexpr int G_QET = 0, G_KET = 24576, G_KDT = 49152, G_VIM = 67584, G_AM = 100352, G_TOT = 109568, G_DV = 113664, G_SSQ = 114176, G_END = 116224;
static_assert(G_END <= RING_BYTES, "gla lds");
struct GlaP { const GAS bf16* QG; const GAS bf16* KG; const GAS bf16* VG; const GAS bf16* GK; const GAS bf16* RG; const GAS bf16* GA; const GAS bf16* GB; const GAS bf16* OA; GAS bf16* MG; const GAS float* gnw; };

template <bool FULL, int MODE>
__device__ __forceinline__ void gla_run(LAS unsigned char* lds, const GlaP& P, size_t m0, int h, int nch, f32x16 (&S)[4], float& dsum0, float& dsum1) {
    const int tid = opaque_tid(), lane = tid & 63, w = __builtin_amdgcn_readfirstlane(tid >> 6), r32 = lane & 31, hi = lane >> 5;
    const int trq = ((lane >> 4) & 1) * 32 + (lane & 3) * 8, q4 = (lane & 15) >> 2;
    unsigned gq[8], qv[8], kv[8]; u32x4 vpre[4];
    unsigned lo_g = (unsigned)((8 * w) * 1024 + 4 * lane), lo_v = (unsigned)((lane >> 2) * 2048 + w * 64 + (lane & 3) * 16);
#define GLA_LOADS(chn) do { const size_t mcn = m0 + (size_t)(chn) * 64; asm volatile("" : "+v"(lo_g), "+v"(lo_v)); \
        const GAS char* gkb = (const GAS char*)(P.GK + mcn * 512 + h * 128); const GAS char* qgb = (const GAS char*)(P.QG + mcn * 512 + h * 128); const GAS char* kgb = (const GAS char*)(P.KG + mcn * 512 + h * 128); \
        const GAS char* vgb = (const GAS char*)(P.VG + mcn * 1024 + h * 256); \
        _Pragma("unroll") for (int i = 0; i < 8; ++i) { const bool valid = (MODE == 0) || (8 * w + i < 16); \
            gq[i] = valid ? *(const GAS unsigned*)(gkb + i * 1024 + lo_g) : 0u; if (FULL) qv[i] = valid ? *(const GAS unsigned*)(qgb + i * 1024 + lo_g) : 0u; kv[i] = valid ? *(const GAS unsigned*)(kgb + i * 1024 + lo_g) : 0u; } \
        _Pragma("unroll") for (int i = 0; i < 4; ++i) { const int s = (lane >> 2) + 16 * i; const bool valid = (MODE == 0) || (s < 16); \
            vpre[i] = valid ? *(const GAS u32x4*)(vgb + i * 32768 + lo_v) : (u32x4){0u, 0u, 0u, 0u}; } } while (0)
    GLA_LOADS(0);
    for (int ch = 0; ch < nch; ++ch) {
        const size_t mc = m0 + (size_t)ch * 64;
        {
            float b0[8], b1[8];
#pragma unroll
            for (int i = 0; i < 8; ++i) { b0[i] = bflo(gq[i]); b1[i] = bfhi(gq[i]); }
#pragma unroll
            for (int i = 1; i < 8; ++i) { b0[i] += b0[i - 1]; b1[i] += b1[i - 1]; }
            LAS float* TOT = (LAS float*)(lds + G_TOT);
            *(LAS f32x2*)(TOT + w * 128 + 2 * lane) = (f32x2){b0[7], b1[7]};
            __syncthreads();
            float p0 = 0.f, p1 = 0.f, t0 = 0.f, t1 = 0.f;
#pragma unroll
            for (int ww = 0; ww < 8; ++ww) { const f32x2 tv = *(const LAS f32x2*)(TOT + ww * 128 + 2 * lane); if (ww < w) { p0 += tv.x; p1 += tv.y; } t0 += tv.x; t1 += tv.y; }
            u32x4 qe0, qe1, ke0, ke1, kd0, kd1;
#pragma unroll
            for (int i = 0; i < 8; i += 2) {
                float v[12];
#pragma unroll
                for (int j = 0; j < 2; ++j) {
                    const float ba = b0[i + j] + p0, bb = b1[i + j] + p1;
                    const float ka = bflo(kv[i + j]), kb_ = bfhi(kv[i + j]);
                    v[8 + j] = ka * __expf(t0 - ba); v[10 + j] = kb_ * __expf(t1 - bb);
                    if (FULL) { const float qa = bflo(qv[i + j]), qb = bfhi(qv[i + j]);
                        v[j] = qa * __expf(ba); v[2 + j] = qb * __expf(bb); v[4 + j] = ka * __expf(-ba); v[6 + j] = kb_ * __expf(-bb); }
                }
                if (FULL) { qe0[i >> 1] = pk2(v[0], v[1]); qe1[i >> 1] = pk2(v[2], v[3]); ke0[i >> 1] = pk2(v[4], v[5]); ke1[i >> 1] = pk2(v[6], v[7]); }
                kd0[i >> 1] = pk2(v[8], v[9]); kd1[i >> 1] = pk2(v[10], v[11]);
            }
            const int c0 = 2 * lane;
            if (FULL) {
                *(LAS u32x4*)(lds + G_QET + c0 * 192 + w * 16) = qe0; *(LAS u32x4*)(lds + G_QET + (c0 + 1) * 192 + w * 16) = qe1;
                *(LAS u32x4*)(lds + G_KET + c0 * 192 + w * 16) = ke0; *(LAS u32x4*)(lds + G_KET + (c0 + 1) * 192 + w * 16) = ke1;
            }
            *(LAS u32x4*)(lds + G_KDT + c0 * 144 + w * 16) = kd0; *(LAS u32x4*)(lds + G_KDT + (c0 + 1) * 144 + w * 16) = kd1;
            if (w == 0) { *(LAS f32x2*)((LAS float*)(lds + G_DV) + c0) = (f32x2){__expf(t0), __expf(t1)}; }
            dsum0 += t0; dsum1 += t1;
#pragma unroll
            for (int i = 0; i < 4; ++i) { const int s = (lane >> 2) + 16 * i; *(LAS u32x4*)(lds + G_VIM + w * 4096 + s * 64 + (lane & 3) * 16) = vpre[i]; }
            if (ch + 1 < nch) GLA_LOADS(ch + 1);
        }
        asm volatile("s_waitcnt lgkmcnt(0)\n\ts_barrier" ::: "memory");
        f32x16 o[2];
        if (FULL) {
            if (w < 3) {
                const int tb = (w + 1) >> 1, sb = w >> 1;
                f32x16 c;
#pragma unroll
                for (int r = 0; r < 16; ++r) c[r] = 0.f;
                const int tro = trq + (8 * hi + q4) * 192;
#pragma unroll
                for (int ks = 0; ks < 8; ++ks) {
                    const LAS unsigned char* ap = lds + G_KET + tro + ks * 16 * 192 + sb * 64; const LAS unsigned char* bp = lds + G_QET + tro + ks * 16 * 192 + tb * 64;
                    c = MFMA32(cat8(tr16(ap), tr16(ap + 4 * 192)), cat8(tr16(bp), tr16(bp + 4 * 192)), c);
                }
                const int t = 32 * tb + r32;
#pragma unroll
                for (int g = 0; g < 4; ++g) { const int s0 = 32 * sb + 8 * g + 4 * hi; float x[4];
#pragma unroll
                    for (int e = 0; e < 4; ++e) x[e] = (s0 + e <= t) ? c[4 * g + e] : 0.f;
                    *(LAS u32x2*)(lds + G_AM + t * 144 + s0 * 2) = (u32x2){pk2(x[0], x[1]), pk2(x[2], x[3])}; }
            } else if (w == 3) {
#pragma unroll
                for (int g = 0; g < 4; ++g) *(LAS u32x2*)(lds + G_AM + r32 * 144 + (32 + 8 * g + 4 * hi) * 2) = (u32x2){0u, 0u};
            }
            asm volatile("s_waitcnt lgkmcnt(0)\n\ts_barrier" ::: "memory");
        }
        bf16x8 vf[4];
        { const LAS unsigned char* vp = lds + G_VIM + w * 4096 + trq + (8 * hi + q4) * 64;
#pragma unroll
          for (int ss = 0; ss < 4; ++ss) vf[ss] = cat8(tr16(vp + ss * 1024), tr16(vp + ss * 1024 + 256)); }
        if (FULL) {
#pragma unroll
            for (int tb = 0; tb < 2; ++tb)
#pragma unroll
                for (int r = 0; r < 16; ++r) o[tb][r] = 0.f;
            const int trk = trq + (4 * hi + q4) * 192;
#pragma unroll
            for (int kb = 0; kb < 4; ++kb)
#pragma unroll
                for (int s2 = 0; s2 < 2; ++s2) {
                    u32x4 x; x.x = pk2(S[kb][8 * s2 + 0], S[kb][8 * s2 + 1]); x.y = pk2(S[kb][8 * s2 + 2], S[kb][8 * s2 + 3]); x.z = pk2(S[kb][8 * s2 + 4], S[kb][8 * s2 + 5]); x.w = pk2(S[kb][8 * s2 + 6], S[kb][8 * s2 + 7]);
                    const bf16x8 bS = __builtin_bit_cast(bf16x8, x);
#pragma unroll
                    for (int tb = 0; tb < 2; ++tb) { const LAS unsigned char* ap = lds + G_QET + trk + (32 * kb + 16 * s2) * 192 + tb * 64;
                        o[tb] = MFMA32(cat8(tr16(ap), tr16(ap + 8 * 192)), bS, o[tb]); }
                }
#pragma unroll
            for (int ss = 0; ss < 4; ++ss)
#pragma unroll
                for (int tb = 0; tb < 2; ++tb) { const bf16x8 a = *(const LAS bf16x8*)(lds + G_AM + (32 * tb + r32) * 144 + (16 * ss + 8 * hi) * 2);
                    o[tb] = MFMA32(a, vf[ss], o[tb]); }
        }
#pragma unroll
        for (int kb = 0; kb < 4; ++kb) {
#pragma unroll
            for (int g = 0; g < 4; ++g) { const f32x4 d4 = *(const LAS f32x4*)((LAS float*)(lds + G_DV) + 32 * kb + 8 * g + 4 * hi);
#pragma unroll
                for (int e = 0; e < 4; ++e) S[kb][4 * g + e] *= d4[e]; }
#pragma unroll
            for (int ss = 0; ss < 4; ++ss) { const bf16x8 a = *(const LAS bf16x8*)(lds + G_KDT + (32 * kb + r32) * 144 + (16 * ss + 8 * hi) * 2);
                S[kb] = MFMA32(a, vf[ss], S[kb]); }
        }
        if (FULL) {
            asm volatile("s_waitcnt lgkmcnt(0)\n\ts_barrier" ::: "memory");
            LAS float* OST = (LAS float*)lds;
#pragma unroll
            for (int tb = 0; tb < 2; ++tb)
#pragma unroll
                for (int r = 0; r < 16; ++r) OST[(32 * tb + crow(r, hi)) * 256 + 32 * w + r32] = o[tb][r];
            u32x4 erg[2], ega[2], egb[2], eoa[2];
            unsigned lo_e = (unsigned)((((MODE == 0) ? (tid >> 5) : ((tid >> 5) & 15)) * 1024 + 8 * (tid & 31)) * 2);
#define GLA_ELOADS(i0) do { asm volatile("" : "+v"(lo_e)); _Pragma("unroll") for (int i = 0; i < 2; ++i) { \
                const size_t ub = ((mc + ((MODE == 0) ? 16 * ((i0) + i) : 0)) * 1024 + h * 256) * 2; \
                erg[i] = *(const GAS u32x4*)((const GAS char*)P.RG + ub + lo_e); ega[i] = *(const GAS u32x4*)((const GAS char*)P.GA + ub + lo_e); \
                egb[i] = *(const GAS u32x4*)((const GAS char*)P.GB + ub + lo_e); eoa[i] = *(const GAS u32x4*)((const GAS char*)P.OA + ub + lo_e); } } while (0)
            GLA_ELOADS(0);
            asm volatile("s_waitcnt lgkmcnt(0)\n\ts_barrier" ::: "memory");
#pragma unroll
            for (int i0 = 0; i0 < 4; i0 += 2) {
#pragma unroll
              for (int i = 0; i < 2; ++i) {
                const int idx = tid + 512 * (i0 + i), t = idx >> 5, c8 = idx & 31;
                const f32x4 oa4 = *(const LAS f32x4*)(OST + t * 256 + 8 * c8), ob4 = *(const LAS f32x4*)(OST + t * 256 + 8 * c8 + 4);
                float ssq = (oa4.x * oa4.x + oa4.y * oa4.y) + (oa4.z * oa4.z + oa4.w * oa4.w) + (ob4.x * ob4.x + ob4.y * ob4.y) + (ob4.z * ob4.z + ob4.w * ob4.w);
                ssq = half_sum(ssq);
                const float rstd = frsq(ssq * (1.0f / 256.0f) + EPS);
                if (MODE == 0 || t < 16) {
                    const size_t off = (mc + t) * 1024 + h * 256 + 8 * c8;
                    const f32x4 gw0 = *(const GAS f32x4*)(P.gnw + 8 * c8), gw1 = *(const GAS f32x4*)(P.gnw + 8 * c8 + 4);
                    float ov[8] = {oa4.x, oa4.y, oa4.z, oa4.w, ob4.x, ob4.y, ob4.z, ob4.w}; float gwv[8] = {gw0.x, gw0.y, gw0.z, gw0.w, gw1.x, gw1.y, gw1.z, gw1.w};
                    float res[8];
#pragma unroll
                    for (int e = 0; e < 8; ++e) {
                        const unsigned ru = erg[i][e >> 1], gau = ega[i][e >> 1], gbu = egb[i][e >> 1], oau = eoa[i][e >> 1];
                        const float rv = (e & 1) ? bfhi(ru) : bflo(ru), gav = (e & 1) ? bfhi(gau) : bflo(gau), gbv = (e & 1) ? bfhi(gbu) : bflo(gbu), oav = (e & 1) ? bfhi(oau) : bflo(oau);
                        const float og = ov[e] * rstd * gwv[e] * (rv * sigmoidf_(rv));
                        res[e] = sigmoidf_(gav) * oav + sigmoidf_(gbv) * og;
                    }
                    u32x4 mo; mo.x = pk2(res[0], res[1]); mo.y = pk2(res[2], res[3]); mo.z = pk2(res[4], res[5]); mo.w = pk2(res[6], res[7]);
                    *(GAS u32x4*)(P.MG + off) = mo;
                }
              }
              if (i0 == 0) { asm volatile("" ::: "memory"); GLA_ELOADS(2); }
            }
#undef GLA_ELOADS
        }
        asm volatile("s_waitcnt lgkmcnt(0)\n\ts_barrier" ::: "memory");
    }
#undef GLA_LOADS
}
__device__ __forceinline__ void gla_store_state(GAS float* p, const f32x16 (&S)[4], int w, int r32, int hi) {
    unsigned off = (unsigned)(4 * hi * 256 + 32 * w + r32);
#pragma unroll
    for (int kb = 0; kb < 4; ++kb)
#pragma unroll
        for (int g4 = 0; g4 < 4; ++g4) {
#pragma unroll
            for (int e = 0; e < 4; ++e) p[off + e * 256] = S[kb][4 * g4 + e];
            off += 8 * 256; asm volatile("" : "+v"(off)); }
}
__device__ __forceinline__ void gla_load_state(const GAS float* p, f32x16 (&S)[4], int w, int r32, int hi) {
    unsigned off = (unsigned)(4 * hi * 256 + 32 * w + r32);
#pragma unroll
    for (int kb = 0; kb < 4; ++kb)
#pragma unroll
        for (int g4 = 0; g4 < 4; ++g4) {
#pragma unroll
            for (int e = 0; e < 4; ++e) S[kb][4 * g4 + e] = p[off + e * 256];
            off += 8 * 256; asm volatile("" : "+v"(off)); }
}

__device__ __forceinline__ void rowpass(const GAS float* tmp, const GAS float* xin_p, const GAS float* xin_s, GAS float* xout, const GAS float* wpost, const GAS float* wnext, GAS bf16* xn, int gw, int ngw, int lane) {
    for (int m = gw; m < MT; m += ngw) {
        const GAS f32x4* tr = (const GAS f32x4*)(tmp + (size_t)m * DM) + lane;
        const GAS float* xrow = (m < MP) ? xin_p + (size_t)m * DM : xin_s + (size_t)(m - MP) * DM;
        const GAS f32x4* xr = (const GAS f32x4*)xrow + lane;
        f32x4 tv[4], xv[4]; float s = 0.f;
#pragma unroll
        for (int j = 0; j < 4; ++j) { tv[j] = tr[64 * j]; xv[j] = xr[64 * j]; s += (tv[j].x * tv[j].x + tv[j].y * tv[j].y) + (tv[j].z * tv[j].z + tv[j].w * tv[j].w); }
        const float r1 = frsq(wave_sum(s) * (1.f / DM) + EPS);
        float s2 = 0.f;
#pragma unroll
        for (int j = 0; j < 4; ++j) { const f32x4 g = *((const GAS f32x4*)wpost + lane + 64 * j); xv[j] = xv[j] + tv[j] * r1 * g; s2 += (xv[j].x * xv[j].x + xv[j].y * xv[j].y) + (xv[j].z * xv[j].z + xv[j].w * xv[j].w); }
        GAS f32x4* orow = (GAS f32x4*)(xout + (size_t)m * DM) + lane;
#pragma unroll
        for (int j = 0; j < 4; ++j) orow[64 * j] = xv[j];
        if (xn) {
            const float r2 = frsq(wave_sum(s2) * (1.f / DM) + EPS);
            GAS u32x2* o8 = (GAS u32x2*)(xn + (size_t)m * DM) + lane;
#pragma unroll
            for (int j = 0; j < 4; ++j) { const f32x4 g = *((const GAS f32x4*)wnext + lane + 64 * j); u32x2 o; o.x = pk2(xv[j].x * r2 * g.x, xv[j].y * r2 * g.y); o.y = pk2(xv[j].z * r2 * g.z, xv[j].w * r2 * g.w); o8[64 * j] = o; }
        }
    }
}
__device__ __forceinline__ float gelu_tanh(float x) {
    const float u = 0.7978845608028654f * (x + 0.044715f * x * x * x);
    const float e = __expf(2.f * u);
    const float th = 1.f - 2.f * frcp(e + 1.f);
    return 0.5f * x * (1.f + th);
}
__device__ __forceinline__ void act_pass(const GAS bf16* UG, GAS bf16* ACT, const GAS float* convw, const GAS float* convb, const GAS float* sconv  ,
                                         GAS float* cout_p, GAS float* cout_s, int vcu, int G, int tid) {
    if (tid >= DFF / 8) return;
    const int c = tid * 8;
    float w0[8], w1[8], w2[8], cb[8];
#pragma unroll
    for (int e = 0; e < 8; ++e) { w0[e] = convw[c + e]; w1[e] = convw[DFF + c + e]; w2[e] = convw[2 * DFF + c + e]; cb[e] = convb[c + e]; }
    for (int strip = vcu; strip < MT / 16; strip += G) {
        const int m0 = strip * 16; const bool sample = (m0 >= MP);
        float gm2[8], gm1[8];
        if (sample) { const int b = (m0 - MP) >> 4; const GAS float* sc = sconv + (size_t)b * 2 * DFF + c;
#pragma unroll
            for (int e = 0; e < 8; ++e) { gm2[e] = sc[e]; gm1[e] = sc[DFF + e]; } }
        else if ((m0 & (SEQ - 1)) == 0) {
#pragma unroll
            for (int e = 0; e < 8; ++e) { gm2[e] = 0.f; gm1[e] = 0.f; } }
        else { const u32x4 a = *(const GAS u32x4*)(UG + (size_t)(m0 - 2) * 5632 + DFF + c), bq = *(const GAS u32x4*)(UG + (size_t)(m0 - 1) * 5632 + DFF + c);
#pragma unroll
            for (int e = 0; e < 4; ++e) { gm2[2 * e] = bflo(a[e]); gm2[2 * e + 1] = bfhi(a[e]); gm1[2 * e] = bflo(bq[e]); gm1[2 * e + 1] = bfhi(bq[e]); } }
#pragma unroll 4
        for (int i = 0; i < 16; ++i) {
            const size_t m = (size_t)m0 + i;
            const u32x4 uu = *(const GAS u32x4*)(UG + m * 5632 + c), gg = *(const GAS u32x4*)(UG + m * 5632 + DFF + c);
            float g0[8], res[8];
#pragma unroll
            for (int e = 0; e < 4; ++e) { g0[2 * e] = bflo(gg[e]); g0[2 * e + 1] = bfhi(gg[e]); }
#pragma unroll
            for (int e = 0; e < 8; ++e) { const float uv = (e & 1) ? bfhi(uu[e >> 1]) : bflo(uu[e >> 1]);
                const float gc = cb[e] + w0[e] * gm2[e] + w1[e] * gm1[e] + w2[e] * g0[e]; res[e] = gelu_tanh(gc) * uv; gm2[e] = gm1[e]; gm1[e] = g0[e]; }
            u32x4 o; o.x = pk2(res[0], res[1]); o.y = pk2(res[2], res[3]); o.z = pk2(res[4], res[5]); o.w = pk2(res[6], res[7]);
            *(GAS u32x4*)(ACT + m * DFF + c) = o;
        }
        if (sample) { const int b = (m0 - MP) >> 4; GAS float* co = cout_s + (size_t)b * 2 * DFF + c;
#pragma unroll
            for (int e = 0; e < 8; ++e) { co[e] = gm2[e]; co[DFF + e] = gm1[e]; } }
        else if ((m0 & (SEQ - 1)) == SEQ - 16) { const int b = m0 >> 13; GAS float* co = cout_p + (size_t)b * 2 * DFF + c;
#pragma unroll
            for (int e = 0; e < 8; ++e) { co[e] = gm2[e]; co[DFF + e] = gm1[e]; } }
    }
}

__global__ void __launch_bounds__(NWAVES * 64, 2) mega_fwd(Args args) {
#define AIN(i) ((const GAS float*)args.in[i])
    extern __shared__ __attribute__((aligned(16))) unsigned char lds_raw[];
    LAS unsigned char* lds = (LAS unsigned char*)lds_raw;
    volatile LAS unsigned* MISC = (volatile LAS unsigned*)(lds + MISC_OFF);
    const int tid0 = threadIdx.x;
    const int G0 = gridDim.x; const int bx0 = blockIdx.x; const int vcu0 = (G0 % 8 == 0) ? (bx0 % 8) * (G0 / 8) + bx0 / 8 : bx0;
    GAS unsigned char* ws0 = (GAS unsigned char*)args.ws;
#define OPQ() GAS unsigned char* ws = ws0; GAS float* out = out0; asm volatile("" : "+s"(ws), "+s"(out)); int G = G0, bx = bx0, vcu = vcu0; asm volatile("" : "+s"(G), "+s"(bx), "+s"(vcu)); const int NGW = G * NWAVES; (void)NGW; (void)bx; const int tid = opaque_tid(), lane = tid & 63, wave = __builtin_amdgcn_readfirstlane(tid >> 6), gw = vcu * NWAVES + wave; (void)gw; (void)lane
#define GRID_BAR() xcd_barrier_ni(bar.bar, bar.x, bar.st)
    for (int u = tid0; u < (LDS_BYTES - MISC_OFF) / 4; u += NWAVES * 64) ((LAS unsigned*)(lds + MISC_OFF))[u] = 0u;
    __syncthreads();
    XcdBarrier bar = xcd_barrier_post((unsigned*)args.ws + CW_BAR, MISC + 8);
    (void)args.ph_lo;
#ifndef PHMASK
#define PHMASK 0xfffff
#endif
#define IN(k) true
#define EN(i) ((PHMASK >> (i)) & 1)
#ifndef REPMASK
#define REPMASK 0
#endif
#define REP(i) ((REPMASK >> (i)) & 1)
#ifndef NOFOLD
#define NOFOLD 0
#endif
    GAS float* const out0 = (GAS float*)args.out;

    if (EN(0) && IN(0)) { OPQ(); GAS bf16* const XN = (GAS bf16*)(ws + WS_XN);
        LAS float* scr = (LAS float*)(lds + wave * 16384);
        for (int li = 0; li < DEPTH; ++li) {
            GAS unsigned char* wl = ws + WS_W + (size_t)li * W_LAYER;
            const GAS float* w_in = AIN(I_WIN) + (size_t)li * DM * DIN; const GAS float* w_gk2 = AIN(I_WGK2) + (size_t)li * 16 * 512;
            const GAS float* w_o = AIN(I_WO) + (size_t)li * DM * DM; const GAS float* w_up = AIN(I_WUP) + (size_t)li * DM * 2 * DFF; const GAS float* w_dn = AIN(I_WDOWN) + (size_t)li * DFF * DM;
            constexpr int IT_IN = (NIN / 32) * 16, IT_O = 32 * 16, IT_UP = (2 * DFF / 32) * 16, IT_DN = 32 * (DFF / 64);
            for (int it = gw; it < IT_IN + IT_O + IT_UP + IT_DN; it += NGW) {
                int r = it;
                if (r < IT_IN) { const int nb = r >> 4, kb = r & 15;
                    if (nb < 192) transpose_item(w_in, DIN, DM, (GAS bf16*)(wl + W_IN), scr, kb, 32 * nb, 32 * nb, lane, nullptr);
                    else if (nb < 256) transpose_item(w_in, DIN, DM, (GAS bf16*)(wl + W_IN), scr, kb, 32 * nb + 16, 32 * nb, lane, nullptr);
                    else transpose_item(w_in, DIN, DM, (GAS bf16*)(wl + W_IN), scr, kb, 32 * (nb - 256), 32 * nb, lane, w_gk2);
                    continue; }
                r -= IT_IN;
                if (r < IT_O) { transpose_item(w_o, DM, DM, (GAS bf16*)(wl + W_O), scr, r & 15, 32 * (r >> 4), 32 * (r >> 4), lane, nullptr); continue; }
                r -= IT_O;
                if (r < IT_UP) { transpose_item(w_up, 2 * DFF, DM, (GAS bf16*)(wl + W_UP), scr, r & 15, 32 * (r >> 4), 32 * (r >> 4), lane, nullptr); continue; }
                r -= IT_UP;
                { const int nb = r / (DFF / 64), kb = r % (DFF / 64); transpose_item(w_dn, DM, DFF, (GAS bf16*)(wl + W_DN), scr, kb, 32 * nb, 32 * nb, lane, nullptr); }
            }
        }
        for (int i = vcu * 512 + tid; i < SEQ * 8; i += G * 512) { const int pos = i >> 3, f = i & 7; float sn, cs; sincos_acc((float)pos * args.inv_freq[f], sn, cs);
            ((GAS float*)(ws + WS_ROPE))[pos * 16 + f] = cs; ((GAS float*)(ws + WS_ROPE))[pos * 16 + 8 + f] = sn; }
        for (int m = gw; m < MT; m += NGW) { const GAS float* xrow = (m < MP) ? AIN(I_XP) + (size_t)m * DM : AIN(I_XS) + (size_t)(m - MP) * DM;
            rms_row_to_bf16(xrow, AIN(I_PREMIX), XN + (size_t)m * DM, lane); }
        GRID_BAR();
    }

    for (int li = 0; li < DEPTH; ++li) {
        const int pb = 1 + li * 16;
        if (EN(1) && IN(pb + 0)) { OPQ(); GAS unsigned char* wl = ws + WS_W + (size_t)li * W_LAYER; GAS bf16* const XN = (GAS bf16*)(ws + WS_XN); const GAS float* rope = (const GAS float*)(ws + WS_ROPE);
          for (int rep = 0; rep < ((REP(1) && li == 0) ? 2 : 1); ++rep) {
            pg8::Gemm g{(const GAS pg8::bf16_t*)XN, (const GAS pg8::bf16_t*)(wl + W_IN), MT, NIN, DM}; pg8::StaticOrder S; S.init(MT, NIN, G, bx);
            EpiIn E{ws, out + O_KP + (size_t)li * MP * DM, out + O_VP + (size_t)li * MP * DM, out + O_KS + (size_t)li * MS * DM, out + O_VS + (size_t)li * MS * DM, rope, AIN(I_BGK2) + li * 512};
            pg8::gemm_phase<EpiIn, pg8::StaticOrder, true, true>(lds, g, S, E);
            GRID_BAR();
          }
        }
        if (EN(2) && IN(pb + 1)) { OPQ(); GAS unsigned char* wl = ws + WS_W + (size_t)li * W_LAYER; GAS bf16* const XN = (GAS bf16*)(ws + WS_XN); const GAS float* rope = (const GAS float*)(ws + WS_ROPE);
          for (int rep = 0; rep < ((REP(2) && li == 0) ? 2 : 1); ++rep) {
            float lam, onem;
            { const float a = wave_sum(AIN(I_LQ1)[li * 64 + lane] * AIN(I_LK1)[li * 64 + lane]), c = wave_sum(AIN(I_LQ2)[li * 64 + lane] * AIN(I_LK2)[li * 64 + lane]);
              const float lam_init = 0.8f - 0.6f * expf(-0.3f * (float)li); lam = expf(a) - expf(c) + lam_init; onem = 1.0f - lam_init; }
            const GAS bf16* QA = (const GAS bf16*)(ws + WS_QA); const GAS bf16* KA = (const GAS bf16*)(ws + WS_KA); const GAS bf16* VA = (const GAS bf16*)(ws + WS_VA);
            const GAS float* nw = AIN(I_DANW) + li * 128;
            for (int rp = 0; rp < ((REP(10) && li == 0) ? 2 : 1); ++rp)
            if (EN(10)) for (int un = vcu; un < DB * 8; un += G)
                attn_unit<1>(lds, QA, KA, VA, (GAS bf16*)(ws + WS_OA), AIN(I_CK) + (size_t)li * DB * PAST * DM, AIN(I_CV) + (size_t)li * DB * PAST * DM, un >> 3, un & 7, 0, lam, onem, nw);
            for (int rp = 0; rp < ((REP(11) && li == 0) ? 2 : 1); ++rp)
            if (EN(11)) for (int it = vcu; it < 256; it += G) {
                GlaP P{(const GAS bf16*)(ws + WS_QG), (const GAS bf16*)(ws + WS_KG), (const GAS bf16*)(ws + WS_VG), (const GAS bf16*)(ws + WS_GK), nullptr, nullptr, nullptr, nullptr, nullptr, nullptr};
                f32x16 S[4];
#pragma unroll
                for (int kb = 0; kb < 4; ++kb)
#pragma unroll
                    for (int r = 0; r < 16; ++r) S[kb][r] = 0.f;
                float ds0 = 0.f, ds1 = 0.f;
                const int bh = it >> 3, grp = it & 7;
                gla_run<false, 0>(lds, P, (size_t)(bh >> 2) * SEQ + grp * 1024, bh & 3, 16, S, ds0, ds1);
                gla_store_state((GAS float*)(ws + WS_SLOC) + (size_t)it * 32768, S, wave, lane & 31, lane >> 5);
                if (wave == 0) { GAS float* dg = (GAS float*)(ws + WS_DG) + it * 128 + 2 * lane; dg[0] = __expf(ds0); dg[1] = __expf(ds1); }
            }
            if (EN(12)) for (int pi = vcu; pi < 2048; pi += G) {
                const int bh = (pi % 256) >> 2, s = (pi & 3) + 4 * (pi / 256);
                attn_prompt_unit(lds, QA, KA, VA, (GAS bf16*)(ws + WS_OA), bh >> 3, bh & 7, 63 - s, lam, onem, nw);
                attn_prompt_unit(lds, QA, KA, VA, (GAS bf16*)(ws + WS_OA), bh >> 3, bh & 7, s, lam, onem, nw);
            }
            GRID_BAR();
          }
        }
        if (EN(3) && IN(pb + 2)) { OPQ(); GAS unsigned char* wl = ws + WS_W + (size_t)li * W_LAYER; GAS bf16* const XN = (GAS bf16*)(ws + WS_XN); const GAS float* rope = (const GAS float*)(ws + WS_ROPE);
          for (int rep = 0; rep < ((REP(3) && li == 0) ? 2 : 1); ++rep) {
            GlaP P{(const GAS bf16*)(ws + WS_QG), (const GAS bf16*)(ws + WS_KG), (const GAS bf16*)(ws + WS_VG), (const GAS bf16*)(ws + WS_GK), (const GAS bf16*)(ws + WS_RG), (const GAS bf16*)(ws + WS_GA), (const GAS bf16*)(ws + WS_GB),
                   (const GAS bf16*)(ws + WS_OA), (GAS bf16*)(ws + WS_QA), AIN(I_GLANW) + li * 256};
            const int r32 = lane & 31, hh = lane >> 5;
            if (EN(13)) for (int it = vcu; it < 256; it += G) {
                const int bh = it >> 3, grp = it & 7;
                f32x16 S[4];
#pragma unroll
                for (int kb = 0; kb < 4; ++kb)
#pragma unroll
                    for (int r = 0; r < 16; ++r) S[kb][r] = 0.f;
                for (int j = 0; j < (NOFOLD ? 0 : grp); ++j) {
                    const GAS float* dg = (const GAS float*)(ws + WS_DG) + (size_t)(bh * 8 + j) * 128 + 4 * hh; const GAS float* sl = (const GAS float*)(ws + WS_SLOC) + (size_t)(bh * 8 + j) * 32768;
                    unsigned off = (unsigned)(4 * hh * 256 + 32 * wave + r32);
#pragma unroll
                    for (int kb = 0; kb < 4; ++kb)
#pragma unroll
                        for (int g4 = 0; g4 < 4; ++g4) { const f32x4 d4 = *(const GAS f32x4*)(dg + 32 * kb + 8 * g4);
#pragma unroll
                            for (int e = 0; e < 4; ++e) S[kb][4 * g4 + e] = S[kb][4 * g4 + e] * d4[e] + sl[off + e * 256];
                            off += 8 * 256; asm volatile("" : "+v"(off)); }
                }
                float ds0 = 0.f, ds1 = 0.f;
                gla_run<true, 0>(lds, P, (size_t)(bh >> 2) * SEQ + grp * 1024, bh & 3, 16, S, ds0, ds1);
                if (grp == 7) gla_store_state(out + O_GP + ((size_t)li * 32 + bh) * 32768, S, wave, r32, hh);
            }
            if (EN(14)) for (int it = vcu; it < DB * 4; it += G) {
                const int b = it >> 2, h = it & 3;
                const GAS float* s0 = AIN(I_SG) + ((size_t)li * DB * 4 + it) * 32768;
                f32x16 S[4];
                gla_load_state(s0, S, wave, r32, hh);
                float ds0 = 0.f, ds1 = 0.f;
                gla_run<true, 1>(lds, P, (size_t)MP + b * 16, h, 1, S, ds0, ds1);
                gla_store_state(out + O_GS + ((size_t)li * DB * 4 + it) * 32768, S, wave, r32, hh);
            }
            GRID_BAR();
          }
        }
        if (EN(4) && IN(pb + 3)) { OPQ(); GAS unsigned char* wl = ws + WS_W + (size_t)li * W_LAYER; GAS bf16* const XN = (GAS bf16*)(ws + WS_XN); const GAS float* rope = (const GAS float*)(ws + WS_ROPE);
          for (int rep = 0; rep < ((REP(4) && li == 0) ? 2 : 1); ++rep) {
            pg8::Gemm g{(const GAS pg8::bf16_t*)(ws + WS_QA), (const GAS pg8::bf16_t*)(wl + W_O), MT, DM, DM}; pg8::StaticOrder S; S.init(MT, DM, G, bx);
            EpiF32 E{(GAS float*)(ws + WS_TMP), DM};
            pg8::gemm_phase<EpiF32, pg8::StaticOrder, true, true>(lds, g, S, E);
            GRID_BAR();
          }
        }
        if (EN(5) && IN(pb + 4)) { OPQ(); GAS unsigned char* wl = ws + WS_W + (size_t)li * W_LAYER; GAS bf16* const XN = (GAS bf16*)(ws + WS_XN); const GAS float* rope = (const GAS float*)(ws + WS_ROPE);
          for (int rep = 0; rep < ((REP(5) && li == 0) ? 2 : 1); ++rep) {
            rowpass((const GAS float*)(ws + WS_TMP), li == 0 ? AIN(I_XP) : out, li == 0 ? AIN(I_XS) : out + (size_t)MP * DM, out,
                    AIN(I_POSTMIX) + li * DM, AIN(I_PREFFN) + li * DM, XN, gw, NGW, lane);
            GRID_BAR();
          }
        }
        if (EN(6) && IN(pb + 5)) { OPQ(); GAS unsigned char* wl = ws + WS_W + (size_t)li * W_LAYER; GAS bf16* const XN = (GAS bf16*)(ws + WS_XN); const GAS float* rope = (const GAS float*)(ws + WS_ROPE);
          for (int rep = 0; rep < ((REP(6) && li == 0) ? 2 : 1); ++rep) {
            pg8::Gemm g{(const GAS pg8::bf16_t*)XN, (const GAS pg8::bf16_t*)(wl + W_UP), MT, 2 * DFF, DM}; pg8::StaticOrder S; S.init(MT, 2 * DFF, G, bx);
            EpiB16 E{(GAS bf16*)(ws + WS_UG), 2 * DFF};
            pg8::gemm_phase<EpiB16, pg8::StaticOrder, true, true>(lds, g, S, E);
            GRID_BAR();
          }
        }
        if (EN(7) && IN(pb + 6)) { OPQ(); GAS unsigned char* wl = ws + WS_W + (size_t)li * W_LAYER; GAS bf16* const XN = (GAS bf16*)(ws + WS_XN); const GAS float* rope = (const GAS float*)(ws + WS_ROPE);
          for (int rep = 0; rep < ((REP(7) && li == 0) ? 2 : 1); ++rep) {
            act_pass((const GAS bf16*)(ws + WS_UG), (GAS bf16*)(ws + WS_ACT), AIN(I_CONVW) + (size_t)li * 3 * DFF, AIN(I_CONVB) + (size_t)li * DFF, AIN(I_SC) + (size_t)li * DB * 2 * DFF,
                     out + O_CP + (size_t)li * NB * 2 * DFF, out + O_CS + (size_t)li * DB * 2 * DFF, vcu, G, tid);
            GRID_BAR();
          }
        }
        if (EN(8) && IN(pb + 7)) { OPQ(); GAS unsigned char* wl = ws + WS_W + (size_t)li * W_LAYER; GAS bf16* const XN = (GAS bf16*)(ws + WS_XN); const GAS float* rope = (const GAS float*)(ws + WS_ROPE);
          for (int rep = 0; rep < ((REP(8) && li == 0) ? 2 : 1); ++rep) {
            pg8::Gemm g{(const GAS pg8::bf16_t*)(ws + WS_ACT), (const GAS pg8::bf16_t*)(wl + W_DN), MT, DM, DFF}; pg8::StaticOrder S; S.init(MT, DM, G, bx);
            EpiF32 E{(GAS float*)(ws + WS_TMP), DM};
            pg8::gemm_phase<EpiF32, pg8::StaticOrder, true, true>(lds, g, S, E);
            GRID_BAR();
          }
        }
        if (EN(9) && IN(pb + 8)) { OPQ(); GAS unsigned char* wl = ws + WS_W + (size_t)li * W_LAYER; GAS bf16* const XN = (GAS bf16*)(ws + WS_XN); const GAS float* rope = (const GAS float*)(ws + WS_ROPE);
            const bool more = (li + 1 < DEPTH);
            rowpass((const GAS float*)(ws + WS_TMP), out, out + (size_t)MP * DM, out, AIN(I_POSTFFN) + li * DM, more ? AIN(I_PREMIX) + (li + 1) * DM : nullptr, more ? XN : nullptr, gw, NGW, lane);
            if (more) GRID_BAR();
        }
    }
#undef IN
}

extern "C" void kernel_launch(void* const* d_in, const int* in_sizes, int n_in, void* d_out, int out_size, void* d_ws, size_t ws_size, hipStream_t stream) {
    static int grid = 0;
    if (grid == 0) {
        if (n_in != 24 || (size_t)out_size != O_END || ws_size < WS_END) { fprintf(stderr, "kernel_launch: unexpected shapes: n_in %d out %d (want %zu) ws %zu (want %zu)\n", n_in, out_size, (size_t)O_END, ws_size, (size_t)WS_END); grid = -1; return; }
        int dev = 0, cus = 0, per_cu = 0;
        if (hipGetDevice(&dev) != hipSuccess || hipDeviceGetAttribute(&cus, hipDeviceAttributeMultiprocessorCount, dev) != hipSuccess) { grid = -1; return; }
        if (hipFuncSetAttribute((const void*)mega_fwd, hipFuncAttributeMaxDynamicSharedMemorySize, LDS_BYTES) != hipSuccess) { fprintf(stderr, "kernel_launch: hipFuncSetAttribute failed\n"); grid = -1; return; }
        if (hipOccupancyMaxActiveBlocksPerMultiprocessor(&per_cu, (const void*)mega_fwd, NWAVES * 64, LDS_BYTES) != hipSuccess || per_cu < 1) { fprintf(stderr, "kernel_launch: occupancy query reports %d\n", per_cu); }
        (void)hipGetLastError();
        grid = cus;
    }
    if (grid < 0) return;
    if (hipMemsetAsync((char*)d_ws + WS_CTL, 0, CTL_ZERO_BYTES, stream) != hipSuccess) return;
    Args a{};
    for (int i = 0; i < 24; ++i) a.in[i] = (const float*)d_in[i];
    a.out = (float*)d_out; a.ws = (unsigned char*)d_ws;
    for (int i = 0; i < 8; ++i) a.inv_freq[i] = (float)pow(500000.0, -(double)i / 8.0);
    a.ph_lo = 0; a.ph_hi = 1000;
    hipLaunchKernelGGL(mega_fwd, dim3(grid), dim3(NWAVES * 64), LDS_BYTES, stream, a);
}
```

```cpp
#include <hip/hip_runtime.h>
#include <cstdio>
#include <cstdint>
#include <cmath>
__device__ __forceinline__ int opaque_tid() { int t = threadIdx.x; asm volatile("" : "+v"(t)); return t; }
namespace pg8 {
#define PG8_LAS __attribute__((address_space(3)))
typedef unsigned short bf16_t;
typedef short bf16x8 __attribute__((ext_vector_type(8)));
typedef float f32x4 __attribute__((ext_vector_type(4)));
typedef unsigned u32x4 __attribute__((ext_vector_type(4)));
constexpr int BM = 256, BK = 64, HALF = 128, HTB = HALF * BK * 2  , STAGE_BYTES = 8 * HTB, NXCD = 8, WGM = 8;

__host__ __device__ __forceinline__ int lds_byte(int r, int c) { const int st = (r >> 4) * 2 + (c >> 5), rr = r & 15, cc = c & 31, ob = rr * 64 + cc * 2; return st * 1024 + (ob ^ (((ob >> 9) & 1) << 5)); }
__host__ __device__ __forceinline__ void stage_rc(int b, int& R, int& C) { const int st = b / 1024, sb = b % 1024, swz = sb ^ (((sb >> 9) & 1) << 5); R = (st >> 1) * 16 + swz / 64; C = (st & 1) * 32 + (swz % 64) / 2; }
__host__ __device__ __forceinline__ int perm32(int rho) { const int n = rho >> 4, i = rho & 15; return 8 * (i >> 2) + 4 * n + (i & 3); }

struct Unit { int pm, pn, ko; };
struct Gemm { const __attribute__((address_space(1))) bf16_t* A; const __attribute__((address_space(1))) bf16_t* Bt; int M, N, K, ld; };

struct StaticOrder {
    int nM, nN, nwg, G, c;
    __host__ __device__ void init(int M, int N, int G_, int c_) { nM = M / BM; nN = N / BM; nwg = nM * nN; G = G_; c = c_; }
    __host__ __device__ bool next(int i, Unit& u) const {
        const long L = (long)i * G + c; if (L >= nwg) return false;
        int wgid = (int)L; { const int q = nwg / NXCD, r = nwg % NXCD, xcd = wgid % NXCD, off = wgid / NXCD; wgid = (xcd < r ? xcd * (q + 1) : r * (q + 1) + (xcd - r) * q) + off; }
        const int nig = WGM * nN, gid = wgid / nig, fm = gid * WGM, gsz = (nM - fm) < WGM ? (nM - fm) : WGM;
        u.pm = fm + ((wgid % nig) % gsz); u.pn = (wgid % nig) / gsz; u.ko = 0; return true;
    }
    __device__ __forceinline__ void a_ready(const Unit&) const {}
    __device__ __forceinline__ void done(const Unit&) const {}
};

__device__ __forceinline__ unsigned cvt_pk_bf16(float lo, float hi) { unsigned r; asm volatile("v_cvt_pk_bf16_f32 %0, %1, %2" : "=v"(r) : "v"(lo), "v"(hi)); return r; }
template <class Epi, class Sched, bool ALIGN_EPI = false, bool SP2 = false>
__device__ __forceinline__ void gemm_phase(PG8_LAS unsigned char* lds, const Gemm g, const Sched& S, const Epi& E) {
    const int tid = opaque_tid(), wid = __builtin_amdgcn_readfirstlane(tid >> 6), lane = tid & 63, wr = wid >> 2, wc = wid & 3, fr = lane & 15, fq = lane >> 4;
    const int K = g.ld, nt = g.K / BK;
    unsigned voffA[2], voffB[2];
#pragma unroll
    for (int i = 0; i < 2; ++i) { int R, C; stage_rc(tid * 16 + i * 8192, R, C); const int Rb = Epi::PERM ? ((R & ~31) + perm32(R & 31)) : R;
        voffA[i] = (unsigned)(R * K + C) * 2u; voffB[i] = (unsigned)(Rb * K + C) * 2u; }
    const size_t kstep = (size_t)(BK * 2);
    const size_t hstep = (size_t)HALF * K * 2;
    const size_t tstep = 2 * hstep;
    const unsigned ldsw = (unsigned)wid * 1024u;
    const int aoff = lds_byte(wr * 64 + fr, fq * 8), boff = lds_byte(wc * 32 + fr, fq * 8);
#define PG8_SA(b, h) (((b) * 2 + (h)) * HTB)
#define PG8_SB(b, h) ((4 + (b) * 2 + (h)) * HTB)
#define PG8_STAGE(bufoff, gbase, voff) do { _Pragma("unroll") for (int _i = 0; _i < 2; ++_i) \
        __builtin_amdgcn_global_load_lds((const unsigned*)((const char*)(gbase) + (voff)[_i]), (PG8_LAS unsigned*)(lds + (bufoff) + ldsw + _i * 8192), 16, 0, 0); } while (0)
#define PG8_LDA(dst, b, h) do { _Pragma("unroll") for (int m = 0; m < 4; ++m) _Pragma("unroll") for (int k = 0; k < 2; ++k) dst[m][k] = *(const PG8_LAS bf16x8*)(lds + PG8_SA(b, h) + aoff + m * 2048 + k * 1024); } while (0)
#define PG8_LDB(dst, b, h) do { _Pragma("unroll") for (int n = 0; n < 2; ++n) _Pragma("unroll") for (int k = 0; k < 2; ++k) dst[n][k] = *(const PG8_LAS bf16x8*)(lds + PG8_SB(b, h) + boff + n * 2048 + k * 1024); } while (0)
#define PG8_MMA(ai, bj, At, Bt) do { __builtin_amdgcn_s_setprio(1); _Pragma("unroll") for (int m = 0; m < 4; ++m) _Pragma("unroll") for (int n = 0; n < 2; ++n) _Pragma("unroll") for (int k = 0; k < 2; ++k) \
        acc[ai][bj][m][n] = __builtin_amdgcn_mfma_f32_16x16x32_bf16(Bt[n][k], At[m][k], acc[ai][bj][m][n], 0, 0, 0); __builtin_amdgcn_s_setprio(0); } while (0)
#define PG8_WAIT_V(n) asm volatile("s_waitcnt vmcnt(" #n ")" ::: "memory")
#define PG8_WAIT_L(n) asm volatile("s_waitcnt lgkmcnt(" #n ")" ::: "memory")
#define PG8_BAR __builtin_amdgcn_s_barrier()
#define PG8_SCHED __builtin_amdgcn_sched_barrier(0)
    Unit cur, nxt; int ui = 0;
    if (!S.next(0, cur)) return;
    f32x4 acc[2][2][4][2];
#pragma unroll
    for (int a = 0; a < 2; ++a)
#pragma unroll
        for (int b = 0; b < 2; ++b)
#pragma unroll
            for (int m = 0; m < 4; ++m)
#pragma unroll
                for (int n = 0; n < 2; ++n) acc[a][b][m][n] = (f32x4){0.f, 0.f, 0.f, 0.f};
    bf16x8 At[4][2], B0[2][2], B1[2][2];
    const char* cA = (const char*)g.A + (size_t)cur.pm * tstep + (size_t)cur.ko * 2; const char* cB = (const char*)g.Bt + (size_t)cur.pn * tstep + (size_t)cur.ko * 2;
    S.a_ready(cur);
    if constexpr (SP2) {
        PG8_STAGE(PG8_SB(0, 0), cB, voffB); PG8_STAGE(PG8_SB(0, 1), cB + hstep, voffB); PG8_STAGE(PG8_SA(0, 0), cA, voffA); PG8_STAGE(PG8_SA(0, 1), cA + hstep, voffA);
        if (wr == 1) PG8_BAR;
        PG8_WAIT_V(2); PG8_BAR;
        PG8_STAGE(PG8_SB(1, 0), cB + kstep, voffB); PG8_STAGE(PG8_SA(1, 0), cA + kstep, voffA); PG8_STAGE(PG8_SB(1, 1), cB + hstep + kstep, voffB);
        PG8_WAIT_V(6); PG8_BAR;
    } else {
        PG8_STAGE(PG8_SB(0, 0), cB, voffB); PG8_STAGE(PG8_SA(0, 0), cA, voffA); PG8_STAGE(PG8_SB(0, 1), cB + hstep, voffB); PG8_STAGE(PG8_SA(0, 1), cA + hstep, voffA);
        if (wr == 1) PG8_BAR;
        PG8_WAIT_V(4); PG8_BAR;
        PG8_STAGE(PG8_SB(1, 0), cB + kstep, voffB); PG8_STAGE(PG8_SA(1, 0), cA + kstep, voffA); PG8_STAGE(PG8_SB(1, 1), cB + hstep + kstep, voffB);
        PG8_WAIT_V(6); PG8_BAR;
    }
    for (;;) {
        const bool has_next = S.next(ui + 1, nxt);
        const char* nA = has_next ? (const char*)g.A + (size_t)nxt.pm * tstep + (size_t)nxt.ko * 2 : cA; const char* nB = has_next ? (const char*)g.Bt + (size_t)nxt.pn * tstep + (size_t)nxt.ko * 2 : cB;
        for (int t = 0; t < nt; t += 2) {
            const bool last = (t == nt - 2);
            const char* a1 = cA + (size_t)(t + 1) * kstep;
            const char* a2 = last ? nA : cA + (size_t)(t + 2) * kstep; const char* b2 = last ? nB : cB + (size_t)(t + 2) * kstep;
            const char* a3 = a2 + kstep; const char* b3 = b2 + kstep;
            if (last && has_next) S.a_ready(nxt);
            if constexpr (SP2) {
            PG8_LDB(B0, 0, 0); PG8_LDB(B1, 0, 1); PG8_SCHED; PG8_LDA(At, 0, 0); PG8_STAGE(PG8_SA(1, 1), a1 + hstep, voffA);
            PG8_WAIT_V(8); PG8_WAIT_L(0); PG8_BAR; PG8_MMA(0, 0, At, B0); PG8_MMA(0, 1, At, B1); PG8_BAR; PG8_SCHED;
            PG8_LDA(At, 0, 1); PG8_STAGE(PG8_SB(0, 0), b2, voffB); PG8_STAGE(PG8_SB(0, 1), b2 + hstep, voffB); PG8_STAGE(PG8_SA(0, 0), a2, voffA);
            PG8_WAIT_V(8); PG8_WAIT_L(0); PG8_BAR; PG8_MMA(1, 0, At, B0); PG8_MMA(1, 1, At, B1); PG8_BAR; PG8_SCHED;
            PG8_LDB(B0, 1, 0); PG8_LDB(B1, 1, 1); PG8_SCHED; PG8_LDA(At, 1, 0); PG8_STAGE(PG8_SA(0, 1), a2 + hstep, voffA);
            PG8_WAIT_V(8); PG8_WAIT_L(0); PG8_BAR; PG8_MMA(0, 0, At, B0); PG8_MMA(0, 1, At, B1); PG8_BAR; PG8_SCHED;
            PG8_LDA(At, 1, 1); PG8_STAGE(PG8_SB(1, 0), b3, voffB); PG8_STAGE(PG8_SB(1, 1), b3 + hstep, voffB); PG8_STAGE(PG8_SA(1, 0), a3, voffA);
            PG8_WAIT_V(8); PG8_WAIT_L(0); PG8_BAR; PG8_MMA(1, 0, At, B0); PG8_MMA(1, 1, At, B1); PG8_BAR; PG8_SCHED;
            } else {
            PG8_LDB(B0, 0, 0); PG8_SCHED; PG8_LDA(At, 0, 0); PG8_STAGE(PG8_SA(1, 1), a1 + hstep, voffA);
            PG8_WAIT_L(8); PG8_BAR; PG8_WAIT_L(0); PG8_MMA(0, 0, At, B0); PG8_BAR; PG8_SCHED;
            PG8_LDB(B1, 0, 1); PG8_STAGE(PG8_SB(0, 0), b2, voffB);
            PG8_BAR; PG8_WAIT_L(0); PG8_MMA(0, 1, At, B1); PG8_BAR;
            PG8_LDA(At, 0, 1); PG8_STAGE(PG8_SA(0, 0), a2, voffA);
            PG8_BAR; PG8_WAIT_L(0); PG8_MMA(1, 0, At, B0); PG8_BAR; PG8_SCHED;
            PG8_STAGE(PG8_SB(0, 1), b2 + hstep, voffB);
            PG8_WAIT_V(6); PG8_BAR; PG8_MMA(1, 1, At, B1); PG8_BAR;
            PG8_LDB(B0, 1, 0); PG8_SCHED; PG8_LDA(At, 1, 0); PG8_STAGE(PG8_SA(0, 1), a2 + hstep, voffA);
            PG8_WAIT_L(8); PG8_BAR; PG8_WAIT_L(0); PG8_MMA(0, 0, At, B0); PG8_BAR; PG8_SCHED;
            PG8_LDB(B1, 1, 1); PG8_STAGE(PG8_SB(1, 0), b3, voffB);
            PG8_BAR; PG8_WAIT_L(0); PG8_MMA(0, 1, At, B1); PG8_BAR;
            PG8_LDA(At, 1, 1); PG8_STAGE(PG8_SA(1, 0), a3, voffA);
            PG8_BAR; PG8_WAIT_L(0); PG8_MMA(1, 0, At, B0); PG8_BAR; PG8_SCHED;
            PG8_STAGE(PG8_SB(1, 1), b3 + hstep, voffB);
            PG8_WAIT_V(6); PG8_BAR; PG8_MMA(1, 1, At, B1); PG8_BAR;
            }
        }
        if constexpr (ALIGN_EPI) { if (wr == 0) PG8_BAR; }
        if constexpr (!Epi::AFTER_DRAIN) { E(acc, cur, wr, wc, fr, fq); S.done(cur); }
        if (!has_next) break;
#pragma unroll
        for (int a = 0; a < 2; ++a)
#pragma unroll
            for (int b = 0; b < 2; ++b)
#pragma unroll
                for (int m = 0; m < 4; ++m)
#pragma unroll
                    for (int n = 0; n < 2; ++n) acc[a][b][m][n] = (f32x4){0.f, 0.f, 0.f, 0.f};
        cur = nxt; cA = nA; cB = nB; ++ui;
        if constexpr (ALIGN_EPI) { if (wr == 1) PG8_BAR; }
    }
    PG8_WAIT_V(0);
    if constexpr (!ALIGN_EPI) { if (wr == 0) PG8_BAR; }
    PG8_BAR;
    if constexpr (Epi::AFTER_DRAIN) { E.fused(acc, cur, wr, wc, fr, fq, lds, wid, lane); S.done(cur); }
#undef PG8_SA
#undef PG8_SB
#undef PG8_STAGE
#undef PG8_LDA
#undef PG8_LDB
#undef PG8_MMA
#undef PG8_WAIT_V
#undef PG8_WAIT_L
#undef PG8_BAR
#undef PG8_SCHED
}
}

#define GAS __attribute__((address_space(1)))
#define LAS __attribute__((address_space(3)))
typedef unsigned short bf16;
typedef short bf16x8 __attribute__((ext_vector_type(8)));
typedef short s16x4 __attribute__((ext_vector_type(4)));
typedef float f32x4 __attribute__((ext_vector_type(4)));
typedef float f32x2 __attribute__((ext_vector_type(2)));
typedef float f32x16 __attribute__((ext_vector_type(16)));
typedef unsigned u32x4 __attribute__((ext_vector_type(4)));
typedef unsigned u32x2 __attribute__((ext_vector_type(2)));

constexpr int DM = 1024, NB = 8, SEQ = 8192, DEPTH = 2, DB = 32, DL = 16, PAST = 2048;
constexpr int MP = NB * SEQ;
constexpr int MS = DB * DL;
constexpr int MT = MP + MS;
constexpr int DFF = 2816, DIN = 8208, NIN = 8704;
constexpr float EPS = 1e-6f;
constexpr float C2 = 0.125f * 1.4426950408889634f;
constexpr int NWAVES = 8;

constexpr size_t O_Y = 0;
constexpr size_t O_KP = (size_t)MT * DM;
constexpr size_t O_VP = O_KP + (size_t)DEPTH * MP * DM;
constexpr size_t O_GP = O_VP + (size_t)DEPTH * MP * DM;
constexpr size_t O_CP = O_GP + (size_t)DEPTH * NB * 4 * 128 * 256;
constexpr size_t O_KS = O_CP + (size_t)DEPTH * NB * 2 * DFF;
constexpr size_t O_VS = O_KS + (size_t)DEPTH * MS * DM;
constexpr size_t O_GS = O_VS + (size_t)DEPTH * MS * DM;
constexpr size_t O_CS = O_GS + (size_t)DEPTH * DB * 4 * 128 * 256;
constexpr size_t O_END = O_CS + (size_t)DEPTH * DB * 2 * DFF;

constexpr size_t MiB = 1u << 20, HMiB = 1u << 19;
constexpr size_t WS_CTL = 0, CTL_ZERO_BYTES = 1 * MiB;
constexpr size_t WS_ROPE = 1 * MiB;
constexpr size_t WS_DG = 1 * MiB + HMiB;
constexpr size_t WS_W = 2 * MiB;
constexpr size_t W_IN = 0, W_O = 17 * MiB, W_UP = 19 * MiB, W_DN = 30 * MiB, W_LAYER = 35 * MiB + HMiB;
constexpr size_t WS_SLOC = 74 * MiB;
constexpr size_t UB = (size_t)MT * DM * 2;
constexpr size_t WS_XN = 112 * MiB;
constexpr size_t WS_QA = WS_XN + UB, WS_KA = WS_QA + UB, WS_VA = WS_KA + UB, WS_QG = WS_VA + UB, WS_KG = WS_QG + UB / 2, WS_VG = WS_KG + UB / 2,
                 WS_RG = WS_VG + UB, WS_GK = WS_RG + UB, WS_GA = WS_GK + UB / 2, WS_GB = WS_GA + UB, WS_PEND = WS_GB + UB;
constexpr size_t WS_UG = WS_QA;
constexpr size_t WS_ACT = WS_UG + (size_t)MT * 5632 * 2;
constexpr size_t WS_TMP = WS_PEND;
constexpr size_t WS_OA = WS_TMP + 2 * UB;
constexpr size_t WS_PART = WS_OA + UB;
constexpr size_t WS_END = WS_PART + (size_t)11 * MS * DM * 4;
static_assert(WS_ACT + (size_t)MT * DFF * 2 <= WS_PEND, "ws overlay");
static_assert(WS_W + 2 * W_LAYER <= WS_SLOC && WS_SLOC + 32 * MiB <= WS_XN, "ws map");
constexpr int CW_BAR = 4096;

constexpr int RING_BYTES = 131072, MISC_OFF = RING_BYTES, LDS_BYTES = 147456;

__device__ __forceinline__ float bf2f(bf16 b) { return __uint_as_float((unsigned)b << 16); }
__device__ __forceinline__ float bflo(unsigned u) { return __uint_as_float(u << 16); }
__device__ __forceinline__ float bfhi(unsigned u) { return __uint_as_float(u & 0xffff0000u); }
typedef __bf16 bf16x2_t __attribute__((ext_vector_type(2)));
__device__ __forceinline__ unsigned pk2(float lo, float hi) { f32x2 v = {lo, hi}; bf16x2_t b = __builtin_convertvector(v, bf16x2_t); return __builtin_bit_cast(unsigned, b); }
__device__ __forceinline__ bf16 f2bf(float f) { return (bf16)(pk2(f, 0.f) & 0xffffu); }
template <int M> __device__ __forceinline__ float shx(float v) { return __int_as_float(__builtin_amdgcn_ds_swizzle(__float_as_int(v), 0x1F | (M << 10))); }
__device__ __forceinline__ float sum32x(float v) { auto r = __builtin_amdgcn_permlane32_swap(__float_as_uint(v), __float_as_uint(v), false, false); return __uint_as_float(r[0]) + __uint_as_float(r[1]); }
__device__ __forceinline__ float max32x(float v) { auto r = __builtin_amdgcn_permlane32_swap(__float_as_uint(v), __float_as_uint(v), false, false); return fmaxf(__uint_as_float(r[0]), __uint_as_float(r[1])); }
__device__ __forceinline__ float half_sum(float v) { v += shx<1>(v); v += shx<2>(v); v += shx<4>(v); v += shx<8>(v); v += shx<16>(v); return v; }
__device__ __forceinline__ float wave_sum(float v) { return sum32x(half_sum(v)); }
__device__ __forceinline__ float frcp(float x) { return __builtin_amdgcn_rcpf(x); }
__device__ __forceinline__ float frsq(float x) { return __builtin_amdgcn_rsqf(x); }
__device__ __forceinline__ float sigmoidf_(float x) { return frcp(1.0f + __expf(-x)); }
#define LDS_WAIT() asm volatile("s_waitcnt lgkmcnt(0)" ::: "memory")
#define VM_WAIT() asm volatile("s_waitcnt vmcnt(0)" ::: "memory")

struct EpiIn {
    static constexpr bool PERM = true, AFTER_DRAIN = false;
    GAS unsigned char* ws; GAS float* kout_p; GAS float* vout_p; GAS float* kout_s; GAS float* vout_s; const GAS float* rope; const GAS float* bgk;
    template <int KIND>
    __device__ __forceinline__ void run(const pg8::f32x4 (&acc)[2][2][4][2], GAS bf16* dst, int ldc, int tcol, GAS float* fout, int frow0, int row0, bool sample, int wc, int fq) const {
        const int colw = wc * 32 + 8 * fq;
        const bool ropew = (KIND <= 1) && ((wc & 1) == 0);
        const float sgn = (fq == 0) ? -1.f : ((fq == 1) ? 1.f : 0.f);
        const bool rl = (fq < 2);
        f32x4 b0 = {0.f, 0.f, 0.f, 0.f}, b1 = b0, b2 = b0, b3 = b0;
        if (KIND == 5) { b0 = *(const GAS f32x4*)(bgk + tcol + colw); b1 = *(const GAS f32x4*)(bgk + tcol + colw + 4); b2 = *(const GAS f32x4*)(bgk + tcol + 128 + colw); b3 = *(const GAS f32x4*)(bgk + tcol + 128 + colw + 4); }
#pragma unroll
        for (int ai = 0; ai < 2; ++ai)
#pragma unroll
            for (int m = 0; m < 4; ++m) {
                const int row = row0 + ai * 128 + m * 16;
                f32x4 cs0 = {1.f, 1.f, 1.f, 1.f}, cs1 = cs0, sn0 = {0.f, 0.f, 0.f, 0.f}, sn1 = sn0;
                if (KIND <= 1) { if (ropew) {
                    const int pos = sample ? (PAST + (row & 15)) : (row & (SEQ - 1));
                    const GAS f32x4* rp = (const GAS f32x4*)(rope + (size_t)pos * 16);
                    const f32x4 c0 = rp[0], c1 = rp[1], s0 = rp[2], s1 = rp[3];
#pragma unroll
                    for (int e = 0; e < 4; ++e) { cs0[e] = rl ? c0[e] : 1.f; cs1[e] = rl ? c1[e] : 1.f; sn0[e] = s0[e] * sgn; sn1[e] = s1[e] * sgn; }
                } }
#pragma unroll
                for (int bj = 0; bj < 2; ++bj) {
                    f32x4 v0 = acc[ai][bj][m][0], v1 = acc[ai][bj][m][1];
                    const int col = tcol + bj * 128 + colw;
                    if (KIND <= 1) { if (ropew) {
                        f32x4 o0, o1;
#pragma unroll
                        for (int e = 0; e < 4; ++e) { o0[e] = shx<16>(v0[e]); o1[e] = shx<16>(v1[e]); }
                        v0 = v0 * cs0 + o0 * sn0; v1 = v1 * cs1 + o1 * sn1;
                    } }
                    if (KIND == 1 || KIND == 2) {
                        GAS float* fo = fout + (size_t)(row - frow0) * 1024 + col;
                        __builtin_nontemporal_store(v0, (GAS f32x4*)fo); __builtin_nontemporal_store(v1, (GAS f32x4*)(fo + 4));
                    }
                    if (KIND == 0) { v0 = v0 * C2; v1 = v1 * C2; }
                    if (KIND == 3) { v0 = v0 * 0.08838834764831845f; v1 = v1 * 0.08838834764831845f; }
                    if (KIND == 5) {
                        const f32x4 ba = bj ? b2 : b0, bb = bj ? b3 : b1;
#pragma unroll
                        for (int e = 0; e < 4; ++e) {
                            float x = v0[e] + ba[e]; v0[e] = (fminf(x, 0.f) - __logf(1.f + __expf(-fabsf(x)))) * 0.0625f;
                            x = v1[e] + bb[e];       v1[e] = (fminf(x, 0.f) - __logf(1.f + __expf(-fabsf(x)))) * 0.0625f;
                        }
                    }
                    u32x4 w; w.x = pk2(v0[0], v0[1]); w.y = pk2(v0[2], v0[3]); w.z = pk2(v1[0], v1[1]); w.w = pk2(v1[2], v1[3]);
                    *(GAS u32x4*)(dst + (size_t)row * ldc + col) = w;
                }
            }
    }
    __device__ __forceinline__ void operator()(const pg8::f32x4 (&acc)[2][2][4][2], const pg8::Unit& u, int wr, int wc, int fr, int fq) const {
        const int pn = u.pn;
        const int row0 = u.pm * 256 + wr * 64 + fr;
        const bool sample = (u.pm >= 256);
        const int frow0 = sample ? MP : 0;
        if (pn < 4)       run<0>(acc, (GAS bf16*)(ws + WS_QA), 1024, pn * 256, nullptr, 0, row0, sample, wc, fq);
        else if (pn < 8)  run<1>(acc, (GAS bf16*)(ws + WS_KA), 1024, (pn - 4) * 256, sample ? kout_s : kout_p, frow0, row0, sample, wc, fq);
        else if (pn < 12) run<2>(acc, (GAS bf16*)(ws + WS_VA), 1024, (pn - 8) * 256, sample ? vout_s : vout_p, frow0, row0, sample, wc, fq);
        else if (pn < 14) run<3>(acc, (GAS bf16*)(ws + WS_QG), 512, (pn - 12) * 256, nullptr, 0, row0, sample, wc, fq);
        else if (pn < 16) run<4>(acc, (GAS bf16*)(ws + WS_KG), 512, (pn - 14) * 256, nullptr, 0, row0, sample, wc, fq);
        else if (pn < 20) run<4>(acc, (GAS bf16*)(ws + WS_VG), 1024, (pn - 16) * 256, nullptr, 0, row0, sample, wc, fq);
        else if (pn < 24) run<4>(acc, (GAS bf16*)(ws + WS_RG), 1024, (pn - 20) * 256, nullptr, 0, row0, sample, wc, fq);
        else if (pn < 28) run<4>(acc, (GAS bf16*)(ws + WS_GA), 1024, (pn - 24) * 256, nullptr, 0, row0, sample, wc, fq);
        else if (pn < 32) run<4>(acc, (GAS bf16*)(ws + WS_GB), 1024, (pn - 28) * 256, nullptr, 0, row0, sample, wc, fq);
        else              run<5>(acc, (GAS bf16*)(ws + WS_GK), 512, (pn - 32) * 256, nullptr, 0, row0, sample, wc, fq);
    }
};
struct SplitOrder {
    int G, c, nks, kslice;
    __device__ __forceinline__ bool next(int i, pg8::Unit& u) const { const int idx = i * G + c; if (idx >= 8 * nks) return false;
        const int ks = idx % nks, r = idx / nks; u.pn = r & 3; u.pm = 256 + (r >> 2); u.ko = ks * kslice; return true; }
    __device__ __forceinline__ void a_ready(const pg8::Unit&) const {}
    __device__ __forceinline__ void done(const pg8::Unit&) const {}
};
struct EpiPart {
    static constexpr bool PERM = true, AFTER_DRAIN = false;
    GAS float* P; int kslice;
    __device__ __forceinline__ void operator()(const pg8::f32x4 (&acc)[2][2][4][2], const pg8::Unit& u, int wr, int wc, int fr, int fq) const {
        const int row0 = (u.pm - 256) * 256 + wr * 64 + fr, col0 = u.pn * 256 + wc * 32 + 8 * fq; GAS float* base = P + (size_t)(u.ko / kslice) * MS * DM;
#pragma unroll
        for (int ai = 0; ai < 2; ++ai)
#pragma unroll
            for (int m = 0; m < 4; ++m) { GAS float* rowp = base + (size_t)(row0 + ai * 128 + m * 16) * DM + col0;
#pragma unroll
                for (int bj = 0; bj < 2; ++bj) { *(GAS f32x4*)(rowp + bj * 128) = acc[ai][bj][m][0]; *(GAS f32x4*)(rowp + bj * 128 + 4) = acc[ai][bj][m][1]; } }
    }
};
struct EpiF32 {
    static constexpr bool PERM = true, AFTER_DRAIN = false;
    GAS float* O; int ldc;
    __device__ __forceinline__ void operator()(const pg8::f32x4 (&acc)[2][2][4][2], const pg8::Unit& u, int wr, int wc, int fr, int fq) const {
        const int row0 = u.pm * 256 + wr * 64 + fr, col0 = u.pn * 256 + wc * 32 + 8 * fq;
#pragma unroll
        for (int ai = 0; ai < 2; ++ai)
#pragma unroll
            for (int m = 0; m < 4; ++m) { GAS float* rowp = O + (size_t)(row0 + ai * 128 + m * 16) * ldc + col0;
#pragma unroll
                for (int bj = 0; bj < 2; ++bj) { *(GAS f32x4*)(rowp + bj * 128) = acc[ai][bj][m][0]; *(GAS f32x4*)(rowp + bj * 128 + 4) = acc[ai][bj][m][1]; } }
    }
};
struct EpiB16 {
    static constexpr bool PERM = true, AFTER_DRAIN = false;
    GAS bf16* O; int ldc;
    __device__ __forceinline__ void operator()(const pg8::f32x4 (&acc)[2][2][4][2], const pg8::Unit& u, int wr, int wc, int fr, int fq) const {
        const int row0 = u.pm * 256 + wr * 64 + fr, col0 = u.pn * 256 + wc * 32 + 8 * fq;
#pragma unroll
        for (int ai = 0; ai < 2; ++ai)
#pragma unroll
            for (int m = 0; m < 4; ++m) { GAS bf16* rowp = O + (size_t)(row0 + ai * 128 + m * 16) * ldc + col0;
#pragma unroll
                for (int bj = 0; bj < 2; ++bj) { const f32x4 v0 = acc[ai][bj][m][0], v1 = acc[ai][bj][m][1];
                    u32x4 w; w.x = pk2(v0[0], v0[1]); w.y = pk2(v0[2], v0[3]); w.z = pk2(v1[0], v1[1]); w.w = pk2(v1[2], v1[3]);
                    *(GAS u32x4*)(rowp + bj * 128) = w; } }
    }
};
#define XB_TMO      128
#define XB_XCNT(j)  (256  + 64 * (j))
#define XB_XSUB(j)  (1280 + 64 * (j))
#define XB_XGEN(j)  (2304 + 64 * (j))
#define XB_TOP      3328
#define XB_TOPGEN   3392
#define XCD_BAR_WORDS 3456
#define XB_SPIN_CAP (1u << 18)

__device__ __forceinline__ unsigned xb_ld(unsigned* p)              { return __hip_atomic_load(p, __ATOMIC_RELAXED, __HIP_MEMORY_SCOPE_AGENT); }
__device__ __forceinline__ unsigned xb_add(unsigned* p, unsigned v) { return __hip_atomic_fetch_add(p, v, __ATOMIC_RELAXED, __HIP_MEMORY_SCOPE_AGENT); }
__device__ __forceinline__ unsigned xb_xcc_id() { return (unsigned)__builtin_amdgcn_s_getreg((3 << 11) | 20) & 0xFu; }
#define XB_SPIN(cond, bar) do { unsigned _sp = 0; while (cond) { __builtin_amdgcn_s_sleep(1); \
    if ((++_sp & 255u) == 0u) { if (xb_ld(&(bar)[XB_TMO])) break; if (_sp > XB_SPIN_CAP) { atomicAdd(&(bar)[XB_TMO], 1u); break; } } } } while (0)

struct XcdBarrier {
    unsigned* bar; unsigned x;
    volatile LAS unsigned* st;
};

__device__ __forceinline__ XcdBarrier xcd_barrier_post(unsigned* bar, volatile LAS unsigned* st) {
    XcdBarrier b; b.bar = bar; b.x = xb_xcc_id(); b.st = st;
    if (threadIdx.x == 0) (void)xb_add(&bar[XB_XCNT(b.x)], 1u);
    return b;
}
__device__ __forceinline__ void xcd_barrier_complete(unsigned* bar, unsigned x, unsigned& nloc, unsigned& nx) {
    const unsigned G = gridDim.x * gridDim.y * gridDim.z;
    unsigned sum, cnt, mine, sp = 0u;
    for (;;) {
        sum = 0u; cnt = 0u; mine = 0u;
#pragma unroll
        for (unsigned j = 0; j < 16; ++j) { const unsigned c = xb_ld(&bar[XB_XCNT(j)]); sum += c; cnt += (c > 0u) ? 1u : 0u; mine = (j == x) ? c : mine; }
        if (sum == G) break;
        __builtin_amdgcn_s_sleep(1);
        if ((++sp & 255u) == 0u) { if (xb_ld(&bar[XB_TMO])) break; if (sp > XB_SPIN_CAP) { atomicAdd(&bar[XB_TMO], 1u); break; } }
    }
    nloc = mine > 0u ? mine : 1u; nx = cnt > 0u ? cnt : 1u;
}

__device__ __forceinline__ void xcd_barrier(const XcdBarrier& b) {
    asm volatile("s_waitcnt vmcnt(0)" ::: "memory");
    __syncthreads();
    if (threadIdx.x == 0) {
        unsigned* bar = b.bar;
        __builtin_amdgcn_s_waitcnt(0);
        unsigned nloc = b.st[0], nx = b.st[1];
        if (nloc == 0u) { xcd_barrier_complete(bar, b.x, nloc, nx); b.st[0] = nloc; b.st[1] = nx; }
        const unsigned old = xb_add(&bar[XB_XSUB(b.x)], 1u);
        const unsigned gen = old / nloc;
        if (old + 1u == (gen + 1u) * nloc) {
            __builtin_amdgcn_fence(__ATOMIC_RELEASE, "agent");
            asm volatile("s_waitcnt vmcnt(0)" ::: "memory");
            const unsigned og = xb_add(&bar[XB_TOP], 1u);
            const unsigned tg = og / nx;
            if (og + 1u == (tg + 1u) * nx) xb_add(&bar[XB_TOPGEN], 1u);
            else XB_SPIN(xb_ld(&bar[XB_TOPGEN]) == tg, bar);
            __builtin_amdgcn_fence(__ATOMIC_ACQUIRE, "agent");
            xb_add(&bar[XB_XGEN(b.x)], 1u);
            asm volatile("s_waitcnt vmcnt(0)" ::: "memory");
        } else {
            XB_SPIN(xb_ld(&bar[XB_XGEN(b.x)]) == gen, bar);
            __builtin_amdgcn_fence(__ATOMIC_ACQUIRE, "agent");
            asm volatile("s_waitcnt vmcnt(0)" ::: "memory");
        }
    }
    __syncthreads();
}

__device__ __noinline__ void xcd_barrier_ni(unsigned* bar, unsigned x, volatile LAS unsigned* st) { XcdBarrier b; b.bar = bar; b.x = x; b.st = st; xcd_barrier(b); }

struct Args { const float* in[24]; float* out; unsigned char* ws; float inv_freq[8]; int ph_lo, ph_hi; };
enum { I_XP = 0, I_XS, I_CK, I_CV, I_SG, I_SC, I_WIN, I_WGK2, I_BGK2, I_LQ1, I_LK1, I_LQ2, I_LK2, I_DANW, I_GLANW, I_WO, I_PREMIX, I_POSTMIX, I_PREFFN, I_POSTFFN, I_WUP, I_CONVW, I_CONVB, I_WDOWN };

__device__ __forceinline__ void transpose_item(const GAS float* W, int N, int K, GAS bf16* WT, LAS float* scr, int kb, int n0_src, int n0_dst, int lane, const GAS float* wg) {
    const int k0 = 64 * kb;
    if (wg == nullptr) {
#pragma unroll 8
        for (int i = 0; i < 32; ++i) { const int kk = 2 * i + (lane >> 5); scr[kk * 33 + (lane & 31)] = W[(size_t)(k0 + kk) * N + n0_src + (lane & 31)]; }
    } else {
        float g[16];
#pragma unroll
        for (int r = 0; r < 16; ++r) g[r] = wg[r * 512 + n0_src + (lane & 31)];
        for (int i = 0; i < 32; ++i) { const int kk = 2 * i + (lane >> 5); const GAS float* lr = W + (size_t)(k0 + kk) * N + 6144; float s = 0.f;
#pragma unroll
            for (int r = 0; r < 16; ++r) s += lr[r] * g[r];
            scr[kk * 33 + (lane & 31)] = s; }
    }
    LDS_WAIT(); asm volatile("" ::: "memory");
    const int c = lane & 7;
#pragma unroll
    for (int j = 0; j < 4; ++j) { const int n = (lane >> 3) + 8 * j; const LAS float* s = scr + (8 * c) * 33 + n;
        u32x4 o; o.x = pk2(s[0 * 33], s[1 * 33]); o.y = pk2(s[2 * 33], s[3 * 33]); o.z = pk2(s[4 * 33], s[5 * 33]); o.w = pk2(s[6 * 33], s[7 * 33]);
        *(GAS u32x4*)(WT + (size_t)(n0_dst + n) * K + k0 + 8 * c) = o; }
    LDS_WAIT(); asm volatile("" ::: "memory");
}
__device__ __forceinline__ void rms_row_to_bf16(const GAS float* xrow, const GAS float* w, GAS bf16* orow, int lane) {
    const GAS f32x4* xr = (const GAS f32x4*)xrow + lane; const GAS f32x4* wr = (const GAS f32x4*)w + lane;
    f32x4 v[4]; float s = 0.f;
#pragma unroll
    for (int j = 0; j < 4; ++j) { v[j] = xr[64 * j]; s += (v[j].x * v[j].x + v[j].y * v[j].y) + (v[j].z * v[j].z + v[j].w * v[j].w); }
    const float rstd = frsq(wave_sum(s) * (1.f / DM) + EPS);
    GAS u32x2* o8 = (GAS u32x2*)orow + lane;
#pragma unroll
    for (int j = 0; j < 4; ++j) { const f32x4 g = wr[64 * j]; u32x2 o; o.x = pk2(v[j].x * rstd * g.x, v[j].y * rstd * g.y); o.y = pk2(v[j].z * rstd * g.z, v[j].w * rstd * g.w); o8[64 * j] = o; }
}
__device__ __forceinline__ void sincos_acc(float angf, float& sn, float& cs) {
    const double a = (double)angf; const double k = rint(a * 0.15915494309189535); const double r = a - k * 6.283185307179586476925;
    const double r2 = r * r; double ts = 1.0, tc = 1.0, ss = 1.0, sc = 1.0;
#pragma unroll
    for (int n = 1; n <= 13; ++n) { tc = -tc * r2 / (double)((2 * n - 1) * (2 * n)); ts = -ts * r2 / (double)((2 * n) * (2 * n + 1)); sc += tc; ss += ts; }
    sn = (float)(ss * r); cs = (float)sc;
}

#define MFMA32(a, b, c) __builtin_amdgcn_mfma_f32_32x32x16_bf16((a), (b), (c), 0, 0, 0)
__device__ __forceinline__ int crow(int r, int hi) { return (r & 3) + 8 * (r >> 2) + 4 * hi; }
__device__ __forceinline__ s16x4 tr16(const LAS unsigned char* p) { return __builtin_bit_cast(s16x4, __builtin_amdgcn_ds_read_tr16_b64_v4i16((LAS s16x4*)p)); }
__device__ __forceinline__ bf16x8 cat8(s16x4 lo, s16x4 hi) { return (bf16x8){lo[0], lo[1], lo[2], lo[3], hi[0], hi[1], hi[2], hi[3]}; }
__device__ __forceinline__ u32x4 cvt8(f32x4 a, f32x4 b) { u32x4 w; w.x = pk2(a[0], a[1]); w.y = pk2(a[2], a[3]); w.z = pk2(b[0], b[1]); w.w = pk2(b[2], b[3]); return w; }

__device__ __forceinline__ void glds16(const GAS void* gsrc, unsigned lds_dst) { unsigned keep;
    asm volatile("s_mov_b32 %0, m0\n\ts_mov_b32 m0, %2\n\ts_nop 0\n\tglobal_load_lds_dwordx4 %1, off\n\ts_mov_b32 m0, %0" : "=&s"(keep) : "v"(gsrc), "s"(lds_dst) : "memory"); }
template <int MODE>
__device__ __forceinline__ void attn_unit(LAS unsigned char* lds, const GAS bf16* Q, const GAS bf16* Kb, const GAS bf16* Vb, GAS bf16* O, const GAS float* ck, const GAS float* cv,
                                          int b, int h, int qblk, float lam, float onem, const GAS float* normw) {
    const int tid = opaque_tid(), lane = tid & 63, w = __builtin_amdgcn_readfirstlane(tid >> 6), r32 = lane & 31, hi = lane >> 5;
    const int comp = w & 1, rg = w >> 1, half = w >> 2;
    int NT, my_nt; size_t qrow, orow0;
    if (MODE == 0) { NT = 2 * qblk + 2; my_nt = 2 * qblk + 1 + half; orow0 = (size_t)b * SEQ + qblk * 128 + rg * 32; qrow = orow0 + r32; }
    else { NT = 33; my_nt = (rg == 0) ? 33 : 0; orow0 = (size_t)MP + b * 16; qrow = orow0 + (r32 < 15 ? r32 : 15); }
    bf16x8 qr[4];
    { const GAS bf16* qp = Q + qrow * 1024 + h * 128 + comp * 64 + hi * 8;
#pragma unroll
      for (int s = 0; s < 4; ++s) qr[s] = *(const GAS bf16x8*)(qp + 16 * s); }
    asm volatile("" : "+v"(qr[0]), "+v"(qr[1]), "+v"(qr[2]), "+v"(qr[3]));
    LAS float* wsf = (LAS float*)(lds + 98304) + w * 64;
    f32x16 o[4];
#pragma unroll
    for (int d = 0; d < 4; ++d)
#pragma unroll
        for (int r = 0; r < 16; ++r) o[d][r] = 0.f;
    float mrow = 0.f, lrow = 0.f;
    u32x4 kst[2], vst[2];
    bf16x8 pw[4];
#pragma unroll
    for (int k = 0; k < 4; ++k) pw[k] = (bf16x8){0, 0, 0, 0, 0, 0, 0, 0};
    const int vrow_l = lane >> 2, vpc = lane & 3;
#define ATT_LOAD(t) do { \
        if (MODE == 0) { const size_t kr0 = (size_t)b * SEQ + 64 * (t); \
            _Pragma("unroll") for (int i = 0; i < 2; ++i) { const int p = w + 8 * i; \
                kst[i] = *(const GAS u32x4*)(Kb + (kr0 + lane) * 1024 + h * 128 + p * 8); \
                vst[i] = *(const GAS u32x4*)(Vb + (kr0 + 16 * (p & 3) + vrow_l) * 1024 + h * 128 + 32 * (p >> 2) + 8 * vpc); } } \
        else if ((t) < 32) { const size_t kr0 = (size_t)b * PAST + 64 * (t); \
            _Pragma("unroll") for (int i = 0; i < 2; ++i) { const int p = w + 8 * i; \
                const GAS float* kp = ck + ((kr0 + lane) * 8 + h) * 128 + p * 8; kst[i] = cvt8(*(const GAS f32x4*)kp, *(const GAS f32x4*)(kp + 4)); \
                const GAS float* vp = cv + ((kr0 + 16 * (p & 3) + vrow_l) * 8 + h) * 128 + 32 * (p >> 2) + 8 * vpc; vst[i] = cvt8(*(const GAS f32x4*)vp, *(const GAS f32x4*)(vp + 4)); } } \
        else { const size_t kr0 = (size_t)MP + b * 16; \
            _Pragma("unroll") for (int i = 0; i < 2; ++i) { const int p = w + 8 * i; const int vr = 16 * (p & 3) + vrow_l; \
                kst[i] = (lane < 16) ? *(const GAS u32x4*)(Kb + (kr0 + lane) * 1024 + h * 128 + p * 8) : (u32x4){0u, 0u, 0u, 0u}; \
                vst[i] = (vr < 16) ? *(const GAS u32x4*)(Vb + (kr0 + vr) * 1024 + h * 128 + 32 * (p >> 2) + 8 * vpc) : (u32x4){0u, 0u, 0u, 0u}; } } \
    } while (0)
#define ATT_STORE(bufo) do { _Pragma("unroll") for (int i = 0; i < 2; ++i) { const int p = w + 8 * i; \
        *(LAS u32x4*)(lds + (bufo) + p * 1024 + lane * 16) = kst[i]; *(LAS u32x4*)(lds + (bufo) + 16384 + p * 1024 + lane * 16) = vst[i]; } } while (0)
#define ATT_X(t, bo) do { \
        f32x16 p0, p1; \
        _Pragma("unroll") for (int r = 0; r < 16; ++r) { p0[r] = 0.f; p1[r] = 0.f; } \
        const LAS unsigned char* kb_ = lds + (bo) + kfo; \
        _Pragma("unroll") for (int s = 0; s < 4; ++s) { const bf16x8 a0 = *(const LAS bf16x8*)(kb_ + s * 2048), a1 = *(const LAS bf16x8*)(kb_ + s * 2048 + 512); \
            p0 = MFMA32(a0, qr[s], p0); p1 = MFMA32(a1, qr[s], p1); } \
        if (MODE == 1 && (t) == 32) { _Pragma("unroll") for (int r = 0; r < 16; ++r) { if (r >= 8) p0[r] = -INFINITY; p1[r] = -INFINITY; } } \
        float mx = fmaxf(p0[0], p1[0]); \
        _Pragma("unroll") for (int r = 1; r < 16; ++r) mx = fmaxf(mx, fmaxf(p0[r], p1[r])); \
        mx = max32x(mx); \
        if ((t) == 0) mrow = mx; \
        else if (__any(mx > mrow + 8.f)) { \
            const float mn = fmaxf(mrow, mx); const float f = __builtin_amdgcn_exp2f(mrow - mn); lrow *= f; mrow = mn; \
            if (hi == 0) wsf[r32] = f; \
            LDS_WAIT(); \
            _Pragma("unroll") for (int r = 0; r < 16; ++r) { const float fr_ = wsf[crow(r, hi)]; \
                _Pragma("unroll") for (int d = 0; d < 4; ++d) o[d][r] *= fr_; } } \
        float ls = 0.f; \
        _Pragma("unroll") for (int r = 0; r < 16; ++r) { p0[r] = __builtin_amdgcn_exp2f(p0[r] - mrow); p1[r] = __builtin_amdgcn_exp2f(p1[r] - mrow); ls += p0[r] + p1[r]; } \
        lrow += ls; \
        { u32x4 x; \
          x.x = pk2(p0[0], p0[1]); x.y = pk2(p0[2], p0[3]); x.z = pk2(p0[4], p0[5]); x.w = pk2(p0[6], p0[7]); pw[0] = __builtin_bit_cast(bf16x8, x); \
          x.x = pk2(p0[8], p0[9]); x.y = pk2(p0[10], p0[11]); x.z = pk2(p0[12], p0[13]); x.w = pk2(p0[14], p0[15]); pw[1] = __builtin_bit_cast(bf16x8, x); \
          x.x = pk2(p1[0], p1[1]); x.y = pk2(p1[2], p1[3]); x.z = pk2(p1[4], p1[5]); x.w = pk2(p1[6], p1[7]); pw[2] = __builtin_bit_cast(bf16x8, x); \
          x.x = pk2(p1[8], p1[9]); x.y = pk2(p1[10], p1[11]); x.z = pk2(p1[12], p1[13]); x.w = pk2(p1[14], p1[15]); pw[3] = __builtin_bit_cast(bf16x8, x); } \
    } while (0)
#define ATT_Y(bo) do { const LAS unsigned char* vb_ = lds + (bo) + vfo; \
        _Pragma("unroll") for (int d = 0; d < 4; ++d) { \
            _Pragma("unroll") for (int ks = 0; ks < 4; ++ks) { const s16x4 lo_ = tr16(vb_ + d * 4096 + ks * 1024), hh_ = tr16(vb_ + d * 4096 + ks * 1024 + 512); \
                o[d] = MFMA32(pw[ks], cat8(lo_, hh_), o[d]); } \
            __builtin_amdgcn_sched_barrier(0); } } while (0)
#define ATT_DMA(t, bufo) do { const size_t kr0 = (size_t)b * SEQ + 64 * (t); \
        _Pragma("unroll") for (int i = 0; i < 2; ++i) { const int p = w + 8 * i; \
            glds16(Kb + (kr0 + lane) * 1024 + h * 128 + p * 8, (unsigned)__builtin_amdgcn_readfirstlane((int)(lds0 + (bufo) + p * 1024))); \
            glds16(Vb + (kr0 + 16 * (p & 3) + vrow_l) * 1024 + h * 128 + 32 * (p >> 2) + 8 * vpc, (unsigned)__builtin_amdgcn_readfirstlane((int)(lds0 + (bufo) + 16384 + p * 1024))); } } while (0)
    const unsigned lds0 = (unsigned)(size_t)lds;
    if (MODE == 0) { ATT_DMA(0, 0); VM_WAIT(); } else { ATT_LOAD(0); ATT_STORE(0); }
    __syncthreads();
    const int kfo = (8 * comp + hi) * 1024 + r32 * 16;
    const int vfo = 16384 + ((lane >> 4) & 1) * 32 + (lane & 3) * 8 + (4 * hi + ((lane & 15) >> 2)) * 64;
    int b_prev = 0, b_cur = 0, b_next = 32768;
    const int NI = (MODE == 0) ? NT + 1 : NT;
    for (int i = 0; i < NI; ++i) {
        if (i + 1 < NT) { if (MODE == 0) { ATT_DMA(i + 1, b_next); } else { ATT_LOAD(i + 1); } }
        if (half == 0) { if (i < my_nt) { ATT_X(i, b_cur); ATT_Y(b_cur); } }
        else if (MODE == 0) { if (i >= 1) ATT_Y(b_prev); if (i < NT) ATT_X(i, b_cur); }
        if (MODE == 1 && i + 1 < NT) ATT_STORE(b_next);
        if (MODE == 0) VM_WAIT();
        __syncthreads();
        b_prev = b_cur; b_cur = b_next; b_next = (b_next == 65536) ? 0 : b_next + 32768;
    }
#undef ATT_LOAD
#undef ATT_STORE
#undef ATT_DMA
#undef ATT_X
#undef ATT_Y
    const bool active = (MODE == 0) || (rg == 0);
    if (active) {
        const float lt = sum32x(lrow);
        if (hi == 0) wsf[32 + r32] = lt;
        LDS_WAIT();
#pragma unroll
        for (int r = 0; r < 16; ++r) { const float il = frcp(wsf[32 + crow(r, hi)]);
#pragma unroll
            for (int d = 0; d < 4; ++d) o[d][r] *= il; }
    }
    LAS float* X = (LAS float*)lds;
    if (active && comp == 1) {
#pragma unroll
        for (int d = 0; d < 4; ++d)
#pragma unroll
            for (int r = 0; r < 16; ++r) X[((rg * 4 + d) * 16 + r) * 64 + lane] = o[d][r];
    }
    __syncthreads();
    if (active && comp == 0) {
        float nw[4];
#pragma unroll
        for (int d = 0; d < 4; ++d) nw[d] = normw[32 * d + r32];
#pragma unroll
        for (int r = 0; r < 16; ++r) {
            float ss = 0.f;
#pragma unroll
            for (int d = 0; d < 4; ++d) { const float x = o[d][r] - lam * X[((rg * 4 + d) * 16 + r) * 64 + lane]; o[d][r] = x; ss += x * x; }
            ss = half_sum(ss);
            const float rs = onem * frsq(ss * (1.0f / 128.0f) + EPS);
            const int rr = crow(r, hi);
            if (MODE == 0 || rr < 16) {
                GAS bf16* op = O + (orow0 + rr) * 1024 + h * 128 + r32;
#pragma unroll
                for (int d = 0; d < 4; ++d) op[32 * d] = f2bf(o[d][r] * rs * nw[d]);
            }
        }
    }
    __syncthreads();
}

constexpr int ATT_WSF = 131072 + 1024;
#define ASBAR() __builtin_amdgcn_sched_barrier(0)
#define APIN(x) asm volatile("" : "+v"(x))
__device__ __forceinline__ float max3f(float a, float b, float c) { float r; asm("v_max3_f32 %0, %1, %2, %3" : "=v"(r) : "v"(a), "v"(b), "v"(c)); return r; }
__device__ __forceinline__ void attn_prompt_unit(LAS unsigned char* lds, const GAS bf16* Q, const GAS bf16* Kb, const GAS bf16* Vb, GAS bf16* O,
                                                 int b, int h, int qblk, float lam, float onem, const GAS float* normw) {
    const int tid = opaque_tid(), lane = tid & 63, w = __builtin_amdgcn_readfirstlane(tid >> 6), r32 = lane & 31, hi = lane >> 5;
    const int comp = w & 1, rg = w >> 1, half = w >> 2;
    const int NT = 2 * qblk + 2, my_nt = NT - 1 + half;
    const size_t orow0 = (size_t)b * SEQ + qblk * 128 + rg * 32;
    bf16x8 qr[4];
    { const GAS bf16* qp = Q + (orow0 + r32) * 1024 + h * 128 + comp * 64 + hi * 8;
#pragma unroll
      for (int s = 0; s < 4; ++s) qr[s] = *(const GAS bf16x8*)(qp + 16 * s); }
    asm volatile("" : "+v"(qr[0]), "+v"(qr[1]), "+v"(qr[2]), "+v"(qr[3]));
    LAS float* wsf = (LAS float*)(lds + ATT_WSF) + w * 64;
    f32x16 o[4];
#pragma unroll
    for (int d = 0; d < 4; ++d)
#pragma unroll
        for (int r = 0; r < 16; ++r) o[d][r] = 0.f;
    float mrow = 0.f, lrow = 0.f;
    f32x16 pA0, pA1, pB0, pB1;
    const f32x16 zero16 = {0.f, 0.f, 0.f, 0.f, 0.f, 0.f, 0.f, 0.f, 0.f, 0.f, 0.f, 0.f, 0.f, 0.f, 0.f, 0.f};
    const unsigned lds0 = (unsigned)(size_t)lds;
    const int vrow_l = lane >> 2, vpc = lane & 3;
    const int kfo = (8 * comp + hi) * 1024 + r32 * 16;
    const int vfo = 16384 + ((lane >> 4) & 1) * 32 + (lane & 3) * 8 + (4 * hi + ((lane & 15) >> 2)) * 64;
    const GAS bf16* kg = Kb + ((size_t)b * SEQ + lane) * 1024 + h * 128 + w * 8;
    const GAS bf16* vg = Vb + ((size_t)b * SEQ + 16 * (w & 3) + vrow_l) * 1024 + h * 128 + 32 * (w >> 2) + 8 * vpc;
#define PA_DMA(t) do { const int so_ = ((t) & 3) * 32768; const size_t to_ = (size_t)(t) * 65536; \
        glds16(kg + to_, (unsigned)__builtin_amdgcn_readfirstlane((int)(lds0 + so_ + w * 1024))); \
        glds16(kg + to_ + 64, (unsigned)__builtin_amdgcn_readfirstlane((int)(lds0 + so_ + (w + 8) * 1024))); \
        glds16(vg + to_, (unsigned)__builtin_amdgcn_readfirstlane((int)(lds0 + so_ + 16384 + w * 1024))); \
        glds16(vg + to_ + 64, (unsigned)__builtin_amdgcn_readfirstlane((int)(lds0 + so_ + 16384 + (w + 8) * 1024))); } while (0)
#define PA_KF(so, j) (*(const LAS bf16x8*)(lds + (so) + kfo + ((j) >> 1) * 2048 + ((j) & 1) * 512))
#define PA_VF(so, g) cat8(tr16(lds + (so) + vfo + ((g) >> 2) * 4096 + ((g) & 3) * 1024), tr16(lds + (so) + vfo + ((g) >> 2) * 4096 + ((g) & 3) * 1024 + 512))
#define PA_SEL(P0, P1, e) (((e) < 16) ? P0[(e) & 15] : P1[(e) & 15])
#define PA_WAITBAR(n) asm volatile("s_waitcnt vmcnt(" #n ") lgkmcnt(0)\n\ts_barrier" ::: "memory")
#define PA_KFJ(so, j) PA_KF(so, ((j) < 4 ? 2 * (j) : 2 * ((j) - 4) + 1))
#define PA_STEP(C0, C1, P0, P1, kso, vso, MASKED, FIRST) do { \
        bf16x8 kf_[8]; bf16x8 vf_[16]; u32x4 pk_[4]; bool resc_ = false; \
        kf_[0] = PA_KFJ(kso, 0); kf_[1] = PA_KFJ(kso, 1); kf_[2] = PA_KFJ(kso, 2); ASBAR(); \
        float sacc_ = P0[0] + P0[1]; float ma_ = 0.f; \
        _Pragma("unroll") for (int j = 0; j < 8; ++j) { \
            if (j + 3 < 8) kf_[j + 3] = PA_KFJ(kso, j + 3); else vf_[j - 5] = PA_VF(vso, j - 5); \
            if (j == 0) C0 = MFMA32(kf_[0], qr[0], negm); else if (j < 4) C0 = MFMA32(kf_[j], qr[j], C0); \
            else if (j == 4) C1 = MFMA32(kf_[4], qr[0], negm); else C1 = MFMA32(kf_[j], qr[j - 4], C1); \
            sacc_ += PA_SEL(P0, P1, 2 + 4 * j); sacc_ += PA_SEL(P0, P1, 3 + 4 * j); \
            if (j < 7) { sacc_ += PA_SEL(P0, P1, 4 + 4 * j); sacc_ += PA_SEL(P0, P1, 5 + 4 * j); } \
            APIN(sacc_); \
            pk_[j >> 1][(j & 1) * 2] = pk2(PA_SEL(P0, P1, 4 * j), PA_SEL(P0, P1, 4 * j + 1)); pk_[j >> 1][(j & 1) * 2 + 1] = pk2(PA_SEL(P0, P1, 4 * j + 2), PA_SEL(P0, P1, 4 * j + 3)); \
            APIN(pk_[j >> 1]); \
            if (j == 4) { ma_ = max3f(C0[0], C0[1], C0[2]); ma_ = max3f(ma_, C0[3], C0[4]); APIN(ma_); } \
            if (j == 5) { ma_ = max3f(ma_, C0[5], C0[6]); ma_ = max3f(ma_, C0[7], C0[8]); APIN(ma_); } \
            if (j == 6) { ma_ = max3f(ma_, C0[9], C0[10]); ma_ = max3f(ma_, C0[11], C0[12]); APIN(ma_); } \
            if (j == 7) { ma_ = max3f(ma_, C0[13], C0[14]); ma_ = fmaxf(ma_, C0[15]); APIN(ma_); } \
            ASBAR(); } \
        lrow += sacc_; \
        if (MASKED) { _Pragma("unroll") for (int r = 0; r < 16; ++r) { C0[r] = -1.0e30f; C1[r] = -1.0e30f; } ma_ = -1.0e30f; } \
        { float b_ = max3f(C1[0], C1[1], C1[2]); ma_ = max3f(ma_, C1[3], C1[4]); \
          _Pragma("unroll") for (int r = 5; r < 13; r += 4) { b_ = max3f(b_, C1[r], C1[r + 1]); ma_ = max3f(ma_, C1[r + 2], C1[r + 3]); } \
          b_ = max3f(b_, C1[13], C1[14]); ma_ = fmaxf(ma_, C1[15]); \
          const float mx_ = max32x(fmaxf(ma_, b_)); \
          if (__builtin_expect((FIRST) || __any(mx_ > 8.f), 0)) { const float dl_ = (FIRST) ? mx_ : fmaxf(mx_, 0.f); mrow += dl_; \
              _Pragma("unroll") for (int r = 0; r < 16; ++r) { C0[r] -= dl_; C1[r] -= dl_; negm[r] = -mrow; } \
              const float f_ = (FIRST) ? 0.f : __builtin_amdgcn_exp2f(-dl_); lrow *= f_; if (hi == 0) wsf[r32] = f_; resc_ = true; } } \
        ASBAR(); \
        _Pragma("unroll") for (int g = 0; g < 16; ++g) { \
            if (g + 3 < 16) vf_[g + 3] = PA_VF(vso, g + 3); \
            o[g >> 2] = MFMA32(__builtin_bit_cast(bf16x8, pk_[g & 3]), vf_[g], o[g >> 2]); \
            if (g < 8) { C0[2 * g] = __builtin_amdgcn_exp2f(C0[2 * g]); C0[2 * g + 1] = __builtin_amdgcn_exp2f(C0[2 * g + 1]); APIN(C0); } \
            else { C1[2 * g - 16] = __builtin_amdgcn_exp2f(C1[2 * g - 16]); C1[2 * g - 15] = __builtin_amdgcn_exp2f(C1[2 * g - 15]); APIN(C1); } \
            ASBAR(); } \
        if (resc_) { LDS_WAIT(); \
            _Pragma("unroll") for (int r = 0; r < 16; ++r) { const float fr_ = wsf[crow(r, hi)]; \
                _Pragma("unroll") for (int d = 0; d < 4; ++d) o[d][r] *= fr_; } } \
    } while (0)
#define PA_DRAIN(P0, P1, vso) do { float sacc_ = 0.f; \
        _Pragma("unroll") for (int r = 0; r < 16; ++r) sacc_ += P0[r] + P1[r]; \
        lrow += sacc_; u32x4 pk_[4]; \
        _Pragma("unroll") for (int k = 0; k < 4; ++k) { pk_[k][0] = pk2(PA_SEL(P0, P1, 8 * k), PA_SEL(P0, P1, 8 * k + 1)); pk_[k][1] = pk2(PA_SEL(P0, P1, 8 * k + 2), PA_SEL(P0, P1, 8 * k + 3)); \
            pk_[k][2] = pk2(PA_SEL(P0, P1, 8 * k + 4), PA_SEL(P0, P1, 8 * k + 5)); pk_[k][3] = pk2(PA_SEL(P0, P1, 8 * k + 6), PA_SEL(P0, P1, 8 * k + 7)); } \
        _Pragma("unroll") for (int g = 0; g < 16; ++g) o[g >> 2] = MFMA32(__builtin_bit_cast(bf16x8, pk_[g & 3]), PA_VF(vso, g), o[g >> 2]); } while (0)
#pragma unroll
    for (int r = 0; r < 16; ++r) { pB0[r] = 0.f; pB1[r] = 0.f; }
    mrow = 0.f;
    f32x16 negm = zero16; asm volatile("" : "+v"(negm));
    PA_DMA(0); PA_DMA(1); PA_WAITBAR(4);
    for (int i = 0; i < NT; i += 2) {
        if (i + 2 < NT) PA_DMA(i + 2);
        PA_STEP(pA0, pA1, pB0, pB1, (i & 3) * 32768, ((i == 0 ? 0 : i - 1) & 3) * 32768, false, (i == 0));
        if (i + 2 < NT) PA_WAITBAR(4); else PA_WAITBAR(0);
        if (i + 3 < NT) PA_DMA(i + 3);
        PA_STEP(pB0, pB1, pA0, pA1, ((i + 1) & 3) * 32768, (i & 3) * 32768, (half == 0 && i + 2 == NT), false);
        if (i + 3 < NT) PA_WAITBAR(4); else PA_WAITBAR(0);
    }
    PA_DRAIN(pB0, pB1, ((NT - 1) & 3) * 32768);
    __syncthreads();
#undef PA_DMA
#undef PA_KF
#undef PA_KFJ
#undef PA_VF
#undef PA_SEL
#undef PA_WAITBAR
#undef PA_STEP
#undef PA_DRAIN
    {
        const float lt = sum32x(lrow);
        if (hi == 0) wsf[32 + r32] = lt;
        LDS_WAIT();
#pragma unroll
        for (int r = 0; r < 16; ++r) { const float il = frcp(wsf[32 + crow(r, hi)]);
#pragma unroll
            for (int d = 0; d < 4; ++d) o[d][r] *= il; }
    }
    LAS float* X = (LAS float*)lds;
    if (comp == 1) {
#pragma unroll
        for (int d = 0; d < 4; ++d)
#pragma unroll
            for (int r = 0; r < 16; ++r) X[((rg * 4 + d) * 16 + r) * 64 + lane] = o[d][r];
    }
    __syncthreads();
    if (comp == 0) {
        float nw[4];
#pragma unroll
        for (int d = 0; d < 4; ++d) nw[d] = normw[32 * d + r32];
#pragma unroll
        for (int r = 0; r < 16; ++r) {
            float ss = 0.f;
#pragma unroll
            for (int d = 0; d < 4; ++d) { const float x = o[d][r] - lam * X[((rg * 4 + d) * 16 + r) * 64 + lane]; o[d][r] = x; ss += x * x; }
            ss = half_sum(ss);
            const float rs = onem * frsq(ss * (1.0f / 128.0f) + EPS);
            GAS bf16* op = O + (orow0 + crow(r, hi)) * 1024 + h * 128 + r32;
#pragma unroll
            for (int d = 0; d < 4; ++d) op[32 * d] = f2bf(o[d][r] * rs * nw[d]);
        }
    }
    __syncthreads();
}

constexpr int G_QET = 0, G_KET = 24576, G_KDT = 49152, G_VIM = 67584, G_AM = 100352, G_TOT = 109568, G_DV = 113664, G_SSQ = 114176, G_END = 116224;
static_assert(G_END <= RING_BYTES, "gla lds");
struct GlaP { const GAS bf16* QG; const GAS bf16* KG; const GAS bf16* VG; const GAS bf16* GK; const GAS bf16* RG; const GAS bf16* GA; const GAS bf16* GB; const GAS bf16* OA; GAS bf16* MG; const GAS float* gnw; };

template <bool FULL, int MODE>
__device__ __forceinline__ void gla_run(LAS unsigned char* lds, const GlaP& P, size_t m0, int h, int nch, f32x16 (&S)[4], float& dsum0, float& dsum1) {
    const int tid = opaque_tid(), lane = tid & 63, w = __builtin_amdgcn_readfirstlane(tid >> 6), r32 = lane & 31, hi = lane >> 5;
    const int trq = ((lane >> 4) & 1) * 32 + (lane & 3) * 8, q4 = (lane & 15) >> 2;
    unsigned gq[8], qv[8], kv[8]; u32x4 vpre[4];
    unsigned lo_g = (unsigned)((8 * w) * 1024 + 4 * lane), lo_v = (unsigned)((lane >> 2) * 2048 + w * 64 + (lane & 3) * 16);
#define GLA_LOADS(chn) do { const size_t mcn = m0 + (size_t)(chn) * 64; asm volatile("" : "+v"(lo_g), "+v"(lo_v)); \
        const GAS char* gkb = (const GAS char*)(P.GK + mcn * 512 + h * 128); const GAS char* qgb = (const GAS char*)(P.QG + mcn * 512 + h * 128); const GAS char* kgb = (const GAS char*)(P.KG + mcn * 512 + h * 128); \
        const GAS char* vgb = (const GAS char*)(P.VG + mcn * 1024 + h * 256); \
        _Pragma("unroll") for (int i = 0; i < 8; ++i) { const bool valid = (MODE == 0) || (8 * w + i < 16); \
            gq[i] = valid ? *(const GAS unsigned*)(gkb + i * 1024 + lo_g) : 0u; if (FULL) qv[i] = valid ? *(const GAS unsigned*)(qgb + i * 1024 + lo_g) : 0u; kv[i] = valid ? *(const GAS unsigned*)(kgb + i * 1024 + lo_g) : 0u; } \
        _Pragma("unroll") for (int i = 0; i < 4; ++i) { const int s = (lane >> 2) + 16 * i; const bool valid = (MODE == 0) || (s < 16); \
            vpre[i] = valid ? *(const GAS u32x4*)(vgb + i * 32768 + lo_v) : (u32x4){0u, 0u, 0u, 0u}; } } while (0)
    GLA_LOADS(0);
    for (int ch = 0; ch < nch; ++ch) {
        const size_t mc = m0 + (size_t)ch * 64;
        {
            float b0[8], b1[8];
#pragma unroll
            for (int i = 0; i < 8; ++i) { b0[i] = bflo(gq[i]); b1[i] = bfhi(gq[i]); }
#pragma unroll
            for (int i = 1; i < 8; ++i) { b0[i] += b0[i - 1]; b1[i] += b1[i - 1]; }
            LAS float* TOT = (LAS float*)(lds + G_TOT);
            *(LAS f32x2*)(TOT + w * 128 + 2 * lane) = (f32x2){b0[7], b1[7]};
            __syncthreads();
            float p0 = 0.f, p1 = 0.f, t0 = 0.f, t1 = 0.f;
#pragma unroll
            for (int ww = 0; ww < 8; ++ww) { const f32x2 tv = *(const LAS f32x2*)(TOT + ww * 128 + 2 * lane); if (ww < w) { p0 += tv.x; p1 += tv.y; } t0 += tv.x; t1 += tv.y; }
            u32x4 qe0, qe1, ke0, ke1, kd0, kd1;
#pragma unroll
            for (int i = 0; i < 8; i += 2) {
                float v[12];
#pragma unroll
                for (int j = 0; j < 2; ++j) {
                    const float ba = b0[i + j] + p0, bb = b1[i + j] + p1;
                    const float ka = bflo(kv[i + j]), kb_ = bfhi(kv[i + j]);
                    v[8 + j] = ka * __expf(t0 - ba); v[10 + j] = kb_ * __expf(t1 - bb);
                    if (FULL) { const float qa = bflo(qv[i + j]), qb = bfhi(qv[i + j]);
                        v[j] = qa * __expf(ba); v[2 + j] = qb * __expf(bb); v[4 + j] = ka * __expf(-ba); v[6 + j] = kb_ * __expf(-bb); }
                }
                if (FULL) { qe0[i >> 1] = pk2(v[0], v[1]); qe1[i >> 1] = pk2(v[2], v[3]); ke0[i >> 1] = pk2(v[4], v[5]); ke1[i >> 1] = pk2(v[6], v[7]); }
                kd0[i >> 1] = pk2(v[8], v[9]); kd1[i >> 1] = pk2(v[10], v[11]);
            }
            const int c0 = 2 * lane;
            if (FULL) {
                *(LAS u32x4*)(lds + G_QET + c0 * 192 + w * 16) = qe0; *(LAS u32x4*)(lds + G_QET + (c0 + 1) * 192 + w * 16) = qe1;
                *(LAS u32x4*)(lds + G_KET + c0 * 192 + w * 16) = ke0; *(LAS u32x4*)(lds + G_KET + (c0 + 1) * 192 + w * 16) = ke1;
            }
            *(LAS u32x4*)(lds + G_KDT + c0 * 144 + w * 16) = kd0; *(LAS u32x4*)(lds + G_KDT + (c0 + 1) * 144 + w * 16) = kd1;
            if (w == 0) { *(LAS f32x2*)((LAS float*)(lds + G_DV) + c0) = (f32x2){__expf(t0), __expf(t1)}; }
            dsum0 += t0; dsum1 += t1;
#pragma unroll
            for (int i = 0; i < 4; ++i) { const int s = (lane >> 2) + 16 * i; *(LAS u32x4*)(lds + G_VIM + w * 4096 + s * 64 + (lane & 3) * 16) = vpre[i]; }
            if (ch + 1 < nch) GLA_LOADS(ch + 1);
        }
        asm volatile("s_waitcnt lgkmcnt(0)\n\ts_barrier" ::: "memory");
        f32x16 o[2];
        if (FULL) {
            if (w < 3) {
                const int tb = (w + 1) >> 1, sb = w >> 1;
                f32x16 c;
#pragma unroll
                for (int r = 0; r < 16; ++r) c[r] = 0.f;
                const int tro = trq + (8 * hi + q4) * 192;
#pragma unroll
                for (int ks = 0; ks < 8; ++ks) {
                    const LAS unsigned char* ap = lds + G_KET + tro + ks * 16 * 192 + sb * 64; const LAS unsigned char* bp = lds + G_QET + tro + ks * 16 * 192 + tb * 64;
                    c = MFMA32(cat8(tr16(ap), tr16(ap + 4 * 192)), cat8(tr16(bp), tr16(bp + 4 * 192)), c);
                }
                const int t = 32 * tb + r32;
#pragma unroll
                for (int g = 0; g < 4; ++g) { const int s0 = 32 * sb + 8 * g + 4 * hi; float x[4];
#pragma unroll
                    for (int e = 0; e < 4; ++e) x[e] = (s0 + e <= t) ? c[4 * g + e] : 0.f;
                    *(LAS u32x2*)(lds + G_AM + t * 144 + s0 * 2) = (u32x2){pk2(x[0], x[1]), pk2(x[2], x[3])}; }
            } else if (w == 3) {
#pragma unroll
                for (int g = 0; g < 4; ++g) *(LAS u32x2*)(lds + G_AM + r32 * 144 + (32 + 8 * g + 4 * hi) * 2) = (u32x2){0u, 0u};
            }
            asm volatile("s_waitcnt lgkmcnt(0)\n\ts_barrier" ::: "memory");
        }
        bf16x8 vf[4];
        { const LAS unsigned char* vp = lds + G_VIM + w * 4096 + trq + (8 * hi + q4) * 64;
#pragma unroll
          for (int ss = 0; ss < 4; ++ss) vf[ss] = cat8(tr16(vp + ss * 1024), tr16(vp + ss * 1024 + 256)); }
        if (FULL) {
#pragma unroll
            for (int tb = 0; tb < 2; ++tb)
#pragma unroll
                for (int r = 0; r < 16; ++r) o[tb][r] = 0.f;
            const int trk = trq + (4 * hi + q4) * 192;
#pragma unroll
            for (int kb = 0; kb < 4; ++kb)
#pragma unroll
                for (int s2 = 0; s2 < 2; ++s2) {
                    u32x4 x; x.x = pk2(S[kb][8 * s2 + 0], S[kb][8 * s2 + 1]); x.y = pk2(S[kb][8 * s2 + 2], S[kb][8 * s2 + 3]); x.z = pk2(S[kb][8 * s2 + 4], S[kb][8 * s2 + 5]); x.w = pk2(S[kb][8 * s2 + 6], S[kb][8 * s2 + 7]);
                    const bf16x8 bS = __builtin_bit_cast(bf16x8, x);
#pragma unroll
                    for (int tb = 0; tb < 2; ++tb) { const LAS unsigned char* ap = lds + G_QET + trk + (32 * kb + 16 * s2) * 192 + tb * 64;
                        o[tb] = MFMA32(cat8(tr16(ap), tr16(ap + 8 * 192)), bS, o[tb]); }
                }
#pragma unroll
            for (int ss = 0; ss < 4; ++ss)
#pragma unroll
                for (int tb = 0; tb < 2; ++tb) { const bf16x8 a = *(const LAS bf16x8*)(lds + G_AM + (32 * tb + r32) * 144 + (16 * ss + 8 * hi) * 2);
                    o[tb] = MFMA32(a, vf[ss], o[tb]); }
        }
#pragma unroll
        for (int kb = 0; kb < 4; ++kb) {
#pragma unroll
            for (int g = 0; g < 4; ++g) { const f32x4 d4 = *(const LAS f32x4*)((LAS float*)(lds + G_DV) + 32 * kb + 8 * g + 4 * hi);
#pragma unroll
                for (int e = 0; e < 4; ++e) S[kb][4 * g + e] *= d4[e]; }
#pragma unroll
            for (int ss = 0; ss < 4; ++ss) { const bf16x8 a = *(const LAS bf16x8*)(lds + G_KDT + (32 * kb + r32) * 144 + (16 * ss + 8 * hi) * 2);
                S[kb] = MFMA32(a, vf[ss], S[kb]); }
        }
        if (FULL) {
            asm volatile("s_waitcnt lgkmcnt(0)\n\ts_barrier" ::: "memory");
            LAS float* OST = (LAS float*)lds;
#pragma unroll
            for (int tb = 0; tb < 2; ++tb)
#pragma unroll
                for (int r = 0; r < 16; ++r) OST[(32 * tb + crow(r, hi)) * 256 + 32 * w + r32] = o[tb][r];
            u32x4 erg[2], ega[2], egb[2], eoa[2];
            unsigned lo_e = (unsigned)((((MODE == 0) ? (tid >> 5) : ((tid >> 5) & 15)) * 1024 + 8 * (tid & 31)) * 2);
#define GLA_ELOADS(i0) do { asm volatile("" : "+v"(lo_e)); _Pragma("unroll") for (int i = 0; i < 2; ++i) { \
                const size_t ub = ((mc + ((MODE == 0) ? 16 * ((i0) + i) : 0)) * 1024 + h * 256) * 2; \
                erg[i] = *(const GAS u32x4*)((const GAS char*)P.RG + ub + lo_e); ega[i] = *(const GAS u32x4*)((const GAS char*)P.GA + ub + lo_e); \
                egb[i] = *(const GAS u32x4*)((const GAS char*)P.GB + ub + lo_e); eoa[i] = *(const GAS u32x4*)((const GAS char*)P.OA + ub + lo_e); } } while (0)
            GLA_ELOADS(0);
            asm volatile("s_waitcnt lgkmcnt(0)\n\ts_barrier" ::: "memory");
#pragma unroll
            for (int i0 = 0; i0 < 4; i0 += 2) {
#pragma unroll
              for (int i = 0; i < 2; ++i) {
                const int idx = tid + 512 * (i0 + i), t = idx >> 5, c8 = idx & 31;
                const f32x4 oa4 = *(const LAS f32x4*)(OST + t * 256 + 8 * c8), ob4 = *(const LAS f32x4*)(OST + t * 256 + 8 * c8 + 4);
                float ssq = (oa4.x * oa4.x + oa4.y * oa4.y) + (oa4.z * oa4.z + oa4.w * oa4.w) + (ob4.x * ob4.x + ob4.y * ob4.y) + (ob4.z * ob4.z + ob4.w * ob4.w);
                ssq = half_sum(ssq);
                const float rstd = frsq(ssq * (1.0f / 256.0f) + EPS);
                if (MODE == 0 || t < 16) {
                    const size_t off = (mc + t) * 1024 + h * 256 + 8 * c8;
                    const f32x4 gw0 = *(const GAS f32x4*)(P.gnw + 8 * c8), gw1 = *(const GAS f32x4*)(P.gnw + 8 * c8 + 4);
                    float ov[8] = {oa4.x, oa4.y, oa4.z, oa4.w, ob4.x, ob4.y, ob4.z, ob4.w}; float gwv[8] = {gw0.x, gw0.y, gw0.z, gw0.w, gw1.x, gw1.y, gw1.z, gw1.w};
                    float res[8];
#pragma unroll
                    for (int e = 0; e < 8; ++e) {
                        const unsigned ru = erg[i][e >> 1], gau = ega[i][e >> 1], gbu = egb[i][e >> 1], oau = eoa[i][e >> 1];
                        const float rv = (e & 1) ? bfhi(ru) : bflo(ru), gav = (e & 1) ? bfhi(gau) : bflo(gau), gbv = (e & 1) ? bfhi(gbu) : bflo(gbu), oav = (e & 1) ? bfhi(oau) : bflo(oau);
                        const float og = ov[e] * rstd * gwv[e] * (rv * sigmoidf_(rv));
                        res[e] = sigmoidf_(gav) * oav + sigmoidf_(gbv) * og;
                    }
                    u32x4 mo; mo.x = pk2(res[0], res[1]); mo.y = pk2(res[2], res[3]); mo.z = pk2(res[4], res[5]); mo.w = pk2(res[6], res[7]);
                    *(GAS u32x4*)(P.MG + off) = mo;
                }
              }
              if (i0 == 0) { asm volatile("" ::: "memory"); GLA_ELOADS(2); }
            }
#undef GLA_ELOADS
        }
        asm volatile("s_waitcnt lgkmcnt(0)\n\ts_barrier" ::: "memory");
    }
#undef GLA_LOADS
}
__device__ __forceinline__ void gla_store_state(GAS float* p, const f32x16 (&S)[4], int w, int r32, int hi) {
    unsigned off = (unsigned)(4 * hi * 256 + 32 * w + r32);
#pragma unroll
    for (int kb = 0; kb < 4; ++kb)
#pragma unroll
        for (int g4 = 0; g4 < 4; ++g4) {
#pragma unroll
            for (int e = 0; e < 4; ++e) p[off + e * 256] = S[kb][4 * g4 + e];
            off += 8 * 256; asm volatile("" : "+v"(off)); }
}
__device__ __forceinline__ void gla_load_state(const GAS float* p, f32x16 (&S)[4], int w, int r32, int hi) {
    unsigned off = (unsigned)(4 * hi * 256 + 32 * w + r32);
#pragma unroll
    for (int kb = 0; kb < 4; ++kb)
#pragma unroll
        for (int g4 = 0; g4 < 4; ++g4) {
#pragma unroll
            for (int e = 0; e < 4; ++e) S[kb][4 * g4 + e] = p[off + e * 256];
            off += 8 * 256; asm volatile("" : "+v"(off)); }
}

__device__ __forceinline__ void rowpass(const GAS bf16* tmp, const GAS float* part, int nks, const GAS float* xin_p, const GAS float* xin_s, GAS float* xout, const GAS float* wpost, const GAS float* wnext, GAS bf16* xn, int gw, int ngw, int lane) {
    for (int m = gw; m < MT; m += ngw) {
        const GAS u32x2* tr = (const GAS u32x2*)(tmp + (size_t)m * DM) + lane;
        const GAS float* xrow = (m < MP) ? xin_p + (size_t)m * DM : xin_s + (size_t)(m - MP) * DM;
        const GAS f32x4* xr = (const GAS f32x4*)xrow + lane;
        f32x4 tv[4], xv[4]; float s = 0.f;
#pragma unroll
        for (int j = 0; j < 4; ++j) {
            if (m < MP) { const u32x2 tb_ = tr[64 * j]; tv[j] = (f32x4){bflo(tb_.x), bfhi(tb_.x), bflo(tb_.y), bfhi(tb_.y)}; }
            else { f32x4 a_ = {0.f, 0.f, 0.f, 0.f}; for (int ks = 0; ks < nks; ++ks) a_ = a_ + *((const GAS f32x4*)(part + ((size_t)ks * MS + (m - MP)) * DM) + lane + 64 * j); tv[j] = a_; }
            xv[j] = xr[64 * j]; s += (tv[j].x * tv[j].x + tv[j].y * tv[j].y) + (tv[j].z * tv[j].z + tv[j].w * tv[j].w); }
        const float r1 = frsq(wave_sum(s) * (1.f / DM) + EPS);
        float s2 = 0.f;
#pragma unroll
        for (int j = 0; j < 4; ++j) { const f32x4 g = *((const GAS f32x4*)wpost + lane + 64 * j); xv[j] = xv[j] + tv[j] * r1 * g; s2 += (xv[j].x * xv[j].x + xv[j].y * xv[j].y) + (xv[j].z * xv[j].z + xv[j].w * xv[j].w); }
        GAS f32x4* orow = (GAS f32x4*)(xout + (size_t)m * DM) + lane;
#pragma unroll
        for (int j = 0; j < 4; ++j) orow[64 * j] = xv[j];
        if (xn) {
            const float r2 = frsq(wave_sum(s2) * (1.f / DM) + EPS);
            GAS u32x2* o8 = (GAS u32x2*)(xn + (size_t)m * DM) + lane;
#pragma unroll
            for (int j = 0; j < 4; ++j) { const f32x4 g = *((const GAS f32x4*)wnext + lane + 64 * j); u32x2 o; o.x = pk2(xv[j].x * r2 * g.x, xv[j].y * r2 * g.y); o.y = pk2(xv[j].z * r2 * g.z, xv[j].w * r2 * g.w); o8[64 * j] = o; }
        }
    }
}
__device__ __forceinline__ float gelu_tanh(float x) {
    const float u = 0.7978845608028654f * (x + 0.044715f * x * x * x);
    const float e = __expf(2.f * u);
    const float th = 1.f - 2.f * frcp(e + 1.f);
    return 0.5f * x * (1.f + th);
}
__device__ __forceinline__ void act_pass(const GAS bf16* UG, GAS bf16* ACT, const GAS float* convw, const GAS float* convb, const GAS float* sconv  ,
                                         GAS float* cout_p, GAS float* cout_s, int vcu, int G, int tid) {
    if (tid >= DFF / 8) return;
    const int c = tid * 8;
    float w0[8], w1[8], w2[8], cb[8];
#pragma unroll
    for (int e = 0; e < 8; ++e) { w0[e] = convw[c + e]; w1[e] = convw[DFF + c + e]; w2[e] = convw[2 * DFF + c + e]; cb[e] = convb[c + e]; }
    for (int strip = vcu; strip < MT / 16; strip += G) {
        const int m0 = strip * 16; const bool sample = (m0 >= MP);
        float gm2[8], gm1[8];
        if (sample) { const int b = (m0 - MP) >> 4; const GAS float* sc = sconv + (size_t)b * 2 * DFF + c;
#pragma unroll
            for (int e = 0; e < 8; ++e) { gm2[e] = sc[e]; gm1[e] = sc[DFF + e]; } }
        else if ((m0 & (SEQ - 1)) == 0) {
#pragma unroll
            for (int e = 0; e < 8; ++e) { gm2[e] = 0.f; gm1[e] = 0.f; } }
        else { const u32x4 a = *(const GAS u32x4*)(UG + (size_t)(m0 - 2) * 5632 + DFF + c), bq = *(const GAS u32x4*)(UG + (size_t)(m0 - 1) * 5632 + DFF + c);
#pragma unroll
            for (int e = 0; e < 4; ++e) { gm2[2 * e] = bflo(a[e]); gm2[2 * e + 1] = bfhi(a[e]); gm1[2 * e] = bflo(bq[e]); gm1[2 * e + 1] = bfhi(bq[e]); } }
#pragma unroll 4
        for (int i = 0; i < 16; ++i) {
            const size_t m = (size_t)m0 + i;
            const u32x4 uu = *(const GAS u32x4*)(UG + m * 5632 + c), gg = *(const GAS u32x4*)(UG + m * 5632 + DFF + c);
            float g0[8], res[8];
#pragma unroll
            for (int e = 0; e < 4; ++e) { g0[2 * e] = bflo(gg[e]); g0[2 * e + 1] = bfhi(gg[e]); }
#pragma unroll
            for (int e = 0; e < 8; ++e) { const float uv = (e & 1) ? bfhi(uu[e >> 1]) : bflo(uu[e >> 1]);
                const float gc = cb[e] + w0[e] * gm2[e] + w1[e] * gm1[e] + w2[e] * g0[e]; res[e] = gelu_tanh(gc) * uv; gm2[e] = gm1[e]; gm1[e] = g0[e]; }
            u32x4 o; o.x = pk2(res[0], res[1]); o.y = pk2(res[2], res[3]); o.z = pk2(res[4], res[5]); o.w = pk2(res[6], res[7]);
            *(GAS u32x4*)(ACT + m * DFF + c) = o;
        }
        if (sample) { const int b = (m0 - MP) >> 4; GAS float* co = cout_s + (size_t)b * 2 * DFF + c;
#pragma unroll
            for (int e = 0; e < 8; ++e) { co[e] = gm2[e]; co[DFF + e] = gm1[e]; } }
        else if ((m0 & (SEQ - 1)) == SEQ - 16) { const int b = m0 >> 13; GAS float* co = cout_p + (size_t)b * 2 * DFF + c;
#pragma unroll
            for (int e = 0; e < 8; ++e) { co[e] = gm2[e]; co[DFF + e] = gm1[e]; } }
    }
}

__device__ __forceinline__ void kv_out_rows(const GAS bf16* KA, const GAS bf16* VA, GAS float* kp, GAS float* vp, GAS float* ks, GAS float* vs, int r0, int r1, int wave, int lane) {
    for (int m = r0 + wave; m < r1; m += NWAVES) {
        const GAS u32x4* kr = (const GAS u32x4*)(KA + (size_t)m * DM) + 2 * lane; const GAS u32x4* vr = (const GAS u32x4*)(VA + (size_t)m * DM) + 2 * lane;
        const u32x4 k0 = kr[0], k1 = kr[1], v0 = vr[0], v1 = vr[1];
        GAS f32x4* ko = (GAS f32x4*)((m < MP ? kp + (size_t)m * DM : ks + (size_t)(m - MP) * DM)) + 4 * lane;
        GAS f32x4* vo = (GAS f32x4*)((m < MP ? vp + (size_t)m * DM : vs + (size_t)(m - MP) * DM)) + 4 * lane;
        __builtin_nontemporal_store(((f32x4){bflo(k0.x), bfhi(k0.x), bflo(k0.y), bfhi(k0.y)}), ko);     __builtin_nontemporal_store(((f32x4){bflo(k0.z), bfhi(k0.z), bflo(k0.w), bfhi(k0.w)}), ko + 1);
        __builtin_nontemporal_store(((f32x4){bflo(k1.x), bfhi(k1.x), bflo(k1.y), bfhi(k1.y)}), ko + 2); __builtin_nontemporal_store(((f32x4){bflo(k1.z), bfhi(k1.z), bflo(k1.w), bfhi(k1.w)}), ko + 3);
        __builtin_nontemporal_store(((f32x4){bflo(v0.x), bfhi(v0.x), bflo(v0.y), bfhi(v0.y)}), vo);     __builtin_nontemporal_store(((f32x4){bflo(v0.z), bfhi(v0.z), bflo(v0.w), bfhi(v0.w)}), vo + 1);
        __builtin_nontemporal_store(((f32x4){bflo(v1.x), bfhi(v1.x), bflo(v1.y), bfhi(v1.y)}), vo + 2); __builtin_nontemporal_store(((f32x4){bflo(v1.z), bfhi(v1.z), bflo(v1.w), bfhi(v1.w)}), vo + 3);
    }
}

__global__ void __launch_bounds__(NWAVES * 64, 2) mega_fwd(Args args) {
#define AIN(i) ((const GAS float*)args.in[i])
    extern __shared__ __attribute__((aligned(16))) unsigned char lds_raw[];
    LAS unsigned char* lds = (LAS unsigned char*)lds_raw;
    volatile LAS unsigned* MISC = (volatile LAS unsigned*)(lds + MISC_OFF);
    const int tid0 = threadIdx.x;
    const int G0 = gridDim.x; const int bx0 = blockIdx.x; const int vcu0 = (G0 % 8 == 0) ? (bx0 % 8) * (G0 / 8) + bx0 / 8 : bx0;
    GAS unsigned char* ws0 = (GAS unsigned char*)args.ws;
#define OPQ() GAS unsigned char* ws = ws0; GAS float* out = out0; asm volatile("" : "+s"(ws), "+s"(out)); int G = G0, bx = bx0, vcu = vcu0; asm volatile("" : "+s"(G), "+s"(bx), "+s"(vcu)); const int NGW = G * NWAVES; (void)NGW; (void)bx; const int tid = opaque_tid(), lane = tid & 63, wave = __builtin_amdgcn_readfirstlane(tid >> 6), gw = vcu * NWAVES + wave; (void)gw; (void)lane
#define GRID_BAR() xcd_barrier_ni(bar.bar, bar.x, bar.st)
    for (int u = tid0; u < (LDS_BYTES - MISC_OFF) / 4; u += NWAVES * 64) ((LAS unsigned*)(lds + MISC_OFF))[u] = 0u;
    __syncthreads();
    XcdBarrier bar = xcd_barrier_post((unsigned*)args.ws + CW_BAR, MISC + 8);
    (void)args.ph_lo;
#ifndef PHMASK
#define PHMASK 0xfffff
#endif
#define IN(k) true
#define EN(i) ((PHMASK >> (i)) & 1)
#ifndef REPMASK
#define REPMASK 0
#endif
#define REP(i) ((REPMASK >> (i)) & 1)
#ifndef NOFOLD
#define NOFOLD 0
#endif
    GAS float* const out0 = (GAS float*)args.out;

    if (EN(0) && IN(0)) { OPQ(); GAS bf16* const XN = (GAS bf16*)(ws + WS_XN);
        LAS float* scr = (LAS float*)(lds + wave * 16384);
        for (int li = 0; li < DEPTH; ++li) {
            GAS unsigned char* wl = ws + WS_W + (size_t)li * W_LAYER;
            const GAS float* w_in = AIN(I_WIN) + (size_t)li * DM * DIN; const GAS float* w_gk2 = AIN(I_WGK2) + (size_t)li * 16 * 512;
            const GAS float* w_o = AIN(I_WO) + (size_t)li * DM * DM; const GAS float* w_up = AIN(I_WUP) + (size_t)li * DM * 2 * DFF; const GAS float* w_dn = AIN(I_WDOWN) + (size_t)li * DFF * DM;
            constexpr int IT_IN = (NIN / 32) * 16, IT_O = 32 * 16, IT_UP = (2 * DFF / 32) * 16, IT_DN = 32 * (DFF / 64);
            for (int it = gw; it < IT_IN + IT_O + IT_UP + IT_DN; it += NGW) {
                int r = it;
                if (r < IT_IN) { const int nb = r >> 4, kb = r & 15;
                    if (nb < 192) transpose_item(w_in, DIN, DM, (GAS bf16*)(wl + W_IN), scr, kb, 32 * nb, 32 * nb, lane, nullptr);
                    else if (nb < 256) transpose_item(w_in, DIN, DM, (GAS bf16*)(wl + W_IN), scr, kb, 32 * nb + 16, 32 * nb, lane, nullptr);
                    else transpose_item(w_in, DIN, DM, (GAS bf16*)(wl + W_IN), scr, kb, 32 * (nb - 256), 32 * nb, lane, w_gk2);
                    continue; }
                r -= IT_IN;
                if (r < IT_O) { transpose_item(w_o, DM, DM, (GAS bf16*)(wl + W_O), scr, r & 15, 32 * (r >> 4), 32 * (r >> 4), lane, nullptr); continue; }
                r -= IT_O;
                if (r < IT_UP) { transpose_item(w_up, 2 * DFF, DM, (GAS bf16*)(wl + W_UP), scr, r & 15, 32 * (r >> 4), 32 * (r >> 4), lane, nullptr); continue; }
                r -= IT_UP;
                { const int nb = r / (DFF / 64), kb = r % (DFF / 64); transpose_item(w_dn, DM, DFF, (GAS bf16*)(wl + W_DN), scr, kb, 32 * nb, 32 * nb, lane, nullptr); }
            }
        }
        for (int i = vcu * 512 + tid; i < SEQ * 8; i += G * 512) { const int pos = i >> 3, f = i & 7; float sn, cs; sincos_acc((float)pos * args.inv_freq[f], sn, cs);
            ((GAS float*)(ws + WS_ROPE))[pos * 16 + f] = cs; ((GAS float*)(ws + WS_ROPE))[pos * 16 + 8 + f] = sn; }
        for (int m = gw; m < MT; m += NGW) { const GAS float* xrow = (m < MP) ? AIN(I_XP) + (size_t)m * DM : AIN(I_XS) + (size_t)(m - MP) * DM;
            rms_row_to_bf16(xrow, AIN(I_PREMIX), XN + (size_t)m * DM, lane); }
        GRID_BAR();
    }

    for (int li = 0; li < DEPTH; ++li) {
        const int pb = 1 + li * 16;
        if (EN(1) && IN(pb + 0)) { OPQ(); GAS unsigned char* wl = ws + WS_W + (size_t)li * W_LAYER; GAS bf16* const XN = (GAS bf16*)(ws + WS_XN); const GAS float* rope = (const GAS float*)(ws + WS_ROPE);
          for (int rep = 0; rep < ((REP(1) && li == 0) ? 2 : 1); ++rep) {
            pg8::Gemm g{(const GAS pg8::bf16_t*)XN, (const GAS pg8::bf16_t*)(wl + W_IN), MT, NIN, DM, DM}; pg8::StaticOrder S; S.init(MT, NIN, G, bx);
            EpiIn E{ws, out + O_KP + (size_t)li * MP * DM, out + O_VP + (size_t)li * MP * DM, out + O_KS + (size_t)li * MS * DM, out + O_VS + (size_t)li * MS * DM, rope, AIN(I_BGK2) + li * 512};
            pg8::gemm_phase<EpiIn, pg8::StaticOrder, true, true>(lds, g, S, E);
            GRID_BAR();
          }
        }
        if (EN(2) && IN(pb + 1)) { OPQ(); GAS unsigned char* wl = ws + WS_W + (size_t)li * W_LAYER; GAS bf16* const XN = (GAS bf16*)(ws + WS_XN); const GAS float* rope = (const GAS float*)(ws + WS_ROPE);
          for (int rep = 0; rep < ((REP(2) && li == 0) ? 2 : 1); ++rep) {
            float lam, onem;
            { const float a = wave_sum(AIN(I_LQ1)[li * 64 + lane] * AIN(I_LK1)[li * 64 + lane]), c = wave_sum(AIN(I_LQ2)[li * 64 + lane] * AIN(I_LK2)[li * 64 + lane]);
              const float lam_init = 0.8f - 0.6f * expf(-0.3f * (float)li); lam = expf(a) - expf(c) + lam_init; onem = 1.0f - lam_init; }
            const GAS bf16* QA = (const GAS bf16*)(ws + WS_QA); const GAS bf16* KA = (const GAS bf16*)(ws + WS_KA); const GAS bf16* VA = (const GAS bf16*)(ws + WS_VA);
            const GAS float* nw = AIN(I_DANW) + li * 128;
            for (int rp = 0; rp < ((REP(10) && li == 0) ? 2 : 1); ++rp)
            if (EN(10)) for (int un = vcu; un < DB * 8; un += G)
                attn_unit<1>(lds, QA, KA, VA, (GAS bf16*)(ws + WS_OA), AIN(I_CK) + (size_t)li * DB * PAST * DM, AIN(I_CV) + (size_t)li * DB * PAST * DM, un >> 3, un & 7, 0, lam, onem, nw);
            for (int rp = 0; rp < ((REP(11) && li == 0) ? 2 : 1); ++rp)
            if (EN(11)) for (int it = vcu; it < 256; it += G) {
                GlaP P{(const GAS bf16*)(ws + WS_QG), (const GAS bf16*)(ws + WS_KG), (const GAS bf16*)(ws + WS_VG), (const GAS bf16*)(ws + WS_GK), nullptr, nullptr, nullptr, nullptr, nullptr, nullptr};
                f32x16 S[4];
#pragma unroll
                for (int kb = 0; kb < 4; ++kb)
#pragma unroll
                    for (int r = 0; r < 16; ++r) S[kb][r] = 0.f;
                float ds0 = 0.f, ds1 = 0.f;
                const int bh = it >> 3, grp = it & 7;
                gla_run<false, 0>(lds, P, (size_t)(bh >> 2) * SEQ + grp * 1024, bh & 3, 16, S, ds0, ds1);
                gla_store_state((GAS float*)(ws + WS_SLOC) + (size_t)it * 32768, S, wave, lane & 31, lane >> 5);
                if (wave == 0) { GAS float* dg = (GAS float*)(ws + WS_DG) + it * 128 + 2 * lane; dg[0] = __expf(ds0); dg[1] = __expf(ds1); }
            }
            if (EN(12)) for (int pi = vcu; pi < 2048; pi += G) {
                const int bh = (pi % 256) >> 2, s = (pi & 3) + 4 * (pi / 256);
                attn_prompt_unit(lds, QA, KA, VA, (GAS bf16*)(ws + WS_OA), bh >> 3, bh & 7, 63 - s, lam, onem, nw);
                attn_prompt_unit(lds, QA, KA, VA, (GAS bf16*)(ws + WS_OA), bh >> 3, bh & 7, s, lam, onem, nw);
            }
            GRID_BAR();
          }
        }
        if (EN(3) && IN(pb + 2)) { OPQ(); GAS unsigned char* wl = ws + WS_W + (size_t)li * W_LAYER; GAS bf16* const XN = (GAS bf16*)(ws + WS_XN); const GAS float* rope = (const GAS float*)(ws + WS_ROPE);
          for (int rep = 0; rep < ((REP(3) && li == 0) ? 2 : 1); ++rep) {
            GlaP P{(const GAS bf16*)(ws + WS_QG), (const GAS bf16*)(ws + WS_KG), (const GAS bf16*)(ws + WS_VG), (const GAS bf16*)(ws + WS_GK), (const GAS bf16*)(ws + WS_RG), (const GAS bf16*)(ws + WS_GA), (const GAS bf16*)(ws + WS_GB),
                   (const GAS bf16*)(ws + WS_OA), (GAS bf16*)(ws + WS_QA), AIN(I_GLANW) + li * 256};
            const int r32 = lane & 31, hh = lane >> 5;
            if (EN(13)) for (int it = vcu; it < 256; it += G) {
                const int bh = it >> 3, grp = it & 7;
                f32x16 S[4];
#pragma unroll
                for (int kb = 0; kb < 4; ++kb)
#pragma unroll
                    for (int r = 0; r < 16; ++r) S[kb][r] = 0.f;
                for (int j = 0; j < (NOFOLD ? 0 : grp); ++j) {
                    const GAS float* dg = (const GAS float*)(ws + WS_DG) + (size_t)(bh * 8 + j) * 128 + 4 * hh; const GAS float* sl = (const GAS float*)(ws + WS_SLOC) + (size_t)(bh * 8 + j) * 32768;
                    unsigned off = (unsigned)(4 * hh * 256 + 32 * wave + r32);
#pragma unroll
                    for (int kb = 0; kb < 4; ++kb)
#pragma unroll
                        for (int g4 = 0; g4 < 4; ++g4) { const f32x4 d4 = *(const GAS f32x4*)(dg + 32 * kb + 8 * g4);
#pragma unroll
                            for (int e = 0; e < 4; ++e) S[kb][4 * g4 + e] = S[kb][4 * g4 + e] * d4[e] + sl[off + e * 256];
                            off += 8 * 256; asm volatile("" : "+v"(off)); }
                }
                float ds0 = 0.f, ds1 = 0.f;
                gla_run<true, 0>(lds, P, (size_t)(bh >> 2) * SEQ + grp * 1024, bh & 3, 16, S, ds0, ds1);
                if (grp == 7) gla_store_state(out + O_GP + ((size_t)li * 32 + bh) * 32768, S, wave, r32, hh);
            }
            if (EN(14)) for (int it = vcu; it < DB * 4; it += G) {
                const int b = it >> 2, h = it & 3;
                const GAS float* s0 = AIN(I_SG) + ((size_t)li * DB * 4 + it) * 32768;
                f32x16 S[4];
                gla_load_state(s0, S, wave, r32, hh);
                float ds0 = 0.f, ds1 = 0.f;
                gla_run<true, 1>(lds, P, (size_t)MP + b * 16, h, 1, S, ds0, ds1);
                gla_store_state(out + O_GS + ((size_t)li * DB * 4 + it) * 32768, S, wave, r32, hh);
            }
            GRID_BAR();
          }
        }
        if (EN(4) && IN(pb + 3)) { OPQ(); GAS unsigned char* wl = ws + WS_W + (size_t)li * W_LAYER; GAS bf16* const XN = (GAS bf16*)(ws + WS_XN); const GAS float* rope = (const GAS float*)(ws + WS_ROPE);
          for (int rep = 0; rep < ((REP(4) && li == 0) ? 2 : 1); ++rep) {
            pg8::Gemm g{(const GAS pg8::bf16_t*)(ws + WS_QA), (const GAS pg8::bf16_t*)(wl + W_O), MP, DM, DM, DM}; pg8::StaticOrder S; S.init(MP, DM, G, bx);
            EpiB16 E{(GAS bf16*)(ws + WS_TMP), DM};
            pg8::gemm_phase<EpiB16, pg8::StaticOrder, true, true>(lds, g, S, E);
            { pg8::Gemm g2{(const GAS pg8::bf16_t*)(ws + WS_QA), (const GAS pg8::bf16_t*)(wl + W_O), MT, DM, 256, DM}; SplitOrder S2{G, bx, DM / 256, 256};
              EpiPart E2{(GAS float*)(ws + WS_PART), 256};
              pg8::gemm_phase<EpiPart, SplitOrder, true, true>(lds, g2, S2, E2); }
            GRID_BAR();
          }
        }
        if (EN(5) && IN(pb + 4)) { OPQ(); GAS unsigned char* wl = ws + WS_W + (size_t)li * W_LAYER; GAS bf16* const XN = (GAS bf16*)(ws + WS_XN); const GAS float* rope = (const GAS float*)(ws + WS_ROPE);
          for (int rep = 0; rep < ((REP(5) && li == 0) ? 2 : 1); ++rep) {
            rowpass((const GAS bf16*)(ws + WS_TMP), (const GAS float*)(ws + WS_PART), DM / 256, li == 0 ? AIN(I_XP) : out, li == 0 ? AIN(I_XS) : out + (size_t)MP * DM, out,
                    AIN(I_POSTMIX) + li * DM, AIN(I_PREFFN) + li * DM, XN, gw, NGW, lane);
            GRID_BAR();
          }
        }
        if (EN(6) && IN(pb + 5)) { OPQ(); GAS unsigned char* wl = ws + WS_W + (size_t)li * W_LAYER; GAS bf16* const XN = (GAS bf16*)(ws + WS_XN); const GAS float* rope = (const GAS float*)(ws + WS_ROPE);
          for (int rep = 0; rep < ((REP(6) && li == 0) ? 2 : 1); ++rep) {
            pg8::Gemm g{(const GAS pg8::bf16_t*)XN, (const GAS pg8::bf16_t*)(wl + W_UP), MT, 2 * DFF, DM, DM}; pg8::StaticOrder S; S.init(MT, 2 * DFF, G, bx);
            EpiB16 E{(GAS bf16*)(ws + WS_UG), 2 * DFF};
            pg8::gemm_phase<EpiB16, pg8::StaticOrder, true, true>(lds, g, S, E);
            GRID_BAR();
          }
        }
        if (EN(7) && IN(pb + 6)) { OPQ(); GAS unsigned char* wl = ws + WS_W + (size_t)li * W_LAYER; GAS bf16* const XN = (GAS bf16*)(ws + WS_XN); const GAS float* rope = (const GAS float*)(ws + WS_ROPE);
          for (int rep = 0; rep < ((REP(7) && li == 0) ? 2 : 1); ++rep) {
            act_pass((const GAS bf16*)(ws + WS_UG), (GAS bf16*)(ws + WS_ACT), AIN(I_CONVW) + (size_t)li * 3 * DFF, AIN(I_CONVB) + (size_t)li * DFF, AIN(I_SC) + (size_t)li * DB * 2 * DFF,
                     out + O_CP + (size_t)li * NB * 2 * DFF, out + O_CS + (size_t)li * DB * 2 * DFF, vcu, G, tid);
            GRID_BAR();
          }
        }
        if (EN(8) && IN(pb + 7)) { OPQ(); GAS unsigned char* wl = ws + WS_W + (size_t)li * W_LAYER; GAS bf16* const XN = (GAS bf16*)(ws + WS_XN); const GAS float* rope = (const GAS float*)(ws + WS_ROPE);
          for (int rep = 0; rep < ((REP(8) && li == 0) ? 2 : 1); ++rep) {
            pg8::Gemm g{(const GAS pg8::bf16_t*)(ws + WS_ACT), (const GAS pg8::bf16_t*)(wl + W_DN), MP, DM, DFF, DFF}; pg8::StaticOrder S; S.init(MP, DM, G, bx);
            EpiB16 E{(GAS bf16*)(ws + WS_TMP), DM};
            pg8::gemm_phase<EpiB16, pg8::StaticOrder, true, true>(lds, g, S, E);
            { pg8::Gemm g2{(const GAS pg8::bf16_t*)(ws + WS_ACT), (const GAS pg8::bf16_t*)(wl + W_DN), MT, DM, 256, DFF}; SplitOrder S2{G, bx, DFF / 256, 256};
              EpiPart E2{(GAS float*)(ws + WS_PART), 256};
              pg8::gemm_phase<EpiPart, SplitOrder, true, true>(lds, g2, S2, E2); }
            GRID_BAR();
          }
        }
        if (EN(9) && IN(pb + 8)) { OPQ(); GAS unsigned char* wl = ws + WS_W + (size_t)li * W_LAYER; GAS bf16* const XN = (GAS bf16*)(ws + WS_XN); const GAS float* rope = (const GAS float*)(ws + WS_ROPE);
            const bool more = (li + 1 < DEPTH);
            rowpass((const GAS bf16*)(ws + WS_TMP), (const GAS float*)(ws + WS_PART), DFF / 256, out, out + (size_t)MP * DM, out, AIN(I_POSTFFN) + li * DM, more ? AIN(I_PREMIX) + (li + 1) * DM : nullptr, more ? XN : nullptr, gw, NGW, lane);
            if (more) GRID_BAR();
        }
    }
#undef IN
}

extern "C" void kernel_launch(void* const* d_in, const int* in_sizes, int n_in, void* d_out, int out_size, void* d_ws, size_t ws_size, hipStream_t stream) {
    static int grid = 0;
    if (grid == 0) {
        if (n_in != 24 || (size_t)out_size != O_END || ws_size < WS_END) { fprintf(stderr, "kernel_launch: unexpected shapes: n_in %d out %d (want %zu) ws %zu (want %zu)\n", n_in, out_size, (size_t)O_END, ws_size, (size_t)WS_END); grid = -1; return; }
        int dev = 0, cus = 0, per_cu = 0;
        if (hipGetDevice(&dev) != hipSuccess || hipDeviceGetAttribute(&cus, hipDeviceAttributeMultiprocessorCount, dev) != hipSuccess) { grid = -1; return; }
        if (hipFuncSetAttribute((const void*)mega_fwd, hipFuncAttributeMaxDynamicSharedMemorySize, LDS_BYTES) != hipSuccess) { fprintf(stderr, "kernel_launch: hipFuncSetAttribute failed\n"); grid = -1; return; }
        if (hipOccupancyMaxActiveBlocksPerMultiprocessor(&per_cu, (const void*)mega_fwd, NWAVES * 64, LDS_BYTES) != hipSuccess || per_cu < 1) { fprintf(stderr, "kernel_launch: occupancy query reports %d\n", per_cu); }
        (void)hipGetLastError();
        grid = cus;
    }
    if (grid < 0) return;
    if (hipMemsetAsync((char*)d_ws + WS_CTL, 0, CTL_ZERO_BYTES, stream) != hipSuccess) return;
    Args a{};
    for (int i = 0; i < 24; ++i) a.in[i] = (const float*)d_in[i];
    a.out = (float*)d_out; a.ws = (unsigned char*)d_ws;
    for (int i = 0; i < 8; ++i) a.inv_freq[i] = (float)pow(500000.0, -(double)i / 8.0);
    a.ph_lo = 0; a.ph_hi = 1000;
    hipLaunchKernelGGL(mega_fwd, dim3(grid), dim3(NWAVES * 64), LDS_BYTES, stream, a);
}
```

```cpp
#include <hip/hip_runtime.h>
#include <cstdio>
#include <cstdint>
#include <cmath>
__device__ __forceinline__ int opaque_tid() { int t = threadIdx.x; asm volatile("" : "+v"(t)); return t; }
namespace pg8 {
#define PG8_LAS __attribute__((address_space(3)))
typedef unsigned short bf16_t;
typedef short bf16x8 __attribute__((ext_vector_type(8)));
typedef float f32x4 __attribute__((ext_vector_type(4)));
typedef unsigned u32x4 __attribute__((ext_vector_type(4)));
constexpr int BM = 256, BK = 64, HALF = 128, HTB = HALF * BK * 2  , STAGE_BYTES = 8 * HTB, NXCD = 8, WGM = 8;

__host__ __device__ __forceinline__ int lds_byte(int r, int c) { const int st = (r >> 4) * 2 + (c >> 5), rr = r & 15, cc = c & 31, ob = rr * 64 + cc * 2; return st * 1024 + (ob ^ (((ob >> 9) & 1) << 5)); }
__host__ __device__ __forceinline__ void stage_rc(int b, int& R, int& C) { const int st = b / 1024, sb = b % 1024, swz = sb ^ (((sb >> 9) & 1) << 5); R = (st >> 1) * 16 + swz / 64; C = (st & 1) * 32 + (swz % 64) / 2; }
__host__ __device__ __forceinline__ int perm32(int rho) { const int n = rho >> 4, i = rho & 15; return 8 * (i >> 2) + 4 * n + (i & 3); }

struct Unit { int pm, pn, ko; };
struct Gemm { const __attribute__((address_space(1))) bf16_t* A; const __attribute__((address_space(1))) bf16_t* Bt; int M, N, K, ld; };

struct StaticOrder {
    int nM, nN, nwg, G, c;
    __host__ __device__ void init(int M, int N, int G_, int c_) { nM = M / BM; nN = N / BM; nwg = nM * nN; G = G_; c = c_; }
    __host__ __device__ bool next(int i, Unit& u) const {
        const long L = (long)i * G + c; if (L >= nwg) return false;
        int wgid = (int)L; { const int q = nwg / NXCD, r = nwg % NXCD, xcd = wgid % NXCD, off = wgid / NXCD; wgid = (xcd < r ? xcd * (q + 1) : r * (q + 1) + (xcd - r) * q) + off; }
        const int nig = WGM * nN, gid = wgid / nig, fm = gid * WGM, gsz = (nM - fm) < WGM ? (nM - fm) : WGM;
        u.pm = fm + ((wgid % nig) % gsz); u.pn = (wgid % nig) / gsz; u.ko = 0; return true;
    }
    __device__ __forceinline__ void a_ready(const Unit&) const {}
    __device__ __forceinline__ void done(const Unit&) const {}
};

__device__ __forceinline__ unsigned cvt_pk_bf16(float lo, float hi) { unsigned r; asm volatile("v_cvt_pk_bf16_f32 %0, %1, %2" : "=v"(r) : "v"(lo), "v"(hi)); return r; }
template <class Epi, class Sched, bool ALIGN_EPI = false, bool SP2 = false>
__device__ __forceinline__ void gemm_phase(PG8_LAS unsigned char* lds, const Gemm g, const Sched& S, const Epi& E) {
    const int tid = opaque_tid(), wid = __builtin_amdgcn_readfirstlane(tid >> 6), lane = tid & 63, wr = wid >> 2, wc = wid & 3, fr = lane & 15, fq = lane >> 4;
    const int K = g.ld, nt = g.K / BK;
    unsigned voffA[2], voffB[2];
#pragma unroll
    for (int i = 0; i < 2; ++i) { int R, C; stage_rc(tid * 16 + i * 8192, R, C); const int Rb = Epi::PERM ? ((R & ~31) + perm32(R & 31)) : R;
        voffA[i] = (unsigned)(R * K + C) * 2u; voffB[i] = (unsigned)(Rb * K + C) * 2u; }
    const size_t kstep = (size_t)(BK * 2);
    const size_t hstep = (size_t)HALF * K * 2;
    const size_t tstep = 2 * hstep;
    const unsigned ldsw = (unsigned)wid * 1024u;
    const int aoff = lds_byte(wr * 64 + fr, fq * 8), boff = lds_byte(wc * 32 + fr, fq * 8);
#define PG8_SA(b, h) (((b) * 2 + (h)) * HTB)
#define PG8_SB(b, h) ((4 + (b) * 2 + (h)) * HTB)
#define PG8_STAGE(bufoff, gbase, voff) do { _Pragma("unroll") for (int _i = 0; _i < 2; ++_i) \
        __builtin_amdgcn_global_load_lds((const unsigned*)((const char*)(gbase) + (voff)[_i]), (PG8_LAS unsigned*)(lds + (bufoff) + ldsw + _i * 8192), 16, 0, 0); } while (0)
#define PG8_LDA(dst, b, h) do { _Pragma("unroll") for (int m = 0; m < 4; ++m) _Pragma("unroll") for (int k = 0; k < 2; ++k) dst[m][k] = *(const PG8_LAS bf16x8*)(lds + PG8_SA(b, h) + aoff + m * 2048 + k * 1024); } while (0)
#define PG8_LDB(dst, b, h) do { _Pragma("unroll") for (int n = 0; n < 2; ++n) _Pragma("unroll") for (int k = 0; k < 2; ++k) dst[n][k] = *(const PG8_LAS bf16x8*)(lds + PG8_SB(b, h) + boff + n * 2048 + k * 1024); } while (0)
#define PG8_MMA(ai, bj, At, Bt) do { __builtin_amdgcn_s_setprio(1); _Pragma("unroll") for (int m = 0; m < 4; ++m) _Pragma("unroll") for (int n = 0; n < 2; ++n) _Pragma("unroll") for (int k = 0; k < 2; ++k) \
        acc[ai][bj][m][n] = __builtin_amdgcn_mfma_f32_16x16x32_bf16(Bt[n][k], At[m][k], acc[ai][bj][m][n], 0, 0, 0); __builtin_amdgcn_s_setprio(0); } while (0)
#define PG8_WAIT_V(n) asm volatile("s_waitcnt vmcnt(" #n ")" ::: "memory")
#define PG8_WAIT_L(n) asm volatile("s_waitcnt lgkmcnt(" #n ")" ::: "memory")
#define PG8_BAR __builtin_amdgcn_s_barrier()
#define PG8_SCHED __builtin_amdgcn_sched_barrier(0)
    Unit cur, nxt; int ui = 0;
    if (!S.next(0, cur)) return;
    f32x4 acc[2][2][4][2];
#pragma unroll
    for (int a = 0; a < 2; ++a)
#pragma unroll
        for (int b = 0; b < 2; ++b)
#pragma unroll
            for (int m = 0; m < 4; ++m)
#pragma unroll
                for (int n = 0; n < 2; ++n) acc[a][b][m][n] = (f32x4){0.f, 0.f, 0.f, 0.f};
    bf16x8 At[4][2], B0[2][2], B1[2][2];
    const char* cA = (const char*)g.A + (size_t)cur.pm * tstep + (size_t)cur.ko * 2; const char* cB = (const char*)g.Bt + (size_t)cur.pn * tstep + (size_t)cur.ko * 2;
    S.a_ready(cur);
    if constexpr (SP2) {
        PG8_STAGE(PG8_SB(0, 0), cB, voffB); PG8_STAGE(PG8_SB(0, 1), cB + hstep, voffB); PG8_STAGE(PG8_SA(0, 0), cA, voffA); PG8_STAGE(PG8_SA(0, 1), cA + hstep, voffA);
        if (wr == 1) PG8_BAR;
        PG8_WAIT_V(2); PG8_BAR;
        PG8_STAGE(PG8_SB(1, 0), cB + kstep, voffB); PG8_STAGE(PG8_SA(1, 0), cA + kstep, voffA); PG8_STAGE(PG8_SB(1, 1), cB + hstep + kstep, voffB);
        PG8_WAIT_V(6); PG8_BAR;
    } else {
        PG8_STAGE(PG8_SB(0, 0), cB, voffB); PG8_STAGE(PG8_SA(0, 0), cA, voffA); PG8_STAGE(PG8_SB(0, 1), cB + hstep, voffB); PG8_STAGE(PG8_SA(0, 1), cA + hstep, voffA);
        if (wr == 1) PG8_BAR;
        PG8_WAIT_V(4); PG8_BAR;
        PG8_STAGE(PG8_SB(1, 0), cB + kstep, voffB); PG8_STAGE(PG8_SA(1, 0), cA + kstep, voffA); PG8_STAGE(PG8_SB(1, 1), cB + hstep + kstep, voffB);
        PG8_WAIT_V(6); PG8_BAR;
    }
    for (;;) {
        const bool has_next = S.next(ui + 1, nxt);
        const char* nA = has_next ? (const char*)g.A + (size_t)nxt.pm * tstep + (size_t)nxt.ko * 2 : cA; const char* nB = has_next ? (const char*)g.Bt + (size_t)nxt.pn * tstep + (size_t)nxt.ko * 2 : cB;
        for (int t = 0; t < nt; t += 2) {
            const bool last = (t == nt - 2);
            const char* a1 = cA + (size_t)(t + 1) * kstep;
            const char* a2 = last ? nA : cA + (size_t)(t + 2) * kstep; const char* b2 = last ? nB : cB + (size_t)(t + 2) * kstep;
            const char* a3 = a2 + kstep; const char* b3 = b2 + kstep;
            if (last && has_next) S.a_ready(nxt);
            if constexpr (SP2) {
            PG8_LDB(B0, 0, 0); PG8_LDB(B1, 0, 1); PG8_SCHED; PG8_LDA(At, 0, 0); PG8_STAGE(PG8_SA(1, 1), a1 + hstep, voffA);
            PG8_WAIT_V(8); PG8_WAIT_L(0); PG8_BAR; PG8_MMA(0, 0, At, B0); PG8_MMA(0, 1, At, B1); PG8_BAR; PG8_SCHED;
            PG8_LDA(At, 0, 1); PG8_STAGE(PG8_SB(0, 0), b2, voffB); PG8_STAGE(PG8_SB(0, 1), b2 + hstep, voffB); PG8_STAGE(PG8_SA(0, 0), a2, voffA);
            PG8_WAIT_V(8); PG8_WAIT_L(0); PG8_BAR; PG8_MMA(1, 0, At, B0); PG8_MMA(1, 1, At, B1); PG8_BAR; PG8_SCHED;
            PG8_LDB(B0, 1, 0); PG8_LDB(B1, 1, 1); PG8_SCHED; PG8_LDA(At, 1, 0); PG8_STAGE(PG8_SA(0, 1), a2 + hstep, voffA);
            PG8_WAIT_V(8); PG8_WAIT_L(0); PG8_BAR; PG8_MMA(0, 0, At, B0); PG8_MMA(0, 1, At, B1); PG8_BAR; PG8_SCHED;
            PG8_LDA(At, 1, 1); PG8_STAGE(PG8_SB(1, 0), b3, voffB); PG8_STAGE(PG8_SB(1, 1), b3 + hstep, voffB); PG8_STAGE(PG8_SA(1, 0), a3, voffA);
            PG8_WAIT_V(8); PG8_WAIT_L(0); PG8_BAR; PG8_MMA(1, 0, At, B0); PG8_MMA(1, 1, At, B1); PG8_BAR; PG8_SCHED;
            } else {
            PG8_LDB(B0, 0, 0); PG8_SCHED; PG8_LDA(At, 0, 0); PG8_STAGE(PG8_SA(1, 1), a1 + hstep, voffA);
            PG8_WAIT_L(8); PG8_BAR; PG8_WAIT_L(0); PG8_MMA(0, 0, At, B0); PG8_BAR; PG8_SCHED;
            PG8_LDB(B1, 0, 1); PG8_STAGE(PG8_SB(0, 0), b2, voffB);
            PG8_BAR; PG8_WAIT_L(0); PG8_MMA(0, 1, At, B1); PG8_BAR;
            PG8_LDA(At, 0, 1); PG8_STAGE(PG8_SA(0, 0), a2, voffA);
            PG8_BAR; PG8_WAIT_L(0); PG8_MMA(1, 0, At, B0); PG8_BAR; PG8_SCHED;
            PG8_STAGE(PG8_SB(0, 1), b2 + hstep, voffB);
            PG8_WAIT_V(6); PG8_BAR; PG8_MMA(1, 1, At, B1); PG8_BAR;
            PG8_LDB(B0, 1, 0); PG8_SCHED; PG8_LDA(At, 1, 0); PG8_STAGE(PG8_SA(0, 1), a2 + hstep, voffA);
            PG8_WAIT_L(8); PG8_BAR; PG8_WAIT_L(0); PG8_MMA(0, 0, At, B0); PG8_BAR; PG8_SCHED;
            PG8_LDB(B1, 1, 1); PG8_STAGE(PG8_SB(1, 0), b3, voffB);
            PG8_BAR; PG8_WAIT_L(0); PG8_MMA(0, 1, At, B1); PG8_BAR;
            PG8_LDA(At, 1, 1); PG8_STAGE(PG8_SA(1, 0), a3, voffA);
            PG8_BAR; PG8_WAIT_L(0); PG8_MMA(1, 0, At, B0); PG8_BAR; PG8_SCHED;
            PG8_STAGE(PG8_SB(1, 1), b3 + hstep, voffB);
            PG8_WAIT_V(6); PG8_BAR; PG8_MMA(1, 1, At, B1); PG8_BAR;
            }
        }
        if constexpr (ALIGN_EPI) { if (wr == 0) PG8_BAR; }
        if constexpr (!Epi::AFTER_DRAIN) { E(acc, cur, wr, wc, fr, fq); S.done(cur); }
        if (!has_next) break;
#pragma unroll
        for (int a = 0; a < 2; ++a)
#pragma unroll
            for (int b = 0; b < 2; ++b)
#pragma unroll
                for (int m = 0; m < 4; ++m)
#pragma unroll
                    for (int n = 0; n < 2; ++n) acc[a][b][m][n] = (f32x4){0.f, 0.f, 0.f, 0.f};
        cur = nxt; cA = nA; cB = nB; ++ui;
        if constexpr (ALIGN_EPI) { if (wr == 1) PG8_BAR; }
    }
    PG8_WAIT_V(0);
    if constexpr (!ALIGN_EPI) { if (wr == 0) PG8_BAR; }
    PG8_BAR;
    if constexpr (Epi::AFTER_DRAIN) { E.fused(acc, cur, wr, wc, fr, fq, lds, wid, lane); S.done(cur); }
#undef PG8_SA
#undef PG8_SB
#undef PG8_STAGE
#undef PG8_LDA
#undef PG8_LDB
#undef PG8_MMA
#undef PG8_WAIT_V
#undef PG8_WAIT_L
#undef PG8_BAR
#undef PG8_SCHED
}
}

#define GAS __attribute__((address_space(1)))
#define LAS __attribute__((address_space(3)))
typedef unsigned short bf16;
typedef short bf16x8 __attribute__((ext_vector_type(8)));
typedef short s16x4 __attribute__((ext_vector_type(4)));
typedef float f32x4 __attribute__((ext_vector_type(4)));
typedef float f32x2 __attribute__((ext_vector_type(2)));
typedef float f32x16 __attribute__((ext_vector_type(16)));
typedef unsigned u32x4 __attribute__((ext_vector_type(4)));
typedef unsigned u32x2 __attribute__((ext_vector_type(2)));

constexpr int DM = 1024, NB = 8, SEQ = 8192, DEPTH = 2, DB = 32, DL = 16, PAST = 2048;
constexpr int MP = NB * SEQ;
constexpr int MS = DB * DL;
constexpr int MT = MP + MS;
constexpr int DFF = 2816, DIN = 8208, NIN = 8704;
constexpr float EPS = 1e-6f;
constexpr float C2 = 0.125f * 1.4426950408889634f;
constexpr int NWAVES = 8;

constexpr size_t O_Y = 0;
constexpr size_t O_KP = (size_t)MT * DM;
constexpr size_t O_VP = O_KP + (size_t)DEPTH * MP * DM;
constexpr size_t O_GP = O_VP + (size_t)DEPTH * MP * DM;
constexpr size_t O_CP = O_GP + (size_t)DEPTH * NB * 4 * 128 * 256;
constexpr size_t O_KS = O_CP + (size_t)DEPTH * NB * 2 * DFF;
constexpr size_t O_VS = O_KS + (size_t)DEPTH * MS * DM;
constexpr size_t O_GS = O_VS + (size_t)DEPTH * MS * DM;
constexpr size_t O_CS = O_GS + (size_t)DEPTH * DB * 4 * 128 * 256;
constexpr size_t O_END = O_CS + (size_t)DEPTH * DB * 2 * DFF;

constexpr size_t MiB = 1u << 20, HMiB = 1u << 19;
constexpr size_t WS_CTL = 0, CTL_ZERO_BYTES = 1 * MiB;
constexpr size_t WS_ROPE = 1 * MiB;
constexpr size_t WS_DG = 1 * MiB + HMiB;
constexpr size_t WS_W = 2 * MiB;
constexpr size_t W_IN = 0, W_O = 17 * MiB, W_UP = 19 * MiB, W_DN = 30 * MiB, W_LAYER = 35 * MiB + HMiB;
constexpr size_t WS_SLOC = 74 * MiB;
constexpr size_t UB = (size_t)MT * DM * 2;
constexpr size_t WS_XN = 112 * MiB;
constexpr size_t WS_QA = WS_XN + UB, WS_KA = WS_QA + UB, WS_VA = WS_KA + UB, WS_QG = WS_VA + UB, WS_KG = WS_QG + UB / 2, WS_VG = WS_KG + UB / 2,
                 WS_RG = WS_VG + UB, WS_GK = WS_RG + UB, WS_GA = WS_GK + UB / 2, WS_GB = WS_GA + UB, WS_PEND = WS_GB + UB;
constexpr size_t WS_UG = WS_QA;
constexpr size_t WS_ACT = WS_UG + (size_t)MT * 5632 * 2;
constexpr size_t WS_TMP = WS_PEND;
constexpr size_t WS_OA = WS_TMP + 2 * UB;
constexpr size_t WS_PART = WS_OA + UB;
constexpr size_t WS_RS = WS_PART + (size_t)11 * MS * DM * 4;
constexpr size_t WS_END = WS_RS + UB;
static_assert(WS_ACT + (size_t)MT * DFF * 2 <= WS_PEND, "ws overlay");
static_assert(WS_W + 2 * W_LAYER <= WS_SLOC && WS_SLOC + 32 * MiB <= WS_XN, "ws map");
constexpr int CW_BAR = 4096;

constexpr int RING_BYTES = 131072, MISC_OFF = RING_BYTES, LDS_BYTES = 147456;

__device__ __forceinline__ float bf2f(bf16 b) { return __uint_as_float((unsigned)b << 16); }
__device__ __forceinline__ float bflo(unsigned u) { return __uint_as_float(u << 16); }
__device__ __forceinline__ float bfhi(unsigned u) { return __uint_as_float(u & 0xffff0000u); }
typedef __bf16 bf16x2_t __attribute__((ext_vector_type(2)));
__device__ __forceinline__ unsigned pk2(float lo, float hi) { f32x2 v = {lo, hi}; bf16x2_t b = __builtin_convertvector(v, bf16x2_t); return __builtin_bit_cast(unsigned, b); }
__device__ __forceinline__ bf16 f2bf(float f) { return (bf16)(pk2(f, 0.f) & 0xffffu); }
template <int M> __device__ __forceinline__ float shx(float v) { return __int_as_float(__builtin_amdgcn_ds_swizzle(__float_as_int(v), 0x1F | (M << 10))); }
__device__ __forceinline__ float sum32x(float v) { auto r = __builtin_amdgcn_permlane32_swap(__float_as_uint(v), __float_as_uint(v), false, false); return __uint_as_float(r[0]) + __uint_as_float(r[1]); }
__device__ __forceinline__ float max32x(float v) { auto r = __builtin_amdgcn_permlane32_swap(__float_as_uint(v), __float_as_uint(v), false, false); return fmaxf(__uint_as_float(r[0]), __uint_as_float(r[1])); }
__device__ __forceinline__ float half_sum(float v) { v += shx<1>(v); v += shx<2>(v); v += shx<4>(v); v += shx<8>(v); v += shx<16>(v); return v; }
__device__ __forceinline__ float wave_sum(float v) { return sum32x(half_sum(v)); }
__device__ __forceinline__ float frcp(float x) { return __builtin_amdgcn_rcpf(x); }
__device__ __forceinline__ float frsq(float x) { return __builtin_amdgcn_rsqf(x); }
__device__ __forceinline__ float sigmoidf_(float x) { return frcp(1.0f + __expf(-x)); }
#define LDS_WAIT() asm volatile("s_waitcnt lgkmcnt(0)" ::: "memory")
#define VM_WAIT() asm volatile("s_waitcnt vmcnt(0)" ::: "memory")

struct EpiIn {
    static constexpr bool PERM = true, AFTER_DRAIN = false;
    GAS unsigned char* ws; GAS float* kout_p; GAS float* vout_p; GAS float* kout_s; GAS float* vout_s; const GAS float* rope; const GAS float* bgk;
    template <int KIND>
    __device__ __forceinline__ void run(const pg8::f32x4 (&acc)[2][2][4][2], GAS bf16* dst, int ldc, int tcol, GAS float* fout, int frow0, int row0, bool sample, int wc, int fq) const {
        const int colw = wc * 32 + 8 * fq;
        const bool ropew = (KIND <= 1) && ((wc & 1) == 0);
        const float sgn = (fq == 0) ? -1.f : ((fq == 1) ? 1.f : 0.f);
        const bool rl = (fq < 2);
        f32x4 b0 = {0.f, 0.f, 0.f, 0.f}, b1 = b0, b2 = b0, b3 = b0;
        if (KIND == 5) { b0 = *(const GAS f32x4*)(bgk + tcol + colw); b1 = *(const GAS f32x4*)(bgk + tcol + colw + 4); b2 = *(const GAS f32x4*)(bgk + tcol + 128 + colw); b3 = *(const GAS f32x4*)(bgk + tcol + 128 + colw + 4); }
#pragma unroll
        for (int ai = 0; ai < 2; ++ai)
#pragma unroll
            for (int m = 0; m < 4; ++m) {
                const int row = row0 + ai * 128 + m * 16;
                f32x4 cs0 = {1.f, 1.f, 1.f, 1.f}, cs1 = cs0, sn0 = {0.f, 0.f, 0.f, 0.f}, sn1 = sn0;
                if (KIND <= 1) { if (ropew) {
                    const int pos = sample ? (PAST + (row & 15)) : (row & (SEQ - 1));
                    const GAS f32x4* rp = (const GAS f32x4*)(rope + (size_t)pos * 16);
                    const f32x4 c0 = rp[0], c1 = rp[1], s0 = rp[2], s1 = rp[3];
#pragma unroll
                    for (int e = 0; e < 4; ++e) { cs0[e] = rl ? c0[e] : 1.f; cs1[e] = rl ? c1[e] : 1.f; sn0[e] = s0[e] * sgn; sn1[e] = s1[e] * sgn; }
                } }
#pragma unroll
                for (int bj = 0; bj < 2; ++bj) {
                    f32x4 v0 = acc[ai][bj][m][0], v1 = acc[ai][bj][m][1];
                    const int col = tcol + bj * 128 + colw;
                    if (KIND <= 1) { if (ropew) {
                        f32x4 o0, o1;
#pragma unroll
                        for (int e = 0; e < 4; ++e) { o0[e] = shx<16>(v0[e]); o1[e] = shx<16>(v1[e]); }
                        v0 = v0 * cs0 + o0 * sn0; v1 = v1 * cs1 + o1 * sn1;
                    } }
                    if (KIND == 1 || KIND == 2) {
                        GAS float* fo = fout + (size_t)(row - frow0) * 1024 + col;
                        __builtin_nontemporal_store(v0, (GAS f32x4*)fo); __builtin_nontemporal_store(v1, (GAS f32x4*)(fo + 4));
                    }
                    if (KIND == 0) { v0 = v0 * C2; v1 = v1 * C2; }
                    if (KIND == 3) { v0 = v0 * 0.08838834764831845f; v1 = v1 * 0.08838834764831845f; }
                    if (KIND == 5) {
                        const f32x4 ba = bj ? b2 : b0, bb = bj ? b3 : b1;
#pragma unroll
                        for (int e = 0; e < 4; ++e) {
                            float x = v0[e] + ba[e]; v0[e] = (fminf(x, 0.f) - __logf(1.f + __expf(-fabsf(x)))) * 0.0625f;
                            x = v1[e] + bb[e];       v1[e] = (fminf(x, 0.f) - __logf(1.f + __expf(-fabsf(x)))) * 0.0625f;
                        }
                    }
                    u32x4 w; w.x = pk2(v0[0], v0[1]); w.y = pk2(v0[2], v0[3]); w.z = pk2(v1[0], v1[1]); w.w = pk2(v1[2], v1[3]);
                    *(GAS u32x4*)(dst + (size_t)row * ldc + col) = w;
                }
            }
    }
    __device__ __forceinline__ void operator()(const pg8::f32x4 (&acc)[2][2][4][2], const pg8::Unit& u, int wr, int wc, int fr, int fq) const {
        const int pn = u.pn;
        const int row0 = u.pm * 256 + wr * 64 + fr;
        const bool sample = (u.pm >= 256);
        const int frow0 = sample ? MP : 0;
        if (pn < 4)       run<0>(acc, (GAS bf16*)(ws + WS_QA), 1024, pn * 256, nullptr, 0, row0, sample, wc, fq);
        else if (pn < 8)  run<1>(acc, (GAS bf16*)(ws + WS_KA), 1024, (pn - 4) * 256, sample ? kout_s : kout_p, frow0, row0, sample, wc, fq);
        else if (pn < 12) run<2>(acc, (GAS bf16*)(ws + WS_VA), 1024, (pn - 8) * 256, sample ? vout_s : vout_p, frow0, row0, sample, wc, fq);
        else if (pn < 14) run<3>(acc, (GAS bf16*)(ws + WS_QG), 512, (pn - 12) * 256, nullptr, 0, row0, sample, wc, fq);
        else if (pn < 16) run<4>(acc, (GAS bf16*)(ws + WS_KG), 512, (pn - 14) * 256, nullptr, 0, row0, sample, wc, fq);
        else if (pn < 20) run<4>(acc, (GAS bf16*)(ws + WS_VG), 1024, (pn - 16) * 256, nullptr, 0, row0, sample, wc, fq);
        else if (pn < 24) run<4>(acc, (GAS bf16*)(ws + WS_RG), 1024, (pn - 20) * 256, nullptr, 0, row0, sample, wc, fq);
        else if (pn < 28) run<4>(acc, (GAS bf16*)(ws + WS_GA), 1024, (pn - 24) * 256, nullptr, 0, row0, sample, wc, fq);
        else if (pn < 32) run<4>(acc, (GAS bf16*)(ws + WS_GB), 1024, (pn - 28) * 256, nullptr, 0, row0, sample, wc, fq);
        else              run<5>(acc, (GAS bf16*)(ws + WS_GK), 512, (pn - 32) * 256, nullptr, 0, row0, sample, wc, fq);
    }
};
struct SplitOrder {
    int G, c, nks, kslice;
    __device__ __forceinline__ bool next(int i, pg8::Unit& u) const { const int idx = i * G + c; if (idx >= 8 * nks) return false;
        const int ks = idx % nks, r = idx / nks; u.pn = r & 3; u.pm = 256 + (r >> 2); u.ko = ks * kslice; return true; }
    __device__ __forceinline__ void a_ready(const pg8::Unit&) const {}
    __device__ __forceinline__ void done(const pg8::Unit&) const {}
};
struct EpiPart {
    static constexpr bool PERM = true, AFTER_DRAIN = false;
    GAS float* P; int kslice;
    __device__ __forceinline__ void operator()(const pg8::f32x4 (&acc)[2][2][4][2], const pg8::Unit& u, int wr, int wc, int fr, int fq) const {
        const int row0 = (u.pm - 256) * 256 + wr * 64 + fr, col0 = u.pn * 256 + wc * 32 + 8 * fq; GAS float* base = P + (size_t)(u.ko / kslice) * MS * DM;
#pragma unroll
        for (int ai = 0; ai < 2; ++ai)
#pragma unroll
            for (int m = 0; m < 4; ++m) { GAS float* rowp = base + (size_t)(row0 + ai * 128 + m * 16) * DM + col0;
#pragma unroll
                for (int bj = 0; bj < 2; ++bj) { *(GAS f32x4*)(rowp + bj * 128) = acc[ai][bj][m][0]; *(GAS f32x4*)(rowp + bj * 128 + 4) = acc[ai][bj][m][1]; } }
    }
};
struct EpiF32 {
    static constexpr bool PERM = true, AFTER_DRAIN = false;
    GAS float* O; int ldc;
    __device__ __forceinline__ void operator()(const pg8::f32x4 (&acc)[2][2][4][2], const pg8::Unit& u, int wr, int wc, int fr, int fq) const {
        const int row0 = u.pm * 256 + wr * 64 + fr, col0 = u.pn * 256 + wc * 32 + 8 * fq;
#pragma unroll
        for (int ai = 0; ai < 2; ++ai)
#pragma unroll
            for (int m = 0; m < 4; ++m) { GAS float* rowp = O + (size_t)(row0 + ai * 128 + m * 16) * ldc + col0;
#pragma unroll
                for (int bj = 0; bj < 2; ++bj) { *(GAS f32x4*)(rowp + bj * 128) = acc[ai][bj][m][0]; *(GAS f32x4*)(rowp + bj * 128 + 4) = acc[ai][bj][m][1]; } }
    }
};
struct EpiB16 {
    static constexpr bool PERM = true, AFTER_DRAIN = false;
    GAS bf16* O; int ldc;
    __device__ __forceinline__ void operator()(const pg8::f32x4 (&acc)[2][2][4][2], const pg8::Unit& u, int wr, int wc, int fr, int fq) const {
        const int row0 = u.pm * 256 + wr * 64 + fr, col0 = u.pn * 256 + wc * 32 + 8 * fq;
#pragma unroll
        for (int ai = 0; ai < 2; ++ai)
#pragma unroll
            for (int m = 0; m < 4; ++m) { GAS bf16* rowp = O + (size_t)(row0 + ai * 128 + m * 16) * ldc + col0;
#pragma unroll
                for (int bj = 0; bj < 2; ++bj) { const f32x4 v0 = acc[ai][bj][m][0], v1 = acc[ai][bj][m][1];
                    u32x4 w; w.x = pk2(v0[0], v0[1]); w.y = pk2(v0[2], v0[3]); w.z = pk2(v1[0], v1[1]); w.w = pk2(v1[2], v1[3]);
                    *(GAS u32x4*)(rowp + bj * 128) = w; } }
    }
};
#define XB_TMO      128
#define XB_XCNT(j)  (256  + 64 * (j))
#define XB_XSUB(j)  (1280 + 64 * (j))
#define XB_XGEN(j)  (2304 + 64 * (j))
#define XB_TOP      3328
#define XB_TOPGEN   3392
#define XCD_BAR_WORDS 3456
#define XB_SPIN_CAP (1u << 18)

__device__ __forceinline__ unsigned xb_ld(unsigned* p)              { return __hip_atomic_load(p, __ATOMIC_RELAXED, __HIP_MEMORY_SCOPE_AGENT); }
__device__ __forceinline__ unsigned xb_add(unsigned* p, unsigned v) { return __hip_atomic_fetch_add(p, v, __ATOMIC_RELAXED, __HIP_MEMORY_SCOPE_AGENT); }
__device__ __forceinline__ unsigned xb_xcc_id() { return (unsigned)__builtin_amdgcn_s_getreg((3 << 11) | 20) & 0xFu; }
#define XB_SPIN(cond, bar) do { unsigned _sp = 0; while (cond) { __builtin_amdgcn_s_sleep(1); \
    if ((++_sp & 255u) == 0u) { if (xb_ld(&(bar)[XB_TMO])) break; if (_sp > XB_SPIN_CAP) { atomicAdd(&(bar)[XB_TMO], 1u); break; } } } } while (0)

struct XcdBarrier {
    unsigned* bar; unsigned x;
    volatile LAS unsigned* st;
};

__device__ __forceinline__ XcdBarrier xcd_barrier_post(unsigned* bar, volatile LAS unsigned* st) {
    XcdBarrier b; b.bar = bar; b.x = xb_xcc_id(); b.st = st;
    if (threadIdx.x == 0) (void)xb_add(&bar[XB_XCNT(b.x)], 1u);
    return b;
}
__device__ __forceinline__ void xcd_barrier_complete(unsigned* bar, unsigned x, unsigned& nloc, unsigned& nx) {
    const unsigned G = gridDim.x * gridDim.y * gridDim.z;
    unsigned sum, cnt, mine, sp = 0u;
    for (;;) {
        sum = 0u; cnt = 0u; mine = 0u;
#pragma unroll
        for (unsigned j = 0; j < 16; ++j) { const unsigned c = xb_ld(&bar[XB_XCNT(j)]); sum += c; cnt += (c > 0u) ? 1u : 0u; mine = (j == x) ? c : mine; }
        if (sum == G) break;
        __builtin_amdgcn_s_sleep(1);
        if ((++sp & 255u) == 0u) { if (xb_ld(&bar[XB_TMO])) break; if (sp > XB_SPIN_CAP) { atomicAdd(&bar[XB_TMO], 1u); break; } }
    }
    nloc = mine > 0u ? mine : 1u; nx = cnt > 0u ? cnt : 1u;
}

__device__ __forceinline__ void xcd_barrier(const XcdBarrier& b) {
    asm volatile("s_waitcnt vmcnt(0)" ::: "memory");
    __syncthreads();
    if (threadIdx.x == 0) {
        unsigned* bar = b.bar;
        __builtin_amdgcn_s_waitcnt(0);
        unsigned nloc = b.st[0], nx = b.st[1];
        if (nloc == 0u) { xcd_barrier_complete(bar, b.x, nloc, nx); b.st[0] = nloc; b.st[1] = nx; }
        const unsigned old = xb_add(&bar[XB_XSUB(b.x)], 1u);
        const unsigned gen = old / nloc;
        if (old + 1u == (gen + 1u) * nloc) {
            __builtin_amdgcn_fence(__ATOMIC_RELEASE, "agent");
            asm volatile("s_waitcnt vmcnt(0)" ::: "memory");
            const unsigned og = xb_add(&bar[XB_TOP], 1u);
            const unsigned tg = og / nx;
            if (og + 1u == (tg + 1u) * nx) xb_add(&bar[XB_TOPGEN], 1u);
            else XB_SPIN(xb_ld(&bar[XB_TOPGEN]) == tg, bar);
            __builtin_amdgcn_fence(__ATOMIC_ACQUIRE, "agent");
            xb_add(&bar[XB_XGEN(b.x)], 1u);
            asm volatile("s_waitcnt vmcnt(0)" ::: "memory");
        } else {
            XB_SPIN(xb_ld(&bar[XB_XGEN(b.x)]) == gen, bar);
            __builtin_amdgcn_fence(__ATOMIC_ACQUIRE, "agent");
            asm volatile("s_waitcnt vmcnt(0)" ::: "memory");
        }
    }
    __syncthreads();
}

__device__ __noinline__ void xcd_barrier_ni(unsigned* bar, unsigned x, volatile LAS unsigned* st) { XcdBarrier b; b.bar = bar; b.x = x; b.st = st; xcd_barrier(b); }

struct Args { const float* in[24]; float* out; unsigned char* ws; float inv_freq[8]; int ph_lo, ph_hi; };
enum { I_XP = 0, I_XS, I_CK, I_CV, I_SG, I_SC, I_WIN, I_WGK2, I_BGK2, I_LQ1, I_LK1, I_LQ2, I_LK2, I_DANW, I_GLANW, I_WO, I_PREMIX, I_POSTMIX, I_PREFFN, I_POSTFFN, I_WUP, I_CONVW, I_CONVB, I_WDOWN };

__device__ __forceinline__ void transpose_item(const GAS float* W, int N, int K, GAS bf16* WT, LAS float* scr, int kb, int n0_src, int n0_dst, int lane, const GAS float* wg) {
    const int k0 = 64 * kb;
    if (wg == nullptr) {
#pragma unroll 8
        for (int i = 0; i < 32; ++i) { const int kk = 2 * i + (lane >> 5); scr[kk * 33 + (lane & 31)] = W[(size_t)(k0 + kk) * N + n0_src + (lane & 31)]; }
    } else {
        float g[16];
#pragma unroll
        for (int r = 0; r < 16; ++r) g[r] = wg[r * 512 + n0_src + (lane & 31)];
        for (int i = 0; i < 32; ++i) { const int kk = 2 * i + (lane >> 5); const GAS float* lr = W + (size_t)(k0 + kk) * N + 6144; float s = 0.f;
#pragma unroll
            for (int r = 0; r < 16; ++r) s += lr[r] * g[r];
            scr[kk * 33 + (lane & 31)] = s; }
    }
    LDS_WAIT(); asm volatile("" ::: "memory");
    const int c = lane & 7;
#pragma unroll
    for (int j = 0; j < 4; ++j) { const int n = (lane >> 3) + 8 * j; const LAS float* s = scr + (8 * c) * 33 + n;
        u32x4 o; o.x = pk2(s[0 * 33], s[1 * 33]); o.y = pk2(s[2 * 33], s[3 * 33]); o.z = pk2(s[4 * 33], s[5 * 33]); o.w = pk2(s[6 * 33], s[7 * 33]);
        *(GAS u32x4*)(WT + (size_t)(n0_dst + n) * K + k0 + 8 * c) = o; }
    LDS_WAIT(); asm volatile("" ::: "memory");
}
__device__ __forceinline__ void rms_row_to_bf16(const GAS float* xrow, const GAS float* w, GAS bf16* orow, int lane) {
    const GAS f32x4* xr = (const GAS f32x4*)xrow + lane; const GAS f32x4* wr = (const GAS f32x4*)w + lane;
    f32x4 v[4]; float s = 0.f;
#pragma unroll
    for (int j = 0; j < 4; ++j) { v[j] = xr[64 * j]; s += (v[j].x * v[j].x + v[j].y * v[j].y) + (v[j].z * v[j].z + v[j].w * v[j].w); }
    const float rstd = frsq(wave_sum(s) * (1.f / DM) + EPS);
    GAS u32x2* o8 = (GAS u32x2*)orow + lane;
#pragma unroll
    for (int j = 0; j < 4; ++j) { const f32x4 g = wr[64 * j]; u32x2 o; o.x = pk2(v[j].x * rstd * g.x, v[j].y * rstd * g.y); o.y = pk2(v[j].z * rstd * g.z, v[j].w * rstd * g.w); o8[64 * j] = o; }
}
__device__ __forceinline__ void sincos_acc(float angf, float& sn, float& cs) {
    const double a = (double)angf; const double k = rint(a * 0.15915494309189535); const double r = a - k * 6.283185307179586476925;
    const double r2 = r * r; double ts = 1.0, tc = 1.0, ss = 1.0, sc = 1.0;
#pragma unroll
    for (int n = 1; n <= 13; ++n) { tc = -tc * r2 / (double)((2 * n - 1) * (2 * n)); ts = -ts * r2 / (double)((2 * n) * (2 * n + 1)); sc += tc; ss += ts; }
    sn = (float)(ss * r); cs = (float)sc;
}

#define MFMA32(a, b, c) __builtin_amdgcn_mfma_f32_32x32x16_bf16((a), (b), (c), 0, 0, 0)
__device__ __forceinline__ int crow(int r, int hi) { return (r & 3) + 8 * (r >> 2) + 4 * hi; }
__device__ __forceinline__ s16x4 tr16(const LAS unsigned char* p) { return __builtin_bit_cast(s16x4, __builtin_amdgcn_ds_read_tr16_b64_v4i16((LAS s16x4*)p)); }
__device__ __forceinline__ bf16x8 cat8(s16x4 lo, s16x4 hi) { return (bf16x8){lo[0], lo[1], lo[2], lo[3], hi[0], hi[1], hi[2], hi[3]}; }
__device__ __forceinline__ u32x4 cvt8(f32x4 a, f32x4 b) { u32x4 w; w.x = pk2(a[0], a[1]); w.y = pk2(a[2], a[3]); w.z = pk2(b[0], b[1]); w.w = pk2(b[2], b[3]); return w; }

__device__ __forceinline__ void glds16(const GAS void* gsrc, unsigned lds_dst) { unsigned keep;
    asm volatile("s_mov_b32 %0, m0\n\ts_mov_b32 m0, %2\n\ts_nop 0\n\tglobal_load_lds_dwordx4 %1, off\n\ts_mov_b32 m0, %0" : "=&s"(keep) : "v"(gsrc), "s"(lds_dst) : "memory"); }
template <int MODE>
__device__ __forceinline__ void attn_unit(LAS unsigned char* lds, const GAS bf16* Q, const GAS bf16* Kb, const GAS bf16* Vb, GAS bf16* O, const GAS float* ck, const GAS float* cv,
                                          int b, int h, int qblk, float lam, float onem, const GAS float* normw) {
    const int tid = opaque_tid(), lane = tid & 63, w = __builtin_amdgcn_readfirstlane(tid >> 6), r32 = lane & 31, hi = lane >> 5;
    const int comp = w & 1, rg = w >> 1, half = w >> 2;
    int NT, my_nt; size_t qrow, orow0;
    if (MODE == 0) { NT = 2 * qblk + 2; my_nt = 2 * qblk + 1 + half; orow0 = (size_t)b * SEQ + qblk * 128 + rg * 32; qrow = orow0 + r32; }
    else { NT = 33; my_nt = (rg == 0) ? 33 : 0; orow0 = (size_t)MP + b * 16; qrow = orow0 + (r32 < 15 ? r32 : 15); }
    bf16x8 qr[4];
    { const GAS bf16* qp = Q + qrow * 1024 + h * 128 + comp * 64 + hi * 8;
#pragma unroll
      for (int s = 0; s < 4; ++s) qr[s] = *(const GAS bf16x8*)(qp + 16 * s); }
    asm volatile("" : "+v"(qr[0]), "+v"(qr[1]), "+v"(qr[2]), "+v"(qr[3]));
    LAS float* wsf = (LAS float*)(lds + 98304) + w * 64;
    f32x16 o[4];
#pragma unroll
    for (int d = 0; d < 4; ++d)
#pragma unroll
        for (int r = 0; r < 16; ++r) o[d][r] = 0.f;
    float mrow = 0.f, lrow = 0.f;
    u32x4 kst[2], vst[2];
    bf16x8 pw[4];
#pragma unroll
    for (int k = 0; k < 4; ++k) pw[k] = (bf16x8){0, 0, 0, 0, 0, 0, 0, 0};
    const int vrow_l = lane >> 2, vpc = lane & 3;
#define ATT_LOAD(t) do { \
        if (MODE == 0) { const size_t kr0 = (size_t)b * SEQ + 64 * (t); \
            _Pragma("unroll") for (int i = 0; i < 2; ++i) { const int p = w + 8 * i; \
                kst[i] = *(const GAS u32x4*)(Kb + (kr0 + lane) * 1024 + h * 128 + p * 8); \
                vst[i] = *(const GAS u32x4*)(Vb + (kr0 + 16 * (p & 3) + vrow_l) * 1024 + h * 128 + 32 * (p >> 2) + 8 * vpc); } } \
        else if ((t) < 32) { const size_t kr0 = (size_t)b * PAST + 64 * (t); \
            _Pragma("unroll") for (int i = 0; i < 2; ++i) { const int p = w + 8 * i; \
                const GAS float* kp = ck + ((kr0 + lane) * 8 + h) * 128 + p * 8; kst[i] = cvt8(*(const GAS f32x4*)kp, *(const GAS f32x4*)(kp + 4)); \
                const GAS float* vp = cv + ((kr0 + 16 * (p & 3) + vrow_l) * 8 + h) * 128 + 32 * (p >> 2) + 8 * vpc; vst[i] = cvt8(*(const GAS f32x4*)vp, *(const GAS f32x4*)(vp + 4)); } } \
        else { const size_t kr0 = (size_t)MP + b * 16; \
            _Pragma("unroll") for (int i = 0; i < 2; ++i) { const int p = w + 8 * i; const int vr = 16 * (p & 3) + vrow_l; \
                kst[i] = (lane < 16) ? *(const GAS u32x4*)(Kb + (kr0 + lane) * 1024 + h * 128 + p * 8) : (u32x4){0u, 0u, 0u, 0u}; \
                vst[i] = (vr < 16) ? *(const GAS u32x4*)(Vb + (kr0 + vr) * 1024 + h * 128 + 32 * (p >> 2) + 8 * vpc) : (u32x4){0u, 0u, 0u, 0u}; } } \
    } while (0)
#define ATT_STORE(bufo) do { _Pragma("unroll") for (int i = 0; i < 2; ++i) { const int p = w + 8 * i; \
        *(LAS u32x4*)(lds + (bufo) + p * 1024 + lane * 16) = kst[i]; *(LAS u32x4*)(lds + (bufo) + 16384 + p * 1024 + lane * 16) = vst[i]; } } while (0)
#define ATT_X(t, bo) do { \
        f32x16 p0, p1; \
        _Pragma("unroll") for (int r = 0; r < 16; ++r) { p0[r] = 0.f; p1[r] = 0.f; } \
        const LAS unsigned char* kb_ = lds + (bo) + kfo; \
        _Pragma("unroll") for (int s = 0; s < 4; ++s) { const bf16x8 a0 = *(const LAS bf16x8*)(kb_ + s * 2048), a1 = *(const LAS bf16x8*)(kb_ + s * 2048 + 512); \
            p0 = MFMA32(a0, qr[s], p0); p1 = MFMA32(a1, qr[s], p1); } \
        if (MODE == 1 && (t) == 32) { _Pragma("unroll") for (int r = 0; r < 16; ++r) { if (r >= 8) p0[r] = -INFINITY; p1[r] = -INFINITY; } } \
        float mx = fmaxf(p0[0], p1[0]); \
        _Pragma("unroll") for (int r = 1; r < 16; ++r) mx = fmaxf(mx, fmaxf(p0[r], p1[r])); \
        mx = max32x(mx); \
        if ((t) == 0) mrow = mx; \
        else if (__any(mx > mrow + 8.f)) { \
            const float mn = fmaxf(mrow, mx); const float f = __builtin_amdgcn_exp2f(mrow - mn); lrow *= f; mrow = mn; \
            if (hi == 0) wsf[r32] = f; \
            LDS_WAIT(); \
            _Pragma("unroll") for (int r = 0; r < 16; ++r) { const float fr_ = wsf[crow(r, hi)]; \
                _Pragma("unroll") for (int d = 0; d < 4; ++d) o[d][r] *= fr_; } } \
        float ls = 0.f; \
        _Pragma("unroll") for (int r = 0; r < 16; ++r) { p0[r] = __builtin_amdgcn_exp2f(p0[r] - mrow); p1[r] = __builtin_amdgcn_exp2f(p1[r] - mrow); ls += p0[r] + p1[r]; } \
        lrow += ls; \
        { u32x4 x; \
          x.x = pk2(p0[0], p0[1]); x.y = pk2(p0[2], p0[3]); x.z = pk2(p0[4], p0[5]); x.w = pk2(p0[6], p0[7]); pw[0] = __builtin_bit_cast(bf16x8, x); \
          x.x = pk2(p0[8], p0[9]); x.y = pk2(p0[10], p0[11]); x.z = pk2(p0[12], p0[13]); x.w = pk2(p0[14], p0[15]); pw[1] = __builtin_bit_cast(bf16x8, x); \
          x.x = pk2(p1[0], p1[1]); x.y = pk2(p1[2], p1[3]); x.z = pk2(p1[4], p1[5]); x.w = pk2(p1[6], p1[7]); pw[2] = __builtin_bit_cast(bf16x8, x); \
          x.x = pk2(p1[8], p1[9]); x.y = pk2(p1[10], p1[11]); x.z = pk2(p1[12], p1[13]); x.w = pk2(p1[14], p1[15]); pw[3] = __builtin_bit_cast(bf16x8, x); } \
    } while (0)
#define ATT_Y(bo) do { const LAS unsigned char* vb_ = lds + (bo) + vfo; \
        _Pragma("unroll") for (int d = 0; d < 4; ++d) { \
            _Pragma("unroll") for (int ks = 0; ks < 4; ++ks) { const s16x4 lo_ = tr16(vb_ + d * 4096 + ks * 1024), hh_ = tr16(vb_ + d * 4096 + ks * 1024 + 512); \
                o[d] = MFMA32(pw[ks], cat8(lo_, hh_), o[d]); } \
            __builtin_amdgcn_sched_barrier(0); } } while (0)
#define ATT_DMA(t, bufo) do { const size_t kr0 = (size_t)b * SEQ + 64 * (t); \
        _Pragma("unroll") for (int i = 0; i < 2; ++i) { const int p = w + 8 * i; \
            glds16(Kb + (kr0 + lane) * 1024 + h * 128 + p * 8, (unsigned)__builtin_amdgcn_readfirstlane((int)(lds0 + (bufo) + p * 1024))); \
            glds16(Vb + (kr0 + 16 * (p & 3) + vrow_l) * 1024 + h * 128 + 32 * (p >> 2) + 8 * vpc, (unsigned)__builtin_amdgcn_readfirstlane((int)(lds0 + (bufo) + 16384 + p * 1024))); } } while (0)
    const unsigned lds0 = (unsigned)(size_t)lds;
    if (MODE == 0) { ATT_DMA(0, 0); VM_WAIT(); } else { ATT_LOAD(0); ATT_STORE(0); }
    __syncthreads();
    const int kfo = (8 * comp + hi) * 1024 + r32 * 16;
    const int vfo = 16384 + ((lane >> 4) & 1) * 32 + (lane & 3) * 8 + (4 * hi + ((lane & 15) >> 2)) * 64;
    int b_prev = 0, b_cur = 0, b_next = 32768;
    const int NI = (MODE == 0) ? NT + 1 : NT;
    for (int i = 0; i < NI; ++i) {
        if (i + 1 < NT) { if (MODE == 0) { ATT_DMA(i + 1, b_next); } else { ATT_LOAD(i + 1); } }
        if (half == 0) { if (i < my_nt) { ATT_X(i, b_cur); ATT_Y(b_cur); } }
        else if (MODE == 0) { if (i >= 1) ATT_Y(b_prev); if (i < NT) ATT_X(i, b_cur); }
        if (MODE == 1 && i + 1 < NT) ATT_STORE(b_next);
        if (MODE == 0) VM_WAIT();
        __syncthreads();
        b_prev = b_cur; b_cur = b_next; b_next = (b_next == 65536) ? 0 : b_next + 32768;
    }
#undef ATT_LOAD
#undef ATT_STORE
#undef ATT_DMA
#undef ATT_X
#undef ATT_Y
    const bool active = (MODE == 0) || (rg == 0);
    if (active) {
        const float lt = sum32x(lrow);
        if (hi == 0) wsf[32 + r32] = lt;
        LDS_WAIT();
#pragma unroll
        for (int r = 0; r < 16; ++r) { const float il = frcp(wsf[32 + crow(r, hi)]);
#pragma unroll
            for (int d = 0; d < 4; ++d) o[d][r] *= il; }
    }
    LAS float* X = (LAS float*)lds;
    if (active && comp == 1) {
#pragma unroll
        for (int d = 0; d < 4; ++d)
#pragma unroll
            for (int r = 0; r < 16; ++r) X[((rg * 4 + d) * 16 + r) * 64 + lane] = o[d][r];
    }
    __syncthreads();
    if (active && comp == 0) {
        float nw[4];
#pragma unroll
        for (int d = 0; d < 4; ++d) nw[d] = normw[32 * d + r32];
#pragma unroll
        for (int r = 0; r < 16; ++r) {
            float ss = 0.f;
#pragma unroll
            for (int d = 0; d < 4; ++d) { const float x = o[d][r] - lam * X[((rg * 4 + d) * 16 + r) * 64 + lane]; o[d][r] = x; ss += x * x; }
            ss = half_sum(ss);
            const float rs = onem * frsq(ss * (1.0f / 128.0f) + EPS);
            const int rr = crow(r, hi);
            if (MODE == 0 || rr < 16) {
                GAS bf16* op = O + (orow0 + rr) * 1024 + h * 128 + r32;
#pragma unroll
                for (int d = 0; d < 4; ++d) op[32 * d] = f2bf(o[d][r] * rs * nw[d]);
            }
        }
    }
    __syncthreads();
}

constexpr int ATT_WSF = 131072 + 1024;
#define ASBAR() __builtin_amdgcn_sched_barrier(0)
#define APIN(x) asm volatile("" : "+v"(x))
__device__ __forceinline__ float max3f(float a, float b, float c) { float r; asm("v_max3_f32 %0, %1, %2, %3" : "=v"(r) : "v"(a), "v"(b), "v"(c)); return r; }
__device__ __forceinline__ void attn_prompt_unit(LAS unsigned char* lds, const GAS bf16* Q, const GAS bf16* Kb, const GAS bf16* Vb, GAS bf16* O,
                                                 int b, int h, int qblk, float lam, float onem, const GAS float* normw) {
    const int tid = opaque_tid(), lane = tid & 63, w = __builtin_amdgcn_readfirstlane(tid >> 6), r32 = lane & 31, hi = lane >> 5;
    const int comp = w & 1, rg = w >> 1, half = w >> 2;
    const int NT = 2 * qblk + 2, my_nt = NT - 1 + half;
    const size_t orow0 = (size_t)b * SEQ + qblk * 128 + rg * 32;
    bf16x8 qr[4];
    { const GAS bf16* qp = Q + (orow0 + r32) * 1024 + h * 128 + comp * 64 + hi * 8;
#pragma unroll
      for (int s = 0; s < 4; ++s) qr[s] = *(const GAS bf16x8*)(qp + 16 * s); }
    asm volatile("" : "+v"(qr[0]), "+v"(qr[1]), "+v"(qr[2]), "+v"(qr[3]));
    LAS float* wsf = (LAS float*)(lds + ATT_WSF) + w * 64;
    f32x16 o[4];
#pragma unroll
    for (int d = 0; d < 4; ++d)
#pragma unroll
        for (int r = 0; r < 16; ++r) o[d][r] = 0.f;
    float mrow = 0.f, lrow = 0.f;
    f32x16 pA0, pA1, pB0, pB1;
    const f32x16 zero16 = {0.f, 0.f, 0.f, 0.f, 0.f, 0.f, 0.f, 0.f, 0.f, 0.f, 0.f, 0.f, 0.f, 0.f, 0.f, 0.f};
    const unsigned lds0 = (unsigned)(size_t)lds;
    const int vrow_l = lane >> 2, vpc = lane & 3;
    const int kfo = (8 * comp + hi) * 1024 + r32 * 16;
    const int vfo = 16384 + ((lane >> 4) & 1) * 32 + (lane & 3) * 8 + (4 * hi + ((lane & 15) >> 2)) * 64;
    const GAS bf16* kg = Kb + ((size_t)b * SEQ + lane) * 1024 + h * 128 + w * 8;
    const GAS bf16* vg = Vb + ((size_t)b * SEQ + 16 * (w & 3) + vrow_l) * 1024 + h * 128 + 32 * (w >> 2) + 8 * vpc;
#define PA_DMA(t) do { const int so_ = ((t) & 3) * 32768; const size_t to_ = (size_t)(t) * 65536; \
        glds16(kg + to_, (unsigned)__builtin_amdgcn_readfirstlane((int)(lds0 + so_ + w * 1024))); \
        glds16(kg + to_ + 64, (unsigned)__builtin_amdgcn_readfirstlane((int)(lds0 + so_ + (w + 8) * 1024))); \
        glds16(vg + to_, (unsigned)__builtin_amdgcn_readfirstlane((int)(lds0 + so_ + 16384 + w * 1024))); \
        glds16(vg + to_ + 64, (unsigned)__builtin_amdgcn_readfirstlane((int)(lds0 + so_ + 16384 + (w + 8) * 1024))); } while (0)
#define PA_KF(so, j) (*(const LAS bf16x8*)(lds + (so) + kfo + ((j) >> 1) * 2048 + ((j) & 1) * 512))
#define PA_VF(so, g) cat8(tr16(lds + (so) + vfo + ((g) >> 2) * 4096 + ((g) & 3) * 1024), tr16(lds + (so) + vfo + ((g) >> 2) * 4096 + ((g) & 3) * 1024 + 512))
#define PA_SEL(P0, P1, e) (((e) < 16) ? P0[(e) & 15] : P1[(e) & 15])
#define PA_WAITBAR(n) asm volatile("s_waitcnt vmcnt(" #n ") lgkmcnt(0)\n\ts_barrier" ::: "memory")
#define PA_KFJ(so, j) PA_KF(so, ((j) < 4 ? 2 * (j) : 2 * ((j) - 4) + 1))
#define PA_STEP(C0, C1, P0, P1, kso, vso, MASKED, FIRST) do { \
        bf16x8 kf_[8]; bf16x8 vf_[16]; u32x4 pk_[4]; bool resc_ = false; \
        kf_[0] = PA_KFJ(kso, 0); kf_[1] = PA_KFJ(kso, 1); kf_[2] = PA_KFJ(kso, 2); ASBAR(); \
        float sacc_ = P0[0] + P0[1]; float ma_ = 0.f; \
        _Pragma("unroll") for (int j = 0; j < 8; ++j) { \
            if (j + 3 < 8) kf_[j + 3] = PA_KFJ(kso, j + 3); else vf_[j - 5] = PA_VF(vso, j - 5); \
            if (j == 0) C0 = MFMA32(kf_[0], qr[0], negm); else if (j < 4) C0 = MFMA32(kf_[j], qr[j], C0); \
            else if (j == 4) C1 = MFMA32(kf_[4], qr[0], negm); else C1 = MFMA32(kf_[j], qr[j - 4], C1); \
            sacc_ += PA_SEL(P0, P1, 2 + 4 * j); sacc_ += PA_SEL(P0, P1, 3 + 4 * j); \
            if (j < 7) { sacc_ += PA_SEL(P0, P1, 4 + 4 * j); sacc_ += PA_SEL(P0, P1, 5 + 4 * j); } \
            APIN(sacc_); \
            pk_[j >> 1][(j & 1) * 2] = pk2(PA_SEL(P0, P1, 4 * j), PA_SEL(P0, P1, 4 * j + 1)); pk_[j >> 1][(j & 1) * 2 + 1] = pk2(PA_SEL(P0, P1, 4 * j + 2), PA_SEL(P0, P1, 4 * j + 3)); \
            APIN(pk_[j >> 1]); \
            if (j == 4) { ma_ = max3f(C0[0], C0[1], C0[2]); ma_ = max3f(ma_, C0[3], C0[4]); APIN(ma_); } \
            if (j == 5) { ma_ = max3f(ma_, C0[5], C0[6]); ma_ = max3f(ma_, C0[7], C0[8]); APIN(ma_); } \
            if (j == 6) { ma_ = max3f(ma_, C0[9], C0[10]); ma_ = max3f(ma_, C0[11], C0[12]); APIN(ma_); } \
            if (j == 7) { ma_ = max3f(ma_, C0[13], C0[14]); ma_ = fmaxf(ma_, C0[15]); APIN(ma_); } \
            ASBAR(); } \
        lrow += sacc_; \
        if (MASKED) { _Pragma("unroll") for (int r = 0; r < 16; ++r) { C0[r] = -1.0e30f; C1[r] = -1.0e30f; } ma_ = -1.0e30f; } \
        { float b_ = max3f(C1[0], C1[1], C1[2]); ma_ = max3f(ma_, C1[3], C1[4]); \
          _Pragma("unroll") for (int r = 5; r < 13; r += 4) { b_ = max3f(b_, C1[r], C1[r + 1]); ma_ = max3f(ma_, C1[r + 2], C1[r + 3]); } \
          b_ = max3f(b_, C1[13], C1[14]); ma_ = fmaxf(ma_, C1[15]); \
          const float mx_ = max32x(fmaxf(ma_, b_)); \
          if (__builtin_expect((FIRST) || __any(mx_ > 8.f), 0)) { const float dl_ = (FIRST) ? mx_ : fmaxf(mx_, 0.f); mrow += dl_; \
              _Pragma("unroll") for (int r = 0; r < 16; ++r) { C0[r] -= dl_; C1[r] -= dl_; negm[r] = -mrow; } \
              const float f_ = (FIRST) ? 0.f : __builtin_amdgcn_exp2f(-dl_); lrow *= f_; if (hi == 0) wsf[r32] = f_; resc_ = true; } } \
        ASBAR(); \
        _Pragma("unroll") for (int g = 0; g < 16; ++g) { \
            if (g + 3 < 16) vf_[g + 3] = PA_VF(vso, g + 3); \
            o[g >> 2] = MFMA32(__builtin_bit_cast(bf16x8, pk_[g & 3]), vf_[g], o[g >> 2]); \
            if (g < 8) { C0[2 * g] = __builtin_amdgcn_exp2f(C0[2 * g]); C0[2 * g + 1] = __builtin_amdgcn_exp2f(C0[2 * g + 1]); APIN(C0); } \
            else { C1[2 * g - 16] = __builtin_amdgcn_exp2f(C1[2 * g - 16]); C1[2 * g - 15] = __builtin_amdgcn_exp2f(C1[2 * g - 15]); APIN(C1); } \
            ASBAR(); } \
        if (resc_) { LDS_WAIT(); \
            _Pragma("unroll") for (int r = 0; r < 16; ++r) { const float fr_ = wsf[crow(r, hi)]; \
                _Pragma("unroll") for (int d = 0; d < 4; ++d) o[d][r] *= fr_; } } \
    } while (0)
#define PA_DRAIN(P0, P1, vso) do { float sacc_ = 0.f; \
        _Pragma("unroll") for (int r = 0; r < 16; ++r) sacc_ += P0[r] + P1[r]; \
        lrow += sacc_; u32x4 pk_[4]; \
        _Pragma("unroll") for (int k = 0; k < 4; ++k) { pk_[k][0] = pk2(PA_SEL(P0, P1, 8 * k), PA_SEL(P0, P1, 8 * k + 1)); pk_[k][1] = pk2(PA_SEL(P0, P1, 8 * k + 2), PA_SEL(P0, P1, 8 * k + 3)); \
            pk_[k][2] = pk2(PA_SEL(P0, P1, 8 * k + 4), PA_SEL(P0, P1, 8 * k + 5)); pk_[k][3] = pk2(PA_SEL(P0, P1, 8 * k + 6), PA_SEL(P0, P1, 8 * k + 7)); } \
        _Pragma("unroll") for (int g = 0; g < 16; ++g) o[g >> 2] = MFMA32(__builtin_bit_cast(bf16x8, pk_[g & 3]), PA_VF(vso, g), o[g >> 2]); } while (0)
#pragma unroll
    for (int r = 0; r < 16; ++r) { pB0[r] = 0.f; pB1[r] = 0.f; }
    mrow = 0.f;
    f32x16 negm = zero16; asm volatile("" : "+v"(negm));
    PA_DMA(0); PA_DMA(1); PA_WAITBAR(4);
    for (int i = 0; i < NT; i += 2) {
        if (i + 2 < NT) PA_DMA(i + 2);
        PA_STEP(pA0, pA1, pB0, pB1, (i & 3) * 32768, ((i == 0 ? 0 : i - 1) & 3) * 32768, false, (i == 0));
        if (i + 2 < NT) PA_WAITBAR(4); else PA_WAITBAR(0);
        if (i + 3 < NT) PA_DMA(i + 3);
        PA_STEP(pB0, pB1, pA0, pA1, ((i + 1) & 3) * 32768, (i & 3) * 32768, (half == 0 && i + 2 == NT), false);
        if (i + 3 < NT) PA_WAITBAR(4); else PA_WAITBAR(0);
    }
    PA_DRAIN(pB0, pB1, ((NT - 1) & 3) * 32768);
    __syncthreads();
#undef PA_DMA
#undef PA_KF
#undef PA_KFJ
#undef PA_VF
#undef PA_SEL
#undef PA_WAITBAR
#undef PA_STEP
#undef PA_DRAIN
    {
        const float lt = sum32x(lrow);
        if (hi == 0) wsf[32 + r32] = lt;
        LDS_WAIT();
#pragma unroll
        for (int r = 0; r < 16; ++r) { const float il = frcp(wsf[32 + crow(r, hi)]);
#pragma unroll
            for (int d = 0; d < 4; ++d) o[d][r] *= il; }
    }
    LAS float* X = (LAS float*)lds;
    if (comp == 1) {
#pragma unroll
        for (int d = 0; d < 4; ++d)
#pragma unroll
            for (int r = 0; r < 16; ++r) X[((rg * 4 + d) * 16 + r) * 64 + lane] = o[d][r];
    }
    __syncthreads();
    if (comp == 0) {
        float nw[4];
#pragma unroll
        for (int d = 0; d < 4; ++d) nw[d] = normw[32 * d + r32];
#pragma unroll
        for (int r = 0; r < 16; ++r) {
            float ss = 0.f;
#pragma unroll
            for (int d = 0; d < 4; ++d) { const float x = o[d][r] - lam * X[((rg * 4 + d) * 16 + r) * 64 + lane]; o[d][r] = x; ss += x * x; }
            ss = half_sum(ss);
            const float rs = onem * frsq(ss * (1.0f / 128.0f) + EPS);
            GAS bf16* op = O + (orow0 + crow(r, hi)) * 1024 + h * 128 + r32;
#pragma unroll
            for (int d = 0; d < 4; ++d) op[32 * d] = f2bf(o[d][r] * rs * nw[d]);
        }
    }
    __syncthreads();
}

constexpr int G_QET = 0, G_KET = 24576, G_KDT = 49152, G_VIM = 67584, G_AM = 100352, G_TOT = 109568, G_DV = 113664, G_SSQ = 114176, G_END = 116224;
static_assert(G_END <= RING_BYTES, "gla lds");
struct GlaP { const GAS bf16* QG; const GAS bf16* KG; const GAS bf16* VG; const GAS bf16* GK; const GAS bf16* RG; const GAS bf16* GA; const GAS bf16* GB; const GAS bf16* OA; GAS bf16* MG; const GAS float* gnw; };

template <bool FULL, int MODE>
__device__ __forceinline__ void gla_run(LAS unsigned char* lds, const GlaP& P, size_t m0, int h, int nch, f32x16 (&S)[4], float& dsum0, float& dsum1) {
    const int tid = opaque_tid(), lane = tid & 63, w = __builtin_amdgcn_readfirstlane(tid >> 6), r32 = lane & 31, hi = lane >> 5;
    const int trq = ((lane >> 4) & 1) * 32 + (lane & 3) * 8, q4 = (lane & 15) >> 2;
    unsigned gq[8], qv[8], kv[8]; u32x4 vpre[4];
    unsigned lo_g = (unsigned)((8 * w) * 1024 + 4 * lane), lo_v = (unsigned)((lane >> 2) * 2048 + w * 64 + (lane & 3) * 16);
#define GLA_LOADS(chn) do { const size_t mcn = m0 + (size_t)(chn) * 64; asm volatile("" : "+v"(lo_g), "+v"(lo_v)); \
        const GAS char* gkb = (const GAS char*)(P.GK + mcn * 512 + h * 128); const GAS char* qgb = (const GAS char*)(P.QG + mcn * 512 + h * 128); const GAS char* kgb = (const GAS char*)(P.KG + mcn * 512 + h * 128); \
        const GAS char* vgb = (const GAS char*)(P.VG + mcn * 1024 + h * 256); \
        _Pragma("unroll") for (int i = 0; i < 8; ++i) { const bool valid = (MODE == 0) || (8 * w + i < 16); \
            gq[i] = valid ? *(const GAS unsigned*)(gkb + i * 1024 + lo_g) : 0u; if (FULL) qv[i] = valid ? *(const GAS unsigned*)(qgb + i * 1024 + lo_g) : 0u; kv[i] = valid ? *(const GAS unsigned*)(kgb + i * 1024 + lo_g) : 0u; } \
        _Pragma("unroll") for (int i = 0; i < 4; ++i) { const int s = (lane >> 2) + 16 * i; const bool valid = (MODE == 0) || (s < 16); \
            vpre[i] = valid ? *(const GAS u32x4*)(vgb + i * 32768 + lo_v) : (u32x4){0u, 0u, 0u, 0u}; } } while (0)
    GLA_LOADS(0);
    for (int ch = 0; ch < nch; ++ch) {
        const size_t mc = m0 + (size_t)ch * 64;
        {
            float b0[8], b1[8];
#pragma unroll
            for (int i = 0; i < 8; ++i) { b0[i] = bflo(gq[i]); b1[i] = bfhi(gq[i]); }
#pragma unroll
            for (int i = 1; i < 8; ++i) { b0[i] += b0[i - 1]; b1[i] += b1[i - 1]; }
            LAS float* TOT = (LAS float*)(lds + G_TOT);
            *(LAS f32x2*)(TOT + w * 128 + 2 * lane) = (f32x2){b0[7], b1[7]};
            __syncthreads();
            float p0 = 0.f, p1 = 0.f, t0 = 0.f, t1 = 0.f;
#pragma unroll
            for (int ww = 0; ww < 8; ++ww) { const f32x2 tv = *(const LAS f32x2*)(TOT + ww * 128 + 2 * lane); if (ww < w) { p0 += tv.x; p1 += tv.y; } t0 += tv.x; t1 += tv.y; }
            u32x4 qe0, qe1, ke0, ke1, kd0, kd1;
#pragma unroll
            for (int i = 0; i < 8; i += 2) {
                float v[12];
#pragma unroll
                for (int j = 0; j < 2; ++j) {
                    const float ba = b0[i + j] + p0, bb = b1[i + j] + p1;
                    const float ka = bflo(kv[i + j]), kb_ = bfhi(kv[i + j]);
                    v[8 + j] = ka * __expf(t0 - ba); v[10 + j] = kb_ * __expf(t1 - bb);
                    if (FULL) { const float qa = bflo(qv[i + j]), qb = bfhi(qv[i + j]);
                        v[j] = qa * __expf(ba); v[2 + j] = qb * __expf(bb); v[4 + j] = ka * __expf(-ba); v[6 + j] = kb_ * __expf(-bb); }
                }
                if (FULL) { qe0[i >> 1] = pk2(v[0], v[1]); qe1[i >> 1] = pk2(v[2], v[3]); ke0[i >> 1] = pk2(v[4], v[5]); ke1[i >> 1] = pk2(v[6], v[7]); }
                kd0[i >> 1] = pk2(v[8], v[9]); kd1[i >> 1] = pk2(v[10], v[11]);
            }
            const int c0 = 2 * lane;
            if (FULL) {
                *(LAS u32x4*)(lds + G_QET + c0 * 192 + w * 16) = qe0; *(LAS u32x4*)(lds + G_QET + (c0 + 1) * 192 + w * 16) = qe1;
                *(LAS u32x4*)(lds + G_KET + c0 * 192 + w * 16) = ke0; *(LAS u32x4*)(lds + G_KET + (c0 + 1) * 192 + w * 16) = ke1;
            }
            *(LAS u32x4*)(lds + G_KDT + c0 * 144 + w * 16) = kd0; *(LAS u32x4*)(lds + G_KDT + (c0 + 1) * 144 + w * 16) = kd1;
            if (w == 0) { *(LAS f32x2*)((LAS float*)(lds + G_DV) + c0) = (f32x2){__expf(t0), __expf(t1)}; }
            dsum0 += t0; dsum1 += t1;
#pragma unroll
            for (int i = 0; i < 4; ++i) { const int s = (lane >> 2) + 16 * i; *(LAS u32x4*)(lds + G_VIM + w * 4096 + s * 64 + (lane & 3) * 16) = vpre[i]; }
            if (ch + 1 < nch) GLA_LOADS(ch + 1);
        }
        asm volatile("s_waitcnt lgkmcnt(0)\n\ts_barrier" ::: "memory");
        f32x16 o[2];
        if (FULL) {
            if (w < 3) {
                const int tb = (w + 1) >> 1, sb = w >> 1;
                f32x16 c;
#pragma unroll
                for (int r = 0; r < 16; ++r) c[r] = 0.f;
                const int tro = trq + (8 * hi + q4) * 192;
#pragma unroll
                for (int ks = 0; ks < 8; ++ks) {
                    const LAS unsigned char* ap = lds + G_KET + tro + ks * 16 * 192 + sb * 64; const LAS unsigned char* bp = lds + G_QET + tro + ks * 16 * 192 + tb * 64;
                    c = MFMA32(cat8(tr16(ap), tr16(ap + 4 * 192)), cat8(tr16(bp), tr16(bp + 4 * 192)), c);
                }
                const int t = 32 * tb + r32;
#pragma unroll
                for (int g = 0; g < 4; ++g) { const int s0 = 32 * sb + 8 * g + 4 * hi; float x[4];
#pragma unroll
                    for (int e = 0; e < 4; ++e) x[e] = (s0 + e <= t) ? c[4 * g + e] : 0.f;
                    *(LAS u32x2*)(lds + G_AM + t * 144 + s0 * 2) = (u32x2){pk2(x[0], x[1]), pk2(x[2], x[3])}; }
            } else if (w == 3) {
#pragma unroll
                for (int g = 0; g < 4; ++g) *(LAS u32x2*)(lds + G_AM + r32 * 144 + (32 + 8 * g + 4 * hi) * 2) = (u32x2){0u, 0u};
            }
            asm volatile("s_waitcnt lgkmcnt(0)\n\ts_barrier" ::: "memory");
        }
        bf16x8 vf[4];
        { const LAS unsigned char* vp = lds + G_VIM + w * 4096 + trq + (8 * hi + q4) * 64;
#pragma unroll
          for (int ss = 0; ss < 4; ++ss) vf[ss] = cat8(tr16(vp + ss * 1024), tr16(vp + ss * 1024 + 256)); }
        if (FULL) {
#pragma unroll
            for (int tb = 0; tb < 2; ++tb)
#pragma unroll
                for (int r = 0; r < 16; ++r) o[tb][r] = 0.f;
            const int trk = trq + (4 * hi + q4) * 192;
#pragma unroll
            for (int kb = 0; kb < 4; ++kb)
#pragma unroll
                for (int s2 = 0; s2 < 2; ++s2) {
                    u32x4 x; x.x = pk2(S[kb][8 * s2 + 0], S[kb][8 * s2 + 1]); x.y = pk2(S[kb][8 * s2 + 2], S[kb][8 * s2 + 3]); x.z = pk2(S[kb][8 * s2 + 4], S[kb][8 * s2 + 5]); x.w = pk2(S[kb][8 * s2 + 6], S[kb][8 * s2 + 7]);
                    const bf16x8 bS = __builtin_bit_cast(bf16x8, x);
#pragma unroll
                    for (int tb = 0; tb < 2; ++tb) { const LAS unsigned char* ap = lds + G_QET + trk + (32 * kb + 16 * s2) * 192 + tb * 64;
                        o[tb] = MFMA32(cat8(tr16(ap), tr16(ap + 8 * 192)), bS, o[tb]); }
                }
#pragma unroll
            for (int ss = 0; ss < 4; ++ss)
#pragma unroll
                for (int tb = 0; tb < 2; ++tb) { const bf16x8 a = *(const LAS bf16x8*)(lds + G_AM + (32 * tb + r32) * 144 + (16 * ss + 8 * hi) * 2);
                    o[tb] = MFMA32(a, vf[ss], o[tb]); }
        }
#pragma unroll
        for (int kb = 0; kb < 4; ++kb) {
#pragma unroll
            for (int g = 0; g < 4; ++g) { const f32x4 d4 = *(const LAS f32x4*)((LAS float*)(lds + G_DV) + 32 * kb + 8 * g + 4 * hi);
#pragma unroll
                for (int e = 0; e < 4; ++e) S[kb][4 * g + e] *= d4[e]; }
#pragma unroll
            for (int ss = 0; ss < 4; ++ss) { const bf16x8 a = *(const LAS bf16x8*)(lds + G_KDT + (32 * kb + r32) * 144 + (16 * ss + 8 * hi) * 2);
                S[kb] = MFMA32(a, vf[ss], S[kb]); }
        }
        if (FULL) {
            asm volatile("s_waitcnt lgkmcnt(0)\n\ts_barrier" ::: "memory");
            LAS float* OST = (LAS float*)lds;
#pragma unroll
            for (int tb = 0; tb < 2; ++tb)
#pragma unroll
                for (int r = 0; r < 16; ++r) OST[(32 * tb + crow(r, hi)) * 256 + 32 * w + r32] = o[tb][r];
            u32x4 erg[2], ega[2], egb[2], eoa[2];
            unsigned lo_e = (unsigned)((((MODE == 0) ? (tid >> 5) : ((tid >> 5) & 15)) * 1024 + 8 * (tid & 31)) * 2);
#define GLA_ELOADS(i0) do { asm volatile("" : "+v"(lo_e)); _Pragma("unroll") for (int i = 0; i < 2; ++i) { \
                const size_t ub = ((mc + ((MODE == 0) ? 16 * ((i0) + i) : 0)) * 1024 + h * 256) * 2; \
                erg[i] = *(const GAS u32x4*)((const GAS char*)P.RG + ub + lo_e); ega[i] = *(const GAS u32x4*)((const GAS char*)P.GA + ub + lo_e); \
                egb[i] = *(const GAS u32x4*)((const GAS char*)P.GB + ub + lo_e); eoa[i] = *(const GAS u32x4*)((const GAS char*)P.OA + ub + lo_e); } } while (0)
            GLA_ELOADS(0);
            asm volatile("s_waitcnt lgkmcnt(0)\n\ts_barrier" ::: "memory");
#pragma unroll
            for (int i0 = 0; i0 < 4; i0 += 2) {
#pragma unroll
              for (int i = 0; i < 2; ++i) {
                const int idx = tid + 512 * (i0 + i), t = idx >> 5, c8 = idx & 31;
                const f32x4 oa4 = *(const LAS f32x4*)(OST + t * 256 + 8 * c8), ob4 = *(const LAS f32x4*)(OST + t * 256 + 8 * c8 + 4);
                float ssq = (oa4.x * oa4.x + oa4.y * oa4.y) + (oa4.z * oa4.z + oa4.w * oa4.w) + (ob4.x * ob4.x + ob4.y * ob4.y) + (ob4.z * ob4.z + ob4.w * ob4.w);
                ssq = half_sum(ssq);
                const float rstd = frsq(ssq * (1.0f / 256.0f) + EPS);
                if (MODE == 0 || t < 16) {
                    const size_t off = (mc + t) * 1024 + h * 256 + 8 * c8;
                    const f32x4 gw0 = *(const GAS f32x4*)(P.gnw + 8 * c8), gw1 = *(const GAS f32x4*)(P.gnw + 8 * c8 + 4);
                    float ov[8] = {oa4.x, oa4.y, oa4.z, oa4.w, ob4.x, ob4.y, ob4.z, ob4.w}; float gwv[8] = {gw0.x, gw0.y, gw0.z, gw0.w, gw1.x, gw1.y, gw1.z, gw1.w};
                    float res[8];
#pragma unroll
                    for (int e = 0; e < 8; ++e) {
                        const unsigned ru = erg[i][e >> 1], gau = ega[i][e >> 1], gbu = egb[i][e >> 1], oau = eoa[i][e >> 1];
                        const float rv = (e & 1) ? bfhi(ru) : bflo(ru), gav = (e & 1) ? bfhi(gau) : bflo(gau), gbv = (e & 1) ? bfhi(gbu) : bflo(gbu), oav = (e & 1) ? bfhi(oau) : bflo(oau);
                        const float og = ov[e] * rstd * gwv[e] * (rv * sigmoidf_(rv));
                        res[e] = sigmoidf_(gav) * oav + sigmoidf_(gbv) * og;
                    }
                    u32x4 mo; mo.x = pk2(res[0], res[1]); mo.y = pk2(res[2], res[3]); mo.z = pk2(res[4], res[5]); mo.w = pk2(res[6], res[7]);
                    *(GAS u32x4*)(P.MG + off) = mo;
                }
              }
              if (i0 == 0) { asm volatile("" ::: "memory"); GLA_ELOADS(2); }
            }
#undef GLA_ELOADS
        }
        asm volatile("s_waitcnt lgkmcnt(0)\n\ts_barrier" ::: "memory");
    }
#undef GLA_LOADS
}
__device__ __forceinline__ void gla_store_state(GAS float* p, const f32x16 (&S)[4], int w, int r32, int hi) {
    unsigned off = (unsigned)(4 * hi * 256 + 32 * w + r32);
#pragma unroll
    for (int kb = 0; kb < 4; ++kb)
#pragma unroll
        for (int g4 = 0; g4 < 4; ++g4) {
#pragma unroll
            for (int e = 0; e < 4; ++e) p[off + e * 256] = S[kb][4 * g4 + e];
            off += 8 * 256; asm volatile("" : "+v"(off)); }
}
__device__ __forceinline__ void gla_load_state(const GAS float* p, f32x16 (&S)[4], int w, int r32, int hi) {
    unsigned off = (unsigned)(4 * hi * 256 + 32 * w + r32);
#pragma unroll
    for (int kb = 0; kb < 4; ++kb)
#pragma unroll
        for (int g4 = 0; g4 < 4; ++g4) {
#pragma unroll
            for (int e = 0; e < 4; ++e) S[kb][4 * g4 + e] = p[off + e * 256];
            off += 8 * 256; asm volatile("" : "+v"(off)); }
}

template <int XIN, int XOUT>
__device__ __forceinline__ void rowpass(const GAS bf16* tmp, const GAS float* part, int nks, const GAS float* xin_p, const GAS float* xin_s, const GAS bf16* rs_in, GAS float* xout, GAS bf16* rs_out,
                                        const GAS float* wpost, const GAS float* wnext, GAS bf16* xn, int gw, int ngw, int lane) {
    f32x4 gp[4], gn[4];
#pragma unroll
    for (int j = 0; j < 4; ++j) { gp[j] = *((const GAS f32x4*)wpost + lane + 64 * j); gn[j] = xn ? *((const GAS f32x4*)wnext + lane + 64 * j) : (f32x4){0.f, 0.f, 0.f, 0.f}; }
    u32x2 tq[4], tq_n[4]; f32x4 xq[4], xq_n[4]; u32x2 xb[4], xb_n[4];
#define RP_LOAD(mm, T, XF, XB) do { \
        if ((mm) < MP) { const GAS u32x2* tr_ = (const GAS u32x2*)(tmp + (size_t)(mm) * DM) + lane; _Pragma("unroll") for (int j = 0; j < 4; ++j) T[j] = tr_[64 * j]; } \
        if (XIN == 0) { const GAS f32x4* xr_ = (const GAS f32x4*)(((mm) < MP) ? xin_p + (size_t)(mm) * DM : xin_s + (size_t)((mm) - MP) * DM) + lane; _Pragma("unroll") for (int j = 0; j < 4; ++j) XF[j] = xr_[64 * j]; } \
        else { const GAS u32x2* xr_ = (const GAS u32x2*)(rs_in + (size_t)(mm) * DM) + lane; _Pragma("unroll") for (int j = 0; j < 4; ++j) XB[j] = xr_[64 * j]; } } while (0)
    int m = gw;
    if (m < MT) RP_LOAD(m, tq, xq, xb);
    for (; m < MT; m += ngw) {
        const int mn = m + ngw;
        if (mn < MT) RP_LOAD(mn, tq_n, xq_n, xb_n);
        f32x4 tv[4], xv[4]; float s = 0.f;
#pragma unroll
        for (int j = 0; j < 4; ++j) {
            if (m < MP) tv[j] = (f32x4){bflo(tq[j].x), bfhi(tq[j].x), bflo(tq[j].y), bfhi(tq[j].y)};
            else { f32x4 a_ = {0.f, 0.f, 0.f, 0.f}; for (int ks = 0; ks < nks; ++ks) a_ = a_ + *((const GAS f32x4*)(part + ((size_t)ks * MS + (m - MP)) * DM) + lane + 64 * j); tv[j] = a_; }
            xv[j] = (XIN == 0) ? xq[j] : (f32x4){bflo(xb[j].x), bfhi(xb[j].x), bflo(xb[j].y), bfhi(xb[j].y)};
            s += (tv[j].x * tv[j].x + tv[j].y * tv[j].y) + (tv[j].z * tv[j].z + tv[j].w * tv[j].w); }
        const float r1 = frsq(wave_sum(s) * (1.f / DM) + EPS);
        float s2 = 0.f;
#pragma unroll
        for (int j = 0; j < 4; ++j) { xv[j] = xv[j] + tv[j] * r1 * gp[j]; s2 += (xv[j].x * xv[j].x + xv[j].y * xv[j].y) + (xv[j].z * xv[j].z + xv[j].w * xv[j].w); }
        if (XOUT == 0) { GAS f32x4* orow = (GAS f32x4*)(xout + (size_t)m * DM) + lane;
#pragma unroll
            for (int j = 0; j < 4; ++j) orow[64 * j] = xv[j]; }
        else { GAS u32x2* orow = (GAS u32x2*)(rs_out + (size_t)m * DM) + lane;
#pragma unroll
            for (int j = 0; j < 4; ++j) { u32x2 o; o.x = pk2(xv[j].x, xv[j].y); o.y = pk2(xv[j].z, xv[j].w); orow[64 * j] = o; } }
        if (xn) {
            const float r2 = frsq(wave_sum(s2) * (1.f / DM) + EPS);
            GAS u32x2* o8 = (GAS u32x2*)(xn + (size_t)m * DM) + lane;
#pragma unroll
            for (int j = 0; j < 4; ++j) { const f32x4 g = gn[j]; u32x2 o; o.x = pk2(xv[j].x * r2 * g.x, xv[j].y * r2 * g.y); o.y = pk2(xv[j].z * r2 * g.z, xv[j].w * r2 * g.w); o8[64 * j] = o; }
        }
#pragma unroll
        for (int j = 0; j < 4; ++j) { tq[j] = tq_n[j]; xq[j] = xq_n[j]; xb[j] = xb_n[j]; }
    }
#undef RP_LOAD
}
__device__ __forceinline__ float gelu_tanh(float x) {
    const float u = 0.7978845608028654f * (x + 0.044715f * x * x * x);
    const float e = __expf(2.f * u);
    const float th = 1.f - 2.f * frcp(e + 1.f);
    return 0.5f * x * (1.f + th);
}
__device__ __forceinline__ void act_pass(const GAS bf16* UG, GAS bf16* ACT, const GAS float* convw, const GAS float* convb, const GAS float* sconv  ,
                                         GAS float* cout_p, GAS float* cout_s, int vcu, int G, int tid) {
    if (tid >= DFF / 8) return;
    const int c = tid * 8;
    float w0[8], w1[8], w2[8], cb[8];
#pragma unroll
    for (int e = 0; e < 8; ++e) { w0[e] = convw[c + e]; w1[e] = convw[DFF + c + e]; w2[e] = convw[2 * DFF + c + e]; cb[e] = convb[c + e]; }
    for (int strip = vcu; strip < MT / 16; strip += G) {
        const int m0 = strip * 16; const bool sample = (m0 >= MP);
        float gm2[8], gm1[8];
        if (sample) { const int b = (m0 - MP) >> 4; const GAS float* sc = sconv + (size_t)b * 2 * DFF + c;
#pragma unroll
            for (int e = 0; e < 8; ++e) { gm2[e] = sc[e]; gm1[e] = sc[DFF + e]; } }
        else if ((m0 & (SEQ - 1)) == 0) {
#pragma unroll
            for (int e = 0; e < 8; ++e) { gm2[e] = 0.f; gm1[e] = 0.f; } }
        else { const u32x4 a = *(const GAS u32x4*)(UG + (size_t)(m0 - 2) * 5632 + DFF + c), bq = *(const GAS u32x4*)(UG + (size_t)(m0 - 1) * 5632 + DFF + c);
#pragma unroll
            for (int e = 0; e < 4; ++e) { gm2[2 * e] = bflo(a[e]); gm2[2 * e + 1] = bfhi(a[e]); gm1[2 * e] = bflo(bq[e]); gm1[2 * e + 1] = bfhi(bq[e]); } }
#pragma unroll 4
        for (int i = 0; i < 16; ++i) {
            const size_t m = (size_t)m0 + i;
            const u32x4 uu = *(const GAS u32x4*)(UG + m * 5632 + c), gg = *(const GAS u32x4*)(UG + m * 5632 + DFF + c);
            float g0[8], res[8];
#pragma unroll
            for (int e = 0; e < 4; ++e) { g0[2 * e] = bflo(gg[e]); g0[2 * e + 1] = bfhi(gg[e]); }
#pragma unroll
            for (int e = 0; e < 8; ++e) { const float uv = (e & 1) ? bfhi(uu[e >> 1]) : bflo(uu[e >> 1]);
                const float gc = cb[e] + w0[e] * gm2[e] + w1[e] * gm1[e] + w2[e] * g0[e]; res[e] = gelu_tanh(gc) * uv; gm2[e] = gm1[e]; gm1[e] = g0[e]; }
            u32x4 o; o.x = pk2(res[0], res[1]); o.y = pk2(res[2], res[3]); o.z = pk2(res[4], res[5]); o.w = pk2(res[6], res[7]);
            *(GAS u32x4*)(ACT + m * DFF + c) = o;
        }
        if (sample) { const int b = (m0 - MP) >> 4; GAS float* co = cout_s + (size_t)b * 2 * DFF + c;
#pragma unroll
            for (int e = 0; e < 8; ++e) { co[e] = gm2[e]; co[DFF + e] = gm1[e]; } }
        else if ((m0 & (SEQ - 1)) == SEQ - 16) { const int b = m0 >> 13; GAS float* co = cout_p + (size_t)b * 2 * DFF + c;
#pragma unroll
            for (int e = 0; e < 8; ++e) { co[e] = gm2[e]; co[DFF + e] = gm1[e]; } }
    }
}

__device__ __forceinline__ void kv_out_rows(const GAS bf16* KA, const GAS bf16* VA, GAS float* kp, GAS float* vp, GAS float* ks, GAS float* vs, int r0, int r1, int wave, int lane) {
    for (int m = r0 + wave; m < r1; m += NWAVES) {
        const GAS u32x4* kr = (const GAS u32x4*)(KA + (size_t)m * DM) + 2 * lane; const GAS u32x4* vr = (const GAS u32x4*)(VA + (size_t)m * DM) + 2 * lane;
        const u32x4 k0 = kr[0], k1 = kr[1], v0 = vr[0], v1 = vr[1];
        GAS f32x4* ko = (GAS f32x4*)((m < MP ? kp + (size_t)m * DM : ks + (size_t)(m - MP) * DM)) + 4 * lane;
        GAS f32x4* vo = (GAS f32x4*)((m < MP ? vp + (size_t)m * DM : vs + (size_t)(m - MP) * DM)) + 4 * lane;
        __builtin_nontemporal_store(((f32x4){bflo(k0.x), bfhi(k0.x), bflo(k0.y), bfhi(k0.y)}), ko);     __builtin_nontemporal_store(((f32x4){bflo(k0.z), bfhi(k0.z), bflo(k0.w), bfhi(k0.w)}), ko + 1);
        __builtin_nontemporal_store(((f32x4){bflo(k1.x), bfhi(k1.x), bflo(k1.y), bfhi(k1.y)}), ko + 2); __builtin_nontemporal_store(((f32x4){bflo(k1.z), bfhi(k1.z), bflo(k1.w), bfhi(k1.w)}), ko + 3);
        __builtin_nontemporal_store(((f32x4){bflo(v0.x), bfhi(v0.x), bflo(v0.y), bfhi(v0.y)}), vo);     __builtin_nontemporal_store(((f32x4){bflo(v0.z), bfhi(v0.z), bflo(v0.w), bfhi(v0.w)}), vo + 1);
        __builtin_nontemporal_store(((f32x4){bflo(v1.x), bfhi(v1.x), bflo(v1.y), bfhi(v1.y)}), vo + 2); __builtin_nontemporal_store(((f32x4){bflo(v1.z), bfhi(v1.z), bflo(v1.w), bfhi(v1.w)}), vo + 3);
    }
}

__global__ void __launch_bounds__(NWAVES * 64, 2) mega_fwd(Args args) {
#define AIN(i) ((const GAS float*)args.in[i])
    extern __shared__ __attribute__((aligned(16))) unsigned char lds_raw[];
    LAS unsigned char* lds = (LAS unsigned char*)lds_raw;
    volatile LAS unsigned* MISC = (volatile LAS unsigned*)(lds + MISC_OFF);
    const int tid0 = threadIdx.x;
    const int G0 = gridDim.x; const int bx0 = blockIdx.x; const int vcu0 = (G0 % 8 == 0) ? (bx0 % 8) * (G0 / 8) + bx0 / 8 : bx0;
    GAS unsigned char* ws0 = (GAS unsigned char*)args.ws;
#define OPQ() GAS unsigned char* ws = ws0; GAS float* out = out0; asm volatile("" : "+s"(ws), "+s"(out)); int G = G0, bx = bx0, vcu = vcu0; asm volatile("" : "+s"(G), "+s"(bx), "+s"(vcu)); const int NGW = G * NWAVES; (void)NGW; (void)bx; const int tid = opaque_tid(), lane = tid & 63, wave = __builtin_amdgcn_readfirstlane(tid >> 6), gw = vcu * NWAVES + wave; (void)gw; (void)lane
#define GRID_BAR() xcd_barrier_ni(bar.bar, bar.x, bar.st)
    for (int u = tid0; u < (LDS_BYTES - MISC_OFF) / 4; u += NWAVES * 64) ((LAS unsigned*)(lds + MISC_OFF))[u] = 0u;
    __syncthreads();
    XcdBarrier bar = xcd_barrier_post((unsigned*)args.ws + CW_BAR, MISC + 8);
    (void)args.ph_lo;
#ifndef PHMASK
#define PHMASK 0xfffff
#endif
#define IN(k) true
#define EN(i) ((PHMASK >> (i)) & 1)
#ifndef REPMASK
#define REPMASK 0
#endif
#define REP(i) ((REPMASK >> (i)) & 1)
#ifndef NOFOLD
#define NOFOLD 0
#endif
    GAS float* const out0 = (GAS float*)args.out;

    if (EN(0) && IN(0)) { OPQ(); GAS bf16* const XN = (GAS bf16*)(ws + WS_XN);
        LAS float* scr = (LAS float*)(lds + wave * 16384);
        for (int li = 0; li < DEPTH; ++li) {
            GAS unsigned char* wl = ws + WS_W + (size_t)li * W_LAYER;
            const GAS float* w_in = AIN(I_WIN) + (size_t)li * DM * DIN; const GAS float* w_gk2 = AIN(I_WGK2) + (size_t)li * 16 * 512;
            const GAS float* w_o = AIN(I_WO) + (size_t)li * DM * DM; const GAS float* w_up = AIN(I_WUP) + (size_t)li * DM * 2 * DFF; const GAS float* w_dn = AIN(I_WDOWN) + (size_t)li * DFF * DM;
            constexpr int IT_IN = (NIN / 32) * 16, IT_O = 32 * 16, IT_UP = (2 * DFF / 32) * 16, IT_DN = 32 * (DFF / 64);
            for (int it = gw; it < IT_IN + IT_O + IT_UP + IT_DN; it += NGW) {
                int r = it;
                if (r < IT_IN) { const int nb = r >> 4, kb = r & 15;
                    if (nb < 192) transpose_item(w_in, DIN, DM, (GAS bf16*)(wl + W_IN), scr, kb, 32 * nb, 32 * nb, lane, nullptr);
                    else if (nb < 256) transpose_item(w_in, DIN, DM, (GAS bf16*)(wl + W_IN), scr, kb, 32 * nb + 16, 32 * nb, lane, nullptr);
                    else transpose_item(w_in, DIN, DM, (GAS bf16*)(wl + W_IN), scr, kb, 32 * (nb - 256), 32 * nb, lane, w_gk2);
                    continue; }
                r -= IT_IN;
                if (r < IT_O) { transpose_item(w_o, DM, DM, (GAS bf16*)(wl + W_O), scr, r & 15, 32 * (r >> 4), 32 * (r >> 4), lane, nullptr); continue; }
                r -= IT_O;
                if (r < IT_UP) { transpose_item(w_up, 2 * DFF, DM, (GAS bf16*)(wl + W_UP), scr, r & 15, 32 * (r >> 4), 32 * (r >> 4), lane, nullptr); continue; }
                r -= IT_UP;
                { const int nb = r / (DFF / 64), kb = r % (DFF / 64); transpose_item(w_dn, DM, DFF, (GAS bf16*)(wl + W_DN), scr, kb, 32 * nb, 32 * nb, lane, nullptr); }
            }
        }
        for (int i = vcu * 512 + tid; i < SEQ * 8; i += G * 512) { const int pos = i >> 3, f = i & 7; float sn, cs; sincos_acc((float)pos * args.inv_freq[f], sn, cs);
            ((GAS float*)(ws + WS_ROPE))[pos * 16 + f] = cs; ((GAS float*)(ws + WS_ROPE))[pos * 16 + 8 + f] = sn; }
        for (int m = gw; m < MT; m += NGW) { const GAS float* xrow = (m < MP) ? AIN(I_XP) + (size_t)m * DM : AIN(I_XS) + (size_t)(m - MP) * DM;
            rms_row_to_bf16(xrow, AIN(I_PREMIX), XN + (size_t)m * DM, lane); }
        GRID_BAR();
    }

    for (int li = 0; li < DEPTH; ++li) {
        const int pb = 1 + li * 16;
        if (EN(1) && IN(pb + 0)) { OPQ(); GAS unsigned char* wl = ws + WS_W + (size_t)li * W_LAYER; GAS bf16* const XN = (GAS bf16*)(ws + WS_XN); const GAS float* rope = (const GAS float*)(ws + WS_ROPE);
          for (int rep = 0; rep < ((REP(1) && li == 0) ? 2 : 1); ++rep) {
            pg8::Gemm g{(const GAS pg8::bf16_t*)XN, (const GAS pg8::bf16_t*)(wl + W_IN), MT, NIN, DM, DM}; pg8::StaticOrder S; S.init(MT, NIN, G, bx);
            EpiIn E{ws, out + O_KP + (size_t)li * MP * DM, out + O_VP + (size_t)li * MP * DM, out + O_KS + (size_t)li * MS * DM, out + O_VS + (size_t)li * MS * DM, rope, AIN(I_BGK2) + li * 512};
            pg8::gemm_phase<EpiIn, pg8::StaticOrder, true, true>(lds, g, S, E);
            GRID_BAR();
          }
        }
        if (EN(2) && IN(pb + 1)) { OPQ(); GAS unsigned char* wl = ws + WS_W + (size_t)li * W_LAYER; GAS bf16* const XN = (GAS bf16*)(ws + WS_XN); const GAS float* rope = (const GAS float*)(ws + WS_ROPE);
          for (int rep = 0; rep < ((REP(2) && li == 0) ? 2 : 1); ++rep) {
            float lam, onem;
            { const float a = wave_sum(AIN(I_LQ1)[li * 64 + lane] * AIN(I_LK1)[li * 64 + lane]), c = wave_sum(AIN(I_LQ2)[li * 64 + lane] * AIN(I_LK2)[li * 64 + lane]);
              const float lam_init = 0.8f - 0.6f * expf(-0.3f * (float)li); lam = expf(a) - expf(c) + lam_init; onem = 1.0f - lam_init; }
            const GAS bf16* QA = (const GAS bf16*)(ws + WS_QA); const GAS bf16* KA = (const GAS bf16*)(ws + WS_KA); const GAS bf16* VA = (const GAS bf16*)(ws + WS_VA);
            const GAS float* nw = AIN(I_DANW) + li * 128;
            for (int rp = 0; rp < ((REP(10) && li == 0) ? 2 : 1); ++rp)
            if (EN(10)) for (int un = vcu; un < DB * 8; un += G)
                attn_unit<1>(lds, QA, KA, VA, (GAS bf16*)(ws + WS_OA), AIN(I_CK) + (size_t)li * DB * PAST * DM, AIN(I_CV) + (size_t)li * DB * PAST * DM, un >> 3, un & 7, 0, lam, onem, nw);
            for (int rp = 0; rp < ((REP(11) && li == 0) ? 2 : 1); ++rp)
            if (EN(11)) for (int it = vcu; it < 256; it += G) {
                GlaP P{(const GAS bf16*)(ws + WS_QG), (const GAS bf16*)(ws + WS_KG), (const GAS bf16*)(ws + WS_VG), (const GAS bf16*)(ws + WS_GK), nullptr, nullptr, nullptr, nullptr, nullptr, nullptr};
                f32x16 S[4];
#pragma unroll
                for (int kb = 0; kb < 4; ++kb)
#pragma unroll
                    for (int r = 0; r < 16; ++r) S[kb][r] = 0.f;
                float ds0 = 0.f, ds1 = 0.f;
                const int bh = it >> 3, grp = it & 7;
                gla_run<false, 0>(lds, P, (size_t)(bh >> 2) * SEQ + grp * 1024, bh & 3, 16, S, ds0, ds1);
                gla_store_state((GAS float*)(ws + WS_SLOC) + (size_t)it * 32768, S, wave, lane & 31, lane >> 5);
                if (wave == 0) { GAS float* dg = (GAS float*)(ws + WS_DG) + it * 128 + 2 * lane; dg[0] = __expf(ds0); dg[1] = __expf(ds1); }
            }
            if (EN(12)) for (int pi = vcu; pi < 2048; pi += G) {
                const int bh = (pi % 256) >> 2, s = (pi & 3) + 4 * (pi / 256);
                attn_prompt_unit(lds, QA, KA, VA, (GAS bf16*)(ws + WS_OA), bh >> 3, bh & 7, 63 - s, lam, onem, nw);
                attn_prompt_unit(lds, QA, KA, VA, (GAS bf16*)(ws + WS_OA), bh >> 3, bh & 7, s, lam, onem, nw);
            }
            GRID_BAR();
          }
        }
        if (EN(3) && IN(pb + 2)) { OPQ(); GAS unsigned char* wl = ws + WS_W + (size_t)li * W_LAYER; GAS bf16* const XN = (GAS bf16*)(ws + WS_XN); const GAS float* rope = (const GAS float*)(ws + WS_ROPE);
          for (int rep = 0; rep < ((REP(3) && li == 0) ? 2 : 1); ++rep) {
            GlaP P{(const GAS bf16*)(ws + WS_QG), (const GAS bf16*)(ws + WS_KG), (const GAS bf16*)(ws + WS_VG), (const GAS bf16*)(ws + WS_GK), (const GAS bf16*)(ws + WS_RG), (const GAS bf16*)(ws + WS_GA), (const GAS bf16*)(ws + WS_GB),
                   (const GAS bf16*)(ws + WS_OA), (GAS bf16*)(ws + WS_QA), AIN(I_GLANW) + li * 256};
            const int r32 = lane & 31, hh = lane >> 5;
            if (EN(13)) for (int it = vcu; it < 256; it += G) {
                const int bh = it >> 3, grp = it & 7;
                f32x16 S[4];
#pragma unroll
                for (int kb = 0; kb < 4; ++kb)
#pragma unroll
                    for (int r = 0; r < 16; ++r) S[kb][r] = 0.f;
                for (int j = 0; j < (NOFOLD ? 0 : grp); ++j) {
                    const GAS float* dg = (const GAS float*)(ws + WS_DG) + (size_t)(bh * 8 + j) * 128 + 4 * hh; const GAS float* sl = (const GAS float*)(ws + WS_SLOC) + (size_t)(bh * 8 + j) * 32768;
                    unsigned off = (unsigned)(4 * hh * 256 + 32 * wave + r32);
#pragma unroll
                    for (int kb = 0; kb < 4; ++kb)
#pragma unroll
                        for (int g4 = 0; g4 < 4; ++g4) { const f32x4 d4 = *(const GAS f32x4*)(dg + 32 * kb + 8 * g4);
#pragma unroll
                            for (int e = 0; e < 4; ++e) S[kb][4 * g4 + e] = S[kb][4 * g4 + e] * d4[e] + sl[off + e * 256];
                            off += 8 * 256; asm volatile("" : "+v"(off)); }
                }
                float ds0 = 0.f, ds1 = 0.f;
                gla_run<true, 0>(lds, P, (size_t)(bh >> 2) * SEQ + grp * 1024, bh & 3, 16, S, ds0, ds1);
                if (grp == 7) gla_store_state(out + O_GP + ((size_t)li * 32 + bh) * 32768, S, wave, r32, hh);
            }
            if (EN(14)) for (int it = vcu; it < DB * 4; it += G) {
                const int b = it >> 2, h = it & 3;
                const GAS float* s0 = AIN(I_SG) + ((size_t)li * DB * 4 + it) * 32768;
                f32x16 S[4];
                gla_load_state(s0, S, wave, r32, hh);
                float ds0 = 0.f, ds1 = 0.f;
                gla_run<true, 1>(lds, P, (size_t)MP + b * 16, h, 1, S, ds0, ds1);
                gla_store_state(out + O_GS + ((size_t)li * DB * 4 + it) * 32768, S, wave, r32, hh);
            }
            GRID_BAR();
          }
        }
        if (EN(4) && IN(pb + 3)) { OPQ(); GAS unsigned char* wl = ws + WS_W + (size_t)li * W_LAYER; GAS bf16* const XN = (GAS bf16*)(ws + WS_XN); const GAS float* rope = (const GAS float*)(ws + WS_ROPE);
          for (int rep = 0; rep < ((REP(4) && li == 0) ? 2 : 1); ++rep) {
            pg8::Gemm g{(const GAS pg8::bf16_t*)(ws + WS_QA), (const GAS pg8::bf16_t*)(wl + W_O), MP, DM, DM, DM}; pg8::StaticOrder S; S.init(MP, DM, G, bx);
            EpiB16 E{(GAS bf16*)(ws + WS_TMP), DM};
            pg8::gemm_phase<EpiB16, pg8::StaticOrder, true, true>(lds, g, S, E);
            { pg8::Gemm g2{(const GAS pg8::bf16_t*)(ws + WS_QA), (const GAS pg8::bf16_t*)(wl + W_O), MT, DM, 256, DM}; SplitOrder S2{G, bx, DM / 256, 256};
              EpiPart E2{(GAS float*)(ws + WS_PART), 256};
              pg8::gemm_phase<EpiPart, SplitOrder, true, true>(lds, g2, S2, E2); }
            GRID_BAR();
          }
        }
        if (EN(5) && IN(pb + 4)) { OPQ(); GAS unsigned char* wl = ws + WS_W + (size_t)li * W_LAYER; GAS bf16* const XN = (GAS bf16*)(ws + WS_XN); const GAS float* rope = (const GAS float*)(ws + WS_ROPE);
          for (int rep = 0; rep < ((REP(5) && li == 0) ? 2 : 1); ++rep) {
            { const GAS bf16* tmp_ = (const GAS bf16*)(ws + WS_TMP); const GAS float* part_ = (const GAS float*)(ws + WS_PART); GAS bf16* rs_ = (GAS bf16*)(ws + WS_RS);
              if (li == 0) rowpass<0, 1>(tmp_, part_, DM / 256, AIN(I_XP), AIN(I_XS), nullptr, nullptr, rs_, AIN(I_POSTMIX) + li * DM, AIN(I_PREFFN) + li * DM, XN, gw, NGW, lane);
              else         rowpass<1, 1>(tmp_, part_, DM / 256, nullptr, nullptr, rs_, nullptr, rs_, AIN(I_POSTMIX) + li * DM, AIN(I_PREFFN) + li * DM, XN, gw, NGW, lane); }
            GRID_BAR();
          }
        }
        if (EN(6) && IN(pb + 5)) { OPQ(); GAS unsigned char* wl = ws + WS_W + (size_t)li * W_LAYER; GAS bf16* const XN = (GAS bf16*)(ws + WS_XN); const GAS float* rope = (const GAS float*)(ws + WS_ROPE);
          for (int rep = 0; rep < ((REP(6) && li == 0) ? 2 : 1); ++rep) {
            pg8::Gemm g{(const GAS pg8::bf16_t*)XN, (const GAS pg8::bf16_t*)(wl + W_UP), MT, 2 * DFF, DM, DM}; pg8::StaticOrder S; S.init(MT, 2 * DFF, G, bx);
            EpiB16 E{(GAS bf16*)(ws + WS_UG), 2 * DFF};
            pg8::gemm_phase<EpiB16, pg8::StaticOrder, true, true>(lds, g, S, E);
            GRID_BAR();
          }
        }
        if (EN(7) && IN(pb + 6)) { OPQ(); GAS unsigned char* wl = ws + WS_W + (size_t)li * W_LAYER; GAS bf16* const XN = (GAS bf16*)(ws + WS_XN); const GAS float* rope = (const GAS float*)(ws + WS_ROPE);
          for (int rep = 0; rep < ((REP(7) && li == 0) ? 2 : 1); ++rep) {
            act_pass((const GAS bf16*)(ws + WS_UG), (GAS bf16*)(ws + WS_ACT), AIN(I_CONVW) + (size_t)li * 3 * DFF, AIN(I_CONVB) + (size_t)li * DFF, AIN(I_SC) + (size_t)li * DB * 2 * DFF,
                     out + O_CP + (size_t)li * NB * 2 * DFF, out + O_CS + (size_t)li * DB * 2 * DFF, vcu, G, tid);
            GRID_BAR();
          }
        }
        if (EN(8) && IN(pb + 7)) { OPQ(); GAS unsigned char* wl = ws + WS_W + (size_t)li * W_LAYER; GAS bf16* const XN = (GAS bf16*)(ws + WS_XN); const GAS float* rope = (const GAS float*)(ws + WS_ROPE);
          for (int rep = 0; rep < ((REP(8) && li == 0) ? 2 : 1); ++rep) {
            pg8::Gemm g{(const GAS pg8::bf16_t*)(ws + WS_ACT), (const GAS pg8::bf16_t*)(wl + W_DN), MP, DM, DFF, DFF}; pg8::StaticOrder S; S.init(MP, DM, G, bx);
            EpiB16 E{(GAS bf16*)(ws + WS_TMP), DM};
            pg8::gemm_phase<EpiB16, pg8::StaticOrder, true, true>(lds, g, S, E);
            { pg8::Gemm g2{(const GAS pg8::bf16_t*)(ws + WS_ACT), (const GAS pg8::bf16_t*)(wl + W_DN), MT, DM, 256, DFF}; SplitOrder S2{G, bx, DFF / 256, 256};
              EpiPart E2{(GAS float*)(ws + WS_PART), 256};
              pg8::gemm_phase<EpiPart, SplitOrder, true, true>(lds, g2, S2, E2); }
            GRID_BAR();
          }
        }
        if (EN(9) && IN(pb + 8)) { OPQ(); GAS unsigned char* wl = ws + WS_W + (size_t)li * W_LAYER; GAS bf16* const XN = (GAS bf16*)(ws + WS_XN); const GAS float* rope = (const GAS float*)(ws + WS_ROPE);
            const bool more = (li + 1 < DEPTH);
            { const GAS bf16* tmp_ = (const GAS bf16*)(ws + WS_TMP); const GAS float* part_ = (const GAS float*)(ws + WS_PART); GAS bf16* rs_ = (GAS bf16*)(ws + WS_RS);
              if (more) rowpass<1, 1>(tmp_, part_, DFF / 256, nullptr, nullptr, rs_, nullptr, rs_, AIN(I_POSTFFN) + li * DM, AIN(I_PREMIX) + (li + 1) * DM, XN, gw, NGW, lane);
              else      rowpass<1, 0>(tmp_, part_, DFF / 256, nullptr, nullptr, rs_, out, nullptr, AIN(I_POSTFFN) + li * DM, nullptr, nullptr, gw, NGW, lane); }
            if (more) GRID_BAR();
        }
    }
#undef IN
}

extern "C" void kernel_launch(void* const* d_in, const int* in_sizes, int n_in, void* d_out, int out_size, void* d_ws, size_t ws_size, hipStream_t stream) {
    static int grid = 0;
    if (grid == 0) {
        if (n_in != 24 || (size_t)out_size != O_END || ws_size < WS_END) { fprintf(stderr, "kernel_launch: unexpected shapes: n_in %d out %d (want %zu) ws %zu (want %zu)\n", n_in, out_size, (size_t)O_END, ws_size, (size_t)WS_END); grid = -1; return; }
        int dev = 0, cus = 0, per_cu = 0;
        if (hipGetDevice(&dev) != hipSuccess || hipDeviceGetAttribute(&cus, hipDeviceAttributeMultiprocessorCount, dev) != hipSuccess) { grid = -1; return; }
        if (hipFuncSetAttribute((const void*)mega_fwd, hipFuncAttributeMaxDynamicSharedMemorySize, LDS_BYTES) != hipSuccess) { fprintf(stderr, "kernel_launch: hipFuncSetAttribute failed\n"); grid = -1; return; }
        if (hipOccupancyMaxActiveBlocksPerMultiprocessor(&per_cu, (const void*)mega_fwd, NWAVES * 64, LDS_BYTES) != hipSuccess || per_cu < 1) { fprintf(stderr, "kernel_launch: occupancy query reports %d\n", per_cu); }
        (void)hipGetLastError();
        grid = cus;
    }
    if (grid < 0) return;
    if (hipMemsetAsync((char*)d_ws + WS_CTL, 0, CTL_ZERO_BYTES, stream) != hipSuccess) return;
    Args a{};
    for (int i = 0; i < 24; ++i) a.in[i] = (const float*)d_in[i];
    a.out = (float*)d_out; a.ws = (unsigned char*)d_ws;
    for (int i = 0; i < 8; ++i) a.inv_freq[i] = (float)pow(500000.0, -(double)i / 8.0);
    a.ph_lo = 0; a.ph_hi = 1000;
    hipLaunchKernelGGL(mega_fwd, dim3(grid), dim3(NWAVES * 64), LDS_BYTES, stream, a);
}
```

```cpp
#include <hip/hip_runtime.h>
#include <cstdio>
#include <cstdint>
#include <cmath>
__device__ __forceinline__ int opaque_tid() { int t = threadIdx.x; asm volatile("" : "+v"(t)); return t; }
namespace pg8 {
#define PG8_LAS __attribute__((address_space(3)))
typedef unsigned short bf16_t;
typedef short bf16x8 __attribute__((ext_vector_type(8)));
typedef float f32x4 __attribute__((ext_vector_type(4)));
typedef unsigned u32x4 __attribute__((ext_vector_type(4)));
constexpr int BM = 256, BK = 64, HALF = 128, HTB = HALF * BK * 2  , STAGE_BYTES = 8 * HTB, NXCD = 8, WGM = 8;

__host__ __device__ __forceinline__ int lds_byte(int r, int c) { const int st = (r >> 4) * 2 + (c >> 5), rr = r & 15, cc = c & 31, ob = rr * 64 + cc * 2; return st * 1024 + (ob ^ (((ob >> 9) & 1) << 5)); }
__host__ __device__ __forceinline__ void stage_rc(int b, int& R, int& C) { const int st = b / 1024, sb = b % 1024, swz = sb ^ (((sb >> 9) & 1) << 5); R = (st >> 1) * 16 + swz / 64; C = (st & 1) * 32 + (swz % 64) / 2; }
__host__ __device__ __forceinline__ int perm32(int rho) { const int n = rho >> 4, i = rho & 15; return 8 * (i >> 2) + 4 * n + (i & 3); }

struct Unit { int pm, pn, ko; };
struct Gemm { const __attribute__((address_space(1))) bf16_t* A; const __attribute__((address_space(1))) bf16_t* Bt; int M, N, K, ld; };

struct StaticOrder {
    int nM, nN, nwg, G, c, rot;
    __host__ __device__ void init(int M, int N, int G_, int c_, int rot_ = 0) { nM = M / BM; nN = N / BM; nwg = nM * nN; G = G_; c = c_; rot = rot_; }
    __host__ __device__ bool next(int i, Unit& u) const {
        const long L = (long)i * G + c; if (L >= nwg) return false;
        int wgid = (int)L; { const int q = nwg / NXCD, r = nwg % NXCD, xcd = wgid % NXCD, off = wgid / NXCD; wgid = (xcd < r ? xcd * (q + 1) : r * (q + 1) + (xcd - r) * q) + off; }
        const int nig = WGM * nN, gid = wgid / nig, fm = gid * WGM, gsz = (nM - fm) < WGM ? (nM - fm) : WGM;
        u.pm = fm + ((wgid % nig) % gsz); u.pn = ((wgid % nig) / gsz + rot * gid) % nN; u.ko = 0; return true;
    }
    __device__ __forceinline__ void a_ready(const Unit&) const {}
    __device__ __forceinline__ void done(const Unit&) const {}
};

__device__ __forceinline__ unsigned cvt_pk_bf16(float lo, float hi) { unsigned r; asm volatile("v_cvt_pk_bf16_f32 %0, %1, %2" : "=v"(r) : "v"(lo), "v"(hi)); return r; }
template <class Epi, class Sched, bool ALIGN_EPI = false, bool SP2 = false>
__device__ __forceinline__ void gemm_phase(PG8_LAS unsigned char* lds, const Gemm g, const Sched& S, const Epi& E) {
    const int tid = opaque_tid(), wid = __builtin_amdgcn_readfirstlane(tid >> 6), lane = tid & 63, wr = wid >> 2, wc = wid & 3, fr = lane & 15, fq = lane >> 4;
    const int K = g.ld, nt = g.K / BK;
    unsigned voffA[2], voffB[2];
#pragma unroll
    for (int i = 0; i < 2; ++i) { int R, C; stage_rc(tid * 16 + i * 8192, R, C); const int Rb = Epi::PERM ? ((R & ~31) + perm32(R & 31)) : R;
        voffA[i] = (unsigned)(R * K + C) * 2u; voffB[i] = (unsigned)(Rb * K + C) * 2u; }
    const size_t kstep = (size_t)(BK * 2);
    const size_t hstep = (size_t)HALF * K * 2;
    const size_t tstep = 2 * hstep;
    const unsigned ldsw = (unsigned)wid * 1024u;
    const int aoff = lds_byte(wr * 64 + fr, fq * 8), boff = lds_byte(wc * 32 + fr, fq * 8);
#define PG8_SA(b, h) (((b) * 2 + (h)) * HTB)
#define PG8_SB(b, h) ((4 + (b) * 2 + (h)) * HTB)
#define PG8_STAGE(bufoff, gbase, voff) do { _Pragma("unroll") for (int _i = 0; _i < 2; ++_i) \
        __builtin_amdgcn_global_load_lds((const unsigned*)((const char*)(gbase) + (voff)[_i]), (PG8_LAS unsigned*)(lds + (bufoff) + ldsw + _i * 8192), 16, 0, 0); } while (0)
#define PG8_LDA(dst, b, h) do { _Pragma("unroll") for (int m = 0; m < 4; ++m) _Pragma("unroll") for (int k = 0; k < 2; ++k) dst[m][k] = *(const PG8_LAS bf16x8*)(lds + PG8_SA(b, h) + aoff + m * 2048 + k * 1024); } while (0)
#define PG8_LDB(dst, b, h) do { _Pragma("unroll") for (int n = 0; n < 2; ++n) _Pragma("unroll") for (int k = 0; k < 2; ++k) dst[n][k] = *(const PG8_LAS bf16x8*)(lds + PG8_SB(b, h) + boff + n * 2048 + k * 1024); } while (0)
#define PG8_MMA(ai, bj, At, Bt) do { __builtin_amdgcn_s_setprio(1); _Pragma("unroll") for (int m = 0; m < 4; ++m) _Pragma("unroll") for (int n = 0; n < 2; ++n) _Pragma("unroll") for (int k = 0; k < 2; ++k) \
        acc[ai][bj][m][n] = __builtin_amdgcn_mfma_f32_16x16x32_bf16(Bt[n][k], At[m][k], acc[ai][bj][m][n], 0, 0, 0); __builtin_amdgcn_s_setprio(0); } while (0)
#define PG8_WAIT_V(n) asm volatile("s_waitcnt vmcnt(" #n ")" ::: "memory")
#define PG8_WAIT_L(n) asm volatile("s_waitcnt lgkmcnt(" #n ")" ::: "memory")
#define PG8_BAR __builtin_amdgcn_s_barrier()
#define PG8_SCHED __builtin_amdgcn_sched_barrier(0)
    Unit cur, nxt; int ui = 0;
    if (!S.next(0, cur)) return;
    f32x4 acc[2][2][4][2];
#pragma unroll
    for (int a = 0; a < 2; ++a)
#pragma unroll
        for (int b = 0; b < 2; ++b)
#pragma unroll
            for (int m = 0; m < 4; ++m)
#pragma unroll
                for (int n = 0; n < 2; ++n) acc[a][b][m][n] = (f32x4){0.f, 0.f, 0.f, 0.f};
    bf16x8 At[4][2], B0[2][2], B1[2][2];
    const char* cA = (const char*)g.A + (size_t)cur.pm * tstep + (size_t)cur.ko * 2; const char* cB = (const char*)g.Bt + (size_t)cur.pn * tstep + (size_t)cur.ko * 2;
    S.a_ready(cur);
    if constexpr (SP2) {
        PG8_STAGE(PG8_SB(0, 0), cB, voffB); PG8_STAGE(PG8_SB(0, 1), cB + hstep, voffB); PG8_STAGE(PG8_SA(0, 0), cA, voffA); PG8_STAGE(PG8_SA(0, 1), cA + hstep, voffA);
        if (wr == 1) PG8_BAR;
        PG8_WAIT_V(2); PG8_BAR;
        PG8_STAGE(PG8_SB(1, 0), cB + kstep, voffB); PG8_STAGE(PG8_SA(1, 0), cA + kstep, voffA); PG8_STAGE(PG8_SB(1, 1), cB + hstep + kstep, voffB);
        PG8_WAIT_V(6); PG8_BAR;
    } else {
        PG8_STAGE(PG8_SB(0, 0), cB, voffB); PG8_STAGE(PG8_SA(0, 0), cA, voffA); PG8_STAGE(PG8_SB(0, 1), cB + hstep, voffB); PG8_STAGE(PG8_SA(0, 1), cA + hstep, voffA);
        if (wr == 1) PG8_BAR;
        PG8_WAIT_V(4); PG8_BAR;
        PG8_STAGE(PG8_SB(1, 0), cB + kstep, voffB); PG8_STAGE(PG8_SA(1, 0), cA + kstep, voffA); PG8_STAGE(PG8_SB(1, 1), cB + hstep + kstep, voffB);
        PG8_WAIT_V(6); PG8_BAR;
    }
    for (;;) {
        const bool has_next = S.next(ui + 1, nxt);
        const char* nA = has_next ? (const char*)g.A + (size_t)nxt.pm * tstep + (size_t)nxt.ko * 2 : cA; const char* nB = has_next ? (const char*)g.Bt + (size_t)nxt.pn * tstep + (size_t)nxt.ko * 2 : cB;
        for (int t = 0; t < nt; t += 2) {
            const bool last = (t == nt - 2);
            const char* a1 = cA + (size_t)(t + 1) * kstep;
            const char* a2 = last ? nA : cA + (size_t)(t + 2) * kstep; const char* b2 = last ? nB : cB + (size_t)(t + 2) * kstep;
            const char* a3 = a2 + kstep; const char* b3 = b2 + kstep;
            if (last && has_next) S.a_ready(nxt);
            if constexpr (SP2) {
            PG8_LDB(B0, 0, 0); PG8_LDB(B1, 0, 1); PG8_SCHED; PG8_LDA(At, 0, 0); PG8_STAGE(PG8_SA(1, 1), a1 + hstep, voffA);
            PG8_WAIT_V(8); PG8_WAIT_L(0); PG8_BAR; PG8_MMA(0, 0, At, B0); PG8_MMA(0, 1, At, B1); PG8_BAR; PG8_SCHED;
            PG8_LDA(At, 0, 1); PG8_STAGE(PG8_SB(0, 0), b2, voffB); PG8_STAGE(PG8_SB(0, 1), b2 + hstep, voffB); PG8_STAGE(PG8_SA(0, 0), a2, voffA);
            PG8_WAIT_V(8); PG8_WAIT_L(0); PG8_BAR; PG8_MMA(1, 0, At, B0); PG8_MMA(1, 1, At, B1); PG8_BAR; PG8_SCHED;
            PG8_LDB(B0, 1, 0); PG8_LDB(B1, 1, 1); PG8_SCHED; PG8_LDA(At, 1, 0); PG8_STAGE(PG8_SA(0, 1), a2 + hstep, voffA);
            PG8_WAIT_V(8); PG8_WAIT_L(0); PG8_BAR; PG8_MMA(0, 0, At, B0); PG8_MMA(0, 1, At, B1); PG8_BAR; PG8_SCHED;
            PG8_LDA(At, 1, 1); PG8_STAGE(PG8_SB(1, 0), b3, voffB); PG8_STAGE(PG8_SB(1, 1), b3 + hstep, voffB); PG8_STAGE(PG8_SA(1, 0), a3, voffA);
            PG8_WAIT_V(8); PG8_WAIT_L(0); PG8_BAR; PG8_MMA(1, 0, At, B0); PG8_MMA(1, 1, At, B1); PG8_BAR; PG8_SCHED;
            } else {
            PG8_LDB(B0, 0, 0); PG8_SCHED; PG8_LDA(At, 0, 0); PG8_STAGE(PG8_SA(1, 1), a1 + hstep, voffA);
            PG8_WAIT_L(8); PG8_BAR; PG8_WAIT_L(0); PG8_MMA(0, 0, At, B0); PG8_BAR; PG8_SCHED;
            PG8_LDB(B1, 0, 1); PG8_STAGE(PG8_SB(0, 0), b2, voffB);
            PG8_BAR; PG8_WAIT_L(0); PG8_MMA(0, 1, At, B1); PG8_BAR;
            PG8_LDA(At, 0, 1); PG8_STAGE(PG8_SA(0, 0), a2, voffA);
            PG8_BAR; PG8_WAIT_L(0); PG8_MMA(1, 0, At, B0); PG8_BAR; PG8_SCHED;
            PG8_STAGE(PG8_SB(0, 1), b2 + hstep, voffB);
            PG8_WAIT_V(6); PG8_BAR; PG8_MMA(1, 1, At, B1); PG8_BAR;
            PG8_LDB(B0, 1, 0); PG8_SCHED; PG8_LDA(At, 1, 0); PG8_STAGE(PG8_SA(0, 1), a2 + hstep, voffA);
            PG8_WAIT_L(8); PG8_BAR; PG8_WAIT_L(0); PG8_MMA(0, 0, At, B0); PG8_BAR; PG8_SCHED;
            PG8_LDB(B1, 1, 1); PG8_STAGE(PG8_SB(1, 0), b3, voffB);
            PG8_BAR; PG8_WAIT_L(0); PG8_MMA(0, 1, At, B1); PG8_BAR;
            PG8_LDA(At, 1, 1); PG8_STAGE(PG8_SA(1, 0), a3, voffA);
            PG8_BAR; PG8_WAIT_L(0); PG8_MMA(1, 0, At, B0); PG8_BAR; PG8_SCHED;
            PG8_STAGE(PG8_SB(1, 1), b3 + hstep, voffB);
            PG8_WAIT_V(6); PG8_BAR; PG8_MMA(1, 1, At, B1); PG8_BAR;
            }
        }
        if constexpr (ALIGN_EPI) { if (wr == 0) PG8_BAR; }
        if constexpr (!Epi::AFTER_DRAIN) { E(acc, cur, wr, wc, fr, fq); S.done(cur); }
        if (!has_next) break;
#pragma unroll
        for (int a = 0; a < 2; ++a)
#pragma unroll
            for (int b = 0; b < 2; ++b)
#pragma unroll
                for (int m = 0; m < 4; ++m)
#pragma unroll
                    for (int n = 0; n < 2; ++n) acc[a][b][m][n] = (f32x4){0.f, 0.f, 0.f, 0.f};
        cur = nxt; cA = nA; cB = nB; ++ui;
        if constexpr (ALIGN_EPI) { if (wr == 1) PG8_BAR; }
    }
    PG8_WAIT_V(0);
    if constexpr (!ALIGN_EPI) { if (wr == 0) PG8_BAR; }
    PG8_BAR;
    if constexpr (Epi::AFTER_DRAIN) { E.fused(acc, cur, wr, wc, fr, fq, lds, wid, lane); S.done(cur); }
#undef PG8_SA
#undef PG8_SB
#undef PG8_STAGE
#undef PG8_LDA
#undef PG8_LDB
#undef PG8_MMA
#undef PG8_WAIT_V
#undef PG8_WAIT_L
#undef PG8_BAR
#undef PG8_SCHED
}
}

#define GAS __attribute__((address_space(1)))
#define LAS __attribute__((address_space(3)))
typedef unsigned short bf16;
typedef short bf16x8 __attribute__((ext_vector_type(8)));
typedef short s16x4 __attribute__((ext_vector_type(4)));
typedef float f32x4 __attribute__((ext_vector_type(4)));
typedef float f32x2 __attribute__((ext_vector_type(2)));
typedef float f32x16 __attribute__((ext_vector_type(16)));
typedef unsigned u32x4 __attribute__((ext_vector_type(4)));
typedef unsigned u32x2 __attribute__((ext_vector_type(2)));

constexpr int DM = 1024, NB = 8, SEQ = 8192, DEPTH = 2, DB = 32, DL = 16, PAST = 2048;
constexpr int MP = NB * SEQ;
constexpr int MS = DB * DL;
constexpr int MT = MP + MS;
constexpr int DFF = 2816, DIN = 8208, NIN = 8704;
constexpr float EPS = 1e-6f;
constexpr float C2 = 0.125f * 1.4426950408889634f;
constexpr int NWAVES = 8;

constexpr size_t O_Y = 0;
constexpr size_t O_KP = (size_t)MT * DM;
constexpr size_t O_VP = O_KP + (size_t)DEPTH * MP * DM;
constexpr size_t O_GP = O_VP + (size_t)DEPTH * MP * DM;
constexpr size_t O_CP = O_GP + (size_t)DEPTH * NB * 4 * 128 * 256;
constexpr size_t O_KS = O_CP + (size_t)DEPTH * NB * 2 * DFF;
constexpr size_t O_VS = O_KS + (size_t)DEPTH * MS * DM;
constexpr size_t O_GS = O_VS + (size_t)DEPTH * MS * DM;
constexpr size_t O_CS = O_GS + (size_t)DEPTH * DB * 4 * 128 * 256;
constexpr size_t O_END = O_CS + (size_t)DEPTH * DB * 2 * DFF;

constexpr size_t MiB = 1u << 20, HMiB = 1u << 19;
constexpr size_t WS_CTL = 0, CTL_ZERO_BYTES = 1 * MiB;
constexpr size_t WS_ROPE = 1 * MiB;
constexpr size_t WS_DG = 1 * MiB + HMiB;
constexpr size_t WS_W = 2 * MiB;
constexpr size_t W_IN = 0, W_O = 17 * MiB, W_UP = 19 * MiB, W_DN = 30 * MiB, W_LAYER = 35 * MiB + HMiB;
constexpr size_t WS_SLOC = 74 * MiB;
constexpr size_t UB = (size_t)MT * DM * 2;
constexpr size_t WS_XN = 112 * MiB;
constexpr size_t WS_QA = WS_XN + UB, WS_KA = WS_QA + UB, WS_VA = WS_KA + UB, WS_QG = WS_VA + UB, WS_KG = WS_QG + UB / 2, WS_VG = WS_KG + UB / 2,
                 WS_RG = WS_VG + UB, WS_GK = WS_RG + UB, WS_GA = WS_GK + UB / 2, WS_GB = WS_GA + UB, WS_PEND = WS_GB + UB;
constexpr size_t WS_UG = WS_QA;
constexpr size_t WS_ACT = WS_UG + (size_t)MT * 5632 * 2;
constexpr size_t WS_TMP = WS_PEND;
constexpr size_t WS_OA = WS_TMP + 2 * UB;
constexpr size_t WS_PART = WS_OA + UB;
constexpr size_t WS_RS = WS_PART + (size_t)11 * MS * DM * 4;
constexpr size_t WS_END = WS_RS + UB;
static_assert(WS_ACT + (size_t)MT * DFF * 2 <= WS_PEND, "ws overlay");
static_assert(WS_W + 2 * W_LAYER <= WS_SLOC && WS_SLOC + 32 * MiB <= WS_XN, "ws map");
constexpr int CW_BAR = 4096;

constexpr int RING_BYTES = 131072, MISC_OFF = RING_BYTES, LDS_BYTES = 147456;

__device__ __forceinline__ float bf2f(bf16 b) { return __uint_as_float((unsigned)b << 16); }
__device__ __forceinline__ float bflo(unsigned u) { return __uint_as_float(u << 16); }
__device__ __forceinline__ float bfhi(unsigned u) { return __uint_as_float(u & 0xffff0000u); }
typedef __bf16 bf16x2_t __attribute__((ext_vector_type(2)));
__device__ __forceinline__ unsigned pk2(float lo, float hi) { f32x2 v = {lo, hi}; bf16x2_t b = __builtin_convertvector(v, bf16x2_t); return __builtin_bit_cast(unsigned, b); }
__device__ __forceinline__ bf16 f2bf(float f) { return (bf16)(pk2(f, 0.f) & 0xffffu); }
template <int M> __device__ __forceinline__ float shx(float v) { return __int_as_float(__builtin_amdgcn_ds_swizzle(__float_as_int(v), 0x1F | (M << 10))); }
__device__ __forceinline__ float sum32x(float v) { auto r = __builtin_amdgcn_permlane32_swap(__float_as_uint(v), __float_as_uint(v), false, false); return __uint_as_float(r[0]) + __uint_as_float(r[1]); }
__device__ __forceinline__ float max32x(float v) { auto r = __builtin_amdgcn_permlane32_swap(__float_as_uint(v), __float_as_uint(v), false, false); return fmaxf(__uint_as_float(r[0]), __uint_as_float(r[1])); }
__device__ __forceinline__ float half_sum(float v) { v += shx<1>(v); v += shx<2>(v); v += shx<4>(v); v += shx<8>(v); v += shx<16>(v); return v; }
__device__ __forceinline__ float wave_sum(float v) { return sum32x(half_sum(v)); }
__device__ __forceinline__ float frcp(float x) { return __builtin_amdgcn_rcpf(x); }
__device__ __forceinline__ float frsq(float x) { return __builtin_amdgcn_rsqf(x); }
__device__ __forceinline__ float sigmoidf_(float x) { return frcp(1.0f + __expf(-x)); }
#define LDS_WAIT() asm volatile("s_waitcnt lgkmcnt(0)" ::: "memory")
#define VM_WAIT() asm volatile("s_waitcnt vmcnt(0)" ::: "memory")

struct EpiIn {
    static constexpr bool PERM = true, AFTER_DRAIN = false;
    GAS unsigned char* ws; GAS float* kout_p; GAS float* vout_p; GAS float* kout_s; GAS float* vout_s; const GAS float* rope; const GAS float* bgk;
    template <int KIND>
    __device__ __forceinline__ void run(const pg8::f32x4 (&acc)[2][2][4][2], GAS bf16* dst, int ldc, int tcol, GAS float* fout, int frow0, int row0, bool sample, int wc, int fq) const {
        const int colw = wc * 32 + 8 * fq;
        const bool ropew = (KIND <= 1) && ((wc & 1) == 0);
        const float sgn = (fq == 0) ? -1.f : ((fq == 1) ? 1.f : 0.f);
        const bool rl = (fq < 2);
        f32x4 b0 = {0.f, 0.f, 0.f, 0.f}, b1 = b0, b2 = b0, b3 = b0;
        if (KIND == 5) { b0 = *(const GAS f32x4*)(bgk + tcol + colw); b1 = *(const GAS f32x4*)(bgk + tcol + colw + 4); b2 = *(const GAS f32x4*)(bgk + tcol + 128 + colw); b3 = *(const GAS f32x4*)(bgk + tcol + 128 + colw + 4); }
#pragma unroll
        for (int ai = 0; ai < 2; ++ai)
#pragma unroll
            for (int m = 0; m < 4; ++m) {
                const int row = row0 + ai * 128 + m * 16;
                f32x4 cs0 = {1.f, 1.f, 1.f, 1.f}, cs1 = cs0, sn0 = {0.f, 0.f, 0.f, 0.f}, sn1 = sn0;
                if (KIND <= 1) { if (ropew) {
                    const int pos = sample ? (PAST + (row & 15)) : (row & (SEQ - 1));
                    const GAS f32x4* rp = (const GAS f32x4*)(rope + (size_t)pos * 16);
                    const f32x4 c0 = rp[0], c1 = rp[1], s0 = rp[2], s1 = rp[3];
#pragma unroll
                    for (int e = 0; e < 4; ++e) { cs0[e] = rl ? c0[e] : 1.f; cs1[e] = rl ? c1[e] : 1.f; sn0[e] = s0[e] * sgn; sn1[e] = s1[e] * sgn; }
                } }
#pragma unroll
                for (int bj = 0; bj < 2; ++bj) {
                    f32x4 v0 = acc[ai][bj][m][0], v1 = acc[ai][bj][m][1];
                    const int col = tcol + bj * 128 + colw;
                    if (KIND <= 1) { if (ropew) {
                        f32x4 o0, o1;
#pragma unroll
                        for (int e = 0; e < 4; ++e) { o0[e] = shx<16>(v0[e]); o1[e] = shx<16>(v1[e]); }
                        v0 = v0 * cs0 + o0 * sn0; v1 = v1 * cs1 + o1 * sn1;
                    } }
                    if (KIND == 1 || KIND == 2) {
                        GAS float* fo = fout + (size_t)(row - frow0) * 1024 + col;
                        __builtin_nontemporal_store(v0, (GAS f32x4*)fo); __builtin_nontemporal_store(v1, (GAS f32x4*)(fo + 4));
                    }
                    if (KIND == 0) { v0 = v0 * C2; v1 = v1 * C2; }
                    if (KIND == 3) { v0 = v0 * 0.08838834764831845f; v1 = v1 * 0.08838834764831845f; }
                    if (KIND == 5) {
                        const f32x4 ba = bj ? b2 : b0, bb = bj ? b3 : b1;
#pragma unroll
                        for (int e = 0; e < 4; ++e) {
                            float x = v0[e] + ba[e]; v0[e] = (fminf(x, 0.f) - __logf(1.f + __expf(-fabsf(x)))) * 0.0625f;
                            x = v1[e] + bb[e];       v1[e] = (fminf(x, 0.f) - __logf(1.f + __expf(-fabsf(x)))) * 0.0625f;
                        }
                    }
                    u32x4 w; w.x = pk2(v0[0], v0[1]); w.y = pk2(v0[2], v0[3]); w.z = pk2(v1[0], v1[1]); w.w = pk2(v1[2], v1[3]);
                    *(GAS u32x4*)(dst + (size_t)row * ldc + col) = w;
                }
            }
    }
    __device__ __forceinline__ void operator()(const pg8::f32x4 (&acc)[2][2][4][2], const pg8::Unit& u, int wr, int wc, int fr, int fq) const {
        const int pn = u.pn;
        const int row0 = u.pm * 256 + wr * 64 + fr;
        const bool sample = (u.pm >= 256);
        const int frow0 = sample ? MP : 0;
        if (pn < 4)       run<0>(acc, (GAS bf16*)(ws + WS_QA), 1024, pn * 256, nullptr, 0, row0, sample, wc, fq);
        else if (pn < 8)  run<1>(acc, (GAS bf16*)(ws + WS_KA), 1024, (pn - 4) * 256, sample ? kout_s : kout_p, frow0, row0, sample, wc, fq);
        else if (pn < 12) run<2>(acc, (GAS bf16*)(ws + WS_VA), 1024, (pn - 8) * 256, sample ? vout_s : vout_p, frow0, row0, sample, wc, fq);
        else if (pn < 14) run<3>(acc, (GAS bf16*)(ws + WS_QG), 512, (pn - 12) * 256, nullptr, 0, row0, sample, wc, fq);
        else if (pn < 16) run<4>(acc, (GAS bf16*)(ws + WS_KG), 512, (pn - 14) * 256, nullptr, 0, row0, sample, wc, fq);
        else if (pn < 20) run<4>(acc, (GAS bf16*)(ws + WS_VG), 1024, (pn - 16) * 256, nullptr, 0, row0, sample, wc, fq);
        else if (pn < 24) run<4>(acc, (GAS bf16*)(ws + WS_RG), 1024, (pn - 20) * 256, nullptr, 0, row0, sample, wc, fq);
        else if (pn < 28) run<4>(acc, (GAS bf16*)(ws + WS_GA), 1024, (pn - 24) * 256, nullptr, 0, row0, sample, wc, fq);
        else if (pn < 32) run<4>(acc, (GAS bf16*)(ws + WS_GB), 1024, (pn - 28) * 256, nullptr, 0, row0, sample, wc, fq);
        else              run<5>(acc, (GAS bf16*)(ws + WS_GK), 512, (pn - 32) * 256, nullptr, 0, row0, sample, wc, fq);
    }
};
struct SplitOrder {
    int G, c, nks, kslice;
    __device__ __forceinline__ bool next(int i, pg8::Unit& u) const { const int idx = i * G + c; if (idx >= 8 * nks) return false;
        const int ks = idx % nks, r = idx / nks; u.pn = r & 3; u.pm = 256 + (r >> 2); u.ko = ks * kslice; return true; }
    __device__ __forceinline__ void a_ready(const pg8::Unit&) const {}
    __device__ __forceinline__ void done(const pg8::Unit&) const {}
};
struct EpiPart {
    static constexpr bool PERM = true, AFTER_DRAIN = false;
    GAS float* P; int kslice;
    __device__ __forceinline__ void operator()(const pg8::f32x4 (&acc)[2][2][4][2], const pg8::Unit& u, int wr, int wc, int fr, int fq) const {
        const int row0 = (u.pm - 256) * 256 + wr * 64 + fr, col0 = u.pn * 256 + wc * 32 + 8 * fq; GAS float* base = P + (size_t)(u.ko / kslice) * MS * DM;
#pragma unroll
        for (int ai = 0; ai < 2; ++ai)
#pragma unroll
            for (int m = 0; m < 4; ++m) { GAS float* rowp = base + (size_t)(row0 + ai * 128 + m * 16) * DM + col0;
#pragma unroll
                for (int bj = 0; bj < 2; ++bj) { *(GAS f32x4*)(rowp + bj * 128) = acc[ai][bj][m][0]; *(GAS f32x4*)(rowp + bj * 128 + 4) = acc[ai][bj][m][1]; } }
    }
};
struct EpiF32 {
    static constexpr bool PERM = true, AFTER_DRAIN = false;
    GAS float* O; int ldc;
    __device__ __forceinline__ void operator()(const pg8::f32x4 (&acc)[2][2][4][2], const pg8::Unit& u, int wr, int wc, int fr, int fq) const {
        const int row0 = u.pm * 256 + wr * 64 + fr, col0 = u.pn * 256 + wc * 32 + 8 * fq;
#pragma unroll
        for (int ai = 0; ai < 2; ++ai)
#pragma unroll
            for (int m = 0; m < 4; ++m) { GAS float* rowp = O + (size_t)(row0 + ai * 128 + m * 16) * ldc + col0;
#pragma unroll
                for (int bj = 0; bj < 2; ++bj) { *(GAS f32x4*)(rowp + bj * 128) = acc[ai][bj][m][0]; *(GAS f32x4*)(rowp + bj * 128 + 4) = acc[ai][bj][m][1]; } }
    }
};
struct EpiB16 {
    static constexpr bool PERM = true, AFTER_DRAIN = false;
    GAS bf16* O; int ldc;
    __device__ __forceinline__ void operator()(const pg8::f32x4 (&acc)[2][2][4][2], const pg8::Unit& u, int wr, int wc, int fr, int fq) const {
        const int row0 = u.pm * 256 + wr * 64 + fr, col0 = u.pn * 256 + wc * 32 + 8 * fq;
#pragma unroll
        for (int ai = 0; ai < 2; ++ai)
#pragma unroll
            for (int m = 0; m < 4; ++m) { GAS bf16* rowp = O + (size_t)(row0 + ai * 128 + m * 16) * ldc + col0;
#pragma unroll
                for (int bj = 0; bj < 2; ++bj) { const f32x4 v0 = acc[ai][bj][m][0], v1 = acc[ai][bj][m][1];
                    u32x4 w; w.x = pk2(v0[0], v0[1]); w.y = pk2(v0[2], v0[3]); w.z = pk2(v1[0], v1[1]); w.w = pk2(v1[2], v1[3]);
                    *(GAS u32x4*)(rowp + bj * 128) = w; } }
    }
};
#define XB_TMO      128
#define XB_XCNT(j)  (256  + 64 * (j))
#define XB_XSUB(j)  (1280 + 64 * (j))
#define XB_XGEN(j)  (2304 + 64 * (j))
#define XB_TOP      3328
#define XB_TOPGEN   3392
#define XCD_BAR_WORDS 3456
#define XB_SPIN_CAP (1u << 18)

__device__ __forceinline__ unsigned xb_ld(unsigned* p)              { return __hip_atomic_load(p, __ATOMIC_RELAXED, __HIP_MEMORY_SCOPE_AGENT); }
__device__ __forceinline__ unsigned xb_add(unsigned* p, unsigned v) { return __hip_atomic_fetch_add(p, v, __ATOMIC_RELAXED, __HIP_MEMORY_SCOPE_AGENT); }
__device__ __forceinline__ unsigned xb_xcc_id() { return (unsigned)__builtin_amdgcn_s_getreg((3 << 11) | 20) & 0xFu; }
#define XB_SPIN(cond, bar) do { unsigned _sp = 0; while (cond) { __builtin_amdgcn_s_sleep(1); \
    if ((++_sp & 255u) == 0u) { if (xb_ld(&(bar)[XB_TMO])) break; if (_sp > XB_SPIN_CAP) { atomicAdd(&(bar)[XB_TMO], 1u); break; } } } } while (0)

struct XcdBarrier {
    unsigned* bar; unsigned x;
    volatile LAS unsigned* st;
};

__device__ __forceinline__ XcdBarrier xcd_barrier_post(unsigned* bar, volatile LAS unsigned* st) {
    XcdBarrier b; b.bar = bar; b.x = xb_xcc_id(); b.st = st;
    if (threadIdx.x == 0) (void)xb_add(&bar[XB_XCNT(b.x)], 1u);
    return b;
}
__device__ __forceinline__ void xcd_barrier_complete(unsigned* bar, unsigned x, unsigned& nloc, unsigned& nx) {
    const unsigned G = gridDim.x * gridDim.y * gridDim.z;
    unsigned sum, cnt, mine, sp = 0u;
    for (;;) {
        sum = 0u; cnt = 0u; mine = 0u;
#pragma unroll
        for (unsigned j = 0; j < 16; ++j) { const unsigned c = xb_ld(&bar[XB_XCNT(j)]); sum += c; cnt += (c > 0u) ? 1u : 0u; mine = (j == x) ? c : mine; }
        if (sum == G) break;
        __builtin_amdgcn_s_sleep(1);
        if ((++sp & 255u) == 0u) { if (xb_ld(&bar[XB_TMO])) break; if (sp > XB_SPIN_CAP) { atomicAdd(&bar[XB_TMO], 1u); break; } }
    }
    nloc = mine > 0u ? mine : 1u; nx = cnt > 0u ? cnt : 1u;
}

__device__ __forceinline__ void xcd_barrier(const XcdBarrier& b) {
    asm volatile("s_waitcnt vmcnt(0)" ::: "memory");
    __syncthreads();
    if (threadIdx.x == 0) {
        unsigned* bar = b.bar;
        __builtin_amdgcn_s_waitcnt(0);
        unsigned nloc = b.st[0], nx = b.st[1];
        if (nloc == 0u) { xcd_barrier_complete(bar, b.x, nloc, nx); b.st[0] = nloc; b.st[1] = nx; }
        const unsigned old = xb_add(&bar[XB_XSUB(b.x)], 1u);
        const unsigned gen = old / nloc;
        if (old + 1u == (gen + 1u) * nloc) {
            __builtin_amdgcn_fence(__ATOMIC_RELEASE, "agent");
            asm volatile("s_waitcnt vmcnt(0)" ::: "memory");
            const unsigned og = xb_add(&bar[XB_TOP], 1u);
            const unsigned tg = og / nx;
            if (og + 1u == (tg + 1u) * nx) xb_add(&bar[XB_TOPGEN], 1u);
            else XB_SPIN(xb_ld(&bar[XB_TOPGEN]) == tg, bar);
            __builtin_amdgcn_fence(__ATOMIC_ACQUIRE, "agent");
            xb_add(&bar[XB_XGEN(b.x)], 1u);
            asm volatile("s_waitcnt vmcnt(0)" ::: "memory");
        } else {
            XB_SPIN(xb_ld(&bar[XB_XGEN(b.x)]) == gen, bar);
            __builtin_amdgcn_fence(__ATOMIC_ACQUIRE, "agent");
            asm volatile("s_waitcnt vmcnt(0)" ::: "memory");
        }
    }
    __syncthreads();
}

__device__ __noinline__ void xcd_barrier_ni(unsigned* bar, unsigned x, volatile LAS unsigned* st) { XcdBarrier b; b.bar = bar; b.x = x; b.st = st; xcd_barrier(b); }

struct Args { const float* in[24]; float* out; unsigned char* ws; float inv_freq[8]; int ph_lo, ph_hi; };
enum { I_XP = 0, I_XS, I_CK, I_CV, I_SG, I_SC, I_WIN, I_WGK2, I_BGK2, I_LQ1, I_LK1, I_LQ2, I_LK2, I_DANW, I_GLANW, I_WO, I_PREMIX, I_POSTMIX, I_PREFFN, I_POSTFFN, I_WUP, I_CONVW, I_CONVB, I_WDOWN };

__device__ __forceinline__ void transpose_item(const GAS float* W, int N, int K, GAS bf16* WT, LAS float* scr, int kb, int n0_src, int n0_dst, int lane, const GAS float* wg) {
    const int k0 = 64 * kb;
    if (wg == nullptr) {
#pragma unroll 8
        for (int i = 0; i < 32; ++i) { const int kk = 2 * i + (lane >> 5); scr[kk * 33 + (lane & 31)] = W[(size_t)(k0 + kk) * N + n0_src + (lane & 31)]; }
    } else {
        float g[16];
#pragma unroll
        for (int r = 0; r < 16; ++r) g[r] = wg[r * 512 + n0_src + (lane & 31)];
        for (int i = 0; i < 32; ++i) { const int kk = 2 * i + (lane >> 5); const GAS float* lr = W + (size_t)(k0 + kk) * N + 6144; float s = 0.f;
#pragma unroll
            for (int r = 0; r < 16; ++r) s += lr[r] * g[r];
            scr[kk * 33 + (lane & 31)] = s; }
    }
    LDS_WAIT(); asm volatile("" ::: "memory");
    const int c = lane & 7;
#pragma unroll
    for (int j = 0; j < 4; ++j) { const int n = (lane >> 3) + 8 * j; const LAS float* s = scr + (8 * c) * 33 + n;
        u32x4 o; o.x = pk2(s[0 * 33], s[1 * 33]); o.y = pk2(s[2 * 33], s[3 * 33]); o.z = pk2(s[4 * 33], s[5 * 33]); o.w = pk2(s[6 * 33], s[7 * 33]);
        *(GAS u32x4*)(WT + (size_t)(n0_dst + n) * K + k0 + 8 * c) = o; }
    LDS_WAIT(); asm volatile("" ::: "memory");
}
__device__ __forceinline__ void rms_row_to_bf16(const GAS float* xrow, const GAS float* w, GAS bf16* orow, int lane) {
    const GAS f32x4* xr = (const GAS f32x4*)xrow + lane; const GAS f32x4* wr = (const GAS f32x4*)w + lane;
    f32x4 v[4]; float s = 0.f;
#pragma unroll
    for (int j = 0; j < 4; ++j) { v[j] = xr[64 * j]; s += (v[j].x * v[j].x + v[j].y * v[j].y) + (v[j].z * v[j].z + v[j].w * v[j].w); }
    const float rstd = frsq(wave_sum(s) * (1.f / DM) + EPS);
    GAS u32x2* o8 = (GAS u32x2*)orow + lane;
#pragma unroll
    for (int j = 0; j < 4; ++j) { const f32x4 g = wr[64 * j]; u32x2 o; o.x = pk2(v[j].x * rstd * g.x, v[j].y * rstd * g.y); o.y = pk2(v[j].z * rstd * g.z, v[j].w * rstd * g.w); o8[64 * j] = o; }
}
__device__ __forceinline__ void sincos_acc(float angf, float& sn, float& cs) {
    const double a = (double)angf; const double k = rint(a * 0.15915494309189535); const double r = a - k * 6.283185307179586476925;
    const double r2 = r * r; double ts = 1.0, tc = 1.0, ss = 1.0, sc = 1.0;
#pragma unroll
    for (int n = 1; n <= 13; ++n) { tc = -tc * r2 / (double)((2 * n - 1) * (2 * n)); ts = -ts * r2 / (double)((2 * n) * (2 * n + 1)); sc += tc; ss += ts; }
    sn = (float)(ss * r); cs = (float)sc;
}

#define MFMA32(a, b, c) __builtin_amdgcn_mfma_f32_32x32x16_bf16((a), (b), (c), 0, 0, 0)
__device__ __forceinline__ int crow(int r, int hi) { return (r & 3) + 8 * (r >> 2) + 4 * hi; }
__device__ __forceinline__ s16x4 tr16(const LAS unsigned char* p) { return __builtin_bit_cast(s16x4, __builtin_amdgcn_ds_read_tr16_b64_v4i16((LAS s16x4*)p)); }
__device__ __forceinline__ bf16x8 cat8(s16x4 lo, s16x4 hi) { return (bf16x8){lo[0], lo[1], lo[2], lo[3], hi[0], hi[1], hi[2], hi[3]}; }
__device__ __forceinline__ u32x4 cvt8(f32x4 a, f32x4 b) { u32x4 w; w.x = pk2(a[0], a[1]); w.y = pk2(a[2], a[3]); w.z = pk2(b[0], b[1]); w.w = pk2(b[2], b[3]); return w; }

__device__ __forceinline__ void glds16(const GAS void* gsrc, unsigned lds_dst) { unsigned keep;
    asm volatile("s_mov_b32 %0, m0\n\ts_mov_b32 m0, %2\n\ts_nop 0\n\tglobal_load_lds_dwordx4 %1, off\n\ts_mov_b32 m0, %0" : "=&s"(keep) : "v"(gsrc), "s"(lds_dst) : "memory"); }
template <int MODE>
__device__ __forceinline__ void attn_unit(LAS unsigned char* lds, const GAS bf16* Q, const GAS bf16* Kb, const GAS bf16* Vb, GAS bf16* O, const GAS float* ck, const GAS float* cv,
                                          int b, int h, int qblk, float lam, float onem, const GAS float* normw) {
    const int tid = opaque_tid(), lane = tid & 63, w = __builtin_amdgcn_readfirstlane(tid >> 6), r32 = lane & 31, hi = lane >> 5;
    const int comp = w & 1, rg = w >> 1, half = w >> 2;
    int NT, my_nt; size_t qrow, orow0;
    if (MODE == 0) { NT = 2 * qblk + 2; my_nt = 2 * qblk + 1 + half; orow0 = (size_t)b * SEQ + qblk * 128 + rg * 32; qrow = orow0 + r32; }
    else { NT = 33; my_nt = (rg == 0) ? 33 : 0; orow0 = (size_t)MP + b * 16; qrow = orow0 + (r32 < 15 ? r32 : 15); }
    bf16x8 qr[4];
    { const GAS bf16* qp = Q + qrow * 1024 + h * 128 + comp * 64 + hi * 8;
#pragma unroll
      for (int s = 0; s < 4; ++s) qr[s] = *(const GAS bf16x8*)(qp + 16 * s); }
    asm volatile("" : "+v"(qr[0]), "+v"(qr[1]), "+v"(qr[2]), "+v"(qr[3]));
    LAS float* wsf = (LAS float*)(lds + 98304) + w * 64;
    f32x16 o[4];
#pragma unroll
    for (int d = 0; d < 4; ++d)
#pragma unroll
        for (int r = 0; r < 16; ++r) o[d][r] = 0.f;
    float mrow = 0.f, lrow = 0.f;
    u32x4 kst[2], vst[2];
    bf16x8 pw[4];
#pragma unroll
    for (int k = 0; k < 4; ++k) pw[k] = (bf16x8){0, 0, 0, 0, 0, 0, 0, 0};
    const int vrow_l = lane >> 2, vpc = lane & 3;
#define ATT_LOAD(t) do { \
        if (MODE == 0) { const size_t kr0 = (size_t)b * SEQ + 64 * (t); \
            _Pragma("unroll") for (int i = 0; i < 2; ++i) { const int p = w + 8 * i; \
                kst[i] = *(const GAS u32x4*)(Kb + (kr0 + lane) * 1024 + h * 128 + p * 8); \
                vst[i] = *(const GAS u32x4*)(Vb + (kr0 + 16 * (p & 3) + vrow_l) * 1024 + h * 128 + 32 * (p >> 2) + 8 * vpc); } } \
        else if ((t) < 32) { const size_t kr0 = (size_t)b * PAST + 64 * (t); \
            _Pragma("unroll") for (int i = 0; i < 2; ++i) { const int p = w + 8 * i; \
                const GAS float* kp = ck + ((kr0 + lane) * 8 + h) * 128 + p * 8; kst[i] = cvt8(*(const GAS f32x4*)kp, *(const GAS f32x4*)(kp + 4)); \
                const GAS float* vp = cv + ((kr0 + 16 * (p & 3) + vrow_l) * 8 + h) * 128 + 32 * (p >> 2) + 8 * vpc; vst[i] = cvt8(*(const GAS f32x4*)vp, *(const GAS f32x4*)(vp + 4)); } } \
        else { const size_t kr0 = (size_t)MP + b * 16; \
            _Pragma("unroll") for (int i = 0; i < 2; ++i) { const int p = w + 8 * i; const int vr = 16 * (p & 3) + vrow_l; \
                kst[i] = (lane < 16) ? *(const GAS u32x4*)(Kb + (kr0 + lane) * 1024 + h * 128 + p * 8) : (u32x4){0u, 0u, 0u, 0u}; \
                vst[i] = (vr < 16) ? *(const GAS u32x4*)(Vb + (kr0 + vr) * 1024 + h * 128 + 32 * (p >> 2) + 8 * vpc) : (u32x4){0u, 0u, 0u, 0u}; } } \
    } while (0)
#define ATT_STORE(bufo) do { _Pragma("unroll") for (int i = 0; i < 2; ++i) { const int p = w + 8 * i; \
        *(LAS u32x4*)(lds + (bufo) + p * 1024 + lane * 16) = kst[i]; *(LAS u32x4*)(lds + (bufo) + 16384 + p * 1024 + lane * 16) = vst[i]; } } while (0)
#define ATT_X(t, bo) do { \
        f32x16 p0, p1; \
        _Pragma("unroll") for (int r = 0; r < 16; ++r) { p0[r] = 0.f; p1[r] = 0.f; } \
        const LAS unsigned char* kb_ = lds + (bo) + kfo; \
        _Pragma("unroll") for (int s = 0; s < 4; ++s) { const bf16x8 a0 = *(const LAS bf16x8*)(kb_ + s * 2048), a1 = *(const LAS bf16x8*)(kb_ + s * 2048 + 512); \
            p0 = MFMA32(a0, qr[s], p0); p1 = MFMA32(a1, qr[s], p1); } \
        if (MODE == 1 && (t) == 32) { _Pragma("unroll") for (int r = 0; r < 16; ++r) { if (r >= 8) p0[r] = -INFINITY; p1[r] = -INFINITY; } } \
        float mx = fmaxf(p0[0], p1[0]); \
        _Pragma("unroll") for (int r = 1; r < 16; ++r) mx = fmaxf(mx, fmaxf(p0[r], p1[r])); \
        mx = max32x(mx); \
        if ((t) == 0) mrow = mx; \
        else if (__any(mx > mrow + 8.f)) { \
            const float mn = fmaxf(mrow, mx); const float f = __builtin_amdgcn_exp2f(mrow - mn); lrow *= f; mrow = mn; \
            if (hi == 0) wsf[r32] = f; \
            LDS_WAIT(); \
            _Pragma("unroll") for (int r = 0; r < 16; ++r) { const float fr_ = wsf[crow(r, hi)]; \
                _Pragma("unroll") for (int d = 0; d < 4; ++d) o[d][r] *= fr_; } } \
        float ls = 0.f; \
        _Pragma("unroll") for (int r = 0; r < 16; ++r) { p0[r] = __builtin_amdgcn_exp2f(p0[r] - mrow); p1[r] = __builtin_amdgcn_exp2f(p1[r] - mrow); ls += p0[r] + p1[r]; } \
        lrow += ls; \
        { u32x4 x; \
          x.x = pk2(p0[0], p0[1]); x.y = pk2(p0[2], p0[3]); x.z = pk2(p0[4], p0[5]); x.w = pk2(p0[6], p0[7]); pw[0] = __builtin_bit_cast(bf16x8, x); \
          x.x = pk2(p0[8], p0[9]); x.y = pk2(p0[10], p0[11]); x.z = pk2(p0[12], p0[13]); x.w = pk2(p0[14], p0[15]); pw[1] = __builtin_bit_cast(bf16x8, x); \
          x.x = pk2(p1[0], p1[1]); x.y = pk2(p1[2], p1[3]); x.z = pk2(p1[4], p1[5]); x.w = pk2(p1[6], p1[7]); pw[2] = __builtin_bit_cast(bf16x8, x); \
          x.x = pk2(p1[8], p1[9]); x.y = pk2(p1[10], p1[11]); x.z = pk2(p1[12], p1[13]); x.w = pk2(p1[14], p1[15]); pw[3] = __builtin_bit_cast(bf16x8, x); } \
    } while (0)
#define ATT_Y(bo) do { const LAS unsigned char* vb_ = lds + (bo) + vfo; \
        _Pragma("unroll") for (int d = 0; d < 4; ++d) { \
            _Pragma("unroll") for (int ks = 0; ks < 4; ++ks) { const s16x4 lo_ = tr16(vb_ + d * 4096 + ks * 1024), hh_ = tr16(vb_ + d * 4096 + ks * 1024 + 512); \
                o[d] = MFMA32(pw[ks], cat8(lo_, hh_), o[d]); } \
            __builtin_amdgcn_sched_barrier(0); } } while (0)
#define ATT_DMA(t, bufo) do { const size_t kr0 = (size_t)b * SEQ + 64 * (t); \
        _Pragma("unroll") for (int i = 0; i < 2; ++i) { const int p = w + 8 * i; \
            glds16(Kb + (kr0 + lane) * 1024 + h * 128 + p * 8, (unsigned)__builtin_amdgcn_readfirstlane((int)(lds0 + (bufo) + p * 1024))); \
            glds16(Vb + (kr0 + 16 * (p & 3) + vrow_l) * 1024 + h * 128 + 32 * (p >> 2) + 8 * vpc, (unsigned)__builtin_amdgcn_readfirstlane((int)(lds0 + (bufo) + 16384 + p * 1024))); } } while (0)
    const unsigned lds0 = (unsigned)(size_t)lds;
    if (MODE == 0) { ATT_DMA(0, 0); VM_WAIT(); } else { ATT_LOAD(0); ATT_STORE(0); }
    __syncthreads();
    const int kfo = (8 * comp + hi) * 1024 + r32 * 16;
    const int vfo = 16384 + ((lane >> 4) & 1) * 32 + (lane & 3) * 8 + (4 * hi + ((lane & 15) >> 2)) * 64;
    int b_prev = 0, b_cur = 0, b_next = 32768;
    const int NI = (MODE == 0) ? NT + 1 : NT;
    for (int i = 0; i < NI; ++i) {
        if (i + 1 < NT) { if (MODE == 0) { ATT_DMA(i + 1, b_next); } else { ATT_LOAD(i + 1); } }
        if (half == 0) { if (i < my_nt) { ATT_X(i, b_cur); ATT_Y(b_cur); } }
        else if (MODE == 0) { if (i >= 1) ATT_Y(b_prev); if (i < NT) ATT_X(i, b_cur); }
        if (MODE == 1 && i + 1 < NT) ATT_STORE(b_next);
        if (MODE == 0) VM_WAIT();
        __syncthreads();
        b_prev = b_cur; b_cur = b_next; b_next = (b_next == 65536) ? 0 : b_next + 32768;
    }
#undef ATT_LOAD
#undef ATT_STORE
#undef ATT_DMA
#undef ATT_X
#undef ATT_Y
    const bool active = (MODE == 0) || (rg == 0);
    if (active) {
        const float lt = sum32x(lrow);
        if (hi == 0) wsf[32 + r32] = lt;
        LDS_WAIT();
#pragma unroll
        for (int r = 0; r < 16; ++r) { const float il = frcp(wsf[32 + crow(r, hi)]);
#pragma unroll
            for (int d = 0; d < 4; ++d) o[d][r] *= il; }
    }
    LAS float* X = (LAS float*)lds;
    if (active && comp == 1) {
#pragma unroll
        for (int d = 0; d < 4; ++d)
#pragma unroll
            for (int r = 0; r < 16; ++r) X[((rg * 4 + d) * 16 + r) * 64 + lane] = o[d][r];
    }
    __syncthreads();
    if (active && comp == 0) {
        float nw[4];
#pragma unroll
        for (int d = 0; d < 4; ++d) nw[d] = normw[32 * d + r32];
#pragma unroll
        for (int r = 0; r < 16; ++r) {
            float ss = 0.f;
#pragma unroll
            for (int d = 0; d < 4; ++d) { const float x = o[d][r] - lam * X[((rg * 4 + d) * 16 + r) * 64 + lane]; o[d][r] = x; ss += x * x; }
            ss = half_sum(ss);
            const float rs = onem * frsq(ss * (1.0f / 128.0f) + EPS);
            const int rr = crow(r, hi);
            if (MODE == 0 || rr < 16) {
                GAS bf16* op = O + (orow0 + rr) * 1024 + h * 128 + r32;
#pragma unroll
                for (int d = 0; d < 4; ++d) op[32 * d] = f2bf(o[d][r] * rs * nw[d]);
            }
        }
    }
    __syncthreads();
}

constexpr int ATT_WSF = 131072 + 1024;
#define ASBAR() __builtin_amdgcn_sched_barrier(0)
#define APIN(x) asm volatile("" : "+v"(x))
__device__ __forceinline__ float max3f(float a, float b, float c) { float r; asm("v_max3_f32 %0, %1, %2, %3" : "=v"(r) : "v"(a), "v"(b), "v"(c)); return r; }
__device__ __forceinline__ void attn_prompt_unit(LAS unsigned char* lds, const GAS bf16* Q, const GAS bf16* Kb, const GAS bf16* Vb, GAS bf16* O,
                                                 int b, int h, int qblk, float lam, float onem, const GAS float* normw) {
    const int tid = opaque_tid(), lane = tid & 63, w = __builtin_amdgcn_readfirstlane(tid >> 6), r32 = lane & 31, hi = lane >> 5;
    const int comp = w & 1, rg = w >> 1, half = w >> 2;
    const int NT = 2 * qblk + 2, my_nt = NT - 1 + half;
    const size_t orow0 = (size_t)b * SEQ + qblk * 128 + rg * 32;
    bf16x8 qr[4];
    { const GAS bf16* qp = Q + (orow0 + r32) * 1024 + h * 128 + comp * 64 + hi * 8;
#pragma unroll
      for (int s = 0; s < 4; ++s) qr[s] = *(const GAS bf16x8*)(qp + 16 * s); }
    asm volatile("" : "+v"(qr[0]), "+v"(qr[1]), "+v"(qr[2]), "+v"(qr[3]));
    LAS float* wsf = (LAS float*)(lds + ATT_WSF) + w * 64;
    f32x16 o[4];
#pragma unroll
    for (int d = 0; d < 4; ++d)
#pragma unroll
        for (int r = 0; r < 16; ++r) o[d][r] = 0.f;
    float mrow = 0.f, lrow = 0.f;
    f32x16 pA0, pA1, pB0, pB1;
    const f32x16 zero16 = {0.f, 0.f, 0.f, 0.f, 0.f, 0.f, 0.f, 0.f, 0.f, 0.f, 0.f, 0.f, 0.f, 0.f, 0.f, 0.f};
    const unsigned lds0 = (unsigned)(size_t)lds;
    const int vrow_l = lane >> 2, vpc = lane & 3;
    const int kfo = (8 * comp + hi) * 1024 + r32 * 16;
    const int vfo = 16384 + ((lane >> 4) & 1) * 32 + (lane & 3) * 8 + (4 * hi + ((lane & 15) >> 2)) * 64;
    const GAS bf16* kg = Kb + ((size_t)b * SEQ + lane) * 1024 + h * 128 + w * 8;
    const GAS bf16* vg = Vb + ((size_t)b * SEQ + 16 * (w & 3) + vrow_l) * 1024 + h * 128 + 32 * (w >> 2) + 8 * vpc;
#define PA_DMA(t) do { const int so_ = ((t) & 3) * 32768; const size_t to_ = (size_t)(t) * 65536; \
        glds16(kg + to_, (unsigned)__builtin_amdgcn_readfirstlane((int)(lds0 + so_ + w * 1024))); \
        glds16(kg + to_ + 64, (unsigned)__builtin_amdgcn_readfirstlane((int)(lds0 + so_ + (w + 8) * 1024))); \
        glds16(vg + to_, (unsigned)__builtin_amdgcn_readfirstlane((int)(lds0 + so_ + 16384 + w * 1024))); \
        glds16(vg + to_ + 64, (unsigned)__builtin_amdgcn_readfirstlane((int)(lds0 + so_ + 16384 + (w + 8) * 1024))); } while (0)
#define PA_KF(so, j) (*(const LAS bf16x8*)(lds + (so) + kfo + ((j) >> 1) * 2048 + ((j) & 1) * 512))
#define PA_VF(so, g) cat8(tr16(lds + (so) + vfo + ((g) >> 2) * 4096 + ((g) & 3) * 1024), tr16(lds + (so) + vfo + ((g) >> 2) * 4096 + ((g) & 3) * 1024 + 512))
#define PA_SEL(P0, P1, e) (((e) < 16) ? P0[(e) & 15] : P1[(e) & 15])
#define PA_WAITBAR(n) asm volatile("s_waitcnt vmcnt(" #n ") lgkmcnt(0)\n\ts_barrier" ::: "memory")
#define PA_KFJ(so, j) PA_KF(so, ((j) < 4 ? 2 * (j) : 2 * ((j) - 4) + 1))
#define PA_STEP(C0, C1, P0, P1, kso, vso, MASKED, FIRST) do { \
        bf16x8 kf_[8]; bf16x8 vf_[16]; u32x4 pk_[4]; bool resc_ = false; \
        kf_[0] = PA_KFJ(kso, 0); kf_[1] = PA_KFJ(kso, 1); kf_[2] = PA_KFJ(kso, 2); ASBAR(); \
        float sacc_ = P0[0] + P0[1]; float ma_ = 0.f; \
        _Pragma("unroll") for (int j = 0; j < 8; ++j) { \
            if (j + 3 < 8) kf_[j + 3] = PA_KFJ(kso, j + 3); else vf_[j - 5] = PA_VF(vso, j - 5); \
            if (j == 0) C0 = MFMA32(kf_[0], qr[0], negm); else if (j < 4) C0 = MFMA32(kf_[j], qr[j], C0); \
            else if (j == 4) C1 = MFMA32(kf_[4], qr[0], negm); else C1 = MFMA32(kf_[j], qr[j - 4], C1); \
            sacc_ += PA_SEL(P0, P1, 2 + 4 * j); sacc_ += PA_SEL(P0, P1, 3 + 4 * j); \
            if (j < 7) { sacc_ += PA_SEL(P0, P1, 4 + 4 * j); sacc_ += PA_SEL(P0, P1, 5 + 4 * j); } \
            APIN(sacc_); \
            pk_[j >> 1][(j & 1) * 2] = pk2(PA_SEL(P0, P1, 4 * j), PA_SEL(P0, P1, 4 * j + 1)); pk_[j >> 1][(j & 1) * 2 + 1] = pk2(PA_SEL(P0, P1, 4 * j + 2), PA_SEL(P0, P1, 4 * j + 3)); \
            APIN(pk_[j >> 1]); \
            if (j == 4) { ma_ = max3f(C0[0], C0[1], C0[2]); ma_ = max3f(ma_, C0[3], C0[4]); APIN(ma_); } \
            if (j == 5) { ma_ = max3f(ma_, C0[5], C0[6]); ma_ = max3f(ma_, C0[7], C0[8]); APIN(ma_); } \
            if (j == 6) { ma_ = max3f(ma_, C0[9], C0[10]); ma_ = max3f(ma_, C0[11], C0[12]); APIN(ma_); } \
            if (j == 7) { ma_ = max3f(ma_, C0[13], C0[14]); ma_ = fmaxf(ma_, C0[15]); APIN(ma_); } \
            ASBAR(); } \
        lrow += sacc_; \
        if (MASKED) { _Pragma("unroll") for (int r = 0; r < 16; ++r) { C0[r] = -1.0e30f; C1[r] = -1.0e30f; } ma_ = -1.0e30f; } \
        { float b_ = max3f(C1[0], C1[1], C1[2]); ma_ = max3f(ma_, C1[3], C1[4]); \
          _Pragma("unroll") for (int r = 5; r < 13; r += 4) { b_ = max3f(b_, C1[r], C1[r + 1]); ma_ = max3f(ma_, C1[r + 2], C1[r + 3]); } \
          b_ = max3f(b_, C1[13], C1[14]); ma_ = fmaxf(ma_, C1[15]); \
          const float mx_ = max32x(fmaxf(ma_, b_)); \
          if (__builtin_expect((FIRST) || __any(mx_ > 8.f), 0)) { const float dl_ = (FIRST) ? mx_ : fmaxf(mx_, 0.f); mrow += dl_; \
              _Pragma("unroll") for (int r = 0; r < 16; ++r) { C0[r] -= dl_; C1[r] -= dl_; negm[r] = -mrow; } \
              const float f_ = (FIRST) ? 0.f : __builtin_amdgcn_exp2f(-dl_); lrow *= f_; if (hi == 0) wsf[r32] = f_; resc_ = true; } } \
        ASBAR(); \
        _Pragma("unroll") for (int g = 0; g < 16; ++g) { \
            if (g + 3 < 16) vf_[g + 3] = PA_VF(vso, g + 3); \
            o[g >> 2] = MFMA32(__builtin_bit_cast(bf16x8, pk_[g & 3]), vf_[g], o[g >> 2]); \
            if (g < 8) { C0[2 * g] = __builtin_amdgcn_exp2f(C0[2 * g]); C0[2 * g + 1] = __builtin_amdgcn_exp2f(C0[2 * g + 1]); APIN(C0); } \
            else { C1[2 * g - 16] = __builtin_amdgcn_exp2f(C1[2 * g - 16]); C1[2 * g - 15] = __builtin_amdgcn_exp2f(C1[2 * g - 15]); APIN(C1); } \
            ASBAR(); } \
        if (resc_) { LDS_WAIT(); \
            _Pragma("unroll") for (int r = 0; r < 16; ++r) { const float fr_ = wsf[crow(r, hi)]; \
                _Pragma("unroll") for (int d = 0; d < 4; ++d) o[d][r] *= fr_; } } \
    } while (0)
#define PA_DRAIN(P0, P1, vso) do { float sacc_ = 0.f; \
        _Pragma("unroll") for (int r = 0; r < 16; ++r) sacc_ += P0[r] + P1[r]; \
        lrow += sacc_; u32x4 pk_[4]; \
        _Pragma("unroll") for (int k = 0; k < 4; ++k) { pk_[k][0] = pk2(PA_SEL(P0, P1, 8 * k), PA_SEL(P0, P1, 8 * k + 1)); pk_[k][1] = pk2(PA_SEL(P0, P1, 8 * k + 2), PA_SEL(P0, P1, 8 * k + 3)); \
            pk_[k][2] = pk2(PA_SEL(P0, P1, 8 * k + 4), PA_SEL(P0, P1, 8 * k + 5)); pk_[k][3] = pk2(PA_SEL(P0, P1, 8 * k + 6), PA_SEL(P0, P1, 8 * k + 7)); } \
        _Pragma("unroll") for (int g = 0; g < 16; ++g) o[g >> 2] = MFMA32(__builtin_bit_cast(bf16x8, pk_[g & 3]), PA_VF(vso, g), o[g >> 2]); } while (0)
#pragma unroll
    for (int r = 0; r < 16; ++r) { pB0[r] = 0.f; pB1[r] = 0.f; }
    mrow = 0.f;
    f32x16 negm = zero16; asm volatile("" : "+v"(negm));
    PA_DMA(0); PA_DMA(1); PA_WAITBAR(4);
    for (int i = 0; i < NT; i += 2) {
        if (i + 2 < NT) PA_DMA(i + 2);
        PA_STEP(pA0, pA1, pB0, pB1, (i & 3) * 32768, ((i == 0 ? 0 : i - 1) & 3) * 32768, false, (i == 0));
        if (i + 2 < NT) PA_WAITBAR(4); else PA_WAITBAR(0);
        if (i + 3 < NT) PA_DMA(i + 3);
        PA_STEP(pB0, pB1, pA0, pA1, ((i + 1) & 3) * 32768, (i & 3) * 32768, (half == 0 && i + 2 == NT), false);
        if (i + 3 < NT) PA_WAITBAR(4); else PA_WAITBAR(0);
    }
    PA_DRAIN(pB0, pB1, ((NT - 1) & 3) * 32768);
    __syncthreads();
#undef PA_DMA
#undef PA_KF
#undef PA_KFJ
#undef PA_VF
#undef PA_SEL
#undef PA_WAITBAR
#undef PA_STEP
#undef PA_DRAIN
    {
        const float lt = sum32x(lrow);
        if (hi == 0) wsf[32 + r32] = lt;
        LDS_WAIT();
#pragma unroll
        for (int r = 0; r < 16; ++r) { const float il = frcp(wsf[32 + crow(r, hi)]);
#pragma unroll
            for (int d = 0; d < 4; ++d) o[d][r] *= il; }
    }
    LAS float* X = (LAS float*)lds;
    if (comp == 1) {
#pragma unroll
        for (int d = 0; d < 4; ++d)
#pragma unroll
            for (int r = 0; r < 16; ++r) X[((rg * 4 + d) * 16 + r) * 64 + lane] = o[d][r];
    }
    __syncthreads();
    if (comp == 0) {
        float nw[4];
#pragma unroll
        for (int d = 0; d < 4; ++d) nw[d] = normw[32 * d + r32];
#pragma unroll
        for (int r = 0; r < 16; ++r) {
            float ss = 0.f;
#pragma unroll
            for (int d = 0; d < 4; ++d) { const float x = o[d][r] - lam * X[((rg * 4 + d) * 16 + r) * 64 + lane]; o[d][r] = x; ss += x * x; }
            ss = half_sum(ss);
            const float rs = onem * frsq(ss * (1.0f / 128.0f) + EPS);
            GAS bf16* op = O + (orow0 + crow(r, hi)) * 1024 + h * 128 + r32;
#pragma unroll
            for (int d = 0; d < 4; ++d) op[32 * d] = f2bf(o[d][r] * rs * nw[d]);
        }
    }
    __syncthreads();
}

constexpr int G_QET = 0, G_KET = 24576, G_KDT = 49152, G_VIM = 67584, G_AM = 100352, G_TOT = 109568, G_DV = 113664, G_SSQ = 114176, G_END = 116224;
static_assert(G_END <= RING_BYTES, "gla lds");
struct GlaP { const GAS bf16* QG; const GAS bf16* KG; const GAS bf16* VG; const GAS bf16* GK; const GAS bf16* RG; const GAS bf16* GA; const GAS bf16* GB; const GAS bf16* OA; GAS bf16* MG; const GAS float* gnw; };

template <bool FULL, int MODE>
__device__ __forceinline__ void gla_run(LAS unsigned char* lds, const GlaP& P, size_t m0, int h, int nch, f32x16 (&S)[4], float& dsum0, float& dsum1) {
    const int tid = opaque_tid(), lane = tid & 63, w = __builtin_amdgcn_readfirstlane(tid >> 6), r32 = lane & 31, hi = lane >> 5;
    const int trq = ((lane >> 4) & 1) * 32 + (lane & 3) * 8, q4 = (lane & 15) >> 2;
    unsigned gq[8], qv[8], kv[8]; u32x4 vpre[4];
    unsigned lo_g = (unsigned)((8 * w) * 1024 + 4 * lane), lo_v = (unsigned)((lane >> 2) * 2048 + w * 64 + (lane & 3) * 16);
#define GLA_LOADS(chn) do { const size_t mcn = m0 + (size_t)(chn) * 64; asm volatile("" : "+v"(lo_g), "+v"(lo_v)); \
        const GAS char* gkb = (const GAS char*)(P.GK + mcn * 512 + h * 128); const GAS char* qgb = (const GAS char*)(P.QG + mcn * 512 + h * 128); const GAS char* kgb = (const GAS char*)(P.KG + mcn * 512 + h * 128); \
        const GAS char* vgb = (const GAS char*)(P.VG + mcn * 1024 + h * 256); \
        _Pragma("unroll") for (int i = 0; i < 8; ++i) { const bool valid = (MODE == 0) || (8 * w + i < 16); \
            gq[i] = valid ? *(const GAS unsigned*)(gkb + i * 1024 + lo_g) : 0u; if (FULL) qv[i] = valid ? *(const GAS unsigned*)(qgb + i * 1024 + lo_g) : 0u; kv[i] = valid ? *(const GAS unsigned*)(kgb + i * 1024 + lo_g) : 0u; } \
        _Pragma("unroll") for (int i = 0; i < 4; ++i) { const int s = (lane >> 2) + 16 * i; const bool valid = (MODE == 0) || (s < 16); \
            vpre[i] = valid ? *(const GAS u32x4*)(vgb + i * 32768 + lo_v) : (u32x4){0u, 0u, 0u, 0u}; } } while (0)
    GLA_LOADS(0);
    for (int ch = 0; ch < nch; ++ch) {
        const size_t mc = m0 + (size_t)ch * 64;
        {
            float b0[8], b1[8];
#pragma unroll
            for (int i = 0; i < 8; ++i) { b0[i] = bflo(gq[i]); b1[i] = bfhi(gq[i]); }
#pragma unroll
            for (int i = 1; i < 8; ++i) { b0[i] += b0[i - 1]; b1[i] += b1[i - 1]; }
            LAS float* TOT = (LAS float*)(lds + G_TOT);
            *(LAS f32x2*)(TOT + w * 128 + 2 * lane) = (f32x2){b0[7], b1[7]};
            __syncthreads();
            float p0 = 0.f, p1 = 0.f, t0 = 0.f, t1 = 0.f;
#pragma unroll
            for (int ww = 0; ww < 8; ++ww) { const f32x2 tv = *(const LAS f32x2*)(TOT + ww * 128 + 2 * lane); if (ww < w) { p0 += tv.x; p1 += tv.y; } t0 += tv.x; t1 += tv.y; }
            u32x4 qe0, qe1, ke0, ke1, kd0, kd1;
#pragma unroll
            for (int i = 0; i < 8; i += 2) {
                float v[12];
#pragma unroll
                for (int j = 0; j < 2; ++j) {
                    const float ba = b0[i + j] + p0, bb = b1[i + j] + p1;
                    const float ka = bflo(kv[i + j]), kb_ = bfhi(kv[i + j]);
                    v[8 + j] = ka * __expf(t0 - ba); v[10 + j] = kb_ * __expf(t1 - bb);
                    if (FULL) { const float qa = bflo(qv[i + j]), qb = bfhi(qv[i + j]);
                        v[j] = qa * __expf(ba); v[2 + j] = qb * __expf(bb); v[4 + j] = ka * __expf(-ba); v[6 + j] = kb_ * __expf(-bb); }
                }
                if (FULL) { qe0[i >> 1] = pk2(v[0], v[1]); qe1[i >> 1] = pk2(v[2], v[3]); ke0[i >> 1] = pk2(v[4], v[5]); ke1[i >> 1] = pk2(v[6], v[7]); }
                kd0[i >> 1] = pk2(v[8], v[9]); kd1[i >> 1] = pk2(v[10], v[11]);
            }
            const int c0 = 2 * lane;
            if (FULL) {
                *(LAS u32x4*)(lds + G_QET + c0 * 192 + w * 16) = qe0; *(LAS u32x4*)(lds + G_QET + (c0 + 1) * 192 + w * 16) = qe1;
                *(LAS u32x4*)(lds + G_KET + c0 * 192 + w * 16) = ke0; *(LAS u32x4*)(lds + G_KET + (c0 + 1) * 192 + w * 16) = ke1;
            }
            *(LAS u32x4*)(lds + G_KDT + c0 * 144 + w * 16) = kd0; *(LAS u32x4*)(lds + G_KDT + (c0 + 1) * 144 + w * 16) = kd1;
            if (w == 0) { *(LAS f32x2*)((LAS float*)(lds + G_DV) + c0) = (f32x2){__expf(t0), __expf(t1)}; }
            dsum0 += t0; dsum1 += t1;
#pragma unroll
            for (int i = 0; i < 4; ++i) { const int s = (lane >> 2) + 16 * i; *(LAS u32x4*)(lds + G_VIM + w * 4096 + s * 64 + (lane & 3) * 16) = vpre[i]; }
            if (ch + 1 < nch) GLA_LOADS(ch + 1);
        }
        asm volatile("s_waitcnt lgkmcnt(0)\n\ts_barrier" ::: "memory");
        f32x16 o[2];
        if (FULL) {
            if (w < 3) {
                const int tb = (w + 1) >> 1, sb = w >> 1;
                f32x16 c;
#pragma unroll
                for (int r = 0; r < 16; ++r) c[r] = 0.f;
                const int tro = trq + (8 * hi + q4) * 192;
#pragma unroll
                for (int ks = 0; ks < 8; ++ks) {
                    const LAS unsigned char* ap = lds + G_KET + tro + ks * 16 * 192 + sb * 64; const LAS unsigned char* bp = lds + G_QET + tro + ks * 16 * 192 + tb * 64;
                    c = MFMA32(cat8(tr16(ap), tr16(ap + 4 * 192)), cat8(tr16(bp), tr16(bp + 4 * 192)), c);
                }
                const int t = 32 * tb + r32;
#pragma unroll
                for (int g = 0; g < 4; ++g) { const int s0 = 32 * sb + 8 * g + 4 * hi; float x[4];
#pragma unroll
                    for (int e = 0; e < 4; ++e) x[e] = (s0 + e <= t) ? c[4 * g + e] : 0.f;
                    *(LAS u32x2*)(lds + G_AM + t * 144 + s0 * 2) = (u32x2){pk2(x[0], x[1]), pk2(x[2], x[3])}; }
            } else if (w == 3) {
#pragma unroll
                for (int g = 0; g < 4; ++g) *(LAS u32x2*)(lds + G_AM + r32 * 144 + (32 + 8 * g + 4 * hi) * 2) = (u32x2){0u, 0u};
            }
            asm volatile("s_waitcnt lgkmcnt(0)\n\ts_barrier" ::: "memory");
        }
        bf16x8 vf[4];
        { const LAS unsigned char* vp = lds + G_VIM + w * 4096 + trq + (8 * hi + q4) * 64;
#pragma unroll
          for (int ss = 0; ss < 4; ++ss) vf[ss] = cat8(tr16(vp + ss * 1024), tr16(vp + ss * 1024 + 256)); }
        if (FULL) {
#pragma unroll
            for (int tb = 0; tb < 2; ++tb)
#pragma unroll
                for (int r = 0; r < 16; ++r) o[tb][r] = 0.f;
            const int trk = trq + (4 * hi + q4) * 192;
#pragma unroll
            for (int kb = 0; kb < 4; ++kb)
#pragma unroll
                for (int s2 = 0; s2 < 2; ++s2) {
                    u32x4 x; x.x = pk2(S[kb][8 * s2 + 0], S[kb][8 * s2 + 1]); x.y = pk2(S[kb][8 * s2 + 2], S[kb][8 * s2 + 3]); x.z = pk2(S[kb][8 * s2 + 4], S[kb][8 * s2 + 5]); x.w = pk2(S[kb][8 * s2 + 6], S[kb][8 * s2 + 7]);
                    const bf16x8 bS = __builtin_bit_cast(bf16x8, x);
#pragma unroll
                    for (int tb = 0; tb < 2; ++tb) { const LAS unsigned char* ap = lds + G_QET + trk + (32 * kb + 16 * s2) * 192 + tb * 64;
                        o[tb] = MFMA32(cat8(tr16(ap), tr16(ap + 8 * 192)), bS, o[tb]); }
                }
#pragma unroll
            for (int ss = 0; ss < 4; ++ss)
#pragma unroll
                for (int tb = 0; tb < 2; ++tb) { const bf16x8 a = *(const LAS bf16x8*)(lds + G_AM + (32 * tb + r32) * 144 + (16 * ss + 8 * hi) * 2);
                    o[tb] = MFMA32(a, vf[ss], o[tb]); }
        }
#pragma unroll
        for (int kb = 0; kb < 4; ++kb) {
#pragma unroll
            for (int g = 0; g < 4; ++g) { const f32x4 d4 = *(const LAS f32x4*)((LAS float*)(lds + G_DV) + 32 * kb + 8 * g + 4 * hi);
#pragma unroll
                for (int e = 0; e < 4; ++e) S[kb][4 * g + e] *= d4[e]; }
#pragma unroll
            for (int ss = 0; ss < 4; ++ss) { const bf16x8 a = *(const LAS bf16x8*)(lds + G_KDT + (32 * kb + r32) * 144 + (16 * ss + 8 * hi) * 2);
                S[kb] = MFMA32(a, vf[ss], S[kb]); }
        }
        if (FULL) {
            asm volatile("s_waitcnt lgkmcnt(0)\n\ts_barrier" ::: "memory");
            LAS float* OST = (LAS float*)lds;
#pragma unroll
            for (int tb = 0; tb < 2; ++tb)
#pragma unroll
                for (int r = 0; r < 16; ++r) OST[(32 * tb + crow(r, hi)) * 256 + 32 * w + r32] = o[tb][r];
            u32x4 erg[2], ega[2], egb[2], eoa[2];
            unsigned lo_e = (unsigned)((((MODE == 0) ? (tid >> 5) : ((tid >> 5) & 15)) * 1024 + 8 * (tid & 31)) * 2);
#define GLA_ELOADS(i0) do { asm volatile("" : "+v"(lo_e)); _Pragma("unroll") for (int i = 0; i < 2; ++i) { \
                const size_t ub = ((mc + ((MODE == 0) ? 16 * ((i0) + i) : 0)) * 1024 + h * 256) * 2; \
                erg[i] = *(const GAS u32x4*)((const GAS char*)P.RG + ub + lo_e); ega[i] = *(const GAS u32x4*)((const GAS char*)P.GA + ub + lo_e); \
                egb[i] = *(const GAS u32x4*)((const GAS char*)P.GB + ub + lo_e); eoa[i] = *(const GAS u32x4*)((const GAS char*)P.OA + ub + lo_e); } } while (0)
            GLA_ELOADS(0);
            asm volatile("s_waitcnt lgkmcnt(0)\n\ts_barrier" ::: "memory");
#pragma unroll
            for (int i0 = 0; i0 < 4; i0 += 2) {
#pragma unroll
              for (int i = 0; i < 2; ++i) {
                const int idx = tid + 512 * (i0 + i), t = idx >> 5, c8 = idx & 31;
                const f32x4 oa4 = *(const LAS f32x4*)(OST + t * 256 + 8 * c8), ob4 = *(const LAS f32x4*)(OST + t * 256 + 8 * c8 + 4);
                float ssq = (oa4.x * oa4.x + oa4.y * oa4.y) + (oa4.z * oa4.z + oa4.w * oa4.w) + (ob4.x * ob4.x + ob4.y * ob4.y) + (ob4.z * ob4.z + ob4.w * ob4.w);
                ssq = half_sum(ssq);
                const float rstd = frsq(ssq * (1.0f / 256.0f) + EPS);
                if (MODE == 0 || t < 16) {
                    const size_t off = (mc + t) * 1024 + h * 256 + 8 * c8;
                    const f32x4 gw0 = *(const GAS f32x4*)(P.gnw + 8 * c8), gw1 = *(const GAS f32x4*)(P.gnw + 8 * c8 + 4);
                    float ov[8] = {oa4.x, oa4.y, oa4.z, oa4.w, ob4.x, ob4.y, ob4.z, ob4.w}; float gwv[8] = {gw0.x, gw0.y, gw0.z, gw0.w, gw1.x, gw1.y, gw1.z, gw1.w};
                    float res[8];
#pragma unroll
                    for (int e = 0; e < 8; ++e) {
                        const unsigned ru = erg[i][e >> 1], gau = ega[i][e >> 1], gbu = egb[i][e >> 1], oau = eoa[i][e >> 1];
                        const float rv = (e & 1) ? bfhi(ru) : bflo(ru), gav = (e & 1) ? bfhi(gau) : bflo(gau), gbv = (e & 1) ? bfhi(gbu) : bflo(gbu), oav = (e & 1) ? bfhi(oau) : bflo(oau);
                        const float og = ov[e] * rstd * gwv[e] * (rv * sigmoidf_(rv));
                        res[e] = sigmoidf_(gav) * oav + sigmoidf_(gbv) * og;
                    }
                    u32x4 mo; mo.x = pk2(res[0], res[1]); mo.y = pk2(res[2], res[3]); mo.z = pk2(res[4], res[5]); mo.w = pk2(res[6], res[7]);
                    *(GAS u32x4*)(P.MG + off) = mo;
                }
              }
              if (i0 == 0) { asm volatile("" ::: "memory"); GLA_ELOADS(2); }
            }
#undef GLA_ELOADS
        }
        asm volatile("s_waitcnt lgkmcnt(0)\n\ts_barrier" ::: "memory");
    }
#undef GLA_LOADS
}
__device__ __forceinline__ void gla_store_state(GAS float* p, const f32x16 (&S)[4], int w, int r32, int hi) {
    unsigned off = (unsigned)(4 * hi * 256 + 32 * w + r32);
#pragma unroll
    for (int kb = 0; kb < 4; ++kb)
#pragma unroll
        for (int g4 = 0; g4 < 4; ++g4) {
#pragma unroll
            for (int e = 0; e < 4; ++e) p[off + e * 256] = S[kb][4 * g4 + e];
            off += 8 * 256; asm volatile("" : "+v"(off)); }
}
__device__ __forceinline__ void gla_load_state(const GAS float* p, f32x16 (&S)[4], int w, int r32, int hi) {
    unsigned off = (unsigned)(4 * hi * 256 + 32 * w + r32);
#pragma unroll
    for (int kb = 0; kb < 4; ++kb)
#pragma unroll
        for (int g4 = 0; g4 < 4; ++g4) {
#pragma unroll
            for (int e = 0; e < 4; ++e) S[kb][4 * g4 + e] = p[off + e * 256];
            off += 8 * 256; asm volatile("" : "+v"(off)); }
}

template <int XIN, int XOUT>
__device__ __forceinline__ void rowpass(const GAS bf16* tmp, const GAS float* part, int nks, const GAS float* xin_p, const GAS float* xin_s, const GAS bf16* rs_in, GAS float* xout, GAS bf16* rs_out,
                                        const GAS float* wpost, const GAS float* wnext, GAS bf16* xn, int gw, int ngw, int lane) {
    f32x4 gp[4], gn[4];
#pragma unroll
    for (int j = 0; j < 4; ++j) { gp[j] = *((const GAS f32x4*)wpost + lane + 64 * j); gn[j] = xn ? *((const GAS f32x4*)wnext + lane + 64 * j) : (f32x4){0.f, 0.f, 0.f, 0.f}; }
    u32x2 tq[4], tq_n[4]; f32x4 xq[4], xq_n[4]; u32x2 xb[4], xb_n[4];
#define RP_LOAD(mm, T, XF, XB) do { \
        if ((mm) < MP) { const GAS u32x2* tr_ = (const GAS u32x2*)(tmp + (size_t)(mm) * DM) + lane; _Pragma("unroll") for (int j = 0; j < 4; ++j) T[j] = tr_[64 * j]; } \
        if (XIN == 0) { const GAS f32x4* xr_ = (const GAS f32x4*)(((mm) < MP) ? xin_p + (size_t)(mm) * DM : xin_s + (size_t)((mm) - MP) * DM) + lane; _Pragma("unroll") for (int j = 0; j < 4; ++j) XF[j] = xr_[64 * j]; } \
        else { const GAS u32x2* xr_ = (const GAS u32x2*)(rs_in + (size_t)(mm) * DM) + lane; _Pragma("unroll") for (int j = 0; j < 4; ++j) XB[j] = xr_[64 * j]; } } while (0)
    int m = gw;
    if (m < MT) RP_LOAD(m, tq, xq, xb);
    for (; m < MT; m += ngw) {
        const int mn = m + ngw;
        if (mn < MT) RP_LOAD(mn, tq_n, xq_n, xb_n);
        f32x4 tv[4], xv[4]; float s = 0.f;
#pragma unroll
        for (int j = 0; j < 4; ++j) {
            if (m < MP) tv[j] = (f32x4){bflo(tq[j].x), bfhi(tq[j].x), bflo(tq[j].y), bfhi(tq[j].y)};
            else { f32x4 a_ = {0.f, 0.f, 0.f, 0.f}; for (int ks = 0; ks < nks; ++ks) a_ = a_ + *((const GAS f32x4*)(part + ((size_t)ks * MS + (m - MP)) * DM) + lane + 64 * j); tv[j] = a_; }
            xv[j] = (XIN == 0) ? xq[j] : (f32x4){bflo(xb[j].x), bfhi(xb[j].x), bflo(xb[j].y), bfhi(xb[j].y)};
            s += (tv[j].x * tv[j].x + tv[j].y * tv[j].y) + (tv[j].z * tv[j].z + tv[j].w * tv[j].w); }
        const float r1 = frsq(wave_sum(s) * (1.f / DM) + EPS);
        float s2 = 0.f;
#pragma unroll
        for (int j = 0; j < 4; ++j) { xv[j] = xv[j] + tv[j] * r1 * gp[j]; s2 += (xv[j].x * xv[j].x + xv[j].y * xv[j].y) + (xv[j].z * xv[j].z + xv[j].w * xv[j].w); }
        if (XOUT == 0) { GAS f32x4* orow = (GAS f32x4*)(xout + (size_t)m * DM) + lane;
#pragma unroll
            for (int j = 0; j < 4; ++j) orow[64 * j] = xv[j]; }
        else { GAS u32x2* orow = (GAS u32x2*)(rs_out + (size_t)m * DM) + lane;
#pragma unroll
            for (int j = 0; j < 4; ++j) { u32x2 o; o.x = pk2(xv[j].x, xv[j].y); o.y = pk2(xv[j].z, xv[j].w); orow[64 * j] = o; } }
        if (xn) {
            const float r2 = frsq(wave_sum(s2) * (1.f / DM) + EPS);
            GAS u32x2* o8 = (GAS u32x2*)(xn + (size_t)m * DM) + lane;
#pragma unroll
            for (int j = 0; j < 4; ++j) { const f32x4 g = gn[j]; u32x2 o; o.x = pk2(xv[j].x * r2 * g.x, xv[j].y * r2 * g.y); o.y = pk2(xv[j].z * r2 * g.z, xv[j].w * r2 * g.w); o8[64 * j] = o; }
        }
#pragma unroll
        for (int j = 0; j < 4; ++j) { tq[j] = tq_n[j]; xq[j] = xq_n[j]; xb[j] = xb_n[j]; }
    }
#undef RP_LOAD
}
__device__ __forceinline__ float gelu_tanh(float x) {
    const float u = 0.7978845608028654f * (x + 0.044715f * x * x * x);
    const float e = __expf(2.f * u);
    const float th = 1.f - 2.f * frcp(e + 1.f);
    return 0.5f * x * (1.f + th);
}
__device__ __forceinline__ void act_pass(const GAS bf16* UG, GAS bf16* ACT, const GAS float* convw, const GAS float* convb, const GAS float* sconv  ,
                                         GAS float* cout_p, GAS float* cout_s, int vcu, int G, int tid) {
    if (tid >= DFF / 8) return;
    const int c = tid * 8;
    float w0[8], w1[8], w2[8], cb[8];
#pragma unroll
    for (int e = 0; e < 8; ++e) { w0[e] = convw[c + e]; w1[e] = convw[DFF + c + e]; w2[e] = convw[2 * DFF + c + e]; cb[e] = convb[c + e]; }
    for (int strip = vcu; strip < MT / 16; strip += G) {
        const int m0 = strip * 16; const bool sample = (m0 >= MP);
        float gm2[8], gm1[8];
        if (sample) { const int b = (m0 - MP) >> 4; const GAS float* sc = sconv + (size_t)b * 2 * DFF + c;
#pragma unroll
            for (int e = 0; e < 8; ++e) { gm2[e] = sc[e]; gm1[e] = sc[DFF + e]; } }
        else if ((m0 & (SEQ - 1)) == 0) {
#pragma unroll
            for (int e = 0; e < 8; ++e) { gm2[e] = 0.f; gm1[e] = 0.f; } }
        else { const u32x4 a = *(const GAS u32x4*)(UG + (size_t)(m0 - 2) * 5632 + DFF + c), bq = *(const GAS u32x4*)(UG + (size_t)(m0 - 1) * 5632 + DFF + c);
#pragma unroll
            for (int e = 0; e < 4; ++e) { gm2[2 * e] = bflo(a[e]); gm2[2 * e + 1] = bfhi(a[e]); gm1[2 * e] = bflo(bq[e]); gm1[2 * e + 1] = bfhi(bq[e]); } }
        u32x4 ub[2][8], gb[2][8];
#pragma unroll
        for (int i = 0; i < 8; ++i) { ub[0][i] = *(const GAS u32x4*)(UG + (size_t)(m0 + i) * 5632 + c); gb[0][i] = *(const GAS u32x4*)(UG + (size_t)(m0 + i) * 5632 + DFF + c); }
#pragma unroll
        for (int hb = 0; hb < 2; ++hb) {
            if (hb == 0) {
#pragma unroll
                for (int i = 0; i < 8; ++i) { ub[1][i] = *(const GAS u32x4*)(UG + (size_t)(m0 + 8 + i) * 5632 + c); gb[1][i] = *(const GAS u32x4*)(UG + (size_t)(m0 + 8 + i) * 5632 + DFF + c); }
            }
#pragma unroll
            for (int i = 0; i < 8; ++i) {
                const size_t m = (size_t)m0 + 8 * hb + i;
                const u32x4 uu = ub[hb][i], gg = gb[hb][i];
                float g0[8], res[8];
#pragma unroll
                for (int e = 0; e < 4; ++e) { g0[2 * e] = bflo(gg[e]); g0[2 * e + 1] = bfhi(gg[e]); }
#pragma unroll
                for (int e = 0; e < 8; ++e) { const float uv = (e & 1) ? bfhi(uu[e >> 1]) : bflo(uu[e >> 1]);
                    const float gc = cb[e] + w0[e] * gm2[e] + w1[e] * gm1[e] + w2[e] * g0[e]; res[e] = gelu_tanh(gc) * uv; gm2[e] = gm1[e]; gm1[e] = g0[e]; }
                u32x4 o; o.x = pk2(res[0], res[1]); o.y = pk2(res[2], res[3]); o.z = pk2(res[4], res[5]); o.w = pk2(res[6], res[7]);
                *(GAS u32x4*)(ACT + m * DFF + c) = o;
            }
        }
        if (sample) { const int b = (m0 - MP) >> 4; GAS float* co = cout_s + (size_t)b * 2 * DFF + c;
#pragma unroll
            for (int e = 0; e < 8; ++e) { co[e] = gm2[e]; co[DFF + e] = gm1[e]; } }
        else if ((m0 & (SEQ - 1)) == SEQ - 16) { const int b = m0 >> 13; GAS float* co = cout_p + (size_t)b * 2 * DFF + c;
#pragma unroll
            for (int e = 0; e < 8; ++e) { co[e] = gm2[e]; co[DFF + e] = gm1[e]; } }
    }
}

__device__ __forceinline__ void kv_out_rows(const GAS bf16* KA, const GAS bf16* VA, GAS float* kp, GAS float* vp, GAS float* ks, GAS float* vs, int r0, int r1, int wave, int lane) {
    for (int m = r0 + wave; m < r1; m += NWAVES) {
        const GAS u32x4* kr = (const GAS u32x4*)(KA + (size_t)m * DM) + 2 * lane; const GAS u32x4* vr = (const GAS u32x4*)(VA + (size_t)m * DM) + 2 * lane;
        const u32x4 k0 = kr[0], k1 = kr[1], v0 = vr[0], v1 = vr[1];
        GAS f32x4* ko = (GAS f32x4*)((m < MP ? kp + (size_t)m * DM : ks + (size_t)(m - MP) * DM)) + 4 * lane;
        GAS f32x4* vo = (GAS f32x4*)((m < MP ? vp + (size_t)m * DM : vs + (size_t)(m - MP) * DM)) + 4 * lane;
        __builtin_nontemporal_store(((f32x4){bflo(k0.x), bfhi(k0.x), bflo(k0.y), bfhi(k0.y)}), ko);     __builtin_nontemporal_store(((f32x4){bflo(k0.z), bfhi(k0.z), bflo(k0.w), bfhi(k0.w)}), ko + 1);
        __builtin_nontemporal_store(((f32x4){bflo(k1.x), bfhi(k1.x), bflo(k1.y), bfhi(k1.y)}), ko + 2); __builtin_nontemporal_store(((f32x4){bflo(k1.z), bfhi(k1.z), bflo(k1.w), bfhi(k1.w)}), ko + 3);
        __builtin_nontemporal_store(((f32x4){bflo(v0.x), bfhi(v0.x), bflo(v0.y), bfhi(v0.y)}), vo);     __builtin_nontemporal_store(((f32x4){bflo(v0.z), bfhi(v0.z), bflo(v0.w), bfhi(v0.w)}), vo + 1);
        __builtin_nontemporal_store(((f32x4){bflo(v1.x), bfhi(v1.x), bflo(v1.y), bfhi(v1.y)}), vo + 2); __builtin_nontemporal_store(((f32x4){bflo(v1.z), bfhi(v1.z), bflo(v1.w), bfhi(v1.w)}), vo + 3);
    }
}

__global__ void __launch_bounds__(NWAVES * 64, 2) mega_fwd(Args args) {
#define AIN(i) ((const GAS float*)args.in[i])
    extern __shared__ __attribute__((aligned(16))) unsigned char lds_raw[];
    LAS unsigned char* lds = (LAS unsigned char*)lds_raw;
    volatile LAS unsigned* MISC = (volatile LAS unsigned*)(lds + MISC_OFF);
    const int tid0 = threadIdx.x;
    const int G0 = gridDim.x; const int bx0 = blockIdx.x; const int vcu0 = (G0 % 8 == 0) ? (bx0 % 8) * (G0 / 8) + bx0 / 8 : bx0;
    GAS unsigned char* ws0 = (GAS unsigned char*)args.ws;
#define OPQ() GAS unsigned char* ws = ws0; GAS float* out = out0; asm volatile("" : "+s"(ws), "+s"(out)); int G = G0, bx = bx0, vcu = vcu0; asm volatile("" : "+s"(G), "+s"(bx), "+s"(vcu)); const int NGW = G * NWAVES; (void)NGW; (void)bx; const int tid = opaque_tid(), lane = tid & 63, wave = __builtin_amdgcn_readfirstlane(tid >> 6), gw = vcu * NWAVES + wave; (void)gw; (void)lane
#define GRID_BAR() xcd_barrier_ni(bar.bar, bar.x, bar.st)
    for (int u = tid0; u < (LDS_BYTES - MISC_OFF) / 4; u += NWAVES * 64) ((LAS unsigned*)(lds + MISC_OFF))[u] = 0u;
    __syncthreads();
    XcdBarrier bar = xcd_barrier_post((unsigned*)args.ws + CW_BAR, MISC + 8);
    (void)args.ph_lo;
#ifndef PHMASK
#define PHMASK 0xfffff
#endif
#define IN(k) true
#define EN(i) ((PHMASK >> (i)) & 1)
#ifndef REPMASK
#define REPMASK 0
#endif
#define REP(i) ((REPMASK >> (i)) & 1)
#ifndef NOFOLD
#define NOFOLD 0
#endif
    GAS float* const out0 = (GAS float*)args.out;

    if (EN(0) && IN(0)) { OPQ(); GAS bf16* const XN = (GAS bf16*)(ws + WS_XN);
        LAS float* scr = (LAS float*)(lds + wave * 16384);
        for (int li = 0; li < DEPTH; ++li) {
            GAS unsigned char* wl = ws + WS_W + (size_t)li * W_LAYER;
            const GAS float* w_in = AIN(I_WIN) + (size_t)li * DM * DIN; const GAS float* w_gk2 = AIN(I_WGK2) + (size_t)li * 16 * 512;
            const GAS float* w_o = AIN(I_WO) + (size_t)li * DM * DM; const GAS float* w_up = AIN(I_WUP) + (size_t)li * DM * 2 * DFF; const GAS float* w_dn = AIN(I_WDOWN) + (size_t)li * DFF * DM;
            constexpr int IT_IN = (NIN / 32) * 16, IT_O = 32 * 16, IT_UP = (2 * DFF / 32) * 16, IT_DN = 32 * (DFF / 64);
            for (int it = gw; it < IT_IN + IT_O + IT_UP + IT_DN; it += NGW) {
                int r = it;
                if (r < IT_IN) { const int nb = r >> 4, kb = r & 15;
                    if (nb < 192) transpose_item(w_in, DIN, DM, (GAS bf16*)(wl + W_IN), scr, kb, 32 * nb, 32 * nb, lane, nullptr);
                    else if (nb < 256) transpose_item(w_in, DIN, DM, (GAS bf16*)(wl + W_IN), scr, kb, 32 * nb + 16, 32 * nb, lane, nullptr);
                    else transpose_item(w_in, DIN, DM, (GAS bf16*)(wl + W_IN), scr, kb, 32 * (nb - 256), 32 * nb, lane, w_gk2);
                    continue; }
                r -= IT_IN;
                if (r < IT_O) { transpose_item(w_o, DM, DM, (GAS bf16*)(wl + W_O), scr, r & 15, 32 * (r >> 4), 32 * (r >> 4), lane, nullptr); continue; }
                r -= IT_O;
                if (r < IT_UP) { transpose_item(w_up, 2 * DFF, DM, (GAS bf16*)(wl + W_UP), scr, r & 15, 32 * (r >> 4), 32 * (r >> 4), lane, nullptr); continue; }
                r -= IT_UP;
                { const int nb = r / (DFF / 64), kb = r % (DFF / 64); transpose_item(w_dn, DM, DFF, (GAS bf16*)(wl + W_DN), scr, kb, 32 * nb, 32 * nb, lane, nullptr); }
            }
        }
        for (int i = vcu * 512 + tid; i < SEQ * 8; i += G * 512) { const int pos = i >> 3, f = i & 7; float sn, cs; sincos_acc((float)pos * args.inv_freq[f], sn, cs);
            ((GAS float*)(ws + WS_ROPE))[pos * 16 + f] = cs; ((GAS float*)(ws + WS_ROPE))[pos * 16 + 8 + f] = sn; }
        { f32x4 gpm[4], xc[4], xnx[4];
#pragma unroll
          for (int j = 0; j < 4; ++j) gpm[j] = *((const GAS f32x4*)AIN(I_PREMIX) + lane + 64 * j);
#define P0_LOAD(mm, X) do { const GAS f32x4* xr_ = (const GAS f32x4*)(((mm) < MP) ? AIN(I_XP) + (size_t)(mm) * DM : AIN(I_XS) + (size_t)((mm) - MP) * DM) + lane; _Pragma("unroll") for (int j = 0; j < 4; ++j) X[j] = xr_[64 * j]; } while (0)
          int m = gw; if (m < MT) P0_LOAD(m, xc);
          for (; m < MT; m += NGW) {
              if (m + NGW < MT) P0_LOAD(m + NGW, xnx);
              float sq = 0.f;
#pragma unroll
              for (int j = 0; j < 4; ++j) sq += (xc[j].x * xc[j].x + xc[j].y * xc[j].y) + (xc[j].z * xc[j].z + xc[j].w * xc[j].w);
              const float rstd = frsq(wave_sum(sq) * (1.f / DM) + EPS);
              GAS u32x2* o8 = (GAS u32x2*)(XN + (size_t)m * DM) + lane;
#pragma unroll
              for (int j = 0; j < 4; ++j) { u32x2 o; o.x = pk2(xc[j].x * rstd * gpm[j].x, xc[j].y * rstd * gpm[j].y); o.y = pk2(xc[j].z * rstd * gpm[j].z, xc[j].w * rstd * gpm[j].w); o8[64 * j] = o; }
#pragma unroll
              for (int j = 0; j < 4; ++j) xc[j] = xnx[j];
          }
#undef P0_LOAD
        }
        GRID_BAR();
    }

    for (int li = 0; li < DEPTH; ++li) {
        const int pb = 1 + li * 16;
        if (EN(1) && IN(pb + 0)) { OPQ(); GAS unsigned char* wl = ws + WS_W + (size_t)li * W_LAYER; GAS bf16* const XN = (GAS bf16*)(ws + WS_XN); const GAS float* rope = (const GAS float*)(ws + WS_ROPE);
          for (int rep = 0; rep < ((REP(1) && li == 0) ? 2 : 1); ++rep) {
            pg8::Gemm g{(const GAS pg8::bf16_t*)XN, (const GAS pg8::bf16_t*)(wl + W_IN), MT, NIN, DM, DM}; pg8::StaticOrder S; S.init(MT, NIN, G, bx, 4);
            EpiIn E{ws, out + O_KP + (size_t)li * MP * DM, out + O_VP + (size_t)li * MP * DM, out + O_KS + (size_t)li * MS * DM, out + O_VS + (size_t)li * MS * DM, rope, AIN(I_BGK2) + li * 512};
            pg8::gemm_phase<EpiIn, pg8::StaticOrder, true, true>(lds, g, S, E);
            GRID_BAR();
          }
        }
        if (EN(2) && IN(pb + 1)) { OPQ(); GAS unsigned char* wl = ws + WS_W + (size_t)li * W_LAYER; GAS bf16* const XN = (GAS bf16*)(ws + WS_XN); const GAS float* rope = (const GAS float*)(ws + WS_ROPE);
          for (int rep = 0; rep < ((REP(2) && li == 0) ? 2 : 1); ++rep) {
            float lam, onem;
            { const float a = wave_sum(AIN(I_LQ1)[li * 64 + lane] * AIN(I_LK1)[li * 64 + lane]), c = wave_sum(AIN(I_LQ2)[li * 64 + lane] * AIN(I_LK2)[li * 64 + lane]);
              const float lam_init = 0.8f - 0.6f * expf(-0.3f * (float)li); lam = expf(a) - expf(c) + lam_init; onem = 1.0f - lam_init; }
            const GAS bf16* QA = (const GAS bf16*)(ws + WS_QA); const GAS bf16* KA = (const GAS bf16*)(ws + WS_KA); const GAS bf16* VA = (const GAS bf16*)(ws + WS_VA);
            const GAS float* nw = AIN(I_DANW) + li * 128;
            for (int rp = 0; rp < ((REP(10) && li == 0) ? 2 : 1); ++rp)
            if (EN(10)) for (int un = vcu; un < DB * 8; un += G)
                attn_unit<1>(lds, QA, KA, VA, (GAS bf16*)(ws + WS_OA), AIN(I_CK) + (size_t)li * DB * PAST * DM, AIN(I_CV) + (size_t)li * DB * PAST * DM, un >> 3, un & 7, 0, lam, onem, nw);
            for (int rp = 0; rp < ((REP(11) && li == 0) ? 2 : 1); ++rp)
            if (EN(11)) for (int it = vcu; it < 256; it += G) {
                GlaP P{(const GAS bf16*)(ws + WS_QG), (const GAS bf16*)(ws + WS_KG), (const GAS bf16*)(ws + WS_VG), (const GAS bf16*)(ws + WS_GK), nullptr, nullptr, nullptr, nullptr, nullptr, nullptr};
                f32x16 S[4];
#pragma unroll
                for (int kb = 0; kb < 4; ++kb)
#pragma unroll
                    for (int r = 0; r < 16; ++r) S[kb][r] = 0.f;
                float ds0 = 0.f, ds1 = 0.f;
                const int bh = it >> 3, grp = it & 7;
                gla_run<false, 0>(lds, P, (size_t)(bh >> 2) * SEQ + grp * 1024, bh & 3, 16, S, ds0, ds1);
                gla_store_state((GAS float*)(ws + WS_SLOC) + (size_t)it * 32768, S, wave, lane & 31, lane >> 5);
                if (wave == 0) { GAS float* dg = (GAS float*)(ws + WS_DG) + it * 128 + 2 * lane; dg[0] = __expf(ds0); dg[1] = __expf(ds1); }
            }
            if (EN(12)) for (int pi = vcu; pi < 2048; pi += G) {
                const int bh = (pi % 256) >> 2, s = (pi & 3) + 4 * (pi / 256);
                attn_prompt_unit(lds, QA, KA, VA, (GAS bf16*)(ws + WS_OA), bh >> 3, bh & 7, 63 - s, lam, onem, nw);
                attn_prompt_unit(lds, QA, KA, VA, (GAS bf16*)(ws + WS_OA), bh >> 3, bh & 7, s, lam, onem, nw);
            }
            GRID_BAR();
          }
        }
        if (EN(3) && IN(pb + 2)) { OPQ(); GAS unsigned char* wl = ws + WS_W + (size_t)li * W_LAYER; GAS bf16* const XN = (GAS bf16*)(ws + WS_XN); const GAS float* rope = (const GAS float*)(ws + WS_ROPE);
          for (int rep = 0; rep < ((REP(3) && li == 0) ? 2 : 1); ++rep) {
            GlaP P{(const GAS bf16*)(ws + WS_QG), (const GAS bf16*)(ws + WS_KG), (const GAS bf16*)(ws + WS_VG), (const GAS bf16*)(ws + WS_GK), (const GAS bf16*)(ws + WS_RG), (const GAS bf16*)(ws + WS_GA), (const GAS bf16*)(ws + WS_GB),
                   (const GAS bf16*)(ws + WS_OA), (GAS bf16*)(ws + WS_QA), AIN(I_GLANW) + li * 256};
            const int r32 = lane & 31, hh = lane >> 5;
            if (EN(13)) for (int it = vcu; it < 256; it += G) {
                const int bh = it >> 3, grp = it & 7;
                f32x16 S[4];
#pragma unroll
                for (int kb = 0; kb < 4; ++kb)
#pragma unroll
                    for (int r = 0; r < 16; ++r) S[kb][r] = 0.f;
                for (int j = 0; j < (NOFOLD ? 0 : grp); ++j) {
                    const GAS float* dg = (const GAS float*)(ws + WS_DG) + (size_t)(bh * 8 + j) * 128 + 4 * hh; const GAS float* sl = (const GAS float*)(ws + WS_SLOC) + (size_t)(bh * 8 + j) * 32768;
                    unsigned off = (unsigned)(4 * hh * 256 + 32 * wave + r32);
#pragma unroll
                    for (int kb = 0; kb < 4; ++kb)
#pragma unroll
                        for (int g4 = 0; g4 < 4; ++g4) { const f32x4 d4 = *(const GAS f32x4*)(dg + 32 * kb + 8 * g4);
#pragma unroll
                            for (int e = 0; e < 4; ++e) S[kb][4 * g4 + e] = S[kb][4 * g4 + e] * d4[e] + sl[off + e * 256];
                            off += 8 * 256; asm volatile("" : "+v"(off)); }
                }
                float ds0 = 0.f, ds1 = 0.f;
                gla_run<true, 0>(lds, P, (size_t)(bh >> 2) * SEQ + grp * 1024, bh & 3, 16, S, ds0, ds1);
                if (grp == 7) gla_store_state(out + O_GP + ((size_t)li * 32 + bh) * 32768, S, wave, r32, hh);
            }
            if (EN(14)) for (int it = vcu; it < DB * 4; it += G) {
                const int b = it >> 2, h = it & 3;
                const GAS float* s0 = AIN(I_SG) + ((size_t)li * DB * 4 + it) * 32768;
                f32x16 S[4];
                gla_load_state(s0, S, wave, r32, hh);
                float ds0 = 0.f, ds1 = 0.f;
                gla_run<true, 1>(lds, P, (size_t)MP + b * 16, h, 1, S, ds0, ds1);
                gla_store_state(out + O_GS + ((size_t)li * DB * 4 + it) * 32768, S, wave, r32, hh);
            }
            GRID_BAR();
          }
        }
        if (EN(4) && IN(pb + 3)) { OPQ(); GAS unsigned char* wl = ws + WS_W + (size_t)li * W_LAYER; GAS bf16* const XN = (GAS bf16*)(ws + WS_XN); const GAS float* rope = (const GAS float*)(ws + WS_ROPE);
          for (int rep = 0; rep < ((REP(4) && li == 0) ? 2 : 1); ++rep) {
            pg8::Gemm g{(const GAS pg8::bf16_t*)(ws + WS_QA), (const GAS pg8::bf16_t*)(wl + W_O), MP, DM, DM, DM}; pg8::StaticOrder S; S.init(MP, DM, G, bx);
            EpiB16 E{(GAS bf16*)(ws + WS_TMP), DM};
            pg8::gemm_phase<EpiB16, pg8::StaticOrder, true, true>(lds, g, S, E);
            { pg8::Gemm g2{(const GAS pg8::bf16_t*)(ws + WS_QA), (const GAS pg8::bf16_t*)(wl + W_O), MT, DM, 256, DM}; SplitOrder S2{G, bx, DM / 256, 256};
              EpiPart E2{(GAS float*)(ws + WS_PART), 256};
              pg8::gemm_phase<EpiPart, SplitOrder, true, true>(lds, g2, S2, E2); }
            GRID_BAR();
          }
        }
        if (EN(5) && IN(pb + 4)) { OPQ(); GAS unsigned char* wl = ws + WS_W + (size_t)li * W_LAYER; GAS bf16* const XN = (GAS bf16*)(ws + WS_XN); const GAS float* rope = (const GAS float*)(ws + WS_ROPE);
          for (int rep = 0; rep < ((REP(5) && li == 0) ? 2 : 1); ++rep) {
            { const GAS bf16* tmp_ = (const GAS bf16*)(ws + WS_TMP); const GAS float* part_ = (const GAS float*)(ws + WS_PART); GAS bf16* rs_ = (GAS bf16*)(ws + WS_RS);
              if (li == 0) rowpass<0, 1>(tmp_, part_, DM / 256, AIN(I_XP), AIN(I_XS), nullptr, nullptr, rs_, AIN(I_POSTMIX) + li * DM, AIN(I_PREFFN) + li * DM, XN, gw, NGW, lane);
              else         rowpass<1, 1>(tmp_, part_, DM / 256, nullptr, nullptr, rs_, nullptr, rs_, AIN(I_POSTMIX) + li * DM, AIN(I_PREFFN) + li * DM, XN, gw, NGW, lane); }
            GRID_BAR();
          }
        }
        if (EN(6) && IN(pb + 5)) { OPQ(); GAS unsigned char* wl = ws + WS_W + (size_t)li * W_LAYER; GAS bf16* const XN = (GAS bf16*)(ws + WS_XN); const GAS float* rope = (const GAS float*)(ws + WS_ROPE);
          for (int rep = 0; rep < ((REP(6) && li == 0) ? 2 : 1); ++rep) {
            pg8::Gemm g{(const GAS pg8::bf16_t*)XN, (const GAS pg8::bf16_t*)(wl + W_UP), MT, 2 * DFF, DM, DM}; pg8::StaticOrder S; S.init(MT, 2 * DFF, G, bx);
            EpiB16 E{(GAS bf16*)(ws + WS_UG), 2 * DFF};
            pg8::gemm_phase<EpiB16, pg8::StaticOrder, true, true>(lds, g, S, E);
            GRID_BAR();
          }
        }
        if (EN(7) && IN(pb + 6)) { OPQ(); GAS unsigned char* wl = ws + WS_W + (size_t)li * W_LAYER; GAS bf16* const XN = (GAS bf16*)(ws + WS_XN); const GAS float* rope = (const GAS float*)(ws + WS_ROPE);
          for (int rep = 0; rep < ((REP(7) && li == 0) ? 2 : 1); ++rep) {
            act_pass((const GAS bf16*)(ws + WS_UG), (GAS bf16*)(ws + WS_ACT), AIN(I_CONVW) + (size_t)li * 3 * DFF, AIN(I_CONVB) + (size_t)li * DFF, AIN(I_SC) + (size_t)li * DB * 2 * DFF,
                     out + O_CP + (size_t)li * NB * 2 * DFF, out + O_CS + (size_t)li * DB * 2 * DFF, vcu, G, tid);
            GRID_BAR();
          }
        }
        if (EN(8) && IN(pb + 7)) { OPQ(); GAS unsigned char* wl = ws + WS_W + (size_t)li * W_LAYER; GAS bf16* const XN = (GAS bf16*)(ws + WS_XN); const GAS float* rope = (const GAS float*)(ws + WS_ROPE);
          for (int rep = 0; rep < ((REP(8) && li == 0) ? 2 : 1); ++rep) {
            pg8::Gemm g{(const GAS pg8::bf16_t*)(ws + WS_ACT), (const GAS pg8::bf16_t*)(wl + W_DN), MP, DM, DFF, DFF}; pg8::StaticOrder S; S.init(MP, DM, G, bx);
            EpiB16 E{(GAS bf16*)(ws + WS_TMP), DM};
            pg8::gemm_phase<EpiB16, pg8::StaticOrder, true, true>(lds, g, S, E);
            { pg8::Gemm g2{(const GAS pg8::bf16_t*)(ws + WS_ACT), (const GAS pg8::bf16_t*)(wl + W_DN), MT, DM, 256, DFF}; SplitOrder S2{G, bx, DFF / 256, 256};
              EpiPart E2{(GAS float*)(ws + WS_PART), 256};
              pg8::gemm_phase<EpiPart, SplitOrder, true, true>(lds, g2, S2, E2); }
            GRID_BAR();
          }
        }
        if (EN(9) && IN(pb + 8)) { OPQ(); GAS unsigned char* wl = ws + WS_W + (size_t)li * W_LAYER; GAS bf16* const XN = (GAS bf16*)(ws + WS_XN); const GAS float* rope = (const GAS float*)(ws + WS_ROPE);
            const bool more = (li + 1 < DEPTH);
            { const GAS bf16* tmp_ = (const GAS bf16*)(ws + WS_TMP); const GAS float* part_ = (const GAS float*)(ws + WS_PART); GAS bf16* rs_ = (GAS bf16*)(ws + WS_RS);
              if (more) rowpass<1, 1>(tmp_, part_, DFF / 256, nullptr, nullptr, rs_, nullptr, rs_, AIN(I_POSTFFN) + li * DM, AIN(I_PREMIX) + (li + 1) * DM, XN, gw, NGW, lane);
              else      rowpass<1, 0>(tmp_, part_, DFF / 256, nullptr, nullptr, rs_, out, nullptr, AIN(I_POSTFFN) + li * DM, nullptr, nullptr, gw, NGW, lane); }
            if (more) GRID_BAR();
        }
    }
#undef IN
}

extern "C" void kernel_launch(void* const* d_in, const int* in_sizes, int n_in, void* d_out, int out_size, void* d_ws, size_t ws_size, hipStream_t stream) {
    static int grid = 0;
    if (grid == 0) {
        if (n_in != 24 || (size_t)out_size != O_END || ws_size < WS_END) { fprintf(stderr, "kernel_launch: unexpected shapes: n_in %d out %d (want %zu) ws %zu (want %zu)\n", n_in, out_size, (size_t)O_END, ws_size, (size_t)WS_END); grid = -1; return; }
        int dev = 0, cus = 0, per_cu = 0;
        if (hipGetDevice(&dev) != hipSuccess || hipDeviceGetAttribute(&cus, hipDeviceAttributeMultiprocessorCount, dev) != hipSuccess) { grid = -1; return; }
        if (hipFuncSetAttribute((const void*)mega_fwd, hipFuncAttributeMaxDynamicSharedMemorySize, LDS_BYTES) != hipSuccess) { fprintf(stderr, "kernel_launch: hipFuncSetAttribute failed\n"); grid = -1; return; }
        if (hipOccupancyMaxActiveBlocksPerMultiprocessor(&per_cu, (const void*)mega_fwd, NWAVES * 64, LDS_BYTES) != hipSuccess || per_cu < 1) { fprintf(stderr, "kernel_launch: occupancy query reports %d\n", per_cu); }
        (void)hipGetLastError();
        grid = cus;
    }
    if (grid < 0) return;
    if (hipMemsetAsync((char*)d_ws + WS_CTL, 0, CTL_ZERO_BYTES, stream) != hipSuccess) return;
    Args a{};
    for (int i = 0; i < 24; ++i) a.in[i] = (const float*)d_in[i];
    a.out = (float*)d_out; a.ws = (unsigned char*)d_ws;
    for (int i = 0; i < 8; ++i) a.inv_freq[i] = (float)pow(500000.0, -(double)i / 8.0);
    a.ph_lo = 0; a.ph_hi = 1000;
    hipLaunchKernelGGL(mega_fwd, dim3(grid), dim3(NWAVES * 64), LDS_BYTES, stream, a);
}
```

```cpp
#include <hip/hip_runtime.h>
#include <cstdio>
#include <cstdint>
#include <cmath>
__device__ __forceinline__ int opaque_tid() { int t = threadIdx.x; asm volatile("" : "+v"(t)); return t; }
namespace pg8 {
#define PG8_LAS __attribute__((address_space(3)))
typedef unsigned short bf16_t;
typedef short bf16x8 __attribute__((ext_vector_type(8)));
typedef float f32x4 __attribute__((ext_vector_type(4)));
typedef unsigned u32x4 __attribute__((ext_vector_type(4)));
constexpr int BM = 256, BK = 64, HALF = 128, HTB = HALF * BK * 2  , STAGE_BYTES = 8 * HTB, NXCD = 8, WGM = 8;

__host__ __device__ __forceinline__ int lds_byte(int r, int c) { const int st = (r >> 4) * 2 + (c >> 5), rr = r & 15, cc = c & 31, ob = rr * 64 + cc * 2; return st * 1024 + (ob ^ (((ob >> 9) & 1) << 5)); }
__host__ __device__ __forceinline__ void stage_rc(int b, int& R, int& C) { const int st = b / 1024, sb = b % 1024, swz = sb ^ (((sb >> 9) & 1) << 5); R = (st >> 1) * 16 + swz / 64; C = (st & 1) * 32 + (swz % 64) / 2; }
__host__ __device__ __forceinline__ int perm32(int rho) { const int n = rho >> 4, i = rho & 15; return 8 * (i >> 2) + 4 * n + (i & 3); }

struct Unit { int pm, pn, ko; };
struct Gemm { const __attribute__((address_space(1))) bf16_t* A; const __attribute__((address_space(1))) bf16_t* Bt; int M, N, K, ld; };

struct StaticOrder {
    int nM, nN, nwg, G, c, rot;
    __host__ __device__ void init(int M, int N, int G_, int c_, int rot_ = 0) { nM = M / BM; nN = N / BM; nwg = nM * nN; G = G_; c = c_; rot = rot_; }
    __host__ __device__ bool next(int i, Unit& u) const {
        const long L = (long)i * G + c; if (L >= nwg) return false;
        int wgid = (int)L; { const int q = nwg / NXCD, r = nwg % NXCD, xcd = wgid % NXCD, off = wgid / NXCD; wgid = (xcd < r ? xcd * (q + 1) : r * (q + 1) + (xcd - r) * q) + off; }
        const int nig = WGM * nN, gid = wgid / nig, fm = gid * WGM, gsz = (nM - fm) < WGM ? (nM - fm) : WGM;
        u.pm = fm + ((wgid % nig) % gsz); u.pn = ((wgid % nig) / gsz + rot * gid) % nN; u.ko = 0; return true;
    }
    __device__ __forceinline__ void a_ready(const Unit&) const {}
    __device__ __forceinline__ void done(const Unit&) const {}
};

__device__ __forceinline__ unsigned cvt_pk_bf16(float lo, float hi) { unsigned r; asm volatile("v_cvt_pk_bf16_f32 %0, %1, %2" : "=v"(r) : "v"(lo), "v"(hi)); return r; }
template <class Epi, class Sched, bool ALIGN_EPI = false, bool SP2 = false>
__device__ __forceinline__ void gemm_phase(PG8_LAS unsigned char* lds, const Gemm g, const Sched& S, const Epi& E) {
    const int tid = opaque_tid(), wid = __builtin_amdgcn_readfirstlane(tid >> 6), lane = tid & 63, wr = wid >> 2, wc = wid & 3, fr = lane & 15, fq = lane >> 4;
    const int K = g.ld, nt = g.K / BK;
    unsigned voffA[2], voffB[2];
#pragma unroll
    for (int i = 0; i < 2; ++i) { int R, C; stage_rc(tid * 16 + i * 8192, R, C); const int Rb = Epi::PERM ? ((R & ~31) + perm32(R & 31)) : R;
        voffA[i] = (unsigned)(R * K + C) * 2u; voffB[i] = (unsigned)(Rb * K + C) * 2u; }
    const size_t kstep = (size_t)(BK * 2);
    const size_t hstep = (size_t)HALF * K * 2;
    const size_t tstep = 2 * hstep;
    const unsigned ldsw = (unsigned)wid * 1024u;
    const int aoff = lds_byte(wr * 64 + fr, fq * 8), boff = lds_byte(wc * 32 + fr, fq * 8);
#define PG8_SA(b, h) (((b) * 2 + (h)) * HTB)
#define PG8_SB(b, h) ((4 + (b) * 2 + (h)) * HTB)
#define PG8_STAGE(bufoff, gbase, voff) do { _Pragma("unroll") for (int _i = 0; _i < 2; ++_i) \
        __builtin_amdgcn_global_load_lds((const unsigned*)((const char*)(gbase) + (voff)[_i]), (PG8_LAS unsigned*)(lds + (bufoff) + ldsw + _i * 8192), 16, 0, 0); } while (0)
#define PG8_LDA(dst, b, h) do { _Pragma("unroll") for (int m = 0; m < 4; ++m) _Pragma("unroll") for (int k = 0; k < 2; ++k) dst[m][k] = *(const PG8_LAS bf16x8*)(lds + PG8_SA(b, h) + aoff + m * 2048 + k * 1024); } while (0)
#define PG8_LDB(dst, b, h) do { _Pragma("unroll") for (int n = 0; n < 2; ++n) _Pragma("unroll") for (int k = 0; k < 2; ++k) dst[n][k] = *(const PG8_LAS bf16x8*)(lds + PG8_SB(b, h) + boff + n * 2048 + k * 1024); } while (0)
#define PG8_MMA(ai, bj, At, Bt) do { __builtin_amdgcn_s_setprio(1); _Pragma("unroll") for (int m = 0; m < 4; ++m) _Pragma("unroll") for (int n = 0; n < 2; ++n) _Pragma("unroll") for (int k = 0; k < 2; ++k) \
        acc[ai][bj][m][n] = __builtin_amdgcn_mfma_f32_16x16x32_bf16(Bt[n][k], At[m][k], acc[ai][bj][m][n], 0, 0, 0); __builtin_amdgcn_s_setprio(0); } while (0)
#define PG8_WAIT_V(n) asm volatile("s_waitcnt vmcnt(" #n ")" ::: "memory")
#define PG8_WAIT_L(n) asm volatile("s_waitcnt lgkmcnt(" #n ")" ::: "memory")
#define PG8_BAR __builtin_amdgcn_s_barrier()
#define PG8_SCHED __builtin_amdgcn_sched_barrier(0)
    Unit cur, nxt; int ui = 0;
    if (!S.next(0, cur)) return;
    f32x4 acc[2][2][4][2];
#pragma unroll
    for (int a = 0; a < 2; ++a)
#pragma unroll
        for (int b = 0; b < 2; ++b)
#pragma unroll
            for (int m = 0; m < 4; ++m)
#pragma unroll
                for (int n = 0; n < 2; ++n) acc[a][b][m][n] = (f32x4){0.f, 0.f, 0.f, 0.f};
    bf16x8 At[4][2], B0[2][2], B1[2][2];
    const char* cA = (const char*)g.A + (size_t)cur.pm * tstep + (size_t)cur.ko * 2; const char* cB = (const char*)g.Bt + (size_t)cur.pn * tstep + (size_t)cur.ko * 2;
    S.a_ready(cur);
    if constexpr (SP2) {
        PG8_STAGE(PG8_SB(0, 0), cB, voffB); PG8_STAGE(PG8_SB(0, 1), cB + hstep, voffB); PG8_STAGE(PG8_SA(0, 0), cA, voffA); PG8_STAGE(PG8_SA(0, 1), cA + hstep, voffA);
        if (wr == 1) PG8_BAR;
        PG8_WAIT_V(2); PG8_BAR;
        PG8_STAGE(PG8_SB(1, 0), cB + kstep, voffB); PG8_STAGE(PG8_SA(1, 0), cA + kstep, voffA); PG8_STAGE(PG8_SB(1, 1), cB + hstep + kstep, voffB);
        PG8_WAIT_V(6); PG8_BAR;
    } else {
        PG8_STAGE(PG8_SB(0, 0), cB, voffB); PG8_STAGE(PG8_SA(0, 0), cA, voffA); PG8_STAGE(PG8_SB(0, 1), cB + hstep, voffB); PG8_STAGE(PG8_SA(0, 1), cA + hstep, voffA);
        if (wr == 1) PG8_BAR;
        PG8_WAIT_V(4); PG8_BAR;
        PG8_STAGE(PG8_SB(1, 0), cB + kstep, voffB); PG8_STAGE(PG8_SA(1, 0), cA + kstep, voffA); PG8_STAGE(PG8_SB(1, 1), cB + hstep + kstep, voffB);
        PG8_WAIT_V(6); PG8_BAR;
    }
    for (;;) {
        const bool has_next = S.next(ui + 1, nxt);
        const char* nA = has_next ? (const char*)g.A + (size_t)nxt.pm * tstep + (size_t)nxt.ko * 2 : cA; const char* nB = has_next ? (const char*)g.Bt + (size_t)nxt.pn * tstep + (size_t)nxt.ko * 2 : cB;
        for (int t = 0; t < nt; t += 2) {
            const bool last = (t == nt - 2);
            const char* a1 = cA + (size_t)(t + 1) * kstep;
            const char* a2 = last ? nA : cA + (size_t)(t + 2) * kstep; const char* b2 = last ? nB : cB + (size_t)(t + 2) * kstep;
            const char* a3 = a2 + kstep; const char* b3 = b2 + kstep;
            if (last && has_next) S.a_ready(nxt);
            if constexpr (SP2) {
            PG8_LDB(B0, 0, 0); PG8_LDB(B1, 0, 1); PG8_SCHED; PG8_LDA(At, 0, 0); PG8_STAGE(PG8_SA(1, 1), a1 + hstep, voffA);
            PG8_WAIT_V(8); PG8_WAIT_L(0); PG8_BAR; PG8_MMA(0, 0, At, B0); PG8_MMA(0, 1, At, B1); PG8_BAR; PG8_SCHED;
            PG8_LDA(At, 0, 1); PG8_STAGE(PG8_SB(0, 0), b2, voffB); PG8_STAGE(PG8_SB(0, 1), b2 + hstep, voffB); PG8_STAGE(PG8_SA(0, 0), a2, voffA);
            PG8_WAIT_V(8); PG8_WAIT_L(0); PG8_BAR; PG8_MMA(1, 0, At, B0); PG8_MMA(1, 1, At, B1); PG8_BAR; PG8_SCHED;
            PG8_LDB(B0, 1, 0); PG8_LDB(B1, 1, 1); PG8_SCHED; PG8_LDA(At, 1, 0); PG8_STAGE(PG8_SA(0, 1), a2 + hstep, voffA);
            PG8_WAIT_V(8); PG8_WAIT_L(0); PG8_BAR; PG8_MMA(0, 0, At, B0); PG8_MMA(0, 1, At, B1); PG8_BAR; PG8_SCHED;
            PG8_LDA(At, 1, 1); PG8_STAGE(PG8_SB(1, 0), b3, voffB); PG8_STAGE(PG8_SB(1, 1), b3 + hstep, voffB); PG8_STAGE(PG8_SA(1, 0), a3, voffA);
            PG8_WAIT_V(8); PG8_WAIT_L(0); PG8_BAR; PG8_MMA(1, 0, At, B0); PG8_MMA(1, 1, At, B1); PG8_BAR; PG8_SCHED;
            } else {
            PG8_LDB(B0, 0, 0); PG8_SCHED; PG8_LDA(At, 0, 0); PG8_STAGE(PG8_SA(1, 1), a1 + hstep, voffA);
            PG8_WAIT_L(8); PG8_BAR; PG8_WAIT_L(0); PG8_MMA(0, 0, At, B0); PG8_BAR; PG8_SCHED;
            PG8_LDB(B1, 0, 1); PG8_STAGE(PG8_SB(0, 0), b2, voffB);
            PG8_BAR; PG8_WAIT_L(0); PG8_MMA(0, 1, At, B1); PG8_BAR;
            PG8_LDA(At, 0, 1); PG8_STAGE(PG8_SA(0, 0), a2, voffA);
            PG8_BAR; PG8_WAIT_L(0); PG8_MMA(1, 0, At, B0); PG8_BAR; PG8_SCHED;
            PG8_STAGE(PG8_SB(0, 1), b2 + hstep, voffB);
            PG8_WAIT_V(6); PG8_BAR; PG8_MMA(1, 1, At, B1); PG8_BAR;
            PG8_LDB(B0, 1, 0); PG8_SCHED; PG8_LDA(At, 1, 0); PG8_STAGE(PG8_SA(0, 1), a2 + hstep, voffA);
            PG8_WAIT_L(8); PG8_BAR; PG8_WAIT_L(0); PG8_MMA(0, 0, At, B0); PG8_BAR; PG8_SCHED;
            PG8_LDB(B1, 1, 1); PG8_STAGE(PG8_SB(1, 0), b3, voffB);
            PG8_BAR; PG8_WAIT_L(0); PG8_MMA(0, 1, At, B1); PG8_BAR;
            PG8_LDA(At, 1, 1); PG8_STAGE(PG8_SA(1, 0), a3, voffA);
            PG8_BAR; PG8_WAIT_L(0); PG8_MMA(1, 0, At, B0); PG8_BAR; PG8_SCHED;
            PG8_STAGE(PG8_SB(1, 1), b3 + hstep, voffB);
            PG8_WAIT_V(6); PG8_BAR; PG8_MMA(1, 1, At, B1); PG8_BAR;
            }
        }
        if constexpr (ALIGN_EPI) { if (wr == 0) PG8_BAR; }
        if constexpr (!Epi::AFTER_DRAIN) { E(acc, cur, wr, wc, fr, fq); S.done(cur); }
        if (!has_next) break;
#pragma unroll
        for (int a = 0; a < 2; ++a)
#pragma unroll
            for (int b = 0; b < 2; ++b)
#pragma unroll
                for (int m = 0; m < 4; ++m)
#pragma unroll
                    for (int n = 0; n < 2; ++n) acc[a][b][m][n] = (f32x4){0.f, 0.f, 0.f, 0.f};
        cur = nxt; cA = nA; cB = nB; ++ui;
        if constexpr (ALIGN_EPI) { if (wr == 1) PG8_BAR; }
    }
    PG8_WAIT_V(0);
    if constexpr (!ALIGN_EPI) { if (wr == 0) PG8_BAR; }
    PG8_BAR;
    if constexpr (Epi::AFTER_DRAIN) { E.fused(acc, cur, wr, wc, fr, fq, lds, wid, lane); S.done(cur); }
#undef PG8_SA
#undef PG8_SB
#undef PG8_STAGE
#undef PG8_LDA
#undef PG8_LDB
#undef PG8_MMA
#undef PG8_WAIT_V
#undef PG8_WAIT_L
#undef PG8_BAR
#undef PG8_SCHED
}
}

#define GAS __attribute__((address_space(1)))
#define LAS __attribute__((address_space(3)))
typedef unsigned short bf16;
typedef short bf16x8 __attribute__((ext_vector_type(8)));
typedef short s16x4 __attribute__((ext_vector_type(4)));
typedef float f32x4 __attribute__((ext_vector_type(4)));
typedef float f32x2 __attribute__((ext_vector_type(2)));
typedef float f32x16 __attribute__((ext_vector_type(16)));
typedef unsigned u32x4 __attribute__((ext_vector_type(4)));
typedef unsigned u32x2 __attribute__((ext_vector_type(2)));

constexpr int DM = 1024, NB = 8, SEQ = 8192, DEPTH = 2, DB = 32, DL = 16, PAST = 2048;
constexpr int MP = NB * SEQ;
constexpr int MS = DB * DL;
constexpr int MT = MP + MS;
constexpr int DFF = 2816, DIN = 8208, NIN = 8704;
constexpr float EPS = 1e-6f;
constexpr float C2 = 0.125f * 1.4426950408889634f;
constexpr int NWAVES = 8;

constexpr size_t O_Y = 0;
constexpr size_t O_KP = (size_t)MT * DM;
constexpr size_t O_VP = O_KP + (size_t)DEPTH * MP * DM;
constexpr size_t O_GP = O_VP + (size_t)DEPTH * MP * DM;
constexpr size_t O_CP = O_GP + (size_t)DEPTH * NB * 4 * 128 * 256;
constexpr size_t O_KS = O_CP + (size_t)DEPTH * NB * 2 * DFF;
constexpr size_t O_VS = O_KS + (size_t)DEPTH * MS * DM;
constexpr size_t O_GS = O_VS + (size_t)DEPTH * MS * DM;
constexpr size_t O_CS = O_GS + (size_t)DEPTH * DB * 4 * 128 * 256;
constexpr size_t O_END = O_CS + (size_t)DEPTH * DB * 2 * DFF;

constexpr size_t MiB = 1u << 20, HMiB = 1u << 19;
constexpr size_t WS_CTL = 0, CTL_ZERO_BYTES = 1 * MiB;
constexpr size_t WS_ROPE = 1 * MiB;
constexpr size_t WS_DG = 1 * MiB + HMiB;
constexpr size_t WS_W = 2 * MiB;
constexpr size_t W_IN = 0, W_O = 17 * MiB, W_UP = 19 * MiB, W_DN = 30 * MiB, W_LAYER = 35 * MiB + HMiB;
constexpr size_t WS_SLOC = 74 * MiB;
constexpr size_t UB = (size_t)MT * DM * 2;
constexpr size_t WS_XN = 112 * MiB;
constexpr size_t WS_QA = WS_XN + UB, WS_KA = WS_QA + UB, WS_VA = WS_KA + UB, WS_QG = WS_VA + UB, WS_KG = WS_QG + UB / 2, WS_VG = WS_KG + UB / 2,
                 WS_RG = WS_VG + UB, WS_GK = WS_RG + UB, WS_GA = WS_GK + UB / 2, WS_GB = WS_GA + UB, WS_PEND = WS_GB + UB;
constexpr size_t WS_UG = WS_QA;
constexpr size_t WS_ACT = WS_UG + (size_t)MT * 5632 * 2;
constexpr size_t WS_TMP = WS_PEND;
constexpr size_t WS_OA = WS_TMP + 2 * UB;
constexpr size_t WS_PART = WS_OA + UB;
constexpr size_t WS_RS = WS_PART + (size_t)11 * MS * DM * 4;
constexpr size_t WS_END = WS_RS + UB;
static_assert(WS_ACT + (size_t)MT * DFF * 2 <= WS_PEND, "ws overlay");
static_assert(WS_W + 2 * W_LAYER <= WS_SLOC && WS_SLOC + 32 * MiB <= WS_XN, "ws map");
constexpr int CW_BAR = 4096;

constexpr int RING_BYTES = 131072, MISC_OFF = RING_BYTES, LDS_BYTES = 147456;

__device__ __forceinline__ float bf2f(bf16 b) { return __uint_as_float((unsigned)b << 16); }
__device__ __forceinline__ float bflo(unsigned u) { return __uint_as_float(u << 16); }
__device__ __forceinline__ float bfhi(unsigned u) { return __uint_as_float(u & 0xffff0000u); }
typedef __bf16 bf16x2_t __attribute__((ext_vector_type(2)));
__device__ __forceinline__ unsigned pk2(float lo, float hi) { f32x2 v = {lo, hi}; bf16x2_t b = __builtin_convertvector(v, bf16x2_t); return __builtin_bit_cast(unsigned, b); }
__device__ __forceinline__ bf16 f2bf(float f) { return (bf16)(pk2(f, 0.f) & 0xffffu); }
template <int M> __device__ __forceinline__ float shx(float v) { return __int_as_float(__builtin_amdgcn_ds_swizzle(__float_as_int(v), 0x1F | (M << 10))); }
__device__ __forceinline__ float sum32x(float v) { auto r = __builtin_amdgcn_permlane32_swap(__float_as_uint(v), __float_as_uint(v), false, false); return __uint_as_float(r[0]) + __uint_as_float(r[1]); }
__device__ __forceinline__ float max32x(float v) { auto r = __builtin_amdgcn_permlane32_swap(__float_as_uint(v), __float_as_uint(v), false, false); return fmaxf(__uint_as_float(r[0]), __uint_as_float(r[1])); }
__device__ __forceinline__ float half_sum(float v) { v += shx<1>(v); v += shx<2>(v); v += shx<4>(v); v += shx<8>(v); v += shx<16>(v); return v; }
__device__ __forceinline__ float wave_sum(float v) { return sum32x(half_sum(v)); }
__device__ __forceinline__ float frcp(float x) { return __builtin_amdgcn_rcpf(x); }
__device__ __forceinline__ float frsq(float x) { return __builtin_amdgcn_rsqf(x); }
__device__ __forceinline__ float sigmoidf_(float x) { return frcp(1.0f + __expf(-x)); }
#define LDS_WAIT() asm volatile("s_waitcnt lgkmcnt(0)" ::: "memory")
#define VM_WAIT() asm volatile("s_waitcnt vmcnt(0)" ::: "memory")

struct EpiIn {
    static constexpr bool PERM = true, AFTER_DRAIN = false;
    GAS unsigned char* ws; GAS float* kout_p; GAS float* vout_p; GAS float* kout_s; GAS float* vout_s; const GAS float* rope; const GAS float* bgk;
    template <int KIND>
    __device__ __forceinline__ void run(const pg8::f32x4 (&acc)[2][2][4][2], GAS bf16* dst, int ldc, int tcol, GAS float* fout, int frow0, int row0, bool sample, int wc, int fq) const {
        const int colw = wc * 32 + 8 * fq;
        const bool ropew = (KIND <= 1) && ((wc & 1) == 0);
        const float sgn = (fq == 0) ? -1.f : ((fq == 1) ? 1.f : 0.f);
        const bool rl = (fq < 2);
        f32x4 b0 = {0.f, 0.f, 0.f, 0.f}, b1 = b0, b2 = b0, b3 = b0;
        if (KIND == 5) { b0 = *(const GAS f32x4*)(bgk + tcol + colw); b1 = *(const GAS f32x4*)(bgk + tcol + colw + 4); b2 = *(const GAS f32x4*)(bgk + tcol + 128 + colw); b3 = *(const GAS f32x4*)(bgk + tcol + 128 + colw + 4); }
#pragma unroll
        for (int ai = 0; ai < 2; ++ai)
#pragma unroll
            for (int m = 0; m < 4; ++m) {
                const int row = row0 + ai * 128 + m * 16;
                f32x4 cs0 = {1.f, 1.f, 1.f, 1.f}, cs1 = cs0, sn0 = {0.f, 0.f, 0.f, 0.f}, sn1 = sn0;
                if (KIND <= 1) { if (ropew) {
                    const int pos = sample ? (PAST + (row & 15)) : (row & (SEQ - 1));
                    const GAS f32x4* rp = (const GAS f32x4*)(rope + (size_t)pos * 16);
                    const f32x4 c0 = rp[0], c1 = rp[1], s0 = rp[2], s1 = rp[3];
#pragma unroll
                    for (int e = 0; e < 4; ++e) { cs0[e] = rl ? c0[e] : 1.f; cs1[e] = rl ? c1[e] : 1.f; sn0[e] = s0[e] * sgn; sn1[e] = s1[e] * sgn; }
                } }
#pragma unroll
                for (int bj = 0; bj < 2; ++bj) {
                    f32x4 v0 = acc[ai][bj][m][0], v1 = acc[ai][bj][m][1];
                    const int col = tcol + bj * 128 + colw;
                    if (KIND <= 1) { if (ropew) {
                        f32x4 o0, o1;
#pragma unroll
                        for (int e = 0; e < 4; ++e) { o0[e] = shx<16>(v0[e]); o1[e] = shx<16>(v1[e]); }
                        v0 = v0 * cs0 + o0 * sn0; v1 = v1 * cs1 + o1 * sn1;
                    } }
                    if (KIND == 1 || KIND == 2) {
                        GAS float* fo = fout + (size_t)(row - frow0) * 1024 + col;
                        __builtin_nontemporal_store(v0, (GAS f32x4*)fo); __builtin_nontemporal_store(v1, (GAS f32x4*)(fo + 4));
                    }
                    if (KIND == 0) { v0 = v0 * C2; v1 = v1 * C2; }
                    if (KIND == 3) { v0 = v0 * 0.08838834764831845f; v1 = v1 * 0.08838834764831845f; }
                    if (KIND == 5) {
                        const f32x4 ba = bj ? b2 : b0, bb = bj ? b3 : b1;
#pragma unroll
                        for (int e = 0; e < 4; ++e) {
                            float x = v0[e] + ba[e]; v0[e] = (fminf(x, 0.f) - __logf(1.f + __expf(-fabsf(x)))) * 0.0625f;
                            x = v1[e] + bb[e];       v1[e] = (fminf(x, 0.f) - __logf(1.f + __expf(-fabsf(x)))) * 0.0625f;
                        }
                    }
                    u32x4 w; w.x = pk2(v0[0], v0[1]); w.y = pk2(v0[2], v0[3]); w.z = pk2(v1[0], v1[1]); w.w = pk2(v1[2], v1[3]);
                    *(GAS u32x4*)(dst + (size_t)row * ldc + col) = w;
                }
            }
    }
    __device__ __forceinline__ void operator()(const pg8::f32x4 (&acc)[2][2][4][2], const pg8::Unit& u, int wr, int wc, int fr, int fq) const {
        const int pn = u.pn;
        const int row0 = u.pm * 256 + wr * 64 + fr;
        const bool sample = (u.pm >= 256);
        const int frow0 = sample ? MP : 0;
        if (pn < 4)       run<0>(acc, (GAS bf16*)(ws + WS_QA), 1024, pn * 256, nullptr, 0, row0, sample, wc, fq);
        else if (pn < 8)  run<1>(acc, (GAS bf16*)(ws + WS_KA), 1024, (pn - 4) * 256, sample ? kout_s : kout_p, frow0, row0, sample, wc, fq);
        else if (pn < 12) run<2>(acc, (GAS bf16*)(ws + WS_VA), 1024, (pn - 8) * 256, sample ? vout_s : vout_p, frow0, row0, sample, wc, fq);
        else if (pn < 14) run<3>(acc, (GAS bf16*)(ws + WS_QG), 512, (pn - 12) * 256, nullptr, 0, row0, sample, wc, fq);
        else if (pn < 16) run<4>(acc, (GAS bf16*)(ws + WS_KG), 512, (pn - 14) * 256, nullptr, 0, row0, sample, wc, fq);
        else if (pn < 20) run<4>(acc, (GAS bf16*)(ws + WS_VG), 1024, (pn - 16) * 256, nullptr, 0, row0, sample, wc, fq);
        else if (pn < 24) run<4>(acc, (GAS bf16*)(ws + WS_RG), 1024, (pn - 20) * 256, nullptr, 0, row0, sample, wc, fq);
        else if (pn < 28) run<4>(acc, (GAS bf16*)(ws + WS_GA), 1024, (pn - 24) * 256, nullptr, 0, row0, sample, wc, fq);
        else if (pn < 32) run<4>(acc, (GAS bf16*)(ws + WS_GB), 1024, (pn - 28) * 256, nullptr, 0, row0, sample, wc, fq);
        else              run<5>(acc, (GAS bf16*)(ws + WS_GK), 512, (pn - 32) * 256, nullptr, 0, row0, sample, wc, fq);
    }
};
struct SplitOrder {
    int G, c, nks, kslice;
    __device__ __forceinline__ bool next(int i, pg8::Unit& u) const { const int idx = i * G + c; if (idx >= 8 * nks) return false;
        const int ks = idx % nks, r = idx / nks; u.pn = r & 3; u.pm = 256 + (r >> 2); u.ko = ks * kslice; return true; }
    __device__ __forceinline__ void a_ready(const pg8::Unit&) const {}
    __device__ __forceinline__ void done(const pg8::Unit&) const {}
};
struct EpiPart {
    static constexpr bool PERM = true, AFTER_DRAIN = false;
    GAS float* P; int kslice;
    __device__ __forceinline__ void operator()(const pg8::f32x4 (&acc)[2][2][4][2], const pg8::Unit& u, int wr, int wc, int fr, int fq) const {
        const int row0 = (u.pm - 256) * 256 + wr * 64 + fr, col0 = u.pn * 256 + wc * 32 + 8 * fq; GAS float* base = P + (size_t)(u.ko / kslice) * MS * DM;
#pragma unroll
        for (int ai = 0; ai < 2; ++ai)
#pragma unroll
            for (int m = 0; m < 4; ++m) { GAS float* rowp = base + (size_t)(row0 + ai * 128 + m * 16) * DM + col0;
#pragma unroll
                for (int bj = 0; bj < 2; ++bj) { *(GAS f32x4*)(rowp + bj * 128) = acc[ai][bj][m][0]; *(GAS f32x4*)(rowp + bj * 128 + 4) = acc[ai][bj][m][1]; } }
    }
};
struct EpiF32 {
    static constexpr bool PERM = true, AFTER_DRAIN = false;
    GAS float* O; int ldc;
    __device__ __forceinline__ void operator()(const pg8::f32x4 (&acc)[2][2][4][2], const pg8::Unit& u, int wr, int wc, int fr, int fq) const {
        const int row0 = u.pm * 256 + wr * 64 + fr, col0 = u.pn * 256 + wc * 32 + 8 * fq;
#pragma unroll
        for (int ai = 0; ai < 2; ++ai)
#pragma unroll
            for (int m = 0; m < 4; ++m) { GAS float* rowp = O + (size_t)(row0 + ai * 128 + m * 16) * ldc + col0;
#pragma unroll
                for (int bj = 0; bj < 2; ++bj) { *(GAS f32x4*)(rowp + bj * 128) = acc[ai][bj][m][0]; *(GAS f32x4*)(rowp + bj * 128 + 4) = acc[ai][bj][m][1]; } }
    }
};
struct EpiB16 {
    static constexpr bool PERM = true, AFTER_DRAIN = false;
    GAS bf16* O; int ldc;
    __device__ __forceinline__ void operator()(const pg8::f32x4 (&acc)[2][2][4][2], const pg8::Unit& u, int wr, int wc, int fr, int fq) const {
        const int row0 = u.pm * 256 + wr * 64 + fr, col0 = u.pn * 256 + wc * 32 + 8 * fq;
#pragma unroll
        for (int ai = 0; ai < 2; ++ai)
#pragma unroll
            for (int m = 0; m < 4; ++m) { GAS bf16* rowp = O + (size_t)(row0 + ai * 128 + m * 16) * ldc + col0;
#pragma unroll
                for (int bj = 0; bj < 2; ++bj) { const f32x4 v0 = acc[ai][bj][m][0], v1 = acc[ai][bj][m][1];
                    u32x4 w; w.x = pk2(v0[0], v0[1]); w.y = pk2(v0[2], v0[3]); w.z = pk2(v1[0], v1[1]); w.w = pk2(v1[2], v1[3]);
                    *(GAS u32x4*)(rowp + bj * 128) = w; } }
    }
};
#define XB_TMO      128
#define XB_XCNT(j)  (256  + 64 * (j))
#define XB_XSUB(j)  (1280 + 64 * (j))
#define XB_XGEN(j)  (2304 + 64 * (j))
#define XB_TOP      3328
#define XB_TOPGEN   3392
#define XCD_BAR_WORDS 3456
#define XB_SPIN_CAP (1u << 18)

__device__ __forceinline__ unsigned xb_ld(unsigned* p)              { return __hip_atomic_load(p, __ATOMIC_RELAXED, __HIP_MEMORY_SCOPE_AGENT); }
__device__ __forceinline__ unsigned xb_add(unsigned* p, unsigned v) { return __hip_atomic_fetch_add(p, v, __ATOMIC_RELAXED, __HIP_MEMORY_SCOPE_AGENT); }
__device__ __forceinline__ unsigned xb_xcc_id() { return (unsigned)__builtin_amdgcn_s_getreg((3 << 11) | 20) & 0xFu; }
#define XB_SPIN(cond, bar) do { unsigned _sp = 0; while (cond) { __builtin_amdgcn_s_sleep(1); \
    if ((++_sp & 255u) == 0u) { if (xb_ld(&(bar)[XB_TMO])) break; if (_sp > XB_SPIN_CAP) { atomicAdd(&(bar)[XB_TMO], 1u); break; } } } } while (0)

struct XcdBarrier {
    unsigned* bar; unsigned x;
    volatile LAS unsigned* st;
};

__device__ __forceinline__ XcdBarrier xcd_barrier_post(unsigned* bar, volatile LAS unsigned* st) {
    XcdBarrier b; b.bar = bar; b.x = xb_xcc_id(); b.st = st;
    if (threadIdx.x == 0) (void)xb_add(&bar[XB_XCNT(b.x)], 1u);
    return b;
}
__device__ __forceinline__ void xcd_barrier_complete(unsigned* bar, unsigned x, unsigned& nloc, unsigned& nx) {
    const unsigned G = gridDim.x * gridDim.y * gridDim.z;
    unsigned sum, cnt, mine, sp = 0u;
    for (;;) {
        sum = 0u; cnt = 0u; mine = 0u;
#pragma unroll
        for (unsigned j = 0; j < 16; ++j) { const unsigned c = xb_ld(&bar[XB_XCNT(j)]); sum += c; cnt += (c > 0u) ? 1u : 0u; mine = (j == x) ? c : mine; }
        if (sum == G) break;
        __builtin_amdgcn_s_sleep(1);
        if ((++sp & 255u) == 0u) { if (xb_ld(&bar[XB_TMO])) break; if (sp > XB_SPIN_CAP) { atomicAdd(&bar[XB_TMO], 1u); break; } }
    }
    nloc = mine > 0u ? mine : 1u; nx = cnt > 0u ? cnt : 1u;
}

__device__ __forceinline__ void xcd_barrier(const XcdBarrier& b) {
    asm volatile("s_waitcnt vmcnt(0)" ::: "memory");
    __syncthreads();
    if (threadIdx.x == 0) {
        unsigned* bar = b.bar;
        __builtin_amdgcn_s_waitcnt(0);
        unsigned nloc = b.st[0], nx = b.st[1];
        if (nloc == 0u) { xcd_barrier_complete(bar, b.x, nloc, nx); b.st[0] = nloc; b.st[1] = nx; }
        const unsigned old = xb_add(&bar[XB_XSUB(b.x)], 1u);
        const unsigned gen = old / nloc;
        if (old + 1u == (gen + 1u) * nloc) {
            __builtin_amdgcn_fence(__ATOMIC_RELEASE, "agent");
            asm volatile("s_waitcnt vmcnt(0)" ::: "memory");
            const unsigned og = xb_add(&bar[XB_TOP], 1u);
            const unsigned tg = og / nx;
            if (og + 1u == (tg + 1u) * nx) xb_add(&bar[XB_TOPGEN], 1u);
            else XB_SPIN(xb_ld(&bar[XB_TOPGEN]) == tg, bar);
            __builtin_amdgcn_fence(__ATOMIC_ACQUIRE, "agent");
            xb_add(&bar[XB_XGEN(b.x)], 1u);
            asm volatile("s_waitcnt vmcnt(0)" ::: "memory");
        } else {
            XB_SPIN(xb_ld(&bar[XB_XGEN(b.x)]) == gen, bar);
            __builtin_amdgcn_fence(__ATOMIC_ACQUIRE, "agent");
            asm volatile("s_waitcnt vmcnt(0)" ::: "memory");
        }
    }
    __syncthreads();
}

__device__ __noinline__ void xcd_barrier_ni(unsigned* bar, unsigned x, volatile LAS unsigned* st) { XcdBarrier b; b.bar = bar; b.x = x; b.st = st; xcd_barrier(b); }

struct Args { const float* in[24]; float* out; unsigned char* ws; float inv_freq[8]; int ph_lo, ph_hi; };
enum { I_XP = 0, I_XS, I_CK, I_CV, I_SG, I_SC, I_WIN, I_WGK2, I_BGK2, I_LQ1, I_LK1, I_LQ2, I_LK2, I_DANW, I_GLANW, I_WO, I_PREMIX, I_POSTMIX, I_PREFFN, I_POSTFFN, I_WUP, I_CONVW, I_CONVB, I_WDOWN };

__device__ __forceinline__ void transpose_item(const GAS float* W, int N, int K, GAS bf16* WT, LAS float* scr, int kb, int n0_src, int n0_dst, int lane, const GAS float* wg) {
    const int k0 = 64 * kb;
    if (wg == nullptr) {
#pragma unroll 8
        for (int i = 0; i < 32; ++i) { const int kk = 2 * i + (lane >> 5); scr[kk * 33 + (lane & 31)] = W[(size_t)(k0 + kk) * N + n0_src + (lane & 31)]; }
    } else {
        float g[16];
#pragma unroll
        for (int r = 0; r < 16; ++r) g[r] = wg[r * 512 + n0_src + (lane & 31)];
        for (int i = 0; i < 32; ++i) { const int kk = 2 * i + (lane >> 5); const GAS float* lr = W + (size_t)(k0 + kk) * N + 6144; float s = 0.f;
#pragma unroll
            for (int r = 0; r < 16; ++r) s += lr[r] * g[r];
            scr[kk * 33 + (lane & 31)] = s; }
    }
    LDS_WAIT(); asm volatile("" ::: "memory");
    const int c = lane & 7;
#pragma unroll
    for (int j = 0; j < 4; ++j) { const int n = (lane >> 3) + 8 * j; const LAS float* s = scr + (8 * c) * 33 + n;
        u32x4 o; o.x = pk2(s[0 * 33], s[1 * 33]); o.y = pk2(s[2 * 33], s[3 * 33]); o.z = pk2(s[4 * 33], s[5 * 33]); o.w = pk2(s[6 * 33], s[7 * 33]);
        *(GAS u32x4*)(WT + (size_t)(n0_dst + n) * K + k0 + 8 * c) = o; }
    LDS_WAIT(); asm volatile("" ::: "memory");
}
__device__ __forceinline__ void rms_row_to_bf16(const GAS float* xrow, const GAS float* w, GAS bf16* orow, int lane) {
    const GAS f32x4* xr = (const GAS f32x4*)xrow + lane; const GAS f32x4* wr = (const GAS f32x4*)w + lane;
    f32x4 v[4]; float s = 0.f;
#pragma unroll
    for (int j = 0; j < 4; ++j) { v[j] = xr[64 * j]; s += (v[j].x * v[j].x + v[j].y * v[j].y) + (v[j].z * v[j].z + v[j].w * v[j].w); }
    const float rstd = frsq(wave_sum(s) * (1.f / DM) + EPS);
    GAS u32x2* o8 = (GAS u32x2*)orow + lane;
#pragma unroll
    for (int j = 0; j < 4; ++j) { const f32x4 g = wr[64 * j]; u32x2 o; o.x = pk2(v[j].x * rstd * g.x, v[j].y * rstd * g.y); o.y = pk2(v[j].z * rstd * g.z, v[j].w * rstd * g.w); o8[64 * j] = o; }
}
__device__ __forceinline__ void sincos_acc(float angf, float& sn, float& cs) {
    const double a = (double)angf; const double k = rint(a * 0.15915494309189535); const double r = a - k * 6.283185307179586476925;
    const double r2 = r * r; double ts = 1.0, tc = 1.0, ss = 1.0, sc = 1.0;
#pragma unroll
    for (int n = 1; n <= 13; ++n) { tc = -tc * r2 / (double)((2 * n - 1) * (2 * n)); ts = -ts * r2 / (double)((2 * n) * (2 * n + 1)); sc += tc; ss += ts; }
    sn = (float)(ss * r); cs = (float)sc;
}

#define MFMA32(a, b, c) __builtin_amdgcn_mfma_f32_32x32x16_bf16((a), (b), (c), 0, 0, 0)
__device__ __forceinline__ int crow(int r, int hi) { return (r & 3) + 8 * (r >> 2) + 4 * hi; }
__device__ __forceinline__ s16x4 tr16(const LAS unsigned char* p) { return __builtin_bit_cast(s16x4, __builtin_amdgcn_ds_read_tr16_b64_v4i16((LAS s16x4*)p)); }
__device__ __forceinline__ bf16x8 cat8(s16x4 lo, s16x4 hi) { return (bf16x8){lo[0], lo[1], lo[2], lo[3], hi[0], hi[1], hi[2], hi[3]}; }
__device__ __forceinline__ u32x4 cvt8(f32x4 a, f32x4 b) { u32x4 w; w.x = pk2(a[0], a[1]); w.y = pk2(a[2], a[3]); w.z = pk2(b[0], b[1]); w.w = pk2(b[2], b[3]); return w; }

__device__ __forceinline__ void glds16(const GAS void* gsrc, unsigned lds_dst) { unsigned keep;
    asm volatile("s_mov_b32 %0, m0\n\ts_mov_b32 m0, %2\n\ts_nop 0\n\tglobal_load_lds_dwordx4 %1, off\n\ts_mov_b32 m0, %0" : "=&s"(keep) : "v"(gsrc), "s"(lds_dst) : "memory"); }
template <int MODE>
__device__ __forceinline__ void attn_unit(LAS unsigned char* lds, const GAS bf16* Q, const GAS bf16* Kb, const GAS bf16* Vb, GAS bf16* O, const GAS float* ck, const GAS float* cv,
                                          int b, int h, int qblk, float lam, float onem, const GAS float* normw) {
    const int tid = opaque_tid(), lane = tid & 63, w = __builtin_amdgcn_readfirstlane(tid >> 6), r32 = lane & 31, hi = lane >> 5;
    const int comp = w & 1, rg = w >> 1, half = w >> 2;
    int NT, my_nt; size_t qrow, orow0;
    if (MODE == 0) { NT = 2 * qblk + 2; my_nt = 2 * qblk + 1 + half; orow0 = (size_t)b * SEQ + qblk * 128 + rg * 32; qrow = orow0 + r32; }
    else { NT = 33; my_nt = (rg == 0) ? 33 : 0; orow0 = (size_t)MP + b * 16; qrow = orow0 + (r32 < 15 ? r32 : 15); }
    bf16x8 qr[4];
    { const GAS bf16* qp = Q + qrow * 1024 + h * 128 + comp * 64 + hi * 8;
#pragma unroll
      for (int s = 0; s < 4; ++s) qr[s] = *(const GAS bf16x8*)(qp + 16 * s); }
    asm volatile("" : "+v"(qr[0]), "+v"(qr[1]), "+v"(qr[2]), "+v"(qr[3]));
    LAS float* wsf = (LAS float*)(lds + 98304) + w * 64;
    f32x16 o[4];
#pragma unroll
    for (int d = 0; d < 4; ++d)
#pragma unroll
        for (int r = 0; r < 16; ++r) o[d][r] = 0.f;
    float mrow = 0.f, lrow = 0.f;
    u32x4 kst[2], vst[2];
    bf16x8 pw[4];
#pragma unroll
    for (int k = 0; k < 4; ++k) pw[k] = (bf16x8){0, 0, 0, 0, 0, 0, 0, 0};
    const int vrow_l = lane >> 2, vpc = lane & 3;
#define ATT_LOAD(t) do { \
        if (MODE == 0) { const size_t kr0 = (size_t)b * SEQ + 64 * (t); \
            _Pragma("unroll") for (int i = 0; i < 2; ++i) { const int p = w + 8 * i; \
                kst[i] = *(const GAS u32x4*)(Kb + (kr0 + lane) * 1024 + h * 128 + p * 8); \
                vst[i] = *(const GAS u32x4*)(Vb + (kr0 + 16 * (p & 3) + vrow_l) * 1024 + h * 128 + 32 * (p >> 2) + 8 * vpc); } } \
        else if ((t) < 32) { const size_t kr0 = (size_t)b * PAST + 64 * (t); \
            _Pragma("unroll") for (int i = 0; i < 2; ++i) { const int p = w + 8 * i; \
                const GAS float* kp = ck + ((kr0 + lane) * 8 + h) * 128 + p * 8; kst[i] = cvt8(*(const GAS f32x4*)kp, *(const GAS f32x4*)(kp + 4)); \
                const GAS float* vp = cv + ((kr0 + 16 * (p & 3) + vrow_l) * 8 + h) * 128 + 32 * (p >> 2) + 8 * vpc; vst[i] = cvt8(*(const GAS f32x4*)vp, *(const GAS f32x4*)(vp + 4)); } } \
        else { const size_t kr0 = (size_t)MP + b * 16; \
            _Pragma("unroll") for (int i = 0; i < 2; ++i) { const int p = w + 8 * i; const int vr = 16 * (p & 3) + vrow_l; \
                kst[i] = (lane < 16) ? *(const GAS u32x4*)(Kb + (kr0 + lane) * 1024 + h * 128 + p * 8) : (u32x4){0u, 0u, 0u, 0u}; \
                vst[i] = (vr < 16) ? *(const GAS u32x4*)(Vb + (kr0 + vr) * 1024 + h * 128 + 32 * (p >> 2) + 8 * vpc) : (u32x4){0u, 0u, 0u, 0u}; } } \
    } while (0)
#define ATT_STORE(bufo) do { _Pragma("unroll") for (int i = 0; i < 2; ++i) { const int p = w + 8 * i; \
        *(LAS u32x4*)(lds + (bufo) + p * 1024 + lane * 16) = kst[i]; *(LAS u32x4*)(lds + (bufo) + 16384 + p * 1024 + lane * 16) = vst[i]; } } while (0)
#define ATT_X(t, bo) do { \
        f32x16 p0, p1; \
        _Pragma("unroll") for (int r = 0; r < 16; ++r) { p0[r] = 0.f; p1[r] = 0.f; } \
        const LAS unsigned char* kb_ = lds + (bo) + kfo; \
        _Pragma("unroll") for (int s = 0; s < 4; ++s) { const bf16x8 a0 = *(const LAS bf16x8*)(kb_ + s * 2048), a1 = *(const LAS bf16x8*)(kb_ + s * 2048 + 512); \
            p0 = MFMA32(a0, qr[s], p0); p1 = MFMA32(a1, qr[s], p1); } \
        if (MODE == 1 && (t) == 32) { _Pragma("unroll") for (int r = 0; r < 16; ++r) { if (r >= 8) p0[r] = -INFINITY; p1[r] = -INFINITY; } } \
        float mx = fmaxf(p0[0], p1[0]); \
        _Pragma("unroll") for (int r = 1; r < 16; ++r) mx = fmaxf(mx, fmaxf(p0[r], p1[r])); \
        mx = max32x(mx); \
        if ((t) == 0) mrow = mx; \
        else if (__any(mx > mrow + 8.f)) { \
            const float mn = fmaxf(mrow, mx); const float f = __builtin_amdgcn_exp2f(mrow - mn); lrow *= f; mrow = mn; \
            if (hi == 0) wsf[r32] = f; \
            LDS_WAIT(); \
            _Pragma("unroll") for (int r = 0; r < 16; ++r) { const float fr_ = wsf[crow(r, hi)]; \
                _Pragma("unroll") for (int d = 0; d < 4; ++d) o[d][r] *= fr_; } } \
        float ls = 0.f; \
        _Pragma("unroll") for (int r = 0; r < 16; ++r) { p0[r] = __builtin_amdgcn_exp2f(p0[r] - mrow); p1[r] = __builtin_amdgcn_exp2f(p1[r] - mrow); ls += p0[r] + p1[r]; } \
        lrow += ls; \
        { u32x4 x; \
          x.x = pk2(p0[0], p0[1]); x.y = pk2(p0[2], p0[3]); x.z = pk2(p0[4], p0[5]); x.w = pk2(p0[6], p0[7]); pw[0] = __builtin_bit_cast(bf16x8, x); \
          x.x = pk2(p0[8], p0[9]); x.y = pk2(p0[10], p0[11]); x.z = pk2(p0[12], p0[13]); x.w = pk2(p0[14], p0[15]); pw[1] = __builtin_bit_cast(bf16x8, x); \
          x.x = pk2(p1[0], p1[1]); x.y = pk2(p1[2], p1[3]); x.z = pk2(p1[4], p1[5]); x.w = pk2(p1[6], p1[7]); pw[2] = __builtin_bit_cast(bf16x8, x); \
          x.x = pk2(p1[8], p1[9]); x.y = pk2(p1[10], p1[11]); x.z = pk2(p1[12], p1[13]); x.w = pk2(p1[14], p1[15]); pw[3] = __builtin_bit_cast(bf16x8, x); } \
    } while (0)
#define ATT_Y(bo) do { const LAS unsigned char* vb_ = lds + (bo) + vfo; \
        _Pragma("unroll") for (int d = 0; d < 4; ++d) { \
            _Pragma("unroll") for (int ks = 0; ks < 4; ++ks) { const s16x4 lo_ = tr16(vb_ + d * 4096 + ks * 1024), hh_ = tr16(vb_ + d * 4096 + ks * 1024 + 512); \
                o[d] = MFMA32(pw[ks], cat8(lo_, hh_), o[d]); } \
            __builtin_amdgcn_sched_barrier(0); } } while (0)
#define ATT_DMA(t, bufo) do { const size_t kr0 = (size_t)b * SEQ + 64 * (t); \
        _Pragma("unroll") for (int i = 0; i < 2; ++i) { const int p = w + 8 * i; \
            glds16(Kb + (kr0 + lane) * 1024 + h * 128 + p * 8, (unsigned)__builtin_amdgcn_readfirstlane((int)(lds0 + (bufo) + p * 1024))); \
            glds16(Vb + (kr0 + 16 * (p & 3) + vrow_l) * 1024 + h * 128 + 32 * (p >> 2) + 8 * vpc, (unsigned)__builtin_amdgcn_readfirstlane((int)(lds0 + (bufo) + 16384 + p * 1024))); } } while (0)
    const unsigned lds0 = (unsigned)(size_t)lds;
    if (MODE == 0) { ATT_DMA(0, 0); VM_WAIT(); } else { ATT_LOAD(0); ATT_STORE(0); }
    __syncthreads();
    const int kfo = (8 * comp + hi) * 1024 + r32 * 16;
    const int vfo = 16384 + ((lane >> 4) & 1) * 32 + (lane & 3) * 8 + (4 * hi + ((lane & 15) >> 2)) * 64;
    int b_prev = 0, b_cur = 0, b_next = 32768;
    const int NI = (MODE == 0) ? NT + 1 : NT;
    for (int i = 0; i < NI; ++i) {
        if (i + 1 < NT) { if (MODE == 0) { ATT_DMA(i + 1, b_next); } else { ATT_LOAD(i + 1); } }
        if (half == 0) { if (i < my_nt) { ATT_X(i, b_cur); ATT_Y(b_cur); } }
        else if (MODE == 0) { if (i >= 1) ATT_Y(b_prev); if (i < NT) ATT_X(i, b_cur); }
        if (MODE == 1 && i + 1 < NT) ATT_STORE(b_next);
        if (MODE == 0) VM_WAIT();
        __syncthreads();
        b_prev = b_cur; b_cur = b_next; b_next = (b_next == 65536) ? 0 : b_next + 32768;
    }
#undef ATT_LOAD
#undef ATT_STORE
#undef ATT_DMA
#undef ATT_X
#undef ATT_Y
    const bool active = (MODE == 0) || (rg == 0);
    if (active) {
        const float lt = sum32x(lrow);
        if (hi == 0) wsf[32 + r32] = lt;
        LDS_WAIT();
#pragma unroll
        for (int r = 0; r < 16; ++r) { const float il = frcp(wsf[32 + crow(r, hi)]);
#pragma unroll
            for (int d = 0; d < 4; ++d) o[d][r] *= il; }
    }
    LAS float* X = (LAS float*)lds;
    if (active && comp == 1) {
#pragma unroll
        for (int d = 0; d < 4; ++d)
#pragma unroll
            for (int r = 0; r < 16; ++r) X[((rg * 4 + d) * 16 + r) * 64 + lane] = o[d][r];
    }
    __syncthreads();
    if (active && comp == 0) {
        float nw[4];
#pragma unroll
        for (int d = 0; d < 4; ++d) nw[d] = normw[32 * d + r32];
#pragma unroll
        for (int r = 0; r < 16; ++r) {
            float ss = 0.f;
#pragma unroll
            for (int d = 0; d < 4; ++d) { const float x = o[d][r] - lam * X[((rg * 4 + d) * 16 + r) * 64 + lane]; o[d][r] = x; ss += x * x; }
            ss = half_sum(ss);
            const float rs = onem * frsq(ss * (1.0f / 128.0f) + EPS);
            const int rr = crow(r, hi);
            if (MODE == 0 || rr < 16) {
                GAS bf16* op = O + (orow0 + rr) * 1024 + h * 128 + r32;
#pragma unroll
                for (int d = 0; d < 4; ++d) op[32 * d] = f2bf(o[d][r] * rs * nw[d]);
            }
        }
    }
    __syncthreads();
}

constexpr int ATT_WSF = 131072 + 1024;
#define ASBAR() __builtin_amdgcn_sched_barrier(0)
#define APIN(x) asm volatile("" : "+v"(x))
__device__ __forceinline__ float max3f(float a, float b, float c) { float r; asm("v_max3_f32 %0, %1, %2, %3" : "=v"(r) : "v"(a), "v"(b), "v"(c)); return r; }
__device__ __forceinline__ void attn_prompt_unit(LAS unsigned char* lds, const GAS bf16* Q, const GAS bf16* Kb, const GAS bf16* Vb, GAS bf16* O,
                                                 int b, int h, int qblk, float lam, float onem, const GAS float* normw) {
    const int tid = opaque_tid(), lane = tid & 63, w = __builtin_amdgcn_readfirstlane(tid >> 6), r32 = lane & 31, hi = lane >> 5;
    const int comp = w & 1, rg = w >> 1, half = w >> 2;
    const int NT = 2 * qblk + 2, my_nt = NT - 1 + half;
    const size_t orow0 = (size_t)b * SEQ + qblk * 128 + rg * 32;
    bf16x8 qr[4];
    { const GAS bf16* qp = Q + (orow0 + r32) * 1024 + h * 128 + comp * 64 + hi * 8;
#pragma unroll
      for (int s = 0; s < 4; ++s) qr[s] = *(const GAS bf16x8*)(qp + 16 * s); }
    asm volatile("" : "+v"(qr[0]), "+v"(qr[1]), "+v"(qr[2]), "+v"(qr[3]));
    LAS float* wsf = (LAS float*)(lds + ATT_WSF) + w * 64;
    f32x16 o[4];
#pragma unroll
    for (int d = 0; d < 4; ++d)
#pragma unroll
        for (int r = 0; r < 16; ++r) o[d][r] = 0.f;
    float mrow = 0.f, lrow = 0.f;
    f32x16 pA0, pA1, pB0, pB1;
    const f32x16 zero16 = {0.f, 0.f, 0.f, 0.f, 0.f, 0.f, 0.f, 0.f, 0.f, 0.f, 0.f, 0.f, 0.f, 0.f, 0.f, 0.f};
    const unsigned lds0 = (unsigned)(size_t)lds;
    const int vrow_l = lane >> 2, vpc = lane & 3;
    const int kfo = (8 * comp + hi) * 1024 + r32 * 16;
    const int vfo = 16384 + ((lane >> 4) & 1) * 32 + (lane & 3) * 8 + (4 * hi + ((lane & 15) >> 2)) * 64;
    const GAS bf16* kg = Kb + ((size_t)b * SEQ + lane) * 1024 + h * 128 + w * 8;
    const GAS bf16* vg = Vb + ((size_t)b * SEQ + 16 * (w & 3) + vrow_l) * 1024 + h * 128 + 32 * (w >> 2) + 8 * vpc;
#define PA_DMA(t) do { const int so_ = ((t) & 3) * 32768; const size_t to_ = (size_t)(t) * 65536; \
        glds16(kg + to_, (unsigned)__builtin_amdgcn_readfirstlane((int)(lds0 + so_ + w * 1024))); \
        glds16(kg + to_ + 64, (unsigned)__builtin_amdgcn_readfirstlane((int)(lds0 + so_ + (w + 8) * 1024))); \
        glds16(vg + to_, (unsigned)__builtin_amdgcn_readfirstlane((int)(lds0 + so_ + 16384 + w * 1024))); \
        glds16(vg + to_ + 64, (unsigned)__builtin_amdgcn_readfirstlane((int)(lds0 + so_ + 16384 + (w + 8) * 1024))); } while (0)
#define PA_KF(so, j) (*(const LAS bf16x8*)(lds + (so) + kfo + ((j) >> 1) * 2048 + ((j) & 1) * 512))
#define PA_VF(so, g) cat8(tr16(lds + (so) + vfo + ((g) >> 2) * 4096 + ((g) & 3) * 1024), tr16(lds + (so) + vfo + ((g) >> 2) * 4096 + ((g) & 3) * 1024 + 512))
#define PA_SEL(P0, P1, e) (((e) < 16) ? P0[(e) & 15] : P1[(e) & 15])
#define PA_WAITBAR(n) asm volatile("s_waitcnt vmcnt(" #n ") lgkmcnt(0)\n\ts_barrier" ::: "memory")
#define PA_KFJ(so, j) PA_KF(so, ((j) < 4 ? 2 * (j) : 2 * ((j) - 4) + 1))
#define PA_STEP(C0, C1, P0, P1, kso, vso, MASKED, FIRST) do { \
        bf16x8 kf_[8]; bf16x8 vf_[16]; u32x4 pk_[4]; bool resc_ = false; \
        kf_[0] = PA_KFJ(kso, 0); kf_[1] = PA_KFJ(kso, 1); kf_[2] = PA_KFJ(kso, 2); ASBAR(); \
        float sacc_ = P0[0] + P0[1]; float ma_ = 0.f; \
        _Pragma("unroll") for (int j = 0; j < 8; ++j) { \
            if (j + 3 < 8) kf_[j + 3] = PA_KFJ(kso, j + 3); else vf_[j - 5] = PA_VF(vso, j - 5); \
            if (j == 0) C0 = MFMA32(kf_[0], qr[0], negm); else if (j < 4) C0 = MFMA32(kf_[j], qr[j], C0); \
            else if (j == 4) C1 = MFMA32(kf_[4], qr[0], negm); else C1 = MFMA32(kf_[j], qr[j - 4], C1); \
            sacc_ += PA_SEL(P0, P1, 2 + 4 * j); sacc_ += PA_SEL(P0, P1, 3 + 4 * j); \
            if (j < 7) { sacc_ += PA_SEL(P0, P1, 4 + 4 * j); sacc_ += PA_SEL(P0, P1, 5 + 4 * j); } \
            APIN(sacc_); \
            pk_[j >> 1][(j & 1) * 2] = pk2(PA_SEL(P0, P1, 4 * j), PA_SEL(P0, P1, 4 * j + 1)); pk_[j >> 1][(j & 1) * 2 + 1] = pk2(PA_SEL(P0, P1, 4 * j + 2), PA_SEL(P0, P1, 4 * j + 3)); \
            APIN(pk_[j >> 1]); \
            if (j == 4) { ma_ = __builtin_fmaxf(__builtin_fmaxf(C0[0], C0[1]), C0[2]);     \
                          ma_ = max3f(ma_, C0[3], C0[4]); APIN(ma_); } \
            if (j == 5) { ma_ = max3f(ma_, C0[5], C0[6]); ma_ = max3f(ma_, C0[7], C0[8]); APIN(ma_); } \
            if (j == 6) { ma_ = max3f(ma_, C0[9], C0[10]); ma_ = max3f(ma_, C0[11], C0[12]); APIN(ma_); } \
            if (j == 7) { ma_ = max3f(ma_, C0[13], C0[14]); ma_ = fmaxf(ma_, C0[15]); APIN(ma_); } \
            ASBAR(); } \
        lrow += sacc_; \
        if (MASKED) { _Pragma("unroll") for (int r = 0; r < 16; ++r) { C0[r] = -1.0e30f; C1[r] = -1.0e30f; } ma_ = -1.0e30f; } \
        { float b_ = __builtin_fmaxf(__builtin_fmaxf(C1[0], C1[1]), C1[2]); ma_ = max3f(ma_, C1[3], C1[4]); \
          _Pragma("unroll") for (int r = 5; r < 13; r += 4) { b_ = max3f(b_, C1[r], C1[r + 1]); ma_ = max3f(ma_, C1[r + 2], C1[r + 3]); } \
          b_ = max3f(b_, C1[13], C1[14]); ma_ = fmaxf(ma_, C1[15]); \
          const float mx_ = max32x(fmaxf(ma_, b_)); \
          if (__builtin_expect((FIRST) || __any(mx_ > 8.f), 0)) { const float dl_ = (FIRST) ? mx_ : fmaxf(mx_, 0.f); mrow += dl_; \
              _Pragma("unroll") for (int r = 0; r < 16; ++r) { C0[r] -= dl_; C1[r] -= dl_; negm[r] = -mrow; } \
              const float f_ = (FIRST) ? 0.f : __builtin_amdgcn_exp2f(-dl_); lrow *= f_; if (hi == 0) wsf[r32] = f_; resc_ = true; } } \
        ASBAR(); \
        _Pragma("unroll") for (int g = 0; g < 16; ++g) { \
            if (g + 3 < 16) vf_[g + 3] = PA_VF(vso, g + 3); \
            o[g >> 2] = MFMA32(__builtin_bit_cast(bf16x8, pk_[g & 3]), vf_[g], o[g >> 2]); \
            if (g < 8) { C0[2 * g] = __builtin_amdgcn_exp2f(C0[2 * g]); C0[2 * g + 1] = __builtin_amdgcn_exp2f(C0[2 * g + 1]); APIN(C0); } \
            else { C1[2 * g - 16] = __builtin_amdgcn_exp2f(C1[2 * g - 16]); C1[2 * g - 15] = __builtin_amdgcn_exp2f(C1[2 * g - 15]); APIN(C1); } \
            ASBAR(); } \
        if (resc_) { LDS_WAIT(); \
            _Pragma("unroll") for (int r = 0; r < 16; ++r) { const float fr_ = wsf[crow(r, hi)]; \
                _Pragma("unroll") for (int d = 0; d < 4; ++d) o[d][r] *= fr_; } } \
    } while (0)
#define PA_DRAIN(P0, P1, vso) do { float sacc_ = 0.f; \
        _Pragma("unroll") for (int r = 0; r < 16; ++r) sacc_ += P0[r] + P1[r]; \
        lrow += sacc_; u32x4 pk_[4]; \
        _Pragma("unroll") for (int k = 0; k < 4; ++k) { pk_[k][0] = pk2(PA_SEL(P0, P1, 8 * k), PA_SEL(P0, P1, 8 * k + 1)); pk_[k][1] = pk2(PA_SEL(P0, P1, 8 * k + 2), PA_SEL(P0, P1, 8 * k + 3)); \
            pk_[k][2] = pk2(PA_SEL(P0, P1, 8 * k + 4), PA_SEL(P0, P1, 8 * k + 5)); pk_[k][3] = pk2(PA_SEL(P0, P1, 8 * k + 6), PA_SEL(P0, P1, 8 * k + 7)); } \
        _Pragma("unroll") for (int g = 0; g < 16; ++g) o[g >> 2] = MFMA32(__builtin_bit_cast(bf16x8, pk_[g & 3]), PA_VF(vso, g), o[g >> 2]); } while (0)
#pragma unroll
    for (int r = 0; r < 16; ++r) { pB0[r] = 0.f; pB1[r] = 0.f; }
    mrow = 0.f;
    f32x16 negm = zero16; asm volatile("" : "+v"(negm));
    PA_DMA(0); PA_DMA(1); PA_WAITBAR(4);
    for (int i = 0; i < NT; i += 2) {
        if (i + 2 < NT) PA_DMA(i + 2);
        PA_STEP(pA0, pA1, pB0, pB1, (i & 3) * 32768, ((i == 0 ? 0 : i - 1) & 3) * 32768, false, (i == 0));
        if (i + 2 < NT) PA_WAITBAR(4); else PA_WAITBAR(0);
        if (i + 3 < NT) PA_DMA(i + 3);
        PA_STEP(pB0, pB1, pA0, pA1, ((i + 1) & 3) * 32768, (i & 3) * 32768, (half == 0 && i + 2 == NT), false);
        if (i + 3 < NT) PA_WAITBAR(4); else PA_WAITBAR(0);
    }
    PA_DRAIN(pB0, pB1, ((NT - 1) & 3) * 32768);
    __syncthreads();
#undef PA_DMA
#undef PA_KF
#undef PA_KFJ
#undef PA_VF
#undef PA_SEL
#undef PA_WAITBAR
#undef PA_STEP
#undef PA_DRAIN
    {
        const float lt = sum32x(lrow);
        if (hi == 0) wsf[32 + r32] = lt;
        LDS_WAIT();
#pragma unroll
        for (int r = 0; r < 16; ++r) { const float il = frcp(wsf[32 + crow(r, hi)]);
#pragma unroll
            for (int d = 0; d < 4; ++d) o[d][r] *= il; }
    }
    LAS float* X = (LAS float*)lds;
    if (comp == 1) {
#pragma unroll
        for (int d = 0; d < 4; ++d)
#pragma unroll
            for (int r = 0; r < 16; ++r) X[((rg * 4 + d) * 16 + r) * 64 + lane] = o[d][r];
    }
    __syncthreads();
    if (comp == 0) {
        float nw[4];
#pragma unroll
        for (int d = 0; d < 4; ++d) nw[d] = normw[32 * d + r32];
#pragma unroll
        for (int r = 0; r < 16; ++r) {
            float ss = 0.f;
#pragma unroll
            for (int d = 0; d < 4; ++d) { const float x = o[d][r] - lam * X[((rg * 4 + d) * 16 + r) * 64 + lane]; o[d][r] = x; ss += x * x; }
            ss = half_sum(ss);
            const float rs = onem * frsq(ss * (1.0f / 128.0f) + EPS);
            GAS bf16* op = O + (orow0 + crow(r, hi)) * 1024 + h * 128 + r32;
#pragma unroll
            for (int d = 0; d < 4; ++d) op[32 * d] = f2bf(o[d][r] * rs * nw[d]);
        }
    }
    __syncthreads();
}

constexpr int G_QET = 0, G_KET = 24576, G_KDT = 49152, G_VIM = 67584, G_AM = 100352, G_TOT = 109568, G_DV = 113664, G_SSQ = 114176, G_END = 116224;
static_assert(G_END <= RING_BYTES, "gla lds");
struct GlaP { const GAS bf16* QG; const GAS bf16* KG; const GAS bf16* VG; const GAS bf16* GK; const GAS bf16* RG; const GAS bf16* GA; const GAS bf16* GB; const GAS bf16* OA; GAS bf16* MG; const GAS float* gnw; };

template <bool FULL, int MODE>
__device__ __forceinline__ void gla_run(LAS unsigned char* lds, const GlaP& P, size_t m0, int h, int nch, f32x16 (&S)[4], float& dsum0, float& dsum1) {
    const int tid = opaque_tid(), lane = tid & 63, w = __builtin_amdgcn_readfirstlane(tid >> 6), r32 = lane & 31, hi = lane >> 5;
    const int trq = ((lane >> 4) & 1) * 32 + (lane & 3) * 8, q4 = (lane & 15) >> 2;
    unsigned gq[8], qv[8], kv[8]; u32x4 vpre[4];
    unsigned lo_g = (unsigned)((8 * w) * 1024 + 4 * lane), lo_v = (unsigned)((lane >> 2) * 2048 + w * 64 + (lane & 3) * 16);
#define GLA_LOADS(chn) do { const size_t mcn = m0 + (size_t)(chn) * 64; asm volatile("" : "+v"(lo_g), "+v"(lo_v)); \
        const GAS char* gkb = (const GAS char*)(P.GK + mcn * 512 + h * 128); const GAS char* qgb = (const GAS char*)(P.QG + mcn * 512 + h * 128); const GAS char* kgb = (const GAS char*)(P.KG + mcn * 512 + h * 128); \
        const GAS char* vgb = (const GAS char*)(P.VG + mcn * 1024 + h * 256); \
        _Pragma("unroll") for (int i = 0; i < 8; ++i) { const bool valid = (MODE == 0) || (8 * w + i < 16); \
            gq[i] = valid ? *(const GAS unsigned*)(gkb + i * 1024 + lo_g) : 0u; if (FULL) qv[i] = valid ? *(const GAS unsigned*)(qgb + i * 1024 + lo_g) : 0u; kv[i] = valid ? *(const GAS unsigned*)(kgb + i * 1024 + lo_g) : 0u; } \
        _Pragma("unroll") for (int i = 0; i < 4; ++i) { const int s = (lane >> 2) + 16 * i; const bool valid = (MODE == 0) || (s < 16); \
            vpre[i] = valid ? *(const GAS u32x4*)(vgb + i * 32768 + lo_v) : (u32x4){0u, 0u, 0u, 0u}; } } while (0)
    GLA_LOADS(0);
    for (int ch = 0; ch < nch; ++ch) {
        const size_t mc = m0 + (size_t)ch * 64;
        {
            float b0[8], b1[8];
#pragma unroll
            for (int i = 0; i < 8; ++i) { b0[i] = bflo(gq[i]); b1[i] = bfhi(gq[i]); }
#pragma unroll
            for (int i = 1; i < 8; ++i) { b0[i] += b0[i - 1]; b1[i] += b1[i - 1]; }
            LAS float* TOT = (LAS float*)(lds + G_TOT);
            *(LAS f32x2*)(TOT + w * 128 + 2 * lane) = (f32x2){b0[7], b1[7]};
            __syncthreads();
            float p0 = 0.f, p1 = 0.f, t0 = 0.f, t1 = 0.f;
#pragma unroll
            for (int ww = 0; ww < 8; ++ww) { const f32x2 tv = *(const LAS f32x2*)(TOT + ww * 128 + 2 * lane); if (ww < w) { p0 += tv.x; p1 += tv.y; } t0 += tv.x; t1 += tv.y; }
            u32x4 qe0, qe1, ke0, ke1, kd0, kd1;
#pragma unroll
            for (int i = 0; i < 8; i += 2) {
                float v[12];
#pragma unroll
                for (int j = 0; j < 2; ++j) {
                    const float ba = b0[i + j] + p0, bb = b1[i + j] + p1;
                    const float ka = bflo(kv[i + j]), kb_ = bfhi(kv[i + j]);
                    v[8 + j] = ka * __expf(t0 - ba); v[10 + j] = kb_ * __expf(t1 - bb);
                    if (FULL) { const float qa = bflo(qv[i + j]), qb = bfhi(qv[i + j]);
                        v[j] = qa * __expf(ba); v[2 + j] = qb * __expf(bb); v[4 + j] = ka * __expf(-ba); v[6 + j] = kb_ * __expf(-bb); }
                }
                if (FULL) { qe0[i >> 1] = pk2(v[0], v[1]); qe1[i >> 1] = pk2(v[2], v[3]); ke0[i >> 1] = pk2(v[4], v[5]); ke1[i >> 1] = pk2(v[6], v[7]); }
                kd0[i >> 1] = pk2(v[8], v[9]); kd1[i >> 1] = pk2(v[10], v[11]);
            }
            const int c0 = 2 * lane;
            if (FULL) {
                *(LAS u32x4*)(lds + G_QET + c0 * 192 + w * 16) = qe0; *(LAS u32x4*)(lds + G_QET + (c0 + 1) * 192 + w * 16) = qe1;
                *(LAS u32x4*)(lds + G_KET + c0 * 192 + w * 16) = ke0; *(LAS u32x4*)(lds + G_KET + (c0 + 1) * 192 + w * 16) = ke1;
            }
            *(LAS u32x4*)(lds + G_KDT + c0 * 144 + w * 16) = kd0; *(LAS u32x4*)(lds + G_KDT + (c0 + 1) * 144 + w * 16) = kd1;
            if (w == 0) { *(LAS f32x2*)((LAS float*)(lds + G_DV) + c0) = (f32x2){__expf(t0), __expf(t1)}; }
            dsum0 += t0; dsum1 += t1;
#pragma unroll
            for (int i = 0; i < 4; ++i) { const int s = (lane >> 2) + 16 * i; *(LAS u32x4*)(lds + G_VIM + w * 4096 + s * 64 + (lane & 3) * 16) = vpre[i]; }
            if (ch + 1 < nch) GLA_LOADS(ch + 1);
        }
        asm volatile("s_waitcnt lgkmcnt(0)\n\ts_barrier" ::: "memory");
        f32x16 o[2];
        if (FULL) {
            if (w < 3) {
                const int tb = (w + 1) >> 1, sb = w >> 1;
                f32x16 c;
#pragma unroll
                for (int r = 0; r < 16; ++r) c[r] = 0.f;
                const int tro = trq + (8 * hi + q4) * 192;
#pragma unroll
                for (int ks = 0; ks < 8; ++ks) {
                    const LAS unsigned char* ap = lds + G_KET + tro + ks * 16 * 192 + sb * 64; const LAS unsigned char* bp = lds + G_QET + tro + ks * 16 * 192 + tb * 64;
                    c = MFMA32(cat8(tr16(ap), tr16(ap + 4 * 192)), cat8(tr16(bp), tr16(bp + 4 * 192)), c);
                }
                const int t = 32 * tb + r32;
#pragma unroll
                for (int g = 0; g < 4; ++g) { const int s0 = 32 * sb + 8 * g + 4 * hi; float x[4];
#pragma unroll
                    for (int e = 0; e < 4; ++e) x[e] = (s0 + e <= t) ? c[4 * g + e] : 0.f;
                    *(LAS u32x2*)(lds + G_AM + t * 144 + s0 * 2) = (u32x2){pk2(x[0], x[1]), pk2(x[2], x[3])}; }
            } else if (w == 3) {
#pragma unroll
                for (int g = 0; g < 4; ++g) *(LAS u32x2*)(lds + G_AM + r32 * 144 + (32 + 8 * g + 4 * hi) * 2) = (u32x2){0u, 0u};
            }
            asm volatile("s_waitcnt lgkmcnt(0)\n\ts_barrier" ::: "memory");
        }
        bf16x8 vf[4];
        { const LAS unsigned char* vp = lds + G_VIM + w * 4096 + trq + (8 * hi + q4) * 64;
#pragma unroll
          for (int ss = 0; ss < 4; ++ss) vf[ss] = cat8(tr16(vp + ss * 1024), tr16(vp + ss * 1024 + 256)); }
        if (FULL) {
#pragma unroll
            for (int tb = 0; tb < 2; ++tb)
#pragma unroll
                for (int r = 0; r < 16; ++r) o[tb][r] = 0.f;
            const int trk = trq + (4 * hi + q4) * 192;
#pragma unroll
            for (int kb = 0; kb < 4; ++kb)
#pragma unroll
                for (int s2 = 0; s2 < 2; ++s2) {
                    u32x4 x; x.x = pk2(S[kb][8 * s2 + 0], S[kb][8 * s2 + 1]); x.y = pk2(S[kb][8 * s2 + 2], S[kb][8 * s2 + 3]); x.z = pk2(S[kb][8 * s2 + 4], S[kb][8 * s2 + 5]); x.w = pk2(S[kb][8 * s2 + 6], S[kb][8 * s2 + 7]);
                    const bf16x8 bS = __builtin_bit_cast(bf16x8, x);
#pragma unroll
                    for (int tb = 0; tb < 2; ++tb) { const LAS unsigned char* ap = lds + G_QET + trk + (32 * kb + 16 * s2) * 192 + tb * 64;
                        o[tb] = MFMA32(cat8(tr16(ap), tr16(ap + 8 * 192)), bS, o[tb]); }
                }
#pragma unroll
            for (int ss = 0; ss < 4; ++ss)
#pragma unroll
                for (int tb = 0; tb < 2; ++tb) { const bf16x8 a = *(const LAS bf16x8*)(lds + G_AM + (32 * tb + r32) * 144 + (16 * ss + 8 * hi) * 2);
                    o[tb] = MFMA32(a, vf[ss], o[tb]); }
        }
#pragma unroll
        for (int kb = 0; kb < 4; ++kb) {
#pragma unroll
            for (int g = 0; g < 4; ++g) { const f32x4 d4 = *(const LAS f32x4*)((LAS float*)(lds + G_DV) + 32 * kb + 8 * g + 4 * hi);
#pragma unroll
                for (int e = 0; e < 4; ++e) S[kb][4 * g + e] *= d4[e]; }
#pragma unroll
            for (int ss = 0; ss < 4; ++ss) { const bf16x8 a = *(const LAS bf16x8*)(lds + G_KDT + (32 * kb + r32) * 144 + (16 * ss + 8 * hi) * 2);
                S[kb] = MFMA32(a, vf[ss], S[kb]); }
        }
        if (FULL) {
            asm volatile("s_waitcnt lgkmcnt(0)\n\ts_barrier" ::: "memory");
            LAS float* OST = (LAS float*)lds;
#pragma unroll
            for (int tb = 0; tb < 2; ++tb)
#pragma unroll
                for (int r = 0; r < 16; ++r) OST[(32 * tb + crow(r, hi)) * 256 + 32 * w + r32] = o[tb][r];
            u32x4 erg[2], ega[2], egb[2], eoa[2];
            unsigned lo_e = (unsigned)((((MODE == 0) ? (tid >> 5) : ((tid >> 5) & 15)) * 1024 + 8 * (tid & 31)) * 2);
#define GLA_ELOADS(i0) do { asm volatile("" : "+v"(lo_e)); _Pragma("unroll") for (int i = 0; i < 2; ++i) { \
                const size_t ub = ((mc + ((MODE == 0) ? 16 * ((i0) + i) : 0)) * 1024 + h * 256) * 2; \
                erg[i] = *(const GAS u32x4*)((const GAS char*)P.RG + ub + lo_e); ega[i] = *(const GAS u32x4*)((const GAS char*)P.GA + ub + lo_e); \
                egb[i] = *(const GAS u32x4*)((const GAS char*)P.GB + ub + lo_e); eoa[i] = *(const GAS u32x4*)((const GAS char*)P.OA + ub + lo_e); } } while (0)
            GLA_ELOADS(0);
            asm volatile("s_waitcnt lgkmcnt(0)\n\ts_barrier" ::: "memory");
#pragma unroll
            for (int i0 = 0; i0 < 4; i0 += 2) {
#pragma unroll
              for (int i = 0; i < 2; ++i) {
                const int idx = tid + 512 * (i0 + i), t = idx >> 5, c8 = idx & 31;
                const f32x4 oa4 = *(const LAS f32x4*)(OST + t * 256 + 8 * c8), ob4 = *(const LAS f32x4*)(OST + t * 256 + 8 * c8 + 4);
                float ssq = (oa4.x * oa4.x + oa4.y * oa4.y) + (oa4.z * oa4.z + oa4.w * oa4.w) + (ob4.x * ob4.x + ob4.y * ob4.y) + (ob4.z * ob4.z + ob4.w * ob4.w);
                ssq = half_sum(ssq);
                const float rstd = frsq(ssq * (1.0f / 256.0f) + EPS);
                if (MODE == 0 || t < 16) {
                    const size_t off = (mc + t) * 1024 + h * 256 + 8 * c8;
                    const f32x4 gw0 = *(const GAS f32x4*)(P.gnw + 8 * c8), gw1 = *(const GAS f32x4*)(P.gnw + 8 * c8 + 4);
                    float ov[8] = {oa4.x, oa4.y, oa4.z, oa4.w, ob4.x, ob4.y, ob4.z, ob4.w}; float gwv[8] = {gw0.x, gw0.y, gw0.z, gw0.w, gw1.x, gw1.y, gw1.z, gw1.w};
                    float res[8];
#pragma unroll
                    for (int e = 0; e < 8; ++e) {
                        const unsigned ru = erg[i][e >> 1], gau = ega[i][e >> 1], gbu = egb[i][e >> 1], oau = eoa[i][e >> 1];
                        const float rv = (e & 1) ? bfhi(ru) : bflo(ru), gav = (e & 1) ? bfhi(gau) : bflo(gau), gbv = (e & 1) ? bfhi(gbu) : bflo(gbu), oav = (e & 1) ? bfhi(oau) : bflo(oau);
                        const float og = ov[e] * rstd * gwv[e] * (rv * sigmoidf_(rv));
                        res[e] = sigmoidf_(gav) * oav + sigmoidf_(gbv) * og;
                    }
                    u32x4 mo; mo.x = pk2(res[0], res[1]); mo.y = pk2(res[2], res[3]); mo.z = pk2(res[4], res[5]); mo.w = pk2(res[6], res[7]);
                    *(GAS u32x4*)(P.MG + off) = mo;
                }
              }
              if (i0 == 0) { asm volatile("" ::: "memory"); GLA_ELOADS(2); }
            }
#undef GLA_ELOADS
        }
        asm volatile("s_waitcnt lgkmcnt(0)\n\ts_barrier" ::: "memory");
    }
#undef GLA_LOADS
}
__device__ __forceinline__ void gla_store_state(GAS float* p, const f32x16 (&S)[4], int w, int r32, int hi) {
    unsigned off = (unsigned)(4 * hi * 256 + 32 * w + r32);
#pragma unroll
    for (int kb = 0; kb < 4; ++kb)
#pragma unroll
        for (int g4 = 0; g4 < 4; ++g4) {
#pragma unroll
            for (int e = 0; e < 4; ++e) p[off + e * 256] = S[kb][4 * g4 + e];
            off += 8 * 256; asm volatile("" : "+v"(off)); }
}
__device__ __forceinline__ void gla_load_state(const GAS float* p, f32x16 (&S)[4], int w, int r32, int hi) {
    unsigned off = (unsigned)(4 * hi * 256 + 32 * w + r32);
#pragma unroll
    for (int kb = 0; kb < 4; ++kb)
#pragma unroll
        for (int g4 = 0; g4 < 4; ++g4) {
#pragma unroll
            for (int e = 0; e < 4; ++e) S[kb][4 * g4 + e] = p[off + e * 256];
            off += 8 * 256; asm volatile("" : "+v"(off)); }
}

template <int XIN, int XOUT>
__device__ __forceinline__ void rowpass(const GAS bf16* tmp, const GAS float* part, int nks, const GAS float* xin_p, const GAS float* xin_s, const GAS bf16* rs_in, GAS float* xout, GAS bf16* rs_out,
                                        const GAS float* wpost, const GAS float* wnext, GAS bf16* xn, int gw, int ngw, int lane) {
    f32x4 gp[4], gn[4];
#pragma unroll
    for (int j = 0; j < 4; ++j) { gp[j] = *((const GAS f32x4*)wpost + lane + 64 * j); gn[j] = xn ? *((const GAS f32x4*)wnext + lane + 64 * j) : (f32x4){0.f, 0.f, 0.f, 0.f}; }
    u32x2 tq[4], tq_n[4]; f32x4 xq[4], xq_n[4]; u32x2 xb[4], xb_n[4];
#define RP_LOAD(mm, T, XF, XB) do { \
        if ((mm) < MP) { const GAS u32x2* tr_ = (const GAS u32x2*)(tmp + (size_t)(mm) * DM) + lane; _Pragma("unroll") for (int j = 0; j < 4; ++j) T[j] = tr_[64 * j]; } \
        if (XIN == 0) { const GAS f32x4* xr_ = (const GAS f32x4*)(((mm) < MP) ? xin_p + (size_t)(mm) * DM : xin_s + (size_t)((mm) - MP) * DM) + lane; _Pragma("unroll") for (int j = 0; j < 4; ++j) XF[j] = xr_[64 * j]; } \
        else { const GAS u32x2* xr_ = (const GAS u32x2*)(rs_in + (size_t)(mm) * DM) + lane; _Pragma("unroll") for (int j = 0; j < 4; ++j) XB[j] = xr_[64 * j]; } } while (0)
    int m = gw;
    if (m < MT) RP_LOAD(m, tq, xq, xb);
    for (; m < MT; m += ngw) {
        const int mn = m + ngw;
        if (mn < MT) RP_LOAD(mn, tq_n, xq_n, xb_n);
        f32x4 tv[4], xv[4]; float s = 0.f;
#pragma unroll
        for (int j = 0; j < 4; ++j) {
            if (m < MP) tv[j] = (f32x4){bflo(tq[j].x), bfhi(tq[j].x), bflo(tq[j].y), bfhi(tq[j].y)};
            else { f32x4 a_ = {0.f, 0.f, 0.f, 0.f}; for (int ks = 0; ks < nks; ++ks) a_ = a_ + *((const GAS f32x4*)(part + ((size_t)ks * MS + (m - MP)) * DM) + lane + 64 * j); tv[j] = a_; }
            xv[j] = (XIN == 0) ? xq[j] : (f32x4){bflo(xb[j].x), bfhi(xb[j].x), bflo(xb[j].y), bfhi(xb[j].y)};
            s += (tv[j].x * tv[j].x + tv[j].y * tv[j].y) + (tv[j].z * tv[j].z + tv[j].w * tv[j].w); }
        const float r1 = frsq(wave_sum(s) * (1.f / DM) + EPS);
        float s2 = 0.f;
#pragma unroll
        for (int j = 0; j < 4; ++j) { xv[j] = xv[j] + tv[j] * r1 * gp[j]; s2 += (xv[j].x * xv[j].x + xv[j].y * xv[j].y) + (xv[j].z * xv[j].z + xv[j].w * xv[j].w); }
        if (XOUT == 0) { GAS f32x4* orow = (GAS f32x4*)(xout + (size_t)m * DM) + lane;
#pragma unroll
            for (int j = 0; j < 4; ++j) orow[64 * j] = xv[j]; }
        else { GAS u32x2* orow = (GAS u32x2*)(rs_out + (size_t)m * DM) + lane;
#pragma unroll
            for (int j = 0; j < 4; ++j) { u32x2 o; o.x = pk2(xv[j].x, xv[j].y); o.y = pk2(xv[j].z, xv[j].w); orow[64 * j] = o; } }
        if (xn) {
            const float r2 = frsq(wave_sum(s2) * (1.f / DM) + EPS);
            GAS u32x2* o8 = (GAS u32x2*)(xn + (size_t)m * DM) + lane;
#pragma unroll
            for (int j = 0; j < 4; ++j) { const f32x4 g = gn[j]; u32x2 o; o.x = pk2(xv[j].x * r2 * g.x, xv[j].y * r2 * g.y); o.y = pk2(xv[j].z * r2 * g.z, xv[j].w * r2 * g.w); o8[64 * j] = o; }
        }
#pragma unroll
        for (int j = 0; j < 4; ++j) { tq[j] = tq_n[j]; xq[j] = xq_n[j]; xb[j] = xb_n[j]; }
    }
#undef RP_LOAD
}
__device__ __forceinline__ float gelu_tanh(float x) {
    const float u = 0.7978845608028654f * (x + 0.044715f * x * x * x);
    const float e = __expf(2.f * u);
    const float th = 1.f - 2.f * frcp(e + 1.f);
    return 0.5f * x * (1.f + th);
}
__device__ __forceinline__ void act_pass(const GAS bf16* UG, GAS bf16* ACT, const GAS float* convw, const GAS float* convb, const GAS float* sconv  ,
                                         GAS float* cout_p, GAS float* cout_s, int vcu, int G, int tid) {
    if (tid >= DFF / 8) return;
    const int c = tid * 8;
    float w0[8], w1[8], w2[8], cb[8];
#pragma unroll
    for (int e = 0; e < 8; ++e) { w0[e] = convw[c + e]; w1[e] = convw[DFF + c + e]; w2[e] = convw[2 * DFF + c + e]; cb[e] = convb[c + e]; }
    for (int strip = vcu; strip < MT / 16; strip += G) {
        const int m0 = strip * 16; const bool sample = (m0 >= MP);
        float gm2[8], gm1[8];
        if (sample) { const int b = (m0 - MP) >> 4; const GAS float* sc = sconv + (size_t)b * 2 * DFF + c;
#pragma unroll
            for (int e = 0; e < 8; ++e) { gm2[e] = sc[e]; gm1[e] = sc[DFF + e]; } }
        else if ((m0 & (SEQ - 1)) == 0) {
#pragma unroll
            for (int e = 0; e < 8; ++e) { gm2[e] = 0.f; gm1[e] = 0.f; } }
        else { const u32x4 a = *(const GAS u32x4*)(UG + (size_t)(m0 - 2) * 5632 + DFF + c), bq = *(const GAS u32x4*)(UG + (size_t)(m0 - 1) * 5632 + DFF + c);
#pragma unroll
            for (int e = 0; e < 4; ++e) { gm2[2 * e] = bflo(a[e]); gm2[2 * e + 1] = bfhi(a[e]); gm1[2 * e] = bflo(bq[e]); gm1[2 * e + 1] = bfhi(bq[e]); } }
        u32x4 ub[2][8], gb[2][8];
#pragma unroll
        for (int i = 0; i < 8; ++i) { ub[0][i] = *(const GAS u32x4*)(UG + (size_t)(m0 + i) * 5632 + c); gb[0][i] = *(const GAS u32x4*)(UG + (size_t)(m0 + i) * 5632 + DFF + c); }
#pragma unroll
        for (int hb = 0; hb < 2; ++hb) {
            if (hb == 0) {
#pragma unroll
                for (int i = 0; i < 8; ++i) { ub[1][i] = *(const GAS u32x4*)(UG + (size_t)(m0 + 8 + i) * 5632 + c); gb[1][i] = *(const GAS u32x4*)(UG + (size_t)(m0 + 8 + i) * 5632 + DFF + c); }
            }
#pragma unroll
            for (int i = 0; i < 8; ++i) {
                const size_t m = (size_t)m0 + 8 * hb + i;
                const u32x4 uu = ub[hb][i], gg = gb[hb][i];
                float g0[8], res[8];
#pragma unroll
                for (int e = 0; e < 4; ++e) { g0[2 * e] = bflo(gg[e]); g0[2 * e + 1] = bfhi(gg[e]); }
#pragma unroll
                for (int e = 0; e < 8; ++e) { const float uv = (e & 1) ? bfhi(uu[e >> 1]) : bflo(uu[e >> 1]);
                    const float gc = cb[e] + w0[e] * gm2[e] + w1[e] * gm1[e] + w2[e] * g0[e]; res[e] = gelu_tanh(gc) * uv; gm2[e] = gm1[e]; gm1[e] = g0[e]; }
                u32x4 o; o.x = pk2(res[0], res[1]); o.y = pk2(res[2], res[3]); o.z = pk2(res[4], res[5]); o.w = pk2(res[6], res[7]);
                *(GAS u32x4*)(ACT + m * DFF + c) = o;
            }
        }
        if (sample) { const int b = (m0 - MP) >> 4; GAS float* co = cout_s + (size_t)b * 2 * DFF + c;
#pragma unroll
            for (int e = 0; e < 8; ++e) { co[e] = gm2[e]; co[DFF + e] = gm1[e]; } }
        else if ((m0 & (SEQ - 1)) == SEQ - 16) { const int b = m0 >> 13; GAS float* co = cout_p + (size_t)b * 2 * DFF + c;
#pragma unroll
            for (int e = 0; e < 8; ++e) { co[e] = gm2[e]; co[DFF + e] = gm1[e]; } }
    }
}

__device__ __forceinline__ void kv_out_rows(const GAS bf16* KA, const GAS bf16* VA, GAS float* kp, GAS float* vp, GAS float* ks, GAS float* vs, int r0, int r1, int wave, int lane) {
    for (int m = r0 + wave; m < r1; m += NWAVES) {
        const GAS u32x4* kr = (const GAS u32x4*)(KA + (size_t)m * DM) + 2 * lane; const GAS u32x4* vr = (const GAS u32x4*)(VA + (size_t)m * DM) + 2 * lane;
        const u32x4 k0 = kr[0], k1 = kr[1], v0 = vr[0], v1 = vr[1];
        GAS f32x4* ko = (GAS f32x4*)((m < MP ? kp + (size_t)m * DM : ks + (size_t)(m - MP) * DM)) + 4 * lane;
        GAS f32x4* vo = (GAS f32x4*)((m < MP ? vp + (size_t)m * DM : vs + (size_t)(m - MP) * DM)) + 4 * lane;
        __builtin_nontemporal_store(((f32x4){bflo(k0.x), bfhi(k0.x), bflo(k0.y), bfhi(k0.y)}), ko);     __builtin_nontemporal_store(((f32x4){bflo(k0.z), bfhi(k0.z), bflo(k0.w), bfhi(k0.w)}), ko + 1);
        __builtin_nontemporal_store(((f32x4){bflo(k1.x), bfhi(k1.x), bflo(k1.y), bfhi(k1.y)}), ko + 2); __builtin_nontemporal_store(((f32x4){bflo(k1.z), bfhi(k1.z), bflo(k1.w), bfhi(k1.w)}), ko + 3);
        __builtin_nontemporal_store(((f32x4){bflo(v0.x), bfhi(v0.x), bflo(v0.y), bfhi(v0.y)}), vo);     __builtin_nontemporal_store(((f32x4){bflo(v0.z), bfhi(v0.z), bflo(v0.w), bfhi(v0.w)}), vo + 1);
        __builtin_nontemporal_store(((f32x4){bflo(v1.x), bfhi(v1.x), bflo(v1.y), bfhi(v1.y)}), vo + 2); __builtin_nontemporal_store(((f32x4){bflo(v1.z), bfhi(v1.z), bflo(v1.w), bfhi(v1.w)}), vo + 3);
    }
}

__global__ void __launch_bounds__(NWAVES * 64, 2) mega_fwd(Args args) {
#define AIN(i) ((const GAS float*)args.in[i])
    extern __shared__ __attribute__((aligned(16))) unsigned char lds_raw[];
    LAS unsigned char* lds = (LAS unsigned char*)lds_raw;
    volatile LAS unsigned* MISC = (volatile LAS unsigned*)(lds + MISC_OFF);
    const int tid0 = threadIdx.x;
    const int G0 = gridDim.x; const int bx0 = blockIdx.x; const int vcu0 = (G0 % 8 == 0) ? (bx0 % 8) * (G0 / 8) + bx0 / 8 : bx0;
    GAS unsigned char* ws0 = (GAS unsigned char*)args.ws;
#define OPQ() GAS unsigned char* ws = ws0; GAS float* out = out0; asm volatile("" : "+s"(ws), "+s"(out)); int G = G0, bx = bx0, vcu = vcu0; asm volatile("" : "+s"(G), "+s"(bx), "+s"(vcu)); const int NGW = G * NWAVES; (void)NGW; (void)bx; const int tid = opaque_tid(), lane = tid & 63, wave = __builtin_amdgcn_readfirstlane(tid >> 6), gw = vcu * NWAVES + wave; (void)gw; (void)lane
#define GRID_BAR() xcd_barrier_ni(bar.bar, bar.x, bar.st)
    for (int u = tid0; u < (LDS_BYTES - MISC_OFF) / 4; u += NWAVES * 64) ((LAS unsigned*)(lds + MISC_OFF))[u] = 0u;
    __syncthreads();
    XcdBarrier bar = xcd_barrier_post((unsigned*)args.ws + CW_BAR, MISC + 8);
    (void)args.ph_lo;
#ifndef PHMASK
#define PHMASK 0xfffff
#endif
#define IN(k) true
#define EN(i) ((PHMASK >> (i)) & 1)
#ifndef REPMASK
#define REPMASK 0
#endif
#define REP(i) ((REPMASK >> (i)) & 1)
#ifndef NOFOLD
#define NOFOLD 0
#endif
    GAS float* const out0 = (GAS float*)args.out;

    if (EN(0) && IN(0)) { OPQ(); GAS bf16* const XN = (GAS bf16*)(ws + WS_XN);
        LAS float* scr = (LAS float*)(lds + wave * 16384);
        for (int li = 0; li < DEPTH; ++li) {
            GAS unsigned char* wl = ws + WS_W + (size_t)li * W_LAYER;
            const GAS float* w_in = AIN(I_WIN) + (size_t)li * DM * DIN; const GAS float* w_gk2 = AIN(I_WGK2) + (size_t)li * 16 * 512;
            const GAS float* w_o = AIN(I_WO) + (size_t)li * DM * DM; const GAS float* w_up = AIN(I_WUP) + (size_t)li * DM * 2 * DFF; const GAS float* w_dn = AIN(I_WDOWN) + (size_t)li * DFF * DM;
            constexpr int IT_IN = (NIN / 32) * 16, IT_O = 32 * 16, IT_UP = (2 * DFF / 32) * 16, IT_DN = 32 * (DFF / 64);
            for (int it = gw; it < IT_IN + IT_O + IT_UP + IT_DN; it += NGW) {
                int r = it;
                if (r < IT_IN) { const int nb = r >> 4, kb = r & 15;
                    if (nb < 192) transpose_item(w_in, DIN, DM, (GAS bf16*)(wl + W_IN), scr, kb, 32 * nb, 32 * nb, lane, nullptr);
                    else if (nb < 256) transpose_item(w_in, DIN, DM, (GAS bf16*)(wl + W_IN), scr, kb, 32 * nb + 16, 32 * nb, lane, nullptr);
                    else transpose_item(w_in, DIN, DM, (GAS bf16*)(wl + W_IN), scr, kb, 32 * (nb - 256), 32 * nb, lane, w_gk2);
                    continue; }
                r -= IT_IN;
                if (r < IT_O) { transpose_item(w_o, DM, DM, (GAS bf16*)(wl + W_O), scr, r & 15, 32 * (r >> 4), 32 * (r >> 4), lane, nullptr); continue; }
                r -= IT_O;
                if (r < IT_UP) { transpose_item(w_up, 2 * DFF, DM, (GAS bf16*)(wl + W_UP), scr, r & 15, 32 * (r >> 4), 32 * (r >> 4), lane, nullptr); continue; }
                r -= IT_UP;
                { const int nb = r / (DFF / 64), kb = r % (DFF / 64); transpose_item(w_dn, DM, DFF, (GAS bf16*)(wl + W_DN), scr, kb, 32 * nb, 32 * nb, lane, nullptr); }
            }
        }
        for (int i = vcu * 512 + tid; i < SEQ * 8; i += G * 512) { const int pos = i >> 3, f = i & 7; float sn, cs; sincos_acc((float)pos * args.inv_freq[f], sn, cs);
            ((GAS float*)(ws + WS_ROPE))[pos * 16 + f] = cs; ((GAS float*)(ws + WS_ROPE))[pos * 16 + 8 + f] = sn; }
        { f32x4 gpm[4], xc[4], xnx[4];
#pragma unroll
          for (int j = 0; j < 4; ++j) gpm[j] = *((const GAS f32x4*)AIN(I_PREMIX) + lane + 64 * j);
#define P0_LOAD(mm, X) do { const GAS f32x4* xr_ = (const GAS f32x4*)(((mm) < MP) ? AIN(I_XP) + (size_t)(mm) * DM : AIN(I_XS) + (size_t)((mm) - MP) * DM) + lane; _Pragma("unroll") for (int j = 0; j < 4; ++j) X[j] = xr_[64 * j]; } while (0)
          int m = gw; if (m < MT) P0_LOAD(m, xc);
          for (; m < MT; m += NGW) {
              if (m + NGW < MT) P0_LOAD(m + NGW, xnx);
              float sq = 0.f;
#pragma unroll
              for (int j = 0; j < 4; ++j) sq += (xc[j].x * xc[j].x + xc[j].y * xc[j].y) + (xc[j].z * xc[j].z + xc[j].w * xc[j].w);
              const float rstd = frsq(wave_sum(sq) * (1.f / DM) + EPS);
              GAS u32x2* o8 = (GAS u32x2*)(XN + (size_t)m * DM) + lane;
#pragma unroll
              for (int j = 0; j < 4; ++j) { u32x2 o; o.x = pk2(xc[j].x * rstd * gpm[j].x, xc[j].y * rstd * gpm[j].y); o.y = pk2(xc[j].z * rstd * gpm[j].z, xc[j].w * rstd * gpm[j].w); o8[64 * j] = o; }
#pragma unroll
              for (int j = 0; j < 4; ++j) xc[j] = xnx[j];
          }
#undef P0_LOAD
        }
        GRID_BAR();
    }

    for (int li = 0; li < DEPTH; ++li) {
        const int pb = 1 + li * 16;
        if (EN(1) && IN(pb + 0)) { OPQ(); GAS unsigned char* wl = ws + WS_W + (size_t)li * W_LAYER; GAS bf16* const XN = (GAS bf16*)(ws + WS_XN); const GAS float* rope = (const GAS float*)(ws + WS_ROPE);
          for (int rep = 0; rep < ((REP(1) && li == 0) ? 2 : 1); ++rep) {
            pg8::Gemm g{(const GAS pg8::bf16_t*)XN, (const GAS pg8::bf16_t*)(wl + W_IN), MT, NIN, DM, DM}; pg8::StaticOrder S; S.init(MT, NIN, G, bx, 4);
            EpiIn E{ws, out + O_KP + (size_t)li * MP * DM, out + O_VP + (size_t)li * MP * DM, out + O_KS + (size_t)li * MS * DM, out + O_VS + (size_t)li * MS * DM, rope, AIN(I_BGK2) + li * 512};
            pg8::gemm_phase<EpiIn, pg8::StaticOrder, true, true>(lds, g, S, E);
            GRID_BAR();
          }
        }
        if (EN(2) && IN(pb + 1)) { OPQ(); GAS unsigned char* wl = ws + WS_W + (size_t)li * W_LAYER; GAS bf16* const XN = (GAS bf16*)(ws + WS_XN); const GAS float* rope = (const GAS float*)(ws + WS_ROPE);
          for (int rep = 0; rep < ((REP(2) && li == 0) ? 2 : 1); ++rep) {
            float lam, onem;
            { const float a = wave_sum(AIN(I_LQ1)[li * 64 + lane] * AIN(I_LK1)[li * 64 + lane]), c = wave_sum(AIN(I_LQ2)[li * 64 + lane] * AIN(I_LK2)[li * 64 + lane]);
              const float lam_init = 0.8f - 0.6f * expf(-0.3f * (float)li); lam = expf(a) - expf(c) + lam_init; onem = 1.0f - lam_init; }
            const GAS bf16* QA = (const GAS bf16*)(ws + WS_QA); const GAS bf16* KA = (const GAS bf16*)(ws + WS_KA); const GAS bf16* VA = (const GAS bf16*)(ws + WS_VA);
            const GAS float* nw = AIN(I_DANW) + li * 128;
            for (int rp = 0; rp < ((REP(10) && li == 0) ? 2 : 1); ++rp)
            if (EN(10)) for (int un = vcu; un < DB * 8; un += G)
                attn_unit<1>(lds, QA, KA, VA, (GAS bf16*)(ws + WS_OA), AIN(I_CK) + (size_t)li * DB * PAST * DM, AIN(I_CV) + (size_t)li * DB * PAST * DM, un >> 3, un & 7, 0, lam, onem, nw);
            for (int rp = 0; rp < ((REP(11) && li == 0) ? 2 : 1); ++rp)
            if (EN(11)) for (int it = vcu; it < 256; it += G) {
                GlaP P{(const GAS bf16*)(ws + WS_QG), (const GAS bf16*)(ws + WS_KG), (const GAS bf16*)(ws + WS_VG), (const GAS bf16*)(ws + WS_GK), nullptr, nullptr, nullptr, nullptr, nullptr, nullptr};
                f32x16 S[4];
#pragma unroll
                for (int kb = 0; kb < 4; ++kb)
#pragma unroll
                    for (int r = 0; r < 16; ++r) S[kb][r] = 0.f;
                float ds0 = 0.f, ds1 = 0.f;
                const int bh = it >> 3, grp = it & 7;
                gla_run<false, 0>(lds, P, (size_t)(bh >> 2) * SEQ + grp * 1024, bh & 3, 16, S, ds0, ds1);
                gla_store_state((GAS float*)(ws + WS_SLOC) + (size_t)it * 32768, S, wave, lane & 31, lane >> 5);
                if (wave == 0) { GAS float* dg = (GAS float*)(ws + WS_DG) + it * 128 + 2 * lane; dg[0] = __expf(ds0); dg[1] = __expf(ds1); }
            }
            if (EN(12)) for (int pi = vcu; pi < 2048; pi += G) {
                const int bh = (pi % 256) >> 2, s = (pi & 3) + 4 * (pi / 256);
                attn_prompt_unit(lds, QA, KA, VA, (GAS bf16*)(ws + WS_OA), bh >> 3, bh & 7, 63 - s, lam, onem, nw);
                attn_prompt_unit(lds, QA, KA, VA, (GAS bf16*)(ws + WS_OA), bh >> 3, bh & 7, s, lam, onem, nw);
            }
            GRID_BAR();
          }
        }
        if (EN(3) && IN(pb + 2)) { OPQ(); GAS unsigned char* wl = ws + WS_W + (size_t)li * W_LAYER; GAS bf16* const XN = (GAS bf16*)(ws + WS_XN); const GAS float* rope = (const GAS float*)(ws + WS_ROPE);
          for (int rep = 0; rep < ((REP(3) && li == 0) ? 2 : 1); ++rep) {
            GlaP P{(const GAS bf16*)(ws + WS_QG), (const GAS bf16*)(ws + WS_KG), (const GAS bf16*)(ws + WS_VG), (const GAS bf16*)(ws + WS_GK), (const GAS bf16*)(ws + WS_RG), (const GAS bf16*)(ws + WS_GA), (const GAS bf16*)(ws + WS_GB),
                   (const GAS bf16*)(ws + WS_OA), (GAS bf16*)(ws + WS_QA), AIN(I_GLANW) + li * 256};
            const int r32 = lane & 31, hh = lane >> 5;
            if (EN(13)) for (int it = vcu; it < 256; it += G) {
                const int bh = it >> 3, grp = it & 7;
                f32x16 S[4];
#pragma unroll
                for (int kb = 0; kb < 4; ++kb)
#pragma unroll
                    for (int r = 0; r < 16; ++r) S[kb][r] = 0.f;
                for (int j = 0; j < (NOFOLD ? 0 : grp); ++j) {
                    const GAS float* dg = (const GAS float*)(ws + WS_DG) + (size_t)(bh * 8 + j) * 128 + 4 * hh; const GAS float* sl = (const GAS float*)(ws + WS_SLOC) + (size_t)(bh * 8 + j) * 32768;
                    unsigned off = (unsigned)(4 * hh * 256 + 32 * wave + r32);
#pragma unroll
                    for (int kb = 0; kb < 4; ++kb)
#pragma unroll
                        for (int g4 = 0; g4 < 4; ++g4) { const f32x4 d4 = *(const GAS f32x4*)(dg + 32 * kb + 8 * g4);
#pragma unroll
                            for (int e = 0; e < 4; ++e) S[kb][4 * g4 + e] = S[kb][4 * g4 + e] * d4[e] + sl[off + e * 256];
                            off += 8 * 256; asm volatile("" : "+v"(off)); }
                }
                float ds0 = 0.f, ds1 = 0.f;
                gla_run<true, 0>(lds, P, (size_t)(bh >> 2) * SEQ + grp * 1024, bh & 3, 16, S, ds0, ds1);
                if (grp == 7) gla_store_state(out + O_GP + ((size_t)li * 32 + bh) * 32768, S, wave, r32, hh);
            }
            if (EN(14)) for (int it = vcu; it < DB * 4; it += G) {
                const int b = it >> 2, h = it & 3;
                const GAS float* s0 = AIN(I_SG) + ((size_t)li * DB * 4 + it) * 32768;
                f32x16 S[4];
                gla_load_state(s0, S, wave, r32, hh);
                float ds0 = 0.f, ds1 = 0.f;
                gla_run<true, 1>(lds, P, (size_t)MP + b * 16, h, 1, S, ds0, ds1);
                gla_store_state(out + O_GS + ((size_t)li * DB * 4 + it) * 32768, S, wave, r32, hh);
            }
            GRID_BAR();
          }
        }
        if (EN(4) && IN(pb + 3)) { OPQ(); GAS unsigned char* wl = ws + WS_W + (size_t)li * W_LAYER; GAS bf16* const XN = (GAS bf16*)(ws + WS_XN); const GAS float* rope = (const GAS float*)(ws + WS_ROPE);
          for (int rep = 0; rep < ((REP(4) && li == 0) ? 2 : 1); ++rep) {
            pg8::Gemm g{(const GAS pg8::bf16_t*)(ws + WS_QA), (const GAS pg8::bf16_t*)(wl + W_O), MP, DM, DM, DM}; pg8::StaticOrder S; S.init(MP, DM, G, bx);
            EpiB16 E{(GAS bf16*)(ws + WS_TMP), DM};
            pg8::gemm_phase<EpiB16, pg8::StaticOrder, true, true>(lds, g, S, E);
            { pg8::Gemm g2{(const GAS pg8::bf16_t*)(ws + WS_QA), (const GAS pg8::bf16_t*)(wl + W_O), MT, DM, 256, DM}; SplitOrder S2{G, bx, DM / 256, 256};
              EpiPart E2{(GAS float*)(ws + WS_PART), 256};
              pg8::gemm_phase<EpiPart, SplitOrder, true, true>(lds, g2, S2, E2); }
            GRID_BAR();
          }
        }
        if (EN(5) && IN(pb + 4)) { OPQ(); GAS unsigned char* wl = ws + WS_W + (size_t)li * W_LAYER; GAS bf16* const XN = (GAS bf16*)(ws + WS_XN); const GAS float* rope = (const GAS float*)(ws + WS_ROPE);
          for (int rep = 0; rep < ((REP(5) && li == 0) ? 2 : 1); ++rep) {
            { const GAS bf16* tmp_ = (const GAS bf16*)(ws + WS_TMP); const GAS float* part_ = (const GAS float*)(ws + WS_PART); GAS bf16* rs_ = (GAS bf16*)(ws + WS_RS);
              if (li == 0) rowpass<0, 1>(tmp_, part_, DM / 256, AIN(I_XP), AIN(I_XS), nullptr, nullptr, rs_, AIN(I_POSTMIX) + li * DM, AIN(I_PREFFN) + li * DM, XN, gw, NGW, lane);
              else         rowpass<1, 1>(tmp_, part_, DM / 256, nullptr, nullptr, rs_, nullptr, rs_, AIN(I_POSTMIX) + li * DM, AIN(I_PREFFN) + li * DM, XN, gw, NGW, lane); }
            GRID_BAR();
          }
        }
        if (EN(6) && IN(pb + 5)) { OPQ(); GAS unsigned char* wl = ws + WS_W + (size_t)li * W_LAYER; GAS bf16* const XN = (GAS bf16*)(ws + WS_XN); const GAS float* rope = (const GAS float*)(ws + WS_ROPE);
          for (int rep = 0; rep < ((REP(6) && li == 0) ? 2 : 1); ++rep) {
            pg8::Gemm g{(const GAS pg8::bf16_t*)XN, (const GAS pg8::bf16_t*)(wl + W_UP), MT, 2 * DFF, DM, DM}; pg8::StaticOrder S; S.init(MT, 2 * DFF, G, bx);
            EpiB16 E{(GAS bf16*)(ws + WS_UG), 2 * DFF};
            pg8::gemm_phase<EpiB16, pg8::StaticOrder, true, true>(lds, g, S, E);
            GRID_BAR();
          }
        }
        if (EN(7) && IN(pb + 6)) { OPQ(); GAS unsigned char* wl = ws + WS_W + (size_t)li * W_LAYER; GAS bf16* const XN = (GAS bf16*)(ws + WS_XN); const GAS float* rope = (const GAS float*)(ws + WS_ROPE);
          for (int rep = 0; rep < ((REP(7) && li == 0) ? 2 : 1); ++rep) {
            act_pass((const GAS bf16*)(ws + WS_UG), (GAS bf16*)(ws + WS_ACT), AIN(I_CONVW) + (size_t)li * 3 * DFF, AIN(I_CONVB) + (size_t)li * DFF, AIN(I_SC) + (size_t)li * DB * 2 * DFF,
                     out + O_CP + (size_t)li * NB * 2 * DFF, out + O_CS + (size_t)li * DB * 2 * DFF, vcu, G, tid);
            GRID_BAR();
          }
        }
        if (EN(8) && IN(pb + 7)) { OPQ(); GAS unsigned char* wl = ws + WS_W + (size_t)li * W_LAYER; GAS bf16* const XN = (GAS bf16*)(ws + WS_XN); const GAS float* rope = (const GAS float*)(ws + WS_ROPE);
          for (int rep = 0; rep < ((REP(8) && li == 0) ? 2 : 1); ++rep) {
            pg8::Gemm g{(const GAS pg8::bf16_t*)(ws + WS_ACT), (const GAS pg8::bf16_t*)(wl + W_DN), MP, DM, DFF, DFF}; pg8::StaticOrder S; S.init(MP, DM, G, bx);
            EpiB16 E{(GAS bf16*)(ws + WS_TMP), DM};
            pg8::gemm_phase<EpiB16, pg8::StaticOrder, true, true>(lds, g, S, E);
            { pg8::Gemm g2{(const GAS pg8::bf16_t*)(ws + WS_ACT), (const GAS pg8::bf16_t*)(wl + W_DN), MT, DM, 256, DFF}; SplitOrder S2{G, bx, DFF / 256, 256};
              EpiPart E2{(GAS float*)(ws + WS_PART), 256};
              pg8::gemm_phase<EpiPart, SplitOrder, true, true>(lds, g2, S2, E2); }
            GRID_BAR();
          }
        }
        if (EN(9) && IN(pb + 8)) { OPQ(); GAS unsigned char* wl = ws + WS_W + (size_t)li * W_LAYER; GAS bf16* const XN = (GAS bf16*)(ws + WS_XN); const GAS float* rope = (const GAS float*)(ws + WS_ROPE);
            const bool more = (li + 1 < DEPTH);
            { const GAS bf16* tmp_ = (const GAS bf16*)(ws + WS_TMP); const GAS float* part_ = (const GAS float*)(ws + WS_PART); GAS bf16* rs_ = (GAS bf16*)(ws + WS_RS);
              if (more) rowpass<1, 1>(tmp_, part_, DFF / 256, nullptr, nullptr, rs_, nullptr, rs_, AIN(I_POSTFFN) + li * DM, AIN(I_PREMIX) + (li + 1) * DM, XN, gw, NGW, lane);
              else      rowpass<1, 0>(tmp_, part_, DFF / 256, nullptr, nullptr, rs_, out, nullptr, AIN(I_POSTFFN) + li * DM, nullptr, nullptr, gw, NGW, lane); }
            if (more) GRID_BAR();
        }
    }
#undef IN
}

extern "C" void kernel_launch(void* const* d_in, const int* in_sizes, int n_in, void* d_out, int out_size, void* d_ws, size_t ws_size, hipStream_t stream) {
    static int grid = 0;
    if (grid == 0) {
        if (n_in != 24 || (size_t)out_size != O_END || ws_size < WS_END) { fprintf(stderr, "kernel_launch: unexpected shapes: n_in %d out %d (want %zu) ws %zu (want %zu)\n", n_in, out_size, (size_t)O_END, ws_size, (size_t)WS_END); grid = -1; return; }
        int dev = 0, cus = 0, per_cu = 0;
        if (hipGetDevice(&dev) != hipSuccess || hipDeviceGetAttribute(&cus, hipDeviceAttributeMultiprocessorCount, dev) != hipSuccess) { grid = -1; return; }
        if (hipFuncSetAttribute((const void*)mega_fwd, hipFuncAttributeMaxDynamicSharedMemorySize, LDS_BYTES) != hipSuccess) { fprintf(stderr, "kernel_launch: hipFuncSetAttribute failed\n"); grid = -1; return; }
        if (hipOccupancyMaxActiveBlocksPerMultiprocessor(&per_cu, (const void*)mega_fwd, NWAVES * 64, LDS_BYTES) != hipSuccess || per_cu < 1) { fprintf(stderr, "kernel_launch: occupancy query reports %d\n", per_cu); }
        (void)hipGetLastError();
        grid = cus;
    }
    if (grid < 0) return;
    if (hipMemsetAsync((char*)d_ws + WS_CTL, 0, CTL_ZERO_BYTES, stream) != hipSuccess) return;
    Args a{};
    for (int i = 0; i < 24; ++i) a.in[i] = (const float*)d_in[i];
    a.out = (float*)d_out; a.ws = (unsigned char*)d_ws;
    for (int i = 0; i < 8; ++i) a.inv_freq[i] = (float)pow(500000.0, -(double)i / 8.0);
    a.ph_lo = 0; a.ph_hi = 1000;
    hipLaunchKernelGGL(mega_fwd, dim3(grid), dim3(NWAVES * 64), LDS_BYTES, stream, a);
}
```
